# Optimizing an MI355X kernel written in HIP

```python
import math
import jax, jax.numpy as jnp
from jax import lax
import numpy as np

D_MODEL = 1024
BATCH = 1
SEQ = 16384
DEPTH = 1

D_MIX = D_MODEL
D_SSM = D_MIX // 2
D_HGRN = D_MIX - D_SSM
SSD_HEAD_DIM = 64
SSD_HEADS = D_SSM // SSD_HEAD_DIM
SSD_GROUPS = 2
SSD_STATE = 128
SSD_CONV = 4
SSD_CHUNK = 128
SSD_NORM_GROUP = D_SSM // SSD_GROUPS
D_CONV = D_SSM + 2 * SSD_GROUPS * SSD_STATE
HGRN_HEADS = 4
HGRN_DK = 128
HGRN_DV = D_HGRN // HGRN_HEADS
HGRN_CHUNK = 64
_XBC0 = D_SSM
_DT0 = _XBC0 + D_CONV
_Q0 = _DT0 + SSD_HEADS
_F0 = _Q0 + HGRN_HEADS * HGRN_DK
_I0 = _F0 + HGRN_HEADS * HGRN_DK
_G0 = _I0 + D_HGRN
N_IN = _G0 + D_HGRN
N_EXPERTS = 256
TOP_K = 8
N_EXPERT_GROUPS = 8
TOPK_GROUPS = 4
D_EXPERT = 256
D_SHARED = 256
ROUTED_SCALE = 2.5
EXPERT_BLOCK = 128
ALPHA = (2 * DEPTH) ** 0.25
BETA = (8 * DEPTH) ** -0.25
LN_EPS = 1e-5
RMS_EPS = 1e-6

kernel_name = 'hybrid_ssd_hgrn2_moe_deepnorm'


def _layer_norm(x, g, b):
    xf = x.astype(jnp.float32)
    mu = jnp.mean(xf, -1, keepdims=True)
    var = jnp.mean(jnp.square(xf - mu), -1, keepdims=True)
    return ((xf - mu) * lax.rsqrt(var + LN_EPS) * g + b).astype(x.dtype)


def _causal_depthwise_conv(u, w, b):
    y = lax.conv_general_dilated(u, w[:, None, :].astype(u.dtype), window_strides=(1,),
                                 padding=((w.shape[0] - 1, 0),),
                                 dimension_numbers=('NWC', 'WIO', 'NWC'),
                                 feature_group_count=u.shape[-1])
    return y + b


def _segsum(a):
    n = a.shape[-1]
    cs = jnp.cumsum(a, axis=-1)
    diff = cs[..., :, None] - cs[..., None, :]
    return jnp.where(jnp.tril(jnp.ones((n, n), dtype=bool)), diff, -jnp.inf)


def _ssd_mixer(z, xbc, dt, conv_w, conv_b, dt_bias, a_log, d_skip, norm_w):
    bsz, t, _ = xbc.shape
    nc = t // SSD_CHUNK
    xbc = jax.nn.silu(_causal_depthwise_conv(xbc, conv_w, conv_b))
    xs = xbc[..., :D_SSM]
    bm = xbc[..., D_SSM:D_SSM + SSD_GROUPS * SSD_STATE]
    cm = xbc[..., D_SSM + SSD_GROUPS * SSD_STATE:]
    dt = jax.nn.softplus(dt.astype(jnp.float32) + dt_bias.astype(jnp.float32))
    a = -jnp.exp(a_log.astype(jnp.float32))
    xh = xs.astype(jnp.float32).reshape(bsz, t, SSD_HEADS, SSD_HEAD_DIM)
    hpg = SSD_HEADS // SSD_GROUPS

    def per_head(m):
        m = m.astype(jnp.float32).reshape(bsz, nc, SSD_CHUNK, SSD_GROUPS, SSD_STATE)
        return jnp.repeat(m, hpg, axis=3)

    bh, ch = per_head(bm), per_head(cm)
    xdt = (xh * dt[..., None]).reshape(bsz, nc, SSD_CHUNK, SSD_HEADS, SSD_HEAD_DIM)
    ad = (dt * a).reshape(bsz, nc, SSD_CHUNK, SSD_HEADS).transpose(0, 3, 1, 2)
    a_cum = jnp.cumsum(ad, axis=-1)
    scores = jnp.einsum('bclhn,bcshn->bhcls', ch, bh) * jnp.exp(_segsum(ad))
    y_diag = jnp.einsum('bhcls,bcshp->bclhp', scores, xdt)
    decay_states = jnp.exp(a_cum[..., -1:] - a_cum)
    states = jnp.einsum('bclhn,bhcl,bclhp->bchpn', bh, decay_states, xdt)
    states = jnp.concatenate([jnp.zeros_like(states[:, :1]), states], axis=1)
    chunk_decay = jnp.exp(_segsum(jnp.pad(a_cum[..., -1], ((0, 0), (0, 0), (1, 0)))))
    states = jnp.einsum('bhzc,bchpn->bzhpn', chunk_decay, states)[:, :-1]
    y_off = jnp.einsum('bclhn,bchpn,bhcl->bclhp', ch, states, jnp.exp(a_cum))
    y = (y_diag + y_off).reshape(bsz, t, SSD_HEADS, SSD_HEAD_DIM) + xh * d_skip.astype(jnp.float32)[:, None]
    y = y.reshape(bsz, t, D_SSM) * jax.nn.silu(z.astype(jnp.float32))
    yg = y.reshape(bsz, t, SSD_GROUPS, SSD_NORM_GROUP)
    yg = yg * lax.rsqrt(jnp.mean(jnp.square(yg), -1, keepdims=True) + RMS_EPS)
    return (yg.reshape(bsz, t, D_SSM) * norm_w).astype(z.dtype)


def _hgrn2_mixer(q, f, i, g, lower_bound, norm_w):
    bsz, t, _ = q.shape
    nc = t // HGRN_CHUNK
    fg = lower_bound + (1.0 - lower_bound) * jax.nn.sigmoid(f.astype(jnp.float32))

    def chunks(a, d):
        return a.reshape(bsz, nc, HGRN_CHUNK, HGRN_HEADS, d).transpose(1, 0, 3, 2, 4)

    qc = chunks(jax.nn.silu(q.astype(jnp.float32)), HGRN_DK)
    kc = chunks(1.0 - fg, HGRN_DK)
    lc = chunks(jnp.log(fg), HGRN_DK)
    vc = chunks(i.astype(jnp.float32), HGRN_DV)
    causal = jnp.tril(jnp.ones((HGRN_CHUNK, HGRN_CHUNK), dtype=bool))[:, :, None]

    def step(state, inp):
        qb, kb, vb, lf = inp
        cum = jnp.cumsum(lf, axis=2)
        o_inter = jnp.einsum('bhtd,bhde->bhte', qb * jnp.exp(cum), state)
        diff = cum[:, :, :, None, :] - cum[:, :, None, :, :]
        decay = jnp.exp(jnp.where(causal, diff, -jnp.inf))
        att = jnp.sum(qb[:, :, :, None, :] * kb[:, :, None, :, :] * decay, axis=-1)
        o_intra = jnp.einsum('bhts,bhse->bhte', att, vb)
        last = cum[:, :, -1:, :]
        state = jnp.exp(last[:, :, 0, :, None]) * state + jnp.einsum('bhsd,bhse->bhde', kb * jnp.exp(last - cum), vb)
        return state, o_inter + o_intra

    s0 = jnp.zeros((bsz, HGRN_HEADS, HGRN_DK, HGRN_DV), jnp.float32)
    _, o = lax.scan(step, s0, (qc, kc, vc, lc))
    o = o.transpose(1, 0, 3, 2, 4).reshape(bsz, t, HGRN_HEADS, HGRN_DV)
    o = o * lax.rsqrt(jnp.mean(jnp.square(o), -1, keepdims=True) + RMS_EPS)
    o = o.reshape(bsz, t, D_HGRN) * norm_w * jax.nn.silu(g.astype(jnp.float32))
    return o.astype(q.dtype)


def _routed_experts(xt, w_router, router_bias, w_gate, w_up, w_down):
    n_tok, d = xt.shape
    scores = jax.nn.sigmoid((xt @ w_router).astype(jnp.float32))
    biased = scores + router_bias.astype(jnp.float32)
    per_group = N_EXPERTS // N_EXPERT_GROUPS
    group_score = lax.top_k(biased.reshape(n_tok, N_EXPERT_GROUPS, per_group), 2)[0].sum(-1)
    _, group_idx = lax.top_k(group_score, TOPK_GROUPS)
    group_mask = jax.nn.one_hot(group_idx, N_EXPERT_GROUPS, dtype=jnp.float32).sum(1) > 0
    masked = jnp.where(jnp.repeat(group_mask, per_group, axis=1), biased, -jnp.inf)
    _, idx = lax.top_k(masked, TOP_K)
    gate = jnp.take_along_axis(scores, idx, axis=1)
    gate = gate / jnp.sum(gate, -1, keepdims=True) * ROUTED_SCALE
    n_assign = n_tok * TOP_K
    flat_e = idx.reshape(n_assign).astype(jnp.int32)
    flat_tok = jnp.repeat(jnp.arange(n_tok, dtype=jnp.int32), TOP_K)
    flat_gate = gate.reshape(n_assign).astype(xt.dtype)
    order = jnp.argsort(flat_e)
    sorted_e = flat_e[order]
    counts = jnp.bincount(flat_e, length=N_EXPERTS).astype(jnp.int32)
    padded = (counts + EXPERT_BLOCK - 1) // EXPERT_BLOCK * EXPERT_BLOCK
    pad_end = jnp.cumsum(padded).astype(jnp.int32)
    pad_start = pad_end - padded
    start = jnp.cumsum(counts).astype(jnp.int32) - counts
    dest = pad_start[sorted_e] + jnp.arange(n_assign, dtype=jnp.int32) - start[sorted_e]
    n_blocks = -(-(n_assign + N_EXPERTS * (EXPERT_BLOCK - 1)) // EXPERT_BLOCK)
    n_rows = n_blocks * EXPERT_BLOCK
    row_tok = jnp.full((n_rows,), n_tok, jnp.int32).at[dest].set(flat_tok[order])
    row_gate = jnp.zeros((n_rows,), xt.dtype).at[dest].set(flat_gate[order])
    block_start = jnp.arange(n_blocks, dtype=jnp.int32) * EXPERT_BLOCK
    block_e = jnp.minimum(jnp.searchsorted(pad_end, block_start, side='right'), N_EXPERTS - 1)
    x_pad = jnp.concatenate([xt, jnp.zeros((1, d), xt.dtype)], axis=0)

    def expert_block(args):
        tok, e = args
        xb = x_pad[tok]
        hb = jax.nn.silu(xb @ w_gate[e]) * (xb @ w_up[e])
        return hb @ w_down[e]

    yb = lax.map(expert_block, (row_tok.reshape(n_blocks, EXPERT_BLOCK), block_e))
    y = jnp.zeros_like(x_pad).at[row_tok].add(yb.reshape(n_rows, d) * row_gate[:, None])
    return y[:n_tok]


def _shared_expert(xt, w_gate, w_up, w_down):
    return (jax.nn.silu(xt @ w_gate) * (xt @ w_up)) @ w_down


def setup_inputs(seed: int = 0) -> dict:
    key = jax.random.key(seed)
    ks = jax.random.split(key, 24)
    f32 = jnp.float32

    def nrm(k, shape, scale):
        return jax.random.normal(k, shape, f32) * scale

    x = nrm(ks[0], (BATCH, SEQ, D_MODEL), 1.0)
    col_scale = jnp.ones((N_IN,), f32).at[_XBC0:_XBC0 + D_SSM].set(BETA).at[_I0:_G0].set(BETA)
    w_in = nrm(ks[1], (DEPTH, D_MODEL, N_IN), D_MODEL ** -0.5) * col_scale
    conv_w = jax.random.uniform(ks[2], (DEPTH, SSD_CONV, D_CONV), f32, -1.0, 1.0) * SSD_CONV ** -0.5
    conv_b = nrm(ks[3], (DEPTH, D_CONV), 0.02)
    dt0 = jnp.exp(jax.random.uniform(ks[4], (DEPTH, SSD_HEADS), f32, math.log(1e-3), math.log(1e-1)))
    dt_bias = dt0 + jnp.log(-jnp.expm1(-dt0))
    a_log = jnp.log(jax.random.uniform(ks[5], (DEPTH, SSD_HEADS), f32, 1.0, 16.0))
    d_skip = 1.0 + nrm(ks[6], (DEPTH, SSD_HEADS), 0.1)
    ssd_norm_w = 1.0 + nrm(ks[7], (DEPTH, D_SSM), 0.02)
    hgrn_lb_logits = nrm(ks[8], (DEPTH + 1, HGRN_HEADS * HGRN_DK), 0.5)
    hgrn_norm_w = 1.0 + nrm(ks[9], (DEPTH, D_HGRN), 0.02)
    w_out = nrm(ks[10], (DEPTH, D_MIX, D_MODEL), D_MIX ** -0.5 * BETA)
    ln1_g = 1.0 + nrm(ks[11], (DEPTH, D_MODEL), 0.02)
    ln1_b = nrm(ks[12], (DEPTH, D_MODEL), 0.02)
    w_router = nrm(ks[13], (DEPTH, D_MODEL, N_EXPERTS), D_MODEL ** -0.5)
    router_bias = nrm(ks[14], (DEPTH, N_EXPERTS), 0.01)
    w_gate_e = nrm(ks[15], (DEPTH, N_EXPERTS, D_MODEL, D_EXPERT), D_MODEL ** -0.5)
    w_up_e = nrm(ks[16], (DEPTH, N_EXPERTS, D_MODEL, D_EXPERT), D_MODEL ** -0.5)
    w_down_e = nrm(ks[17], (DEPTH, N_EXPERTS, D_EXPERT, D_MODEL), D_EXPERT ** -0.5 * BETA)
    w_gate_s = nrm(ks[18], (DEPTH, D_MODEL, D_SHARED), D_MODEL ** -0.5)
    w_up_s = nrm(ks[19], (DEPTH, D_MODEL, D_SHARED), D_MODEL ** -0.5)
    w_down_s = nrm(ks[20], (DEPTH, D_SHARED, D_MODEL), D_SHARED ** -0.5 * BETA)
    ln2_g = 1.0 + nrm(ks[21], (DEPTH, D_MODEL), 0.02)
    ln2_b = nrm(ks[22], (DEPTH, D_MODEL), 0.02)
    return {'x': x, 'w_in': w_in, 'conv_w': conv_w, 'conv_b': conv_b, 'dt_bias': dt_bias,
            'a_log': a_log, 'd_skip': d_skip, 'ssd_norm_w': ssd_norm_w,
            'hgrn_lb_logits': hgrn_lb_logits, 'hgrn_norm_w': hgrn_norm_w, 'w_out': w_out,
            'ln1_g': ln1_g, 'ln1_b': ln1_b, 'w_router': w_router, 'router_bias': router_bias,
            'w_gate_e': w_gate_e, 'w_up_e': w_up_e, 'w_down_e': w_down_e,
            'w_gate_s': w_gate_s, 'w_up_s': w_up_s, 'w_down_s': w_down_s,
            'ln2_g': ln2_g, 'ln2_b': ln2_b}


def reference(x, w_in, conv_w, conv_b, dt_bias, a_log, d_skip, ssd_norm_w, hgrn_lb_logits,
              hgrn_norm_w, w_out, ln1_g, ln1_b, w_router, router_bias, w_gate_e, w_up_e,
              w_down_e, w_gate_s, w_up_s, w_down_s, ln2_g, ln2_b):
    bsz, t, d = x.shape
    lower_bounds = jnp.cumsum(jax.nn.softmax(hgrn_lb_logits.astype(jnp.float32), axis=0), axis=0)
    h = x
    for l in range(DEPTH):
        p = h @ w_in[l]
        y_ssd = _ssd_mixer(p[..., :_XBC0], p[..., _XBC0:_DT0], p[..., _DT0:_Q0],
                           conv_w[l], conv_b[l], dt_bias[l], a_log[l], d_skip[l], ssd_norm_w[l])
        y_hgrn = _hgrn2_mixer(p[..., _Q0:_F0], p[..., _F0:_I0], p[..., _I0:_G0], p[..., _G0:],
                              lower_bounds[l], hgrn_norm_w[l])
        mix = jnp.concatenate([y_ssd, y_hgrn], axis=-1) @ w_out[l]
        h = _layer_norm(ALPHA * h + mix, ln1_g[l], ln1_b[l])
        ht = h.reshape(bsz * t, d)
        ffn = (_routed_experts(ht, w_router[l], router_bias[l], w_gate_e[l], w_up_e[l], w_down_e[l])
               + _shared_expert(ht, w_gate_s[l], w_up_s[l], w_down_s[l]))
        h = _layer_norm(ALPHA * h + ffn.reshape(bsz, t, d), ln2_g[l], ln2_b[l])
    return h
```

```cpp
#include <hip/hip_runtime.h>
#include <stdint.h>
#include <cstdio>

#define GAS __attribute__((address_space(1)))
#define LAS __attribute__((address_space(3)))
typedef unsigned short bf16_t;
typedef short bf16x8 __attribute__((ext_vector_type(8)));
typedef float f32x4 __attribute__((ext_vector_type(4)));
typedef unsigned u32x4 __attribute__((ext_vector_type(4)));
typedef unsigned u32x2 __attribute__((ext_vector_type(2)));
typedef float f32x16 __attribute__((ext_vector_type(16)));
typedef short s16x4 __attribute__((ext_vector_type(4)));

constexpr int T_TOK = 16384, DM = 1024, NIN = 3592, PW = 3584;
constexpr int NEXP = 256, LIST_CAP = 16384;
constexpr int PC_Z = 0, PC_XBC = 512, PC_Q = 1536, PC_F = 2048, PC_I = 2560, PC_G = 3072;
#define ALPHA_F 1.189207115002721f
#define LN_EPS_F 1e-5f
#define RMS_EPS_F 1e-6f

constexpr size_t MiB = 1u << 20;
constexpr size_t WS_CTL = 0, CTL_ZERO_BYTES = 1 * MiB;
constexpr size_t WS_WIN_T = 2 * MiB, WS_WOUT_T = 9 * MiB, WS_W3_T = 11 * MiB, WS_WDS_T = 13 * MiB, WS_DTRAW = 14 * MiB;
constexpr size_t WS_TOKE = 15 * MiB, WS_TOKPOS = 15 * MiB + 512 * 1024, WS_TOKGATE = 16 * MiB;
constexpr size_t WS_LISTS = 17 * MiB, WS_LOGITS = 33 * MiB, WS_HS = 49 * MiB, WS_YS = 57 * MiB, WS_H1 = 89 * MiB, WS_H1B = 153 * MiB;
constexpr size_t WS_WGU_T = 185 * MiB, WS_WD_T = 441 * MiB;
constexpr size_t WS_X0 = 569 * MiB;
constexpr size_t WS_XB = WS_X0, WS_P = WS_X0 + 32 * MiB, WS_MIX = WS_X0 + 144 * MiB;
constexpr size_t WS_NXBC = WS_X0 + 176 * MiB, WS_NFGK = WS_X0 + 240 * MiB, WS_NQS = WS_X0 + 272 * MiB, WS_NYSSD = WS_X0 + 304 * MiB, WS_NOH = WS_X0 + 336 * MiB, WS_NDTB = WS_X0 + 368 * MiB;
constexpr size_t WS_SSTATE = WS_X0 + 176 * MiB, WS_SPREV = WS_X0 + 208 * MiB, WS_HKV = WS_X0 + 224 * MiB, WS_HSPREV = WS_X0 + 288 * MiB;
constexpr size_t WS_CDECAY = WS_X0 + 320 * MiB, WS_HDECAY = WS_X0 + 320 * MiB + 64 * 1024;
constexpr size_t WS_H = WS_X0, WS_YB = WS_X0 + 65 * MiB;
constexpr size_t WS_END = WS_X0 + 369 * MiB;
constexpr int CW_BAR = 4096;
constexpr int CW_COUNTS = 16384, CNT_STRIDE = 64;

constexpr int RING_BYTES = 131072;
constexpr int LDS_BYTES = 163840;
constexpr int LDS_MISC = LDS_BYTES - 4096;
constexpr int LDS_PREF = LDS_MISC + 256;
constexpr int LDS_OFFS = LDS_PREF + 1040;
constexpr int LDS_CNT = LDS_OFFS + 1040;
constexpr int LDS_PHASE_BYTES = LDS_MISC;

__device__ __forceinline__ int lane_id() { int l; asm volatile("v_mbcnt_lo_u32_b32 %0, -1, 0\n\tv_mbcnt_hi_u32_b32 %0, -1, %0" : "=v"(l)); return l; }
__device__ __forceinline__ float siluf(float x) { return x / (1.0f + __expf(-x)); }
__device__ __forceinline__ float sigmf(float x) { return 1.0f / (1.0f + __expf(-x)); }
__device__ __forceinline__ float wave_sum(float v) {
#pragma unroll
  for (int o = 1; o < 64; o <<= 1) v += __shfl_xor(v, o);
  return v;
}
__device__ __forceinline__ unsigned cvt_pk_bf16(float lo, float hi) { unsigned r; asm volatile("v_cvt_pk_bf16_f32 %0, %1, %2" : "=v"(r) : "v"(lo), "v"(hi)); return r; }
#define YB_SCALE 64.0f
__device__ __forceinline__ unsigned pk4_fp8(const f32x4 v) {
    const float a = fminf(fmaxf(v[0], -440.f), 440.f), b = fminf(fmaxf(v[1], -440.f), 440.f), c = fminf(fmaxf(v[2], -440.f), 440.f), d = fminf(fmaxf(v[3], -440.f), 440.f);
    int w = 0; w = __builtin_amdgcn_cvt_pk_fp8_f32(a, b, w, false); w = __builtin_amdgcn_cvt_pk_fp8_f32(c, d, w, true); return (unsigned)w; }
__device__ __forceinline__ f32x4 un4_fp8(const unsigned w) { return (f32x4){__builtin_amdgcn_cvt_f32_fp8((int)w, 0), __builtin_amdgcn_cvt_f32_fp8((int)w, 1), __builtin_amdgcn_cvt_f32_fp8((int)w, 2), __builtin_amdgcn_cvt_f32_fp8((int)w, 3)}; }
__device__ __forceinline__ float bf2f(unsigned b) { return __uint_as_float(b << 16); }
__device__ __forceinline__ float bflo(unsigned w) { return __uint_as_float(w << 16); }
__device__ __forceinline__ float bfhi(unsigned w) { return __uint_as_float(w & 0xffff0000u); }

#define XB_TMO      128
#define XB_XCNT(j)  (256  + 64 * (j))
#define XB_XSUB(j)  (1280 + 64 * (j))
#define XB_XGEN(j)  (2304 + 64 * (j))
#define XB_TOP      3328
#define XB_TOPGEN   3392
#define XCD_BAR_WORDS 3456
#define XB_SPIN_CAP (1u << 18)
__device__ __forceinline__ unsigned xb_ld(unsigned* p)              { return __hip_atomic_load(p, __ATOMIC_RELAXED, __HIP_MEMORY_SCOPE_AGENT); }
__device__ __forceinline__ unsigned xb_add(unsigned* p, unsigned v) { return __hip_atomic_fetch_add(p, v, __ATOMIC_RELAXED, __HIP_MEMORY_SCOPE_AGENT); }
__device__ __forceinline__ unsigned xb_xcc_id() { return (unsigned)__builtin_amdgcn_s_getreg((3 << 11) | 20) & 0xFu; }
#define XB_SPIN(cond, bar) do { unsigned _sp = 0; while (cond) { __builtin_amdgcn_s_sleep(1); \
    if ((++_sp & 255u) == 0u) { if (xb_ld(&(bar)[XB_TMO])) break; if (_sp > XB_SPIN_CAP) { atomicAdd(&(bar)[XB_TMO], 1u); break; } } } } while (0)
struct XcdBarrier { unsigned* bar; unsigned x; volatile LAS unsigned* st; int wave; };
__device__ __forceinline__ XcdBarrier xcd_barrier_post(unsigned* bar, volatile LAS unsigned* st, int wave) {
    XcdBarrier b; b.bar = bar; b.x = xb_xcc_id(); b.st = st; b.wave = wave;
    if (wave == 0 && lane_id() == 0) (void)xb_add(&bar[XB_XCNT(b.x)], 1u);
    return b;
}
__device__ __forceinline__ void xcd_barrier_complete(unsigned* bar, unsigned x, unsigned& nloc, unsigned& nx) {
    const unsigned G = gridDim.x * gridDim.y * gridDim.z;
    unsigned sum, cnt, mine, sp = 0u;
    for (;;) {
        sum = 0u; cnt = 0u; mine = 0u;
#pragma unroll
        for (unsigned j = 0; j < 16; ++j) { const unsigned c = xb_ld(&bar[XB_XCNT(j)]); sum += c; cnt += (c > 0u) ? 1u : 0u; mine = (j == x) ? c : mine; }
        if (sum == G) break;
        __builtin_amdgcn_s_sleep(1);
        if ((++sp & 255u) == 0u) { if (xb_ld(&bar[XB_TMO])) break; if (sp > XB_SPIN_CAP) { atomicAdd(&bar[XB_TMO], 1u); break; } }
    }
    nloc = mine > 0u ? mine : 1u; nx = cnt > 0u ? cnt : 1u;
}
__device__ __forceinline__ void xcd_barrier(const XcdBarrier& b) {
    asm volatile("s_waitcnt vmcnt(0)" ::: "memory");
    __syncthreads();
    if (b.wave == 0 && lane_id() == 0) {
        unsigned* bar = b.bar;
        __builtin_amdgcn_s_waitcnt(0);
        unsigned nloc = b.st[0], nx = b.st[1];
        if (nloc == 0u) { xcd_barrier_complete(bar, b.x, nloc, nx); b.st[0] = nloc; b.st[1] = nx; }
        const unsigned old = xb_add(&bar[XB_XSUB(b.x)], 1u);
        const unsigned gen = old / nloc;
        if (old + 1u == (gen + 1u) * nloc) {
            __builtin_amdgcn_fence(__ATOMIC_RELEASE, "agent");
            asm volatile("s_waitcnt vmcnt(0)" ::: "memory");
            const unsigned og = xb_add(&bar[XB_TOP], 1u);
            const unsigned tg = og / nx;
            if (og + 1u == (tg + 1u) * nx) xb_add(&bar[XB_TOPGEN], 1u);
            else XB_SPIN(xb_ld(&bar[XB_TOPGEN]) == tg, bar);
            __builtin_amdgcn_fence(__ATOMIC_ACQUIRE, "agent");
            xb_add(&bar[XB_XGEN(b.x)], 1u);
            asm volatile("s_waitcnt vmcnt(0)" ::: "memory");
        } else {
            XB_SPIN(xb_ld(&bar[XB_XGEN(b.x)]) == gen, bar);
            __builtin_amdgcn_fence(__ATOMIC_ACQUIRE, "agent");
            asm volatile("s_waitcnt vmcnt(0)" ::: "memory");
        }
    }
    __syncthreads();
}

namespace pg8 {
constexpr int BM = 256, BK = 64, HALF = 128, HTB = HALF * BK * 2, STAGE_BYTES = 8 * HTB, NXCD = 8, WGM = 8;
__host__ __device__ __forceinline__ int lds_byte(int r, int c) { const int st = (r >> 4) * 2 + (c >> 5), rr = r & 15, cc = c & 31, ob = rr * 64 + cc * 2; return st * 1024 + (ob ^ (((ob >> 9) & 1) << 5)); }
__host__ __device__ __forceinline__ void stage_rc(int b, int& R, int& C) { const int st = b / 1024, sb = b % 1024, swz = sb ^ (((sb >> 9) & 1) << 5); R = (st >> 1) * 16 + swz / 64; C = (st & 1) * 32 + (swz % 64) / 2; }
__host__ __device__ __forceinline__ int perm32(int rho) { const int n = rho >> 4, i = rho & 15; return 8 * (i >> 2) + 4 * n + (i & 3); }

struct Unit { const char* A; const char* B; int pm, pn, rows, e, slot0, mt; };

struct DenseSched {
    static constexpr bool PER_UNIT_VOFF = false;
    const char* A; const char* B; int K, nM, nN, nwg, G, c;
    __device__ void init(const void* A_, const void* B_, int M, int N, int K_, int G_, int c_) { A = (const char*)A_; B = (const char*)B_; K = K_; nM = M / BM; nN = N / BM; nwg = nM * nN; G = G_; c = c_; }
    __device__ __forceinline__ bool next(int i, Unit& u) const {
        const int L = i * G + c; if (L >= nwg) return false;
        int wgid = L; { const int q = nwg / NXCD, r = nwg % NXCD, xcd = wgid % NXCD, off = wgid / NXCD; wgid = (xcd < r ? xcd * (q + 1) : r * (q + 1) + (xcd - r) * q) + off; }
        const int nig = WGM * nN, gid = wgid / nig, fm = gid * WGM, gsz = (nM - fm) < WGM ? (nM - fm) : WGM;
        u.pm = fm + ((wgid % nig) % gsz); u.pn = (wgid % nig) / gsz; u.rows = 256; u.e = 0; u.slot0 = 0; u.mt = 0;
        u.A = A + (size_t)u.pm * BM * K * 2; u.B = B + (size_t)u.pn * BM * K * 2; return true;
    }
    __device__ __forceinline__ void voff(const Unit&, const int (&sR)[2], const int (&sC)[2], unsigned (&v)[2][2]) const {
#pragma unroll
        for (int h = 0; h < 2; ++h)
#pragma unroll
            for (int i = 0; i < 2; ++i) v[h][i] = (unsigned)((h * HALF + sR[i]) * K + sC[i]) * 2u;
    }
};

template <bool GATHER> struct ExpertSched {
    static constexpr bool PER_UNIT_VOFF = GATHER;
    static constexpr int K = GATHER ? 1024 : 256, NT = GATHER ? 2 : 4;
    static constexpr unsigned WSTRIDE = GATHER ? 512u * 1024u * 2u : 1024u * 256u * 2u;
    LAS unsigned char* lds;
    const int* lists; const char* A; const char* W; int U, G, c;
    __device__ __forceinline__ bool next(int i, Unit& u) const {
        int L = i * G + c; if (L >= U) return false;
        { const int q = U / NXCD, r = U % NXCD, xcd = L % NXCD, off = L / NXCD; L = (xcd < r ? xcd * (q + 1) : r * (q + 1) + (xcd - r) * q) + off; }
        const LAS int* pref = (const LAS int*)(lds + LDS_PREF);
        int lo = 0, hi = NEXP;
        while (hi - lo > 1) { const int mid = (lo + hi) >> 1; const int pv = __builtin_amdgcn_readfirstlane(pref[mid]); if (NT * pv <= L) lo = mid; else hi = mid; }
        const int e = lo, p0 = __builtin_amdgcn_readfirstlane(pref[e]), p1 = __builtin_amdgcn_readfirstlane(pref[e + 1]), tiles = p1 - p0, r = L - NT * p0;
        u.e = e; u.pn = r / tiles; u.mt = r % tiles; u.pm = 0;
        const int n = __builtin_amdgcn_readfirstlane(((const LAS int*)(lds + LDS_CNT))[e]); u.rows = (n - u.mt * 256) < 256 ? (n - u.mt * 256) : 256;
        u.slot0 = __builtin_amdgcn_readfirstlane(((const LAS int*)(lds + LDS_OFFS))[e]) + u.mt * 256;
        u.A = GATHER ? A : A + (size_t)u.slot0 * (K * 2); u.B = W + (size_t)e * WSTRIDE + (size_t)u.pn * (BM * K * 2); return true;
    }
    __device__ __forceinline__ void voff(const Unit& u, const int (&sR)[2], const int (&sC)[2], unsigned (&v)[2][2]) const {
#pragma unroll
        for (int h = 0; h < 2; ++h)
#pragma unroll
            for (int i = 0; i < 2; ++i) {
                const int r = h * HALF + sR[i];
                if (GATHER) { int tok = 0; if (r < u.rows) tok = lists[(size_t)u.e * LIST_CAP + u.mt * 256 + r] >> 3; v[h][i] = (unsigned)(tok * K + sC[i]) * 2u; }
                else v[h][i] = (unsigned)(r * K + sC[i]) * 2u;
            }
    }
};

template <class Epi, class Sched, bool ALIGN_EPI>
__device__ __forceinline__ void gemm_phase(LAS unsigned char* lds, const int K, const Sched& S, const Epi& E, const int wid) {
    const int lane = lane_id(), tid = wid * 64 + lane, wr = wid >> 2, wc = wid & 3, fr = lane & 15, fq = lane >> 4;
    const int nt = K / BK;
    int sR[2], sC[2]; unsigned voffB[2];
#pragma unroll
    for (int i = 0; i < 2; ++i) { stage_rc(tid * 16 + i * 8192, sR[i], sC[i]); const int Rb = Epi::PERM ? ((sR[i] & ~31) + perm32(sR[i] & 31)) : sR[i]; voffB[i] = (unsigned)(Rb * K + sC[i]) * 2u; }
    const size_t kstep = (size_t)(BK * 2);
    const size_t hstep = (size_t)HALF * K * 2;
    const unsigned ldsw = (unsigned)wid * 1024u;
    const int aoff = lds_byte(wr * 64 + fr, fq * 8), boff = lds_byte(wc * 32 + fr, fq * 8);
#define PG8_SA(b, h) (((b) * 2 + (h)) * HTB)
#define PG8_SB(b, h) ((4 + (b) * 2 + (h)) * HTB)
#define PG8_STAGE(bufoff, gbase, voff) do { _Pragma("unroll") for (int _i = 0; _i < 2; ++_i) \
        __builtin_amdgcn_global_load_lds((const unsigned*)((const char*)(gbase) + (voff)[_i]), (LAS unsigned*)(lds + (bufoff) + ldsw + _i * 8192), 16, 0, 0); } while (0)
#define PG8_STAGE_A(bufoff, gbase, h, vset) do { if constexpr (Sched::PER_UNIT_VOFF) { PG8_STAGE(bufoff, gbase, (vset)[h]); } else { PG8_STAGE(bufoff, (gbase) + (h) * hstep, vc[0]); } } while (0)
#define PG8_LDA(dst, b, h) do { _Pragma("unroll") for (int m = 0; m < 4; ++m) _Pragma("unroll") for (int k = 0; k < 2; ++k) dst[m][k] = *(const LAS bf16x8*)(lds + PG8_SA(b, h) + aoff + m * 2048 + k * 1024); } while (0)
#define PG8_LDB(dst, b, h) do { _Pragma("unroll") for (int n = 0; n < 2; ++n) _Pragma("unroll") for (int k = 0; k < 2; ++k) dst[n][k] = *(const LAS bf16x8*)(lds + PG8_SB(b, h) + boff + n * 2048 + k * 1024); } while (0)
#define PG8_MMA(ai, bj, At, Bt) do { __builtin_amdgcn_s_setprio(1); _Pragma("unroll") for (int m = 0; m < 4; ++m) _Pragma("unroll") for (int n = 0; n < 2; ++n) _Pragma("unroll") for (int k = 0; k < 2; ++k) \
        acc[ai][bj][m][n] = __builtin_amdgcn_mfma_f32_16x16x32_bf16(Bt[n][k], At[m][k], acc[ai][bj][m][n], 0, 0, 0); __builtin_amdgcn_s_setprio(0); } while (0)
#define PG8_WAIT_V(n) asm volatile("s_waitcnt vmcnt(" #n ")" ::: "memory")
#define PG8_WAIT_L(n) asm volatile("s_waitcnt lgkmcnt(" #n ")" ::: "memory")
#define PG8_BAR __builtin_amdgcn_s_barrier()
#define PG8_SCHED __builtin_amdgcn_sched_barrier(0)
    Unit cur, nxt; int ui = 0;
    if (!S.next(0, cur)) return;
    unsigned vc[2][2], vn[2][2];
    S.voff(cur, sR, sC, vc);
    f32x4 acc[2][2][4][2];
#pragma unroll
    for (int a = 0; a < 2; ++a)
#pragma unroll
        for (int b = 0; b < 2; ++b)
#pragma unroll
            for (int m = 0; m < 4; ++m)
#pragma unroll
                for (int n = 0; n < 2; ++n) acc[a][b][m][n] = (f32x4){0.f, 0.f, 0.f, 0.f};
    bf16x8 At[4][2], B0[2][2], B1[2][2];
    const char* cA = cur.A; const char* cB = cur.B;
    PG8_STAGE(PG8_SB(0, 0), cB, voffB); PG8_STAGE(PG8_SB(0, 1), cB + hstep, voffB); PG8_STAGE_A(PG8_SA(0, 0), cA, 0, vc); PG8_STAGE_A(PG8_SA(0, 1), cA, 1, vc);
    if (wr == 1) PG8_BAR;
    PG8_WAIT_V(2); PG8_BAR;
    PG8_STAGE(PG8_SB(1, 0), cB + kstep, voffB); PG8_STAGE_A(PG8_SA(1, 0), cA + kstep, 0, vc); PG8_STAGE(PG8_SB(1, 1), cB + hstep + kstep, voffB);
    PG8_WAIT_V(6); PG8_BAR;
    for (;;) {
        const bool has_next = S.next(ui + 1, nxt);
        if constexpr (Sched::PER_UNIT_VOFF) {
            if (has_next) S.voff(nxt, sR, sC, vn);
            else {
#pragma unroll
                for (int h = 0; h < 2; ++h)
#pragma unroll
                    for (int i = 0; i < 2; ++i) vn[h][i] = vc[h][i];
            }
        }
        const char* nA = has_next ? nxt.A : cA; const char* nB = has_next ? nxt.B : cB;
        for (int t = 0; t < nt; t += 2) {
            const bool last = (t == nt - 2);
            const char* a1 = cA + (size_t)(t + 1) * kstep;
            const char* a2 = last ? nA : cA + (size_t)(t + 2) * kstep; const char* b2 = last ? nB : cB + (size_t)(t + 2) * kstep;
            const char* a3 = a2 + kstep; const char* b3 = b2 + kstep;
            unsigned v2[2][2];
#pragma unroll
            for (int h = 0; h < 2; ++h)
#pragma unroll
                for (int i = 0; i < 2; ++i) v2[h][i] = (Sched::PER_UNIT_VOFF && last) ? vn[h][i] : vc[h][i];
            PG8_LDB(B0, 0, 0); PG8_LDB(B1, 0, 1); PG8_SCHED; PG8_LDA(At, 0, 0); PG8_STAGE_A(PG8_SA(1, 1), a1, 1, vc);
            PG8_WAIT_V(8); PG8_WAIT_L(0); PG8_BAR; PG8_MMA(0, 0, At, B0); PG8_MMA(0, 1, At, B1); PG8_BAR; PG8_SCHED;
            PG8_LDA(At, 0, 1); PG8_STAGE(PG8_SB(0, 0), b2, voffB); PG8_STAGE(PG8_SB(0, 1), b2 + hstep, voffB); PG8_STAGE_A(PG8_SA(0, 0), a2, 0, v2);
            PG8_WAIT_V(8); PG8_WAIT_L(0); PG8_BAR; PG8_MMA(1, 0, At, B0); PG8_MMA(1, 1, At, B1); PG8_BAR; PG8_SCHED;
            PG8_LDB(B0, 1, 0); PG8_LDB(B1, 1, 1); PG8_SCHED; PG8_LDA(At, 1, 0); PG8_STAGE_A(PG8_SA(0, 1), a2, 1, v2);
            PG8_WAIT_V(8); PG8_WAIT_L(0); PG8_BAR; PG8_MMA(0, 0, At, B0); PG8_MMA(0, 1, At, B1); PG8_BAR; PG8_SCHED;
            PG8_LDA(At, 1, 1); PG8_STAGE(PG8_SB(1, 0), b3, voffB); PG8_STAGE(PG8_SB(1, 1), b3 + hstep, voffB); PG8_STAGE_A(PG8_SA(1, 0), a3, 0, v2);
            PG8_WAIT_V(8); PG8_WAIT_L(0); PG8_BAR; PG8_MMA(1, 0, At, B0); PG8_MMA(1, 1, At, B1); PG8_BAR; PG8_SCHED;
        }
        if constexpr (ALIGN_EPI) { if (wr == 0) PG8_BAR; }
        E(acc, cur, wr, wc, fr, fq);
        if (!has_next) break;
#pragma unroll
        for (int a = 0; a < 2; ++a)
#pragma unroll
            for (int b = 0; b < 2; ++b)
#pragma unroll
                for (int m = 0; m < 4; ++m)
#pragma unroll
                    for (int n = 0; n < 2; ++n) acc[a][b][m][n] = (f32x4){0.f, 0.f, 0.f, 0.f};
        cur = nxt; cA = nA; cB = nB; ++ui;
        if constexpr (Sched::PER_UNIT_VOFF) {
#pragma unroll
            for (int h = 0; h < 2; ++h)
#pragma unroll
                for (int i = 0; i < 2; ++i) vc[h][i] = vn[h][i];
        }
        if constexpr (ALIGN_EPI) { if (wr == 1) PG8_BAR; }
    }
    PG8_WAIT_V(0);
    if constexpr (!ALIGN_EPI) { if (wr == 0) PG8_BAR; }
    PG8_BAR;
#undef PG8_SA
#undef PG8_SB
#undef PG8_STAGE
#undef PG8_LDA
#undef PG8_STAGE_A
#undef PG8_LDB
#undef PG8_MMA
#undef PG8_WAIT_V
#undef PG8_WAIT_L
#undef PG8_BAR
#undef PG8_SCHED
}

struct EpiP {
    static constexpr bool PERM = true;
    bf16_t* O; int ldc;
    __device__ __forceinline__ void operator()(const f32x4 (&acc)[2][2][4][2], const Unit& u, int wr, int wc, int fr, int fq) const {
        const int row0 = u.pm * BM + wr * 64 + fr, col0 = u.pn * BM + wc * 32 + 8 * fq;
#pragma unroll
        for (int ai = 0; ai < 2; ++ai)
#pragma unroll
            for (int m = 0; m < 4; ++m) { bf16_t* rowp = O + (size_t)(row0 + ai * HALF + m * 16) * ldc + col0;
#pragma unroll
                for (int bj = 0; bj < 2; ++bj) { const f32x4 v0 = acc[ai][bj][m][0], v1 = acc[ai][bj][m][1];
                    u32x4 w; w.x = cvt_pk_bf16(v0[0], v0[1]); w.y = cvt_pk_bf16(v0[2], v0[3]); w.z = cvt_pk_bf16(v1[0], v1[1]); w.w = cvt_pk_bf16(v1[2], v1[3]);
                    *(u32x4*)(rowp + bj * HALF) = w; } }
    }
};
struct EpiU {
    static constexpr bool PERM = false;
    float* U; const float* X;
    __device__ __forceinline__ void operator()(const f32x4 (&acc)[2][2][4][2], const Unit& u, int wr, int wc, int fr, int fq) const {
        const int row0 = u.pm * BM + wr * 64 + fr, col0 = u.pn * BM + wc * 32 + 4 * fq;
#pragma unroll
        for (int ai = 0; ai < 2; ++ai)
#pragma unroll
            for (int m = 0; m < 4; ++m) { const size_t ro = (size_t)(row0 + ai * HALF + m * 16) * DM + col0;
#pragma unroll
                for (int bj = 0; bj < 2; ++bj)
#pragma unroll
                    for (int n = 0; n < 2; ++n) { const f32x4 xv = *(const f32x4*)(X + ro + bj * HALF + n * 16);
                        *(f32x4*)(U + ro + bj * HALF + n * 16) = xv * ALPHA_F + acc[ai][bj][m][n]; } }
    }
};
struct Epi3 {
    static constexpr bool PERM = true;
    float* LG; bf16_t* HS;
    __device__ __forceinline__ void operator()(const f32x4 (&acc)[2][2][4][2], const Unit& u, int wr, int wc, int fr, int fq) const {
        const int row0 = u.pm * BM + wr * 64 + fr;
        if (u.pn == 0) {
#pragma unroll
            for (int ai = 0; ai < 2; ++ai)
#pragma unroll
                for (int m = 0; m < 4; ++m) { float* rowp = LG + (size_t)(row0 + ai * HALF + m * 16) * 256 + wc * 32 + 8 * fq;
#pragma unroll
                    for (int bj = 0; bj < 2; ++bj)
#pragma unroll
                        for (int n = 0; n < 2; ++n) *(f32x4*)(rowp + bj * HALF + 4 * n) = acc[ai][bj][m][n]; }
        } else {
            const int hc0 = (u.pn - 1) * 128 + wc * 32 + 8 * fq;
#pragma unroll
            for (int ai = 0; ai < 2; ++ai)
#pragma unroll
                for (int m = 0; m < 4; ++m) { bf16_t* rowp = HS + (size_t)(row0 + ai * HALF + m * 16) * 256 + hc0;
                    float h[8];
#pragma unroll
                    for (int n = 0; n < 2; ++n)
#pragma unroll
                        for (int j = 0; j < 4; ++j) h[n * 4 + j] = siluf(acc[ai][0][m][n][j]) * acc[ai][1][m][n][j];
                    u32x4 w; w.x = cvt_pk_bf16(h[0], h[1]); w.y = cvt_pk_bf16(h[2], h[3]); w.z = cvt_pk_bf16(h[4], h[5]); w.w = cvt_pk_bf16(h[6], h[7]);
                    *(u32x4*)rowp = w; }
        }
    }
};
struct EpiH {
    static constexpr bool PERM = true;
    bf16_t* H;
    __device__ __forceinline__ void operator()(const f32x4 (&acc)[2][2][4][2], const Unit& u, int wr, int wc, int fr, int fq) const {
        const int hc0 = u.pn * 128 + wc * 32 + 8 * fq;
#pragma unroll
        for (int ai = 0; ai < 2; ++ai)
#pragma unroll
            for (int m = 0; m < 4; ++m) { const int r = ai * HALF + wr * 64 + m * 16 + fr;
                if (r < u.rows) { bf16_t* rowp = H + (size_t)(u.slot0 + r) * 256 + hc0;
                    float h[8];
#pragma unroll
                    for (int n = 0; n < 2; ++n)
#pragma unroll
                        for (int j = 0; j < 4; ++j) h[n * 4 + j] = siluf(acc[ai][0][m][n][j]) * acc[ai][1][m][n][j];
                    u32x4 w; w.x = cvt_pk_bf16(h[0], h[1]); w.y = cvt_pk_bf16(h[2], h[3]); w.z = cvt_pk_bf16(h[4], h[5]); w.w = cvt_pk_bf16(h[6], h[7]);
                    *(u32x4*)rowp = w; } }
    }
};
struct EpiYb {
    static constexpr bool PERM = true;
    bf16_t* YB; const int* lists; const float* tok_gate;
    __device__ __forceinline__ void operator()(const f32x4 (&acc)[2][2][4][2], const Unit& u, int wr, int wc, int fr, int fq) const {
        const int col0 = u.pn * BM + wc * 32 + 8 * fq;
#pragma unroll
        for (int ai = 0; ai < 2; ++ai)
#pragma unroll
            for (int m = 0; m < 4; ++m) { const int r = ai * HALF + wr * 64 + m * 16 + fr;
                if (r < u.rows) { const float g = tok_gate[lists[(size_t)u.e * LIST_CAP + u.mt * 256 + r]];
                    bf16_t* rowp = YB + (size_t)(u.slot0 + r) * 1024 + col0;
#pragma unroll
                    for (int bj = 0; bj < 2; ++bj) { const f32x4 v0 = acc[ai][bj][m][0] * g, v1 = acc[ai][bj][m][1] * g;
                        u32x4 w; w.x = cvt_pk_bf16(v0[0], v0[1]); w.y = cvt_pk_bf16(v0[2], v0[3]); w.z = cvt_pk_bf16(v1[0], v1[1]); w.w = cvt_pk_bf16(v1[2], v1[3]);
                        *(u32x4*)(rowp + bj * HALF) = w; } } }
    }
};
}

template <int OFF> __device__ __forceinline__ unsigned long long karg_u64() { unsigned long long v;
    asm volatile("s_load_dwordx2 %0, %1, %2\n\ts_waitcnt lgkmcnt(0)" : "=s"(v) : "s"(__builtin_amdgcn_kernarg_segment_ptr()), "i"(OFF)); return v; }
#define KARG_IN(k) ((const float*)karg_u64<8 * (k)>())
#define KARG_OUT() ((float*)karg_u64<184>())
struct Args { const float* in[23]; float* out; unsigned char* ws; int ph_lo, ph_hi, mode, li; };
struct Frame { LAS unsigned char* lds; int wave, G, vcu; unsigned char* ws; unsigned* ctl; };
#define F_LANE lane_id()
#define F_TID (F.wave * 64 + lane_id())
constexpr int NPH = 12;

__device__ __forceinline__ void transpose_item(const float* W, int ldw, int c0, int k0, bf16_t* WT, int K, int row0, LAS float* scr, int lane) {
#pragma unroll 8
    for (int i = 0; i < 32; ++i) { const int kk = 2 * i + (lane >> 5); scr[kk * 33 + (lane & 31)] = W[(size_t)(k0 + kk) * ldw + c0 + (lane & 31)]; }
    asm volatile("s_waitcnt lgkmcnt(0)" ::: "memory");
    const int c = lane & 7;
#pragma unroll
    for (int j = 0; j < 4; ++j) { const int n = (lane >> 3) + 8 * j; const LAS float* s = scr + (8 * c) * 33 + n;
        u32x4 o; o.x = cvt_pk_bf16(s[0 * 33], s[1 * 33]); o.y = cvt_pk_bf16(s[2 * 33], s[3 * 33]); o.z = cvt_pk_bf16(s[4 * 33], s[5 * 33]); o.w = cvt_pk_bf16(s[6 * 33], s[7 * 33]);
        *(u32x4*)(WT + (size_t)(row0 + n) * K + k0 + 8 * c) = o; }
    asm volatile("s_waitcnt lgkmcnt(0)" ::: "memory");
}

__device__ __forceinline__ void gu_item(const float* Wg, const float* Wu, bf16_t* WT, int item, LAS float* scr, int lane) {
    const int kb = item >> 4, nb = item & 15, row0 = nb * 32, pn = row0 >> 8, half = (row0 >> 7) & 1, r0 = row0 & 127;
    transpose_item(half ? Wu : Wg, 256, pn * 128 + r0, kb * 64, WT, 1024, row0, scr, lane);
}

__device__ __forceinline__ void phase_prep(const Frame& F, const Args& a) {
    LAS float* scr = (LAS float*)(F.lds + F.wave * 16384);
    const int gw = F.vcu * 8 + F.wave, NGW = F.G * 8;
    unsigned char* ws = F.ws;
    bf16_t* Win_t = (bf16_t*)(ws + WS_WIN_T); bf16_t* Wout_t = (bf16_t*)(ws + WS_WOUT_T); bf16_t* W3_t = (bf16_t*)(ws + WS_W3_T); bf16_t* Wds_t = (bf16_t*)(ws + WS_WDS_T);
    bf16_t* Wgu_t = (bf16_t*)(ws + WS_WGU_T); bf16_t* Wd_t = (bf16_t*)(ws + WS_WD_T);
    const float* w_in = KARG_IN(1); const float* w_out = KARG_IN(10); const float* w_router = KARG_IN(13);
    const float* wge = KARG_IN(15); const float* wue = KARG_IN(16); const float* wde = KARG_IN(17);
    const float* wgs = KARG_IN(18); const float* wus = KARG_IN(19); const float* wds = KARG_IN(20);
    constexpr int I_IN = 16 * (PW / 32), I_OUT = 16 * 32, I_R = 16 * 8, I_S = 16 * 16, I_DS = 4 * 32, I_EGU = 16 * 16, I_ED = 4 * 32;
#if defined(MK_OLD_EXPERTS)
    constexpr int NITEMS = I_IN + I_OUT + I_R + I_S + I_DS + NEXP * (I_EGU + I_ED);
#else
    constexpr int NITEMS = I_IN + I_OUT + I_R + I_S + I_DS;
#endif
    for (int it = gw; it < NITEMS; it += NGW) {
        int r = it;
        if (r < I_IN) { const int kb = r / (PW / 32), nb = r % (PW / 32), row0 = nb * 32; const int c0 = row0 < 1536 ? row0 : row0 + 8;
            transpose_item(w_in, NIN, c0, kb * 64, Win_t, 1024, row0, scr, F_LANE); continue; } r -= I_IN;
        if (r < I_OUT) { transpose_item(w_out, 1024, (r & 31) * 32, (r >> 5) * 64, Wout_t, 1024, (r & 31) * 32, scr, F_LANE); continue; } r -= I_OUT;
        if (r < I_R) { transpose_item(w_router, 256, (r & 7) * 32, (r >> 3) * 64, W3_t, 1024, (r & 7) * 32, scr, F_LANE); continue; } r -= I_R;
        if (r < I_S) { gu_item(wgs, wus, W3_t + (size_t)256 * 1024, r, scr, F_LANE); continue; } r -= I_S;
        if (r < I_DS) { transpose_item(wds, 1024, (r & 31) * 32, (r >> 5) * 64, Wds_t, 256, (r & 31) * 32, scr, F_LANE); continue; } r -= I_DS;
        const int e = r / (I_EGU + I_ED), q = r % (I_EGU + I_ED);
        if (q < I_EGU) gu_item(wge + (size_t)e * 1024 * 256, wue + (size_t)e * 1024 * 256, Wgu_t + (size_t)e * 512 * 1024, q, scr, F_LANE);
        else { const int qq = q - I_EGU; transpose_item(wde + (size_t)e * 256 * 1024, 1024, (qq & 31) * 32, (qq >> 5) * 64, Wd_t + (size_t)e * 1024 * 256, 256, (qq & 31) * 32, scr, F_LANE); }
    }
    const float* x = KARG_IN(0); bf16_t* xb = (bf16_t*)(ws + WS_XB); float* dtraw = (float*)(ws + WS_DTRAW);
    float wdt[16][8];
#pragma unroll
    for (int j = 0; j < 16; ++j) { const int k = (j < 8 ? 8 * F_LANE + j : 512 + 8 * F_LANE + (j - 8));
#pragma unroll
        for (int h = 0; h < 8; ++h) wdt[j][h] = w_in[(size_t)k * NIN + 1536 + h]; }
    f32x4 n0, n1, n2, n3;
    { const float* xr = x + (size_t)(gw < T_TOK ? gw : 0) * DM; n0 = *(const f32x4*)(xr + 8 * F_LANE); n1 = *(const f32x4*)(xr + 8 * F_LANE + 4); n2 = *(const f32x4*)(xr + 512 + 8 * F_LANE); n3 = *(const f32x4*)(xr + 512 + 8 * F_LANE + 4); }
    for (int t = gw; t < T_TOK; t += NGW) {
        const f32x4 a0 = n0, a1 = n1, b0 = n2, b1 = n3;
        { const int tn = t + NGW < T_TOK ? t + NGW : t; const float* xr = x + (size_t)tn * DM;
          n0 = *(const f32x4*)(xr + 8 * F_LANE); n1 = *(const f32x4*)(xr + 8 * F_LANE + 4); n2 = *(const f32x4*)(xr + 512 + 8 * F_LANE); n3 = *(const f32x4*)(xr + 512 + 8 * F_LANE + 4); }
        u32x4 w0; w0.x = cvt_pk_bf16(a0[0], a0[1]); w0.y = cvt_pk_bf16(a0[2], a0[3]); w0.z = cvt_pk_bf16(a1[0], a1[1]); w0.w = cvt_pk_bf16(a1[2], a1[3]);
        u32x4 w1; w1.x = cvt_pk_bf16(b0[0], b0[1]); w1.y = cvt_pk_bf16(b0[2], b0[3]); w1.z = cvt_pk_bf16(b1[0], b1[1]); w1.w = cvt_pk_bf16(b1[2], b1[3]);
        *(u32x4*)(xb + (size_t)t * DM + 8 * F_LANE) = w0; *(u32x4*)(xb + (size_t)t * DM + 512 + 8 * F_LANE) = w1;
        const float xv[16] = {a0[0], a0[1], a0[2], a0[3], a1[0], a1[1], a1[2], a1[3], b0[0], b0[1], b0[2], b0[3], b1[0], b1[1], b1[2], b1[3]};
        float d[8];
#pragma unroll
        for (int h = 0; h < 8; ++h) { float sm = 0.f;
#pragma unroll
            for (int j = 0; j < 16; ++j) sm = fmaf(xv[j], wdt[j][h], sm);
            d[h] = wave_sum(sm); }
        if (F_LANE == 0) { *(f32x4*)(dtraw + t * 8) = (f32x4){d[0], d[1], d[2], d[3]}; *(f32x4*)(dtraw + t * 8 + 4) = (f32x4){d[4], d[5], d[6], d[7]}; }
    }
}

__device__ __forceinline__ void phase_ln1(const Frame& F, const Args& a) {
    const int gw = F.vcu * 8 + F.wave, NGW = F.G * 8;
    float* h1 = (float*)(F.ws + WS_H1); bf16_t* h1b = (bf16_t*)(F.ws + WS_H1B);
    const float* g = KARG_IN(11); const float* b = KARG_IN(12);
    const int c0 = 8 * F_LANE;
    f32x4 gv[4], bv[4];
    gv[0] = *(const f32x4*)(g + c0); gv[1] = *(const f32x4*)(g + c0 + 4); gv[2] = *(const f32x4*)(g + 512 + c0); gv[3] = *(const f32x4*)(g + 512 + c0 + 4);
    bv[0] = *(const f32x4*)(b + c0); bv[1] = *(const f32x4*)(b + c0 + 4); bv[2] = *(const f32x4*)(b + 512 + c0); bv[3] = *(const f32x4*)(b + 512 + c0 + 4);
    for (int t = gw; t < T_TOK; t += NGW) {
        float* r = h1 + (size_t)t * DM;
        f32x4 v[4]; v[0] = *(const f32x4*)(r + c0); v[1] = *(const f32x4*)(r + c0 + 4); v[2] = *(const f32x4*)(r + 512 + c0); v[3] = *(const f32x4*)(r + 512 + c0 + 4);
        float s = 0.f;
#pragma unroll
        for (int j = 0; j < 4; ++j) s += (v[j][0] + v[j][1]) + (v[j][2] + v[j][3]);
        const float mu = wave_sum(s) * (1.0f / 1024.0f);
        float q = 0.f;
#pragma unroll
        for (int j = 0; j < 4; ++j) { v[j] = v[j] - mu; q += (v[j][0] * v[j][0] + v[j][1] * v[j][1]) + (v[j][2] * v[j][2] + v[j][3] * v[j][3]); }
        const float rs = rsqrtf(wave_sum(q) * (1.0f / 1024.0f) + LN_EPS_F);
#pragma unroll
        for (int j = 0; j < 4; ++j) v[j] = v[j] * rs * gv[j] + bv[j];
        u32x4 w0; w0.x = cvt_pk_bf16(v[0][0], v[0][1]); w0.y = cvt_pk_bf16(v[0][2], v[0][3]); w0.z = cvt_pk_bf16(v[1][0], v[1][1]); w0.w = cvt_pk_bf16(v[1][2], v[1][3]);
        u32x4 w1; w1.x = cvt_pk_bf16(v[2][0], v[2][1]); w1.y = cvt_pk_bf16(v[2][2], v[2][3]); w1.z = cvt_pk_bf16(v[3][0], v[3][1]); w1.w = cvt_pk_bf16(v[3][2], v[3][3]);
        *(u32x4*)(h1b + (size_t)t * DM + c0) = w0; *(u32x4*)(h1b + (size_t)t * DM + 512 + c0) = w1;
    }
}

__device__ __forceinline__ void phase_route(const Frame& F, const Args& a) {
    const int gw = F.vcu * 8 + F.wave, NGW = F.G * 8, lane = F_LANE;
    const float* logits = (const float*)(F.ws + WS_LOGITS); const float* rbias = KARG_IN(14);
    int* counts = (int*)(F.ctl + CW_COUNTS); int* tok_e = (int*)(F.ws + WS_TOKE); int* tok_pos = (int*)(F.ws + WS_TOKPOS); float* tok_gate = (float*)(F.ws + WS_TOKGATE);
    int* lists = (int*)(F.ws + WS_LISTS);
    const f32x4 rb = *(const f32x4*)(rbias + lane * 4);
    f32x4 lgn = *(const f32x4*)(logits + (size_t)(gw < T_TOK ? gw : 0) * 256 + lane * 4);
    for (int t = gw; t < T_TOK; t += NGW) {
        const f32x4 lg = lgn;
        { const int tn = t + NGW < T_TOK ? t + NGW : t; lgn = *(const f32x4*)(logits + (size_t)tn * 256 + lane * 4); }
        float sc[4] = {sigmf(lg[0]), sigmf(lg[1]), sigmf(lg[2]), sigmf(lg[3])};
        float bs[4] = {sc[0] + rb[0], sc[1] + rb[1], sc[2] + rb[2], sc[3] + rb[3]};
        float m1 = fmaxf(bs[0], bs[1]), m2 = fminf(bs[0], bs[1]);
        { const float n1 = fmaxf(bs[2], bs[3]), n2 = fminf(bs[2], bs[3]);
          const float a1 = fmaxf(m1, n1), a2 = fmaxf(fminf(m1, n1), fmaxf(m2, n2)); m1 = a1; m2 = a2; }
#pragma unroll
        for (int o = 1; o < 8; o <<= 1) {
            const float n1 = __shfl_xor(m1, o), n2 = __shfl_xor(m2, o);
            const float a1 = fmaxf(m1, n1), a2 = fmaxf(fminf(m1, n1), fmaxf(m2, n2)); m1 = a1; m2 = a2;
        }
        const float gs = m1 + m2; const int mygrp = lane >> 3; int rank = 0;
#pragma unroll
        for (int gI = 0; gI < 8; ++gI) { const float og = __shfl(gs, gI * 8); rank += (og > gs || (og == gs && gI < mygrp)) ? 1 : 0; }
        const bool sel = rank < 4;
        float cand[4];
#pragma unroll
        for (int j = 0; j < 4; ++j) cand[j] = sel ? bs[j] : -INFINITY;
        int my_e = -1; float my_s = 0.f; float gsum = 0.f;
#pragma unroll 1
        for (int k = 0; k < 8; ++k) {
            float bv = cand[0]; int bi = 0;
#pragma unroll
            for (int j = 1; j < 4; ++j) if (cand[j] > bv) { bv = cand[j]; bi = j; }
            int be = lane * 4 + bi;
#pragma unroll
            for (int o = 1; o < 64; o <<= 1) {
                const float ov = __shfl_xor(bv, o); const int oe = __shfl_xor(be, o);
                if (ov > bv || (ov == bv && oe < be)) { bv = ov; be = oe; }
            }
            const int wj = be & 3;
            const float mysc = wj == 0 ? sc[0] : wj == 1 ? sc[1] : wj == 2 ? sc[2] : sc[3];
            const float wsc = __shfl(mysc, be >> 2);
            if (lane == (be >> 2)) {
#pragma unroll
                for (int j = 0; j < 4; ++j) if (j == wj) cand[j] = -INFINITY;
            }
            gsum += wsc;
            if (lane == k) { my_e = be; my_s = wsc; }
        }
        if (lane < 8) {
            const float gate = my_s / gsum * 2.5f;
            const int pos = atomicAdd(&counts[my_e * CNT_STRIDE], 1);
            tok_e[t * 8 + lane] = my_e; tok_pos[t * 8 + lane] = pos; tok_gate[t * 8 + lane] = gate;
            lists[(size_t)my_e * LIST_CAP + pos] = t * 8 + lane;
        }
    }
}

__device__ __forceinline__ void build_tables(const Frame& F) {
    const int* counts = (const int*)(F.ctl + CW_COUNTS);
    LAS int* pref = (LAS int*)(F.lds + LDS_PREF); LAS int* offs = (LAS int*)(F.lds + LDS_OFFS); LAS int* cnt = (LAS int*)(F.lds + LDS_CNT);
    __syncthreads();
    if (F_TID < NEXP) cnt[F_TID] = __hip_atomic_load(&counts[F_TID * CNT_STRIDE], __ATOMIC_RELAXED, __HIP_MEMORY_SCOPE_AGENT);
    __syncthreads();
    if (F_TID <= NEXP) { int s = 0, p = 0; for (int e = 0; e < F_TID; ++e) { const int n = cnt[e]; s += n; p += (n + 255) >> 8; } offs[F_TID] = s; pref[F_TID] = p; }
    __syncthreads();
}

__device__ __forceinline__ void phase_final(const Frame& F, const Args& a) {
    const int gw = F.vcu * 8 + F.wave, NGW = F.G * 8;
    const float* h1 = (const float*)(F.ws + WS_H1); const bf16_t* ys = (const bf16_t*)(F.ws + WS_YS); const bf16_t* yb = (const bf16_t*)(F.ws + WS_YB);
    const int* tok_e = (const int*)(F.ws + WS_TOKE); const int* tok_pos = (const int*)(F.ws + WS_TOKPOS);
    const LAS int* offs = (const LAS int*)(F.lds + LDS_OFFS);
    const float* g = KARG_IN(21); const float* b = KARG_IN(22); float* out = KARG_OUT();
    const int c0 = 8 * F_LANE;
    f32x4 gv[4], bv[4];
    gv[0] = *(const f32x4*)(g + c0); gv[1] = *(const f32x4*)(g + c0 + 4); gv[2] = *(const f32x4*)(g + 512 + c0); gv[3] = *(const f32x4*)(g + 512 + c0 + 4);
    bv[0] = *(const f32x4*)(b + c0); bv[1] = *(const f32x4*)(b + c0 + 4); bv[2] = *(const f32x4*)(b + 512 + c0); bv[3] = *(const f32x4*)(b + 512 + c0 + 4);
    const int lane8 = F_LANE;
    const bf16_t* h1b = (const bf16_t*)(F.ws + WS_H1B); const unsigned char* yb8 = (const unsigned char*)(F.ws + WS_YB);
    int ekn = 0, pkn = 0;
    if (gw < T_TOK && lane8 < 8) { ekn = tok_e[gw * 8 + lane8]; pkn = tok_pos[gw * 8 + lane8]; }
    for (int t = gw; t < T_TOK; t += NGW) {
        const int myrow = lane8 < 8 ? offs[ekn] + pkn : 0;
        const u32x4 r0 = *(const u32x4*)(h1b + (size_t)t * DM + c0), r1 = *(const u32x4*)(h1b + (size_t)t * DM + 512 + c0);
        const u32x4 s0 = *(const u32x4*)(ys + (size_t)t * DM + c0), s1 = *(const u32x4*)(ys + (size_t)t * DM + 512 + c0);
        u32x2 W[8][2];
#pragma unroll
        for (int k = 0; k < 8; ++k) { const unsigned char* src = yb8 + (size_t)__shfl(myrow, k) * 1024; W[k][0] = *(const u32x2*)(src + c0); W[k][1] = *(const u32x2*)(src + 512 + c0); }
        { const int tn = t + NGW; if (tn < T_TOK && lane8 < 8) { ekn = tok_e[tn * 8 + lane8]; pkn = tok_pos[tn * 8 + lane8]; } }
        f32x4 v[4], y[4];
        v[0] = (f32x4){bflo(r0.x), bfhi(r0.x), bflo(r0.y), bfhi(r0.y)}; v[1] = (f32x4){bflo(r0.z), bfhi(r0.z), bflo(r0.w), bfhi(r0.w)};
        v[2] = (f32x4){bflo(r1.x), bfhi(r1.x), bflo(r1.y), bfhi(r1.y)}; v[3] = (f32x4){bflo(r1.z), bfhi(r1.z), bflo(r1.w), bfhi(r1.w)};
#pragma unroll
        for (int j = 0; j < 4; ++j) { v[j] = v[j] * ALPHA_F; y[j] = (f32x4){0.f, 0.f, 0.f, 0.f}; }
        v[0] = v[0] + (f32x4){bflo(s0.x), bfhi(s0.x), bflo(s0.y), bfhi(s0.y)}; v[1] = v[1] + (f32x4){bflo(s0.z), bfhi(s0.z), bflo(s0.w), bfhi(s0.w)};
        v[2] = v[2] + (f32x4){bflo(s1.x), bfhi(s1.x), bflo(s1.y), bfhi(s1.y)}; v[3] = v[3] + (f32x4){bflo(s1.z), bfhi(s1.z), bflo(s1.w), bfhi(s1.w)};
#pragma unroll
        for (int k = 0; k < 8; ++k) { y[0] = y[0] + un4_fp8(W[k][0].x); y[1] = y[1] + un4_fp8(W[k][0].y); y[2] = y[2] + un4_fp8(W[k][1].x); y[3] = y[3] + un4_fp8(W[k][1].y); }
#pragma unroll
        for (int j = 0; j < 4; ++j) v[j] = v[j] + y[j] * (1.0f / YB_SCALE);
        float s = 0.f;
#pragma unroll
        for (int j = 0; j < 4; ++j) s += (v[j][0] + v[j][1]) + (v[j][2] + v[j][3]);
        const float mu = wave_sum(s) * (1.0f / 1024.0f);
        float q = 0.f;
#pragma unroll
        for (int j = 0; j < 4; ++j) { v[j] = v[j] - mu; q += (v[j][0] * v[j][0] + v[j][1] * v[j][1]) + (v[j][2] * v[j][2] + v[j][3] * v[j][3]); }
        const float rs = rsqrtf(wave_sum(q) * (1.0f / 1024.0f) + LN_EPS_F);
        float* o = out + (size_t)t * DM;
#pragma unroll
        for (int j = 0; j < 4; ++j) v[j] = v[j] * rs * gv[j] + bv[j];
        *(f32x4*)(o + c0) = v[0]; *(f32x4*)(o + c0 + 4) = v[1]; *(f32x4*)(o + 512 + c0) = v[2]; *(f32x4*)(o + 512 + c0 + 4) = v[3];
    }
}


namespace xk {
constexpr int B_IMG = 16384, A_SLOT = 16384, L_B0 = 0, L_A0 = 4 * B_IMG, L_GATE = 8 * 16384;
typedef __amdgpu_buffer_rsrc_t rsrc_t;
__device__ __forceinline__ rsrc_t make_rsrc(const void* p) { return __builtin_amdgcn_make_buffer_rsrc((void*)p, 0, 0x7fffffff, 0x00020000); }
__device__ __forceinline__ u32x4 make_srd(const void* p) { const unsigned long long v = (unsigned long long)p; u32x4 d;
    d.x = (unsigned)__builtin_amdgcn_readfirstlane((int)(unsigned)v); d.y = (unsigned)__builtin_amdgcn_readfirstlane((int)(unsigned)(v >> 32)) & 0xffffu; d.z = 0x7fffffffu; d.w = 0x00020000u; return d; }
__device__ __forceinline__ void dma16(const u32x4 srd, unsigned voff, int soff, unsigned lds_addr) {
    asm volatile("s_mov_b32 m0, %0\n\ts_nop 0\n\tbuffer_load_dwordx4 %1, %2, %3 offen lds" :: "s"(lds_addr), "v"(voff), "s"(srd), "s"(soff) : "m0", "memory");
}
__device__ __forceinline__ void a_piece_rc(int b, int& R, int& C) { const int st = b >> 10, sb = b & 1023, ob = sb ^ (((sb >> 9) & 1) << 5); R = st * 16 + (ob >> 6); C = (ob & 63) >> 1; }
struct PassDesc { u32x4 ra; unsigned aoff[2]; rsrc_t rb0, rb1; int bcol, ncol; unsigned boff; int nh; bool preloaded, chain; };
typedef f32x4 Acc[2][4][2][2];

template <bool GU> __device__ __forceinline__ void kloop(LAS unsigned char* lds, const PassDesc& P, const int wid, const int lane, const int bir, Acc& acc, f32x4 (&Br)[4][4]) {
    const int wr = wid >> 2, wc = wid & 3, fr = lane & 15, fq = lane >> 4, hl = lane >> 5;
    const int KB = GU ? 32 * 256 * 4 : 32 * 1024 * 4;
#define XK_DMAA(hh, slot) do { _Pragma("unroll") for (int _i = 0; _i < 2; ++_i) dma16(P.ra, P.aoff[_i], (hh) * 64, (unsigned)(size_t)(lds + L_A0 + (slot) * A_SLOT + _i * 8192 + wid * 1024)); } while (0)
#define XK_LOADB(col, hh, st) do { _Pragma("unroll") for (int _i = 0; _i < 4; ++_i) { \
            const u32x4 _v = GU ? __builtin_amdgcn_raw_buffer_load_b128((_i >> 1) ? P.rb1 : P.rb0, P.boff, (col) + (hh) * KB + (_i & 1) * (2 * 256 * 4), 0) \
                                : __builtin_amdgcn_raw_buffer_load_b128(P.rb0, P.boff, (col) + (hh) * KB + _i * (1024 * 4), 0); \
            Br[st][_i] = __builtin_bit_cast(f32x4, _v); } } while (0)
    const unsigned swg = (unsigned)(((wid >> 1) & 1) << 4);
    unsigned bw0 = (unsigned)(size_t)(lds + L_B0) + (GU ? (4 * wid + hl) * 512 + (bir ^ (hl << 7) ^ swg) : 4 * wid * 512 + (bir ^ swg));
    const int q = (lane & 15) >> 2, p = lane & 3;
    unsigned br0 = (unsigned)(size_t)(lds + L_B0) + (8 * fq + q) * 512 + ((128 * wc + 32 * p) ^ ((q & 1) << 7) ^ (((q >> 1) & 1) << 3) ^ ((fq & 1) << 4));
    const LAS unsigned char* arp = lds + L_A0 + (wr * 4) * 1024 + ((fr * 64 + 16 * fq) ^ ((fr >> 3) << 5));
#define XK_WRITEB(st, img) do { _Pragma("unroll") for (int _i = 0; _i < 4; ++_i) { u32x2 _w; _w.x = cvt_pk_bf16(Br[st][_i][0], Br[st][_i][1]); _w.y = cvt_pk_bf16(Br[st][_i][2], Br[st][_i][3]); \
        if (GU) *(LAS u32x2*)(size_t)((bw0 ^ (unsigned)(((_i >> 1) << 4) | ((_i & 1) << 3))) + (img) * B_IMG + 2 * (_i & 1) * 512) = _w; \
        else *(LAS u32x2*)(size_t)((bw0 ^ (unsigned)(((_i & 1) << 7) | (((_i >> 1) & 1) << 3))) + (img) * B_IMG + _i * 512) = _w; } } while (0)
#define XK_FRAGS(slot, img) do { \
        _Pragma("unroll") for (int gI = 0; gI < 2; ++gI) _Pragma("unroll") for (int nn = 0; nn < 2; ++nn) { \
            const LAS unsigned char* _a = (const LAS unsigned char*)(size_t)((br0 ^ (unsigned)(16 * gI + 8 * nn)) + (img) * B_IMG); \
            const s16x4 _lo = __builtin_amdgcn_ds_read_tr16_b64_v4i16((LAS s16x4*)_a), _hi = __builtin_amdgcn_ds_read_tr16_b64_v4i16((LAS s16x4*)(_a + 2048)); \
            wf[gI][nn] = (bf16x8){_lo[0], _lo[1], _lo[2], _lo[3], _hi[0], _hi[1], _hi[2], _hi[3]}; } \
        _Pragma("unroll") for (int ai = 0; ai < 2; ++ai) _Pragma("unroll") for (int m = 0; m < 4; ++m) xf[ai][m] = *(const LAS bf16x8*)(arp + (slot) * A_SLOT + (8 * ai + m) * 1024); } while (0)
#define XK_MMA() do { __builtin_amdgcn_s_setprio(1); \
        _Pragma("unroll") for (int ai = 0; ai < 2; ++ai) _Pragma("unroll") for (int m = 0; m < 4; ++m) _Pragma("unroll") for (int gI = 0; gI < 2; ++gI) _Pragma("unroll") for (int nn = 0; nn < 2; ++nn) \
            acc[ai][m][gI][nn] = __builtin_amdgcn_mfma_f32_16x16x32_bf16(wf[gI][nn], xf[ai][m], acc[ai][m][gI][nn], 0, 0, 0); \
        __builtin_amdgcn_s_setprio(0); } while (0)
    bf16x8 wf[2][2], xf[2][4];
    const int nh = P.nh;
    if (!P.preloaded) {
        XK_LOADB(P.bcol, 0, 0); XK_LOADB(P.bcol, 1, 1); XK_LOADB(P.bcol, 2, 2); XK_DMAA(0, 0); XK_DMAA(1, 1);
        XK_WRITEB(0, 0);
        asm volatile("s_waitcnt vmcnt(0)" ::: "memory");
        __syncthreads();
    }
    const int tcol = P.chain ? P.ncol : P.bcol;
    if (wid >= 4) __builtin_amdgcn_s_barrier();
#define XK_ITER(j) do { const int _h = hb + (j); asm volatile("" : "+v"(bw0), "+v"(br0));     \
        { const bool _in2 = _h + 2 < nh; XK_DMAA(_in2 ? _h + 2 : _h + 2 - nh, ((j) + 2) & 3); \
          const bool _in3 = _h + 3 < nh; XK_LOADB(_in3 ? P.bcol : tcol, _in3 ? _h + 3 : _h + 3 - nh, ((j) + 3) & 3); } \
        XK_WRITEB(((j) + 1) & 3, ((j) + 1) & 3); \
        XK_FRAGS((j), (j));        \
        asm volatile("s_waitcnt vmcnt(10)" ::: "memory");     \
        asm volatile("s_waitcnt lgkmcnt(0)" ::: "memory"); __builtin_amdgcn_sched_barrier(0); __builtin_amdgcn_s_barrier(); __builtin_amdgcn_sched_barrier(0); \
        XK_MMA(); \
        __builtin_amdgcn_sched_barrier(0); __builtin_amdgcn_s_barrier(); __builtin_amdgcn_sched_barrier(0); } while (0)
    for (int hb = 0; hb < nh; hb += 4) { XK_ITER(0); XK_ITER(1); XK_ITER(2); XK_ITER(3); }
    if (wid < 4) __builtin_amdgcn_s_barrier();
#undef XK_ITER
#undef XK_DMAA
#undef XK_LOADB
#undef XK_WRITEB
#undef XK_FRAGS
#undef XK_MMA
}
}

__device__ __forceinline__ void phase_experts(const Frame& F, const Args& a, const int mode) {
    build_tables(F);
    const int wid = F.wave, wr = wid >> 2, wc = wid & 3;
    const LAS int* pref = (const LAS int*)(F.lds + LDS_PREF);
    const int U = __builtin_amdgcn_readfirstlane(pref[NEXP]);
    const int* lists = (const int*)(F.ws + WS_LISTS); const float* tok_gate = (const float*)(F.ws + WS_TOKGATE);
    const char* h1b = (const char*)(F.ws + WS_H1B); bf16_t* H = (bf16_t*)(F.ws + WS_H); bf16_t* YB = (bf16_t*)(F.ws + WS_YB);
    f32x4 Br[4][4];
    for (int ui = 0;; ++ui) {
        int L = ui * F.G + blockIdx.x; if (L >= U) break;
        { const int qq = U / 8, rr = U % 8, xcd = L % 8, off = L / 8; L = (xcd < rr ? xcd * (qq + 1) : rr * (qq + 1) + (xcd - rr) * qq) + off; }
        int lo = 0, hi = NEXP;
        while (hi - lo > 1) { const int mid = (lo + hi) >> 1; const int pv = __builtin_amdgcn_readfirstlane(pref[mid]); if (pv <= L) lo = mid; else hi = mid; }
        const int e = lo, mt = L - __builtin_amdgcn_readfirstlane(pref[e]);
        const int n = __builtin_amdgcn_readfirstlane(((const LAS int*)(F.lds + LDS_CNT))[e]);
        const int rows = (n - mt * 256) < 256 ? (n - mt * 256) : 256;
        const int slot0 = __builtin_amdgcn_readfirstlane(((const LAS int*)(F.lds + LDS_OFFS))[e]) + mt * 256;
        const int* lst = lists + (size_t)e * LIST_CAP + mt * 256;
        { const int t = wid * 64 + lane_id();
          if (t < 256) ((LAS float*)(F.lds + xk::L_GATE))[t] = t < rows ? tok_gate[lst[t]] : 0.f; }
        const int ew = (mode & 1) ? 0 : e;
        const float* Wg = KARG_IN(15) + (size_t)ew * 1024 * 256; const float* Wu = KARG_IN(16) + (size_t)ew * 1024 * 256; const float* Wd = KARG_IN(17) + (size_t)ew * 256 * 1024;
        {
            xk::PassDesc P; P.ra = xk::make_srd(h1b);
            { const int lane = lane_id(), tid = wid * 64 + lane;
#pragma unroll
              for (int i = 0; i < 2; ++i) { int R, C; xk::a_piece_rc(tid * 16 + i * 8192, R, C); int tok = 0; if (R < rows) tok = lst[R] >> 3; if (mode & 2) tok = (slot0 + R) & 16383; P.aoff[i] = (unsigned)(tok * 1024 + C) * 2u; }
              P.boff = (unsigned)((4 * wid + (lane >> 5)) * 256 + 4 * (lane & 31)) * 4u; }
            P.nh = 32; P.rb0 = xk::make_rsrc(Wg); P.rb1 = xk::make_rsrc(Wu);
#pragma unroll 1
            for (int pn = 0; pn < 2; ++pn) {
                P.bcol = pn * 128 * 4; P.ncol = 128 * 4;
                P.preloaded = pn == 1; P.chain = pn == 0;
                xk::Acc acc;
#pragma unroll
                for (int ai = 0; ai < 2; ++ai)
#pragma unroll
                    for (int m = 0; m < 4; ++m)
#pragma unroll
                        for (int gI = 0; gI < 2; ++gI)
#pragma unroll
                            for (int nn = 0; nn < 2; ++nn) acc[ai][m][gI][nn] = (f32x4){0.f, 0.f, 0.f, 0.f};
                { const int lane = lane_id(); xk::kloop<true>(F.lds, P, wid, lane, 128 * ((lane & 31) >> 3) + 32 * (((lane & 31) >> 1) & 3) + 8 * (lane & 1), acc, Br); }
                const int lane = lane_id(), fr = lane & 15, fq = lane >> 4;
                const xk::rsrc_t rH = xk::make_rsrc(H + (size_t)slot0 * 256);
#pragma unroll
                for (int ai = 0; ai < 2; ++ai)
#pragma unroll
                    for (int m = 0; m < 4; ++m) { const int r = ai * 128 + wr * 64 + m * 16 + fr;
                        if (r < rows && !(mode & 4) && !(mode & 16)) { float h[8];
#pragma unroll
                            for (int nn = 0; nn < 2; ++nn)
#pragma unroll
                                for (int j = 0; j < 4; ++j) h[nn * 4 + j] = siluf(acc[ai][m][0][nn][j]) * acc[ai][m][1][nn][j];
                            u32x4 w; w.x = cvt_pk_bf16(h[0], h[1]); w.y = cvt_pk_bf16(h[2], h[3]); w.z = cvt_pk_bf16(h[4], h[5]); w.w = cvt_pk_bf16(h[6], h[7]);
                            __builtin_amdgcn_raw_buffer_store_b128(w, rH, (unsigned)(r * 256 + pn * 128 + wc * 32 + 8 * fq) * 2u, 0, 0); } }
            }
        }
        asm volatile("s_waitcnt vmcnt(0)" ::: "memory");
        __syncthreads();
        {
            xk::PassDesc P; P.ra = xk::make_srd(H + (size_t)slot0 * 256);
            { const int lane = lane_id(), tid = wid * 64 + lane;
#pragma unroll
              for (int i = 0; i < 2; ++i) { int R, C; xk::a_piece_rc(tid * 16 + i * 8192, R, C); P.aoff[i] = (unsigned)(R * 256 + C) * 2u; }
              P.boff = (unsigned)(4 * wid * 1024 + 4 * lane) * 4u; }
            P.nh = 8; P.rb0 = xk::make_rsrc(Wd); P.rb1 = P.rb0;
#pragma unroll 1
            for (int pn = 0; pn < 4; ++pn) {
                P.bcol = pn * 256 * 4; P.ncol = (pn + 1) * 256 * 4;
                P.preloaded = pn > 0; P.chain = pn < 3;
                xk::Acc acc;
#pragma unroll
                for (int ai = 0; ai < 2; ++ai)
#pragma unroll
                    for (int m = 0; m < 4; ++m)
#pragma unroll
                        for (int gI = 0; gI < 2; ++gI)
#pragma unroll
                            for (int nn = 0; nn < 2; ++nn) acc[ai][m][gI][nn] = (f32x4){0.f, 0.f, 0.f, 0.f};
                { const int lane = lane_id(); xk::kloop<false>(F.lds, P, wid, lane, 8 * lane, acc, Br); }
                const int lane = lane_id(), fr = lane & 15, fq = lane >> 4;
                const xk::rsrc_t rY = xk::make_rsrc((const unsigned char*)YB + (size_t)slot0 * 1024);
#pragma unroll
                for (int ai = 0; ai < 2; ++ai)
#pragma unroll
                    for (int m = 0; m < 4; ++m) { const int r = ai * 128 + wr * 64 + m * 16 + fr;
                        if (r < rows && !(mode & 4) && !(mode & 8)) { const float g = ((const LAS float*)(F.lds + xk::L_GATE))[r] * YB_SCALE;
                            u32x4 w; w.x = pk4_fp8(acc[ai][m][0][0] * g); w.y = pk4_fp8(acc[ai][m][0][1] * g); w.z = pk4_fp8(acc[ai][m][1][0] * g); w.w = pk4_fp8(acc[ai][m][1][1] * g);
                            __builtin_amdgcn_raw_buffer_store_b128(w, rY, (unsigned)(r * 1024 + pn * 256 + 64 * wc + 16 * fq), 0, 0); } }
            }
        }
        __syncthreads();
    }
}

__device__ __forceinline__ float ldp(const bf16_t* p, size_t t, int c) { return bf2f(p[t * PW + c]); }
__device__ __forceinline__ void phase_m1(const Frame& F, const Args& a) {
  const bf16_t* p = (const bf16_t*)(F.ws + WS_P); const float* dtraw = (const float*)(F.ws + WS_DTRAW);
  const float* conv_w = KARG_IN(2); const float* conv_b = KARG_IN(3); const float* dt_bias = KARG_IN(4); const float* lb_logits = KARG_IN(8);
  float* xbc = (float*)(F.ws + WS_NXBC); float* fgk = (float*)(F.ws + WS_NFGK); float* qs = (float*)(F.ws + WS_NQS); float* dtb = (float*)(F.ws + WS_NDTB);
  const int tid = F_TID;
  for (int t = blockIdx.x; t < T_TOK; t += F.G) {
    for (int c = tid; c < 1024; c += 512) {
      float acc = conv_b[c];
#pragma unroll
      for (int j = 0; j < 4; ++j) { const int tt = t - 3 + j; if (tt >= 0) acc = fmaf(conv_w[j * 1024 + c], ldp(p, tt, PC_XBC + c), acc); }
      xbc[(size_t)t * 1024 + c] = siluf(acc);
    }
    { const int c = tid;
      const float l0 = lb_logits[c], l1 = lb_logits[512 + c];
      const float mx = fmaxf(l0, l1);
      const float e0 = expf(l0 - mx), e1 = expf(l1 - mx);
      const float lb = e0 / (e0 + e1);
      const float f = ldp(p, t, PC_F + c);
      fgk[(size_t)t * 512 + c] = lb + (1.0f - lb) * (1.0f / (1.0f + expf(-f)));
      const float q = ldp(p, t, PC_Q + c);
      qs[(size_t)t * 512 + c] = q / (1.0f + expf(-q)); }
    if (tid < 8) { const float v = dtraw[t * 8 + tid] + dt_bias[tid]; dtb[t * 8 + tid] = v > 20.f ? v : log1pf(expf(v)); }
  }
}
__device__ __forceinline__ void phase_m2(const Frame& F, const Args& a) {
  const int item = F.wave * F.G + blockIdx.x, lane = F_LANE;
  const float* xbc = (const float*)(F.ws + WS_NXBC); const float* dtb = (const float*)(F.ws + WS_NDTB);
  const float* fgk = (const float*)(F.ws + WS_NFGK); const float* qs = (const float*)(F.ws + WS_NQS); const bf16_t* p = (const bf16_t*)(F.ws + WS_P);
  float* y_ssd = (float*)(F.ws + WS_NYSSD); float* o_h = (float*)(F.ws + WS_NOH);
  if (item < 512) {
    const int h = item >> 6, pp = item & 63, g = h >> 2;
    const float aa = -expf(KARG_IN(5)[h]), D = KARG_IN(6)[h];
    float h0 = 0.f, h1 = 0.f;
    const float* xp = xbc + h * 64 + pp; const float* Bp = xbc + 512 + g * 128 + lane; const float* Cp = xbc + 768 + g * 128 + lane;
    for (int t0 = 0; t0 < T_TOK; t0 += 8) {
      float Bv0[8], Bv1[8], Cv0[8], Cv1[8], xv[8], dv[8];
#pragma unroll
      for (int i = 0; i < 8; ++i) { const size_t o = (size_t)(t0 + i) * 1024;
        Bv0[i] = Bp[o]; Bv1[i] = Bp[o + 64]; Cv0[i] = Cp[o]; Cv1[i] = Cp[o + 64]; xv[i] = xp[o]; dv[i] = dtb[(t0 + i) * 8 + h]; }
#pragma unroll
      for (int i = 0; i < 8; ++i) {
        const float dA = expf(dv[i] * aa), dx = dv[i] * xv[i];
        h0 = fmaf(dA, h0, dx * Bv0[i]); h1 = fmaf(dA, h1, dx * Bv1[i]);
        float part = wave_sum(Cv0[i] * h0 + Cv1[i] * h1);
        if (lane == 0) y_ssd[(size_t)(t0 + i) * 512 + h * 64 + pp] = part + D * xv[i];
      }
    }
  } else if (item < 1024) {
    const int it = item - 512, h = it >> 7, e = it & 127;
    float S0 = 0.f, S1 = 0.f;
    const float* fp = fgk + h * 128 + lane; const float* qp = qs + h * 128 + lane;
    for (int t0 = 0; t0 < T_TOK; t0 += 8) {
      float f0[8], f1[8], q0[8], q1[8], iv[8];
#pragma unroll
      for (int i = 0; i < 8; ++i) { const size_t o = (size_t)(t0 + i) * 512;
        f0[i] = fp[o]; f1[i] = fp[o + 64]; q0[i] = qp[o]; q1[i] = qp[o + 64]; iv[i] = ldp(p, t0 + i, PC_I + h * 128 + e); }
#pragma unroll
      for (int i = 0; i < 8; ++i) {
        S0 = fmaf(f0[i], S0, (1.0f - f0[i]) * iv[i]); S1 = fmaf(f1[i], S1, (1.0f - f1[i]) * iv[i]);
        float part = wave_sum(q0[i] * S0 + q1[i] * S1);
        if (lane == 0) o_h[(size_t)(t0 + i) * 512 + h * 128 + e] = part;
      }
    }
  }
}
__device__ __forceinline__ void phase_m3(const Frame& F, const Args& a) {
  const int gw = F.vcu * 8 + F.wave, NGW = F.G * 8, lane = F_LANE;
  const float* y_ssd = (const float*)(F.ws + WS_NYSSD); const float* o_h = (const float*)(F.ws + WS_NOH); const bf16_t* p = (const bf16_t*)(F.ws + WS_P);
  const float* snw = KARG_IN(7); const float* hnw = KARG_IN(9); bf16_t* mix = (bf16_t*)(F.ws + WS_MIX);
  for (int idx = gw; idx < T_TOK * 2; idx += NGW) {
    const int t = idx >> 1, g = idx & 1;
    float v[4]; float ss = 0.f;
#pragma unroll
    for (int j = 0; j < 4; ++j) { const int c = g * 256 + lane + 64 * j; v[j] = y_ssd[(size_t)t * 512 + c] * siluf(ldp(p, t, PC_Z + c)); ss += v[j] * v[j]; }
    ss = wave_sum(ss);
    const float r = rsqrtf(ss * (1.0f / 256.0f) + RMS_EPS_F);
#pragma unroll
    for (int j = 0; j < 4; ++j) { const int c = g * 256 + lane + 64 * j; mix[(size_t)t * 1024 + c] = (bf16_t)(cvt_pk_bf16(v[j] * r * snw[c], 0.f) & 0xffffu); }
  }
  for (int idx = gw; idx < T_TOK * 4; idx += NGW) {
    const int t = idx >> 2, h = idx & 3;
    float v[2]; float ss = 0.f;
#pragma unroll
    for (int j = 0; j < 2; ++j) { const int c = h * 128 + lane + 64 * j; v[j] = o_h[(size_t)t * 512 + c]; ss += v[j] * v[j]; }
    ss = wave_sum(ss);
    const float r = rsqrtf(ss * (1.0f / 128.0f) + RMS_EPS_F);
#pragma unroll
    for (int j = 0; j < 2; ++j) { const int c = h * 128 + lane + 64 * j;
      mix[(size_t)t * 1024 + 512 + c] = (bf16_t)(cvt_pk_bf16(v[j] * r * hnw[c] * siluf(ldp(p, t, PC_G + c)), 0.f) & 0xffffu); }
  }
}


#define MFMA32(a, b, c) __builtin_amdgcn_mfma_f32_32x32x16_bf16((a), (b), (c), 0, 0, 0)
__device__ __forceinline__ int drow(int r, int lane) { return (r & 3) + 8 * (r >> 2) + 4 * (lane >> 5); }
__device__ __forceinline__ bf16x8 frag_row(const LAS unsigned char* base, int pitch, int row0, int k0, int lane) {
    return *(const LAS bf16x8*)(base + (row0 + (lane & 31)) * pitch + (k0 + 8 * (lane >> 5)) * 2);
}
template <bool PERM> __device__ __forceinline__ bf16x8 frag_tr(const LAS unsigned char* base, int pitch, int k0, int col0, int lane) {
    const int h = lane >> 5, blk = (lane >> 4) & 1, q = (lane & 15) >> 2, p = lane & 3;
    const LAS unsigned char* a0 = base + (k0 + (PERM ? 4 : 8) * h + q) * pitch + (col0 + 16 * blk + 4 * p) * 2;
    const s16x4 lo = __builtin_amdgcn_ds_read_tr16_b64_v4i16((LAS s16x4*)a0);
    const s16x4 hi = __builtin_amdgcn_ds_read_tr16_b64_v4i16((LAS s16x4*)(a0 + (PERM ? 8 : 4) * pitch));
    return (bf16x8){lo[0], lo[1], lo[2], lo[3], hi[0], hi[1], hi[2], hi[3]};
}
__device__ __forceinline__ bf16x8 acc_frag(const f32x16& x, int s) {
    u32x4 w; w.x = cvt_pk_bf16(x[8 * s + 0], x[8 * s + 1]); w.y = cvt_pk_bf16(x[8 * s + 2], x[8 * s + 3]); w.z = cvt_pk_bf16(x[8 * s + 4], x[8 * s + 5]); w.w = cvt_pk_bf16(x[8 * s + 6], x[8 * s + 7]);
    return __builtin_bit_cast(bf16x8, w);
}
__device__ __forceinline__ float softplusf(float v) { return v > 20.f ? v : log1pf(__expf(v)); }
__device__ __forceinline__ unsigned short f2bf1(float v) { return (unsigned short)(cvt_pk_bf16(v, 0.f) & 0xffffu); }
__device__ __forceinline__ float half_sum(float v) {
#pragma unroll
    for (int o = 1; o < 32; o <<= 1) v += __shfl_xor(v, o);
    return v;
}

constexpr int SX_PITCH = 576, SB_TR_PITCH = 320, SB_ROW_PITCH = 272;
constexpr int SL_X = 0, SL_B = 128 * SX_PITCH  , SL_C = SL_B + 128 * SB_TR_PITCH  ;
constexpr int SL_DT = 151552, SL_ACUM = SL_DT + 2048, SL_SSQ = SL_ACUM + 2048;
static_assert(SL_C + 128 * SB_ROW_PITCH <= SL_DT && SL_SSQ + 1024 <= LDS_PHASE_BYTES, "SSD LDS map");
constexpr int HL_QD = 0, HL_QP = 64 * 272, HL_KP = 2 * 64 * 272, HL_V = 3 * 64 * 272  , HL_KD = HL_V + 64 * 320  , HL_SEG = HL_KD + 64 * 320  , HL_SSQ = HL_SEG + 4096;
static_assert(HL_SSQ + 1024 <= LDS_PHASE_BYTES, "HGRN LDS map");

__device__ __forceinline__ void ssd_dt_acum(const Frame& F, const Args& a, int c, int g) {
    if (F.wave < 4) {
        const int hh = g * 4 + F.wave, lane = F_LANE; const float* dtraw = (const float*)(F.ws + WS_DTRAW);
        const float bias = KARG_IN(4)[hh], aa = -__expf(KARG_IN(5)[hh]);
        const int t = c * 128 + 2 * lane;
        const float d0 = softplusf(dtraw[(size_t)t * 8 + hh] + bias), d1 = softplusf(dtraw[(size_t)(t + 1) * 8 + hh] + bias);
        const float a0 = d0 * aa, a1 = d1 * aa;
        float incl = a0 + a1;
#pragma unroll
        for (int o = 1; o < 64; o <<= 1) { const float v = __shfl_up(incl, o); if (lane >= o) incl += v; }
        LAS float* dts = (LAS float*)(F.lds + SL_DT) + F.wave * 128; LAS float* acs = (LAS float*)(F.lds + SL_ACUM) + F.wave * 128;
        dts[2 * lane] = d0; dts[2 * lane + 1] = d1; acs[2 * lane] = incl - a1; acs[2 * lane + 1] = incl;
    }
}
__device__ __forceinline__ void ssd_conv_item(const Frame& F, const Args& a, int c, int src_ch, int seg, int hl, int mode, LAS unsigned char* dst, int pitch, int dst_col) {
    const bf16_t* p = (const bf16_t*)(F.ws + WS_P) + PC_XBC + src_ch;
    const float* cw = KARG_IN(2) + src_ch; const float* cb = KARG_IN(3) + src_ch;
    float w[4][8], bias[8];
#pragma unroll
    for (int j = 0; j < 4; ++j) { const f32x4 x0 = *(const f32x4*)(cw + j * 1024), x1 = *(const f32x4*)(cw + j * 1024 + 4);
        w[j][0] = x0[0]; w[j][1] = x0[1]; w[j][2] = x0[2]; w[j][3] = x0[3]; w[j][4] = x1[0]; w[j][5] = x1[1]; w[j][6] = x1[2]; w[j][7] = x1[3]; }
    { const f32x4 x0 = *(const f32x4*)cb, x1 = *(const f32x4*)(cb + 4); bias[0] = x0[0]; bias[1] = x0[1]; bias[2] = x0[2]; bias[3] = x0[3]; bias[4] = x1[0]; bias[5] = x1[1]; bias[6] = x1[2]; bias[7] = x1[3]; }
    const int l0 = seg * 16, t0 = c * 128 + l0;
    u32x4 rw[19];
#pragma unroll
    for (int j = 0; j < 19; ++j) { const int tt = t0 - 3 + j; rw[j] = tt >= 0 ? *(const u32x4*)(p + (size_t)tt * PW) : (u32x4){0u, 0u, 0u, 0u}; }
    const LAS float* dts = (const LAS float*)(F.lds + SL_DT) + hl * 128; const LAS float* acs = (const LAS float*)(F.lds + SL_ACUM) + hl * 128;
    const float alast = acs[127];
#pragma unroll
    for (int i = 0; i < 16; ++i) {
        float v[8];
#pragma unroll
        for (int k = 0; k < 4; ++k) {
            const unsigned r0 = rw[i][k], r1 = rw[i + 1][k], r2 = rw[i + 2][k], r3 = rw[i + 3][k];
            v[2 * k] = siluf(fmaf(w[3][2 * k], bflo(r3), fmaf(w[2][2 * k], bflo(r2), fmaf(w[1][2 * k], bflo(r1), fmaf(w[0][2 * k], bflo(r0), bias[2 * k])))));
            v[2 * k + 1] = siluf(fmaf(w[3][2 * k + 1], bfhi(r3), fmaf(w[2][2 * k + 1], bfhi(r2), fmaf(w[1][2 * k + 1], bfhi(r1), fmaf(w[0][2 * k + 1], bfhi(r0), bias[2 * k + 1])))));
        }
        float sc = 1.f;
        if (mode >= 1) sc = dts[l0 + i];
        if (mode == 2) sc *= __expf(alast - acs[l0 + i]);
        u32x4 o; o.x = cvt_pk_bf16(v[0] * sc, v[1] * sc); o.y = cvt_pk_bf16(v[2] * sc, v[3] * sc); o.z = cvt_pk_bf16(v[4] * sc, v[5] * sc); o.w = cvt_pk_bf16(v[6] * sc, v[7] * sc);
        *(LAS u32x4*)(dst + (l0 + i) * pitch + dst_col * 2) = o;
    }
}

__device__ __forceinline__ void ssd_states_unit(const Frame& F, const Args& a, int c, int g) {
    const int tid = F_TID, lane = F_LANE;
    __syncthreads();
    ssd_dt_acum(F, a, c, g);
    __syncthreads();
    { const int cg = tid & 63, seg = tid >> 6; const bool isx = cg < 32;
      if (cg < 48) ssd_conv_item(F, a, c, isx ? g * 256 + cg * 8 : 512 + g * 128 + (cg - 32) * 8, seg, isx ? (cg >> 3) : 0, isx ? 2 : 0,
                                 F.lds + (isx ? SL_X : SL_B), isx ? SX_PITCH : SB_TR_PITCH, isx ? cg * 8 : (cg - 32) * 8); }
    __syncthreads();
    const int hl = F.wave >> 1, pt = F.wave & 1, hh = g * 4 + hl;
    f32x16 S[4];
#pragma unroll
    for (int nt = 0; nt < 4; ++nt)
#pragma unroll
        for (int r = 0; r < 16; ++r) S[nt][r] = 0.f;
#pragma unroll 2
    for (int ks = 0; ks < 8; ++ks) {
        const bf16x8 A = frag_tr<false>(F.lds + SL_X, SX_PITCH, 16 * ks, hl * 64 + 32 * pt, lane);
#pragma unroll
        for (int nt = 0; nt < 4; ++nt) { const bf16x8 B = frag_tr<false>(F.lds + SL_B, SB_TR_PITCH, 16 * ks, 32 * nt, lane); S[nt] = MFMA32(A, B, S[nt]); }
    }
    float* st = (float*)(F.ws + WS_SSTATE) + ((size_t)(c * 8 + hh) * 64 + 32 * pt) * 128;
#pragma unroll
    for (int nt = 0; nt < 4; ++nt)
#pragma unroll
        for (int r = 0; r < 16; ++r) st[(size_t)drow(r, lane) * 128 + 32 * nt + (lane & 31)] = S[nt][r];
    if (tid < 4) ((float*)(F.ws + WS_CDECAY))[c * 8 + g * 4 + tid] = __expf(((const LAS float*)(F.lds + SL_ACUM))[tid * 128 + 127]);
}

__device__ __forceinline__ void ssd_out_unit(const Frame& F, const Args& a, int c, int g) {
    const int lane = F_LANE;
    __syncthreads();
    ssd_dt_acum(F, a, c, g);
    __syncthreads();
    { const int tid = F_TID, cg = tid & 63, seg = tid >> 6; const bool isx = cg < 32, isb = cg < 48;
      ssd_conv_item(F, a, c, isx ? g * 256 + cg * 8 : (isb ? 512 + g * 128 + (cg - 32) * 8 : 768 + g * 128 + (cg - 48) * 8), seg, isx ? (cg >> 3) : 0, isx ? 1 : 0,
                    F.lds + (isx ? SL_X : (isb ? SL_B : SL_C)), isx ? SX_PITCH : SB_ROW_PITCH, isx ? cg * 8 : (isb ? (cg - 32) * 8 : (cg - 48) * 8)); }
    __syncthreads();
    const int lt = F.wave >> 1, hp = F.wave & 1;
    const int lcol = 32 * lt + (lane & 31);
    f32x16 acc[2][2];
#pragma unroll
    for (int hi = 0; hi < 2; ++hi)
#pragma unroll
        for (int pt = 0; pt < 2; ++pt)
#pragma unroll
            for (int r = 0; r < 16; ++r) acc[hi][pt][r] = 0.f;
#pragma unroll
    for (int hi = 0; hi < 2; ++hi) {
        const int hl = hp * 2 + hi, hh = g * 4 + hl;
        const bf16_t* sp = (const bf16_t*)(F.ws + WS_SPREV) + (size_t)(c * 8 + hh) * 64 * 128 + (size_t)(lane & 31) * 128 + 8 * (lane >> 5);
        bf16x8 Bsv[2][8];
#pragma unroll
        for (int pt = 0; pt < 2; ++pt)
#pragma unroll
            for (int ks = 0; ks < 8; ++ks) Bsv[pt][ks] = *(const bf16x8*)(sp + (size_t)(32 * pt) * 128 + 16 * ks);
#pragma unroll
        for (int ks = 0; ks < 8; ++ks) {
            const bf16x8 A = frag_row(F.lds + SL_C, SB_ROW_PITCH, 32 * lt, 16 * ks, lane);
#pragma unroll
            for (int pt = 0; pt < 2; ++pt) acc[hi][pt] = MFMA32(A, Bsv[pt][ks], acc[hi][pt]);
        }
        const LAS float* acs = (const LAS float*)(F.lds + SL_ACUM) + hl * 128;
#pragma unroll
        for (int r = 0; r < 16; ++r) { const float e = __expf(acs[32 * lt + drow(r, lane)]); acc[hi][0][r] *= e; acc[hi][1][r] *= e; }
    }
#pragma unroll 1
    for (int st = 0; st <= lt; ++st) {
        f32x16 GT;
#pragma unroll
        for (int r = 0; r < 16; ++r) GT[r] = 0.f;
#pragma unroll 2
        for (int ks = 0; ks < 8; ++ks) {
            const bf16x8 A = frag_row(F.lds + SL_B, SB_ROW_PITCH, 32 * st, 16 * ks, lane), B = frag_row(F.lds + SL_C, SB_ROW_PITCH, 32 * lt, 16 * ks, lane);
            GT = MFMA32(A, B, GT);
        }
#pragma unroll
        for (int hi = 0; hi < 2; ++hi) {
            const int hl = hp * 2 + hi, hh = g * 4 + hl;
            const LAS float* dts = (const LAS float*)(F.lds + SL_DT) + hl * 128; const LAS float* acs = (const LAS float*)(F.lds + SL_ACUM) + hl * 128;
            const float al = acs[lcol], dsk = KARG_IN(6)[hh] / dts[lcol];
            f32x16 M;
#pragma unroll
            for (int r = 0; r < 16; ++r) { const int srow = 32 * st + drow(r, lane);
                float v = srow <= lcol ? GT[r] * __expf(al - acs[srow]) : 0.f;
                if (srow == lcol) v += dsk;
                M[r] = v; }
#pragma unroll
            for (int s2 = 0; s2 < 2; ++s2) { const bf16x8 A = acc_frag(M, s2);
#pragma unroll
                for (int pt = 0; pt < 2; ++pt) { const bf16x8 B = frag_tr<true>(F.lds + SL_X, SX_PITCH, 32 * st + 16 * s2, hl * 64 + 32 * pt, lane); acc[hi][pt] = MFMA32(A, B, acc[hi][pt]); } }
        }
    }
    float ssq[16];
#pragma unroll
    for (int r = 0; r < 16; ++r) ssq[r] = 0.f;
    {
        const bf16_t* pz = (const bf16_t*)(F.ws + WS_P) + (size_t)(c * 128 + 32 * lt) * PW + PC_Z + g * 256 + hp * 128 + (lane & 31);
#pragma unroll
        for (int hi = 0; hi < 2; ++hi)
#pragma unroll
            for (int pt = 0; pt < 2; ++pt)
#pragma unroll
                for (int r = 0; r < 16; ++r) { const float z = bf2f(pz[(size_t)drow(r, lane) * PW + hi * 64 + 32 * pt]);
                    const float y = acc[hi][pt][r] * siluf(z); acc[hi][pt][r] = y; ssq[r] += y * y; }
    }
    LAS float* ssqs = (LAS float*)(F.lds + SL_SSQ);
#pragma unroll
    for (int r = 0; r < 16; ++r) { const float sm = half_sum(ssq[r]); if ((lane & 31) == 0) ssqs[F.wave * 32 + drow(r, lane)] = sm; }
    __syncthreads();
    const float* nw = KARG_IN(7) + g * 256 + hp * 128 + (lane & 31);
#pragma unroll
    for (int r = 0; r < 16; ++r) { const int row = drow(r, lane);
        const float rs = rsqrtf((ssqs[F.wave * 32 + row] + ssqs[(F.wave ^ 1) * 32 + row]) * (1.0f / 256.0f) + RMS_EPS_F);
#pragma unroll
        for (int hi = 0; hi < 2; ++hi)
#pragma unroll
            for (int pt = 0; pt < 2; ++pt) *(LAS unsigned short*)(F.lds + SL_X + (32 * lt + row) * 528 + (hp * 128 + hi * 64 + 32 * pt + (lane & 31)) * 2) = f2bf1(acc[hi][pt][r] * rs * nw[hi * 64 + 32 * pt]); }
    __syncthreads();
    { const int tid = F_TID; bf16_t* mo = (bf16_t*)(F.ws + WS_MIX) + (size_t)(c * 128) * DM + g * 256;
#pragma unroll
      for (int i = 0; i < 8; ++i) { const int pc = tid + 512 * i, row = pc >> 5, ch = (pc & 31) * 8;
          *(u32x4*)(mo + (size_t)row * DM + ch) = *(const LAS u32x4*)(F.lds + SL_X + row * 528 + ch * 2); } }
}

struct HgrnLocal { float fg[8][2], cum[8][2], qv[8][2], iv[8][2], tot[2], mid[2]; };
struct HgrnRaw { unsigned fw[8], iw[8], qw[8]; };
template <bool NEEDQ> __device__ __forceinline__ void hgrn_fetch(const Frame& F, int c, int h, HgrnRaw& R) {
    const int tid = F_TID, cp = tid & 63, seg = tid >> 6, d0 = 2 * cp;
    const bf16_t* p = (const bf16_t*)(F.ws + WS_P) + (size_t)(c * 64 + seg * 8) * PW + h * 128 + d0;
#pragma unroll
    for (int i = 0; i < 8; ++i) { R.fw[i] = *(const unsigned*)(p + (size_t)i * PW + PC_F); R.iw[i] = *(const unsigned*)(p + (size_t)i * PW + PC_I);
        if (NEEDQ) R.qw[i] = *(const unsigned*)(p + (size_t)i * PW + PC_Q); }
}
template <bool NEEDQ> __device__ __forceinline__ void hgrn_load(const Frame& F, const Args& a, int h, const HgrnRaw& R, HgrnLocal& L) {
    const int tid = F_TID, cp = tid & 63, seg = tid >> 6, d0 = 2 * cp;
    float lb[2];
#pragma unroll
    for (int j = 0; j < 2; ++j) { const float l0 = KARG_IN(8)[h * 128 + d0 + j], l1 = KARG_IN(8)[512 + h * 128 + d0 + j]; const float mx = fmaxf(l0, l1), e0 = __expf(l0 - mx), e1 = __expf(l1 - mx); lb[j] = e0 / (e0 + e1); }
    float run[2] = {0.f, 0.f};
#pragma unroll
    for (int i = 0; i < 8; ++i) {
        const unsigned fw = R.fw[i], iw = R.iw[i];
        const float fr[2] = {bflo(fw), bfhi(fw)};
        L.iv[i][0] = bflo(iw); L.iv[i][1] = bfhi(iw);
        if (NEEDQ) { const unsigned qw = R.qw[i]; L.qv[i][0] = siluf(bflo(qw)); L.qv[i][1] = siluf(bfhi(qw)); }
#pragma unroll
        for (int j = 0; j < 2; ++j) { const float fg = lb[j] + (1.0f - lb[j]) * sigmf(fr[j]); L.fg[i][j] = fg; run[j] += __logf(fg); L.cum[i][j] = run[j]; }
    }
    LAS float* segs = (LAS float*)(F.lds + HL_SEG);
    segs[seg * 128 + d0] = run[0]; segs[seg * 128 + d0 + 1] = run[1];
    __syncthreads();
    float pre[2] = {0.f, 0.f}, tot[2] = {0.f, 0.f}, mid[2] = {0.f, 0.f};
#pragma unroll
    for (int s2 = 0; s2 < 8; ++s2) {
#pragma unroll
        for (int j = 0; j < 2; ++j) { const float v = segs[s2 * 128 + d0 + j]; tot[j] += v; if (s2 < seg) pre[j] += v; if (s2 < 4) mid[j] += v; }
    }
#pragma unroll
    for (int i = 0; i < 8; ++i)
#pragma unroll
        for (int j = 0; j < 2; ++j) L.cum[i][j] += pre[j];
    L.tot[0] = tot[0]; L.tot[1] = tot[1]; L.mid[0] = mid[0]; L.mid[1] = mid[1];
}

__device__ __forceinline__ void hgrn_states_unit(const Frame& F, const Args& a, int c, int h, const HgrnRaw& R) {
    const int tid = F_TID, lane = F_LANE, cp = tid & 63, seg = tid >> 6, d0 = 2 * cp;
    __syncthreads();
    HgrnLocal L; hgrn_load<false>(F, a, h, R, L);
#pragma unroll
    for (int i = 0; i < 8; ++i) { const int t = seg * 8 + i;
        *(LAS unsigned*)(F.lds + HL_KD + t * 320 + d0 * 2) = cvt_pk_bf16((1.0f - L.fg[i][0]) * __expf(L.tot[0] - L.cum[i][0]), (1.0f - L.fg[i][1]) * __expf(L.tot[1] - L.cum[i][1]));
        *(LAS unsigned*)(F.lds + HL_V + t * 320 + d0 * 2) = cvt_pk_bf16(L.iv[i][0], L.iv[i][1]); }
    if (seg == 0) { float* hd = (float*)(F.ws + WS_HDECAY) + (size_t)(c * 4 + h) * 128 + d0; hd[0] = __expf(L.tot[0]); hd[1] = __expf(L.tot[1]); }
    __syncthreads();
    const int et = F.wave >> 1, dh = F.wave & 1;
    f32x16 acc[2];
#pragma unroll
    for (int dj = 0; dj < 2; ++dj)
#pragma unroll
        for (int r = 0; r < 16; ++r) acc[dj][r] = 0.f;
#pragma unroll
    for (int ks = 0; ks < 4; ++ks) {
        const bf16x8 A = frag_tr<false>(F.lds + HL_V, 320, 16 * ks, 32 * et, lane);
#pragma unroll
        for (int dj = 0; dj < 2; ++dj) { const bf16x8 B = frag_tr<false>(F.lds + HL_KD, 320, 16 * ks, 32 * (2 * dh + dj), lane); acc[dj] = MFMA32(A, B, acc[dj]); }
    }
    float* kv = (float*)(F.ws + WS_HKV) + ((size_t)(c * 4 + h) * 128 + 32 * et) * 128;
#pragma unroll
    for (int dj = 0; dj < 2; ++dj)
#pragma unroll
        for (int r = 0; r < 16; ++r) kv[(size_t)drow(r, lane) * 128 + 32 * (2 * dh + dj) + (lane & 31)] = acc[dj][r];
}

__device__ __forceinline__ void hgrn_out_unit(const Frame& F, const Args& a, int c, int h, const HgrnRaw& R) {
    const int tid = F_TID, lane = F_LANE, cp = tid & 63, seg = tid >> 6, d0 = 2 * cp;
    const int tt = F.wave >> 2, et = F.wave & 3;
    bf16x8 Bs[8];
    { const bf16_t* sp = (const bf16_t*)(F.ws + WS_HSPREV) + ((size_t)(c * 4 + h) * 128 + 32 * et) * 128 + (size_t)(lane & 31) * 128 + 8 * (lane >> 5);
#pragma unroll
      for (int ks = 0; ks < 8; ++ks) Bs[ks] = *(const bf16x8*)(sp + 16 * ks); }
    const int e = 32 * et + (lane & 31);
    unsigned short gv[16];
    { const bf16_t* pg = (const bf16_t*)(F.ws + WS_P) + (size_t)(c * 64 + 32 * tt) * PW + PC_G + h * 128 + e;
#pragma unroll
      for (int r = 0; r < 16; ++r) gv[r] = pg[(size_t)drow(r, lane) * PW]; }
    const float nw = KARG_IN(9)[h * 128 + e];
    __syncthreads();
    HgrnLocal L; hgrn_load<true>(F, a, h, R, L);
#pragma unroll
    for (int i = 0; i < 8; ++i) { const int t = seg * 8 + i;
        float qd[2], qp[2], kp[2];
#pragma unroll
        for (int j = 0; j < 2; ++j) { qd[j] = L.qv[i][j] * __expf(L.cum[i][j]); qp[j] = L.qv[i][j] * __expf(L.cum[i][j] - L.mid[j]); kp[j] = (1.0f - L.fg[i][j]) * __expf(L.mid[j] - L.cum[i][j]); }
        *(LAS unsigned*)(F.lds + HL_QD + t * 272 + d0 * 2) = cvt_pk_bf16(qd[0], qd[1]);
        *(LAS unsigned*)(F.lds + HL_QP + t * 272 + d0 * 2) = cvt_pk_bf16(qp[0], qp[1]);
        *(LAS unsigned*)(F.lds + HL_KP + t * 272 + d0 * 2) = cvt_pk_bf16(kp[0], kp[1]);
        *(LAS unsigned*)(F.lds + HL_V + t * 320 + d0 * 2) = cvt_pk_bf16(L.iv[i][0], L.iv[i][1]); }
    __syncthreads();
    f32x16 acc;
#pragma unroll
    for (int r = 0; r < 16; ++r) acc[r] = 0.f;
#pragma unroll
    for (int ks = 0; ks < 8; ++ks) { const bf16x8 A = frag_row(F.lds + HL_QD, 272, 32 * tt, 16 * ks, lane); acc = MFMA32(A, Bs[ks], acc); }
    const int tcol = 32 * tt + (lane & 31);
#pragma unroll
    for (int st = 0; st < 2; ++st) {
        if (st <= tt) {
            f32x16 X;
#pragma unroll
            for (int r = 0; r < 16; ++r) X[r] = 0.f;
#pragma unroll 2
            for (int ks = 0; ks < 8; ++ks) { const bf16x8 A = frag_row(F.lds + HL_KP, 272, 32 * st, 16 * ks, lane), B = frag_row(F.lds + HL_QP, 272, 32 * tt, 16 * ks, lane); X = MFMA32(A, B, X); }
#pragma unroll
            for (int r = 0; r < 16; ++r) X[r] = (32 * st + drow(r, lane) <= tcol) ? X[r] : 0.f;
#pragma unroll
            for (int s2 = 0; s2 < 2; ++s2) { const bf16x8 A = acc_frag(X, s2), B = frag_tr<true>(F.lds + HL_V, 320, 32 * st + 16 * s2, 32 * et, lane); acc = MFMA32(A, B, acc); }
        }
    }
    LAS float* ssqs = (LAS float*)(F.lds + HL_SSQ);
#pragma unroll
    for (int r = 0; r < 16; ++r) { const float sm = half_sum(acc[r] * acc[r]); if ((lane & 31) == 0) ssqs[F.wave * 32 + drow(r, lane)] = sm; }
    __syncthreads();
#pragma unroll
    for (int r = 0; r < 16; ++r) { const int row = drow(r, lane);
        const float ss = ssqs[(tt * 4 + 0) * 32 + row] + ssqs[(tt * 4 + 1) * 32 + row] + ssqs[(tt * 4 + 2) * 32 + row] + ssqs[(tt * 4 + 3) * 32 + row];
        const float rs = rsqrtf(ss * (1.0f / 128.0f) + RMS_EPS_F);
        *(LAS unsigned short*)(F.lds + HL_QD + (32 * tt + row) * 272 + e * 2) = f2bf1(acc[r] * rs * nw * siluf(bf2f(gv[r]))); }
    __syncthreads();
    { bf16_t* mo = (bf16_t*)(F.ws + WS_MIX) + (size_t)(c * 64) * DM + 512 + h * 128;
#pragma unroll
      for (int i = 0; i < 2; ++i) { const int pc = tid + 512 * i, row = pc >> 4, ch = (pc & 15) * 8;
          *(u32x4*)(mo + (size_t)row * DM + ch) = *(const LAS u32x4*)(F.lds + HL_QD + row * 272 + ch * 2); } }
}

__device__ __forceinline__ void phase_mix_states(const Frame& F, const Args& a, const int mode) {
    if (!(mode & 1)) for (int u = blockIdx.x; u < 256; u += F.G) ssd_states_unit(F, a, u >> 1, u & 1);
    if (!(mode & 2)) {
        HgrnRaw Ra, Rb; int u = blockIdx.x;
        if (u < 1024) hgrn_fetch<false>(F, u >> 2, u & 3, Ra);
        while (u < 1024) {
            int un = u + F.G; if (un < 1024) hgrn_fetch<false>(F, un >> 2, un & 3, Rb);
            hgrn_states_unit(F, a, u >> 2, u & 3, Ra); u = un; if (u >= 1024) break;
            un = u + F.G; if (un < 1024) hgrn_fetch<false>(F, un >> 2, un & 3, Ra);
            hgrn_states_unit(F, a, u >> 2, u & 3, Rb); u = un;
        }
    }
}
__device__ __forceinline__ void phase_mix_out(const Frame& F, const Args& a, const int mode) {
    if (!(mode & 1)) for (int u = blockIdx.x; u < 256; u += F.G) ssd_out_unit(F, a, u >> 1, u & 1);
    if (!(mode & 2)) {
        HgrnRaw Ra, Rb; int u = blockIdx.x;
        if (u < 1024) hgrn_fetch<true>(F, u >> 2, u & 3, Ra);
        while (u < 1024) {
            int un = u + F.G; if (un < 1024) hgrn_fetch<true>(F, un >> 2, un & 3, Rb);
            hgrn_out_unit(F, a, u >> 2, u & 3, Ra); u = un; if (u >= 1024) break;
            un = u + F.G; if (un < 1024) hgrn_fetch<true>(F, un >> 2, un & 3, Ra);
            hgrn_out_unit(F, a, u >> 2, u & 3, Rb); u = un;
        }
    }
}
__device__ __forceinline__ void phase_mix_scan(const Frame& F, const Args& a) {
    const int gt = blockIdx.x * 512 + F_TID;
    if (blockIdx.x < 128 || F.G < 256) {
        for (int idx = gt; idx < 65536; idx += (F.G < 256 ? F.G : 128) * 512) {
            const int hh = idx >> 13; const float* st = (const float*)(F.ws + WS_SSTATE) + idx; const float* cd = (const float*)(F.ws + WS_CDECAY) + hh;
            bf16_t* sp = (bf16_t*)(F.ws + WS_SPREV) + idx; float S = 0.f;
            for (int c0 = 0; c0 < 128; c0 += 16) { float v[16], d[16];
#pragma unroll
                for (int i = 0; i < 16; ++i) { v[i] = st[(size_t)(c0 + i) * 65536]; d[i] = cd[(c0 + i) * 8]; }
#pragma unroll
                for (int i = 0; i < 16; ++i) { sp[(size_t)(c0 + i) * 65536] = f2bf1(S); S = fmaf(S, d[i], v[i]); } }
        }
    }
    if (blockIdx.x >= 128 || F.G < 256) {
        const int gt2 = F.G < 256 ? gt : gt - 128 * 512;
        for (int idx = gt2; idx < 65536; idx += (F.G < 256 ? F.G : 128) * 512) {
            const int h = idx >> 14, d = idx & 127; const float* kv = (const float*)(F.ws + WS_HKV) + idx; const float* hd = (const float*)(F.ws + WS_HDECAY) + h * 128 + d;
            bf16_t* sp = (bf16_t*)(F.ws + WS_HSPREV) + idx; float S = 0.f;
            for (int c0 = 0; c0 < 256; c0 += 16) { float v[16], dd[16];
#pragma unroll
                for (int i = 0; i < 16; ++i) { v[i] = kv[(size_t)(c0 + i) * 65536]; dd[i] = hd[(size_t)(c0 + i) * 512]; }
#pragma unroll
                for (int i = 0; i < 16; ++i) { sp[(size_t)(c0 + i) * 65536] = f2bf1(S); S = fmaf(S, dd[i], v[i]); } }
        }
    }
}

__global__ void __launch_bounds__(512, 2) mk_fwd(Args args) {
    extern __shared__ __attribute__((aligned(16))) unsigned char lds_raw[];
    Frame F;
    F.lds = (LAS unsigned char*)lds_raw;
    F.wave = __builtin_amdgcn_readfirstlane(threadIdx.x >> 6);
    F.G = gridDim.x; { const int bx = blockIdx.x; F.vcu = (F.G % 8 == 0) ? (bx % 8) * (F.G / 8) + bx / 8 : bx; }
    F.ws = args.ws; F.ctl = (unsigned*)(args.ws + WS_CTL);
    volatile LAS unsigned* MISC = (volatile LAS unsigned*)(F.lds + LDS_MISC);
    if (F_TID < 64) MISC[F_TID] = 0u;
    __syncthreads();
    const bool use_bar = (args.ph_hi - args.ph_lo) > 1;
    XcdBarrier bar; bar.bar = F.ctl + CW_BAR + args.li * XCD_BAR_WORDS; bar.x = 0; bar.st = MISC + 8; bar.wave = F.wave;
    if (use_bar) bar = xcd_barrier_post(F.ctl + CW_BAR + args.li * XCD_BAR_WORDS, MISC + 8, F.wave);
#define PH(k) (args.ph_lo <= (k) && (k) < args.ph_hi)
#define SEAM(k) do { if (use_bar && (k) + 1 < args.ph_hi && (k) >= args.ph_lo) xcd_barrier(bar); } while (0)
    unsigned char* ws = F.ws;
    if (PH(0)) phase_prep(F, args);
    SEAM(0);
    if (PH(1)) {
        pg8::DenseSched S; S.init(ws + WS_XB, ws + WS_WIN_T, T_TOK, 3072, 1024, F.G, blockIdx.x);
        pg8::EpiP E; E.O = (bf16_t*)(ws + WS_P); E.ldc = PW;
        pg8::gemm_phase<pg8::EpiP, pg8::DenseSched, true>(F.lds, 1024, S, E, F.wave);
    }
    SEAM(1);
#if defined(MK_NAIVE_MIX)
    if (PH(2)) phase_m1(F, args);
    SEAM(2);
    if (PH(3)) phase_m2(F, args);
    SEAM(3);
    if (PH(4)) phase_m3(F, args);
#else
    if (PH(2)) phase_mix_states(F, args, args.mode);
    SEAM(2);
    if (PH(3)) {
        phase_mix_scan(F, args);
        if (blockIdx.x < 128 && F.G >= 256) {
            __syncthreads();
            pg8::DenseSched S; S.init(ws + WS_XB, ws + WS_WIN_T + (size_t)3072 * 1024 * 2, T_TOK, 512, 1024, 128, blockIdx.x);
            pg8::EpiP E; E.O = (bf16_t*)(ws + WS_P) + 3072; E.ldc = PW;
            pg8::gemm_phase<pg8::EpiP, pg8::DenseSched, true>(F.lds, 1024, S, E, F.wave);
        } else if (F.G < 256) {
            __syncthreads();
            pg8::DenseSched S; S.init(ws + WS_XB, ws + WS_WIN_T + (size_t)3072 * 1024 * 2, T_TOK, 512, 1024, F.G, blockIdx.x);
            pg8::EpiP E; E.O = (bf16_t*)(ws + WS_P) + 3072; E.ldc = PW;
            pg8::gemm_phase<pg8::EpiP, pg8::DenseSched, true>(F.lds, 1024, S, E, F.wave);
        }
    }
    SEAM(3);
    if (PH(4)) phase_mix_out(F, args, args.mode);
#endif
    SEAM(4);
    if (PH(5)) {
        pg8::DenseSched S; S.init(ws + WS_MIX, ws + WS_WOUT_T, T_TOK, 1024, 1024, F.G, blockIdx.x);
        pg8::EpiU E; E.U = (float*)(ws + WS_H1); E.X = KARG_IN(0);
        pg8::gemm_phase<pg8::EpiU, pg8::DenseSched, false>(F.lds, 1024, S, E, F.wave);
    }
    SEAM(5);
    if (PH(6)) phase_ln1(F, args);
    SEAM(6);
    if (PH(7)) {
        pg8::DenseSched S; S.init(ws + WS_H1B, ws + WS_W3_T, T_TOK, 768, 1024, F.G, blockIdx.x);
        pg8::Epi3 E; E.LG = (float*)(ws + WS_LOGITS); E.HS = (bf16_t*)(ws + WS_HS);
        pg8::gemm_phase<pg8::Epi3, pg8::DenseSched, false>(F.lds, 1024, S, E, F.wave);
    }
    SEAM(7);
    if (PH(8)) {
        phase_route(F, args);
        pg8::DenseSched S; S.init(ws + WS_HS, ws + WS_WDS_T, T_TOK, 1024, 256, F.G, blockIdx.x);
        pg8::EpiP E; E.O = (bf16_t*)(ws + WS_YS); E.ldc = 1024;
        pg8::gemm_phase<pg8::EpiP, pg8::DenseSched, false>(F.lds, 256, S, E, F.wave);
    }
    SEAM(8);
#if defined(MK_OLD_EXPERTS)
    if (PH(9)) {
        build_tables(F);
        pg8::ExpertSched<true> S; S.lds = F.lds;
        S.lists = (const int*)(ws + WS_LISTS); S.A = (const char*)(ws + WS_H1B); S.W = (const char*)(ws + WS_WGU_T);
        S.U = 2 * __builtin_amdgcn_readfirstlane(((const LAS int*)(F.lds + LDS_PREF))[NEXP]); S.G = F.G; S.c = blockIdx.x;
        pg8::EpiH E; E.H = (bf16_t*)(ws + WS_H);
        pg8::gemm_phase<pg8::EpiH, pg8::ExpertSched<true>, true>(F.lds, 1024, S, E, F.wave);
    }
    SEAM(9);
    if (PH(10)) {
        build_tables(F);
        pg8::ExpertSched<false> S; S.lds = F.lds;
        S.lists = (const int*)(ws + WS_LISTS); S.A = (const char*)(ws + WS_H); S.W = (const char*)(ws + WS_WD_T);
        S.U = 4 * __builtin_amdgcn_readfirstlane(((const LAS int*)(F.lds + LDS_PREF))[NEXP]); S.G = F.G; S.c = blockIdx.x;
        pg8::EpiYb E; E.YB = (bf16_t*)(ws + WS_YB); E.lists = (const int*)(ws + WS_LISTS); E.tok_gate = (const float*)(ws + WS_TOKGATE);
        pg8::gemm_phase<pg8::EpiYb, pg8::ExpertSched<false>, true>(F.lds, 256, S, E, F.wave);
    }
    SEAM(10);
#else
    if (PH(9)) phase_experts(F, args, args.mode);
    SEAM(9);
#endif
    if (PH(11)) { build_tables(F); phase_final(F, args); }
}

extern "C" void kernel_launch(void* const* d_in, const int* in_sizes, int n_in, void* d_out, int out_size, void* d_ws, size_t ws_size, hipStream_t stream) {
    static int grid = 0;
    if (grid == 0) {
        int dev = 0, cus = 0;
        if (hipGetDevice(&dev) != hipSuccess || hipDeviceGetAttribute(&cus, hipDeviceAttributeMultiprocessorCount, dev) != hipSuccess) { fprintf(stderr, "device query failed\n"); grid = -1; return; }
        if (hipFuncSetAttribute((const void*)mk_fwd, hipFuncAttributeMaxDynamicSharedMemorySize, LDS_BYTES) != hipSuccess) { fprintf(stderr, "hipFuncSetAttribute failed\n"); grid = -1; return; }
        if (ws_size < WS_END) { fprintf(stderr, "workspace too small: %zu < %zu\n", ws_size, (size_t)WS_END); grid = -1; return; }
        (void)hipGetLastError();
        grid = cus;
    }
    if (grid < 0) return;
    unsigned char* ws = (unsigned char*)d_ws;
    (void)hipMemsetAsync(ws + WS_CTL, 0, CTL_ZERO_BYTES, stream);
    Args a{};
    for (int i = 0; i < 23; ++i) a.in[i] = (const float*)d_in[i];
    a.out = (float*)d_out; a.ws = ws;
    auto launch = [&](int lo, int hi) { a.ph_lo = lo; a.ph_hi = hi; hipLaunchKernelGGL(mk_fwd, dim3(grid), dim3(512), LDS_BYTES, stream, a); };
#if defined(MK_PER_PHASE)
    for (int ph = 0; ph < NPH; ++ph) launch(ph, ph + 1);
#else
    launch(0, NPH);
#endif
}
```

```cpp
#include <hip/hip_runtime.h>
#include <stdint.h>
#include <cstdio>

#define GAS __attribute__((address_space(1)))
#define LAS __attribute__((address_space(3)))
typedef unsigned short bf16_t;
typedef short bf16x8 __attribute__((ext_vector_type(8)));
typedef float f32x4 __attribute__((ext_vector_type(4)));
typedef unsigned u32x4 __attribute__((ext_vector_type(4)));
typedef unsigned u32x2 __attribute__((ext_vector_type(2)));
typedef float f32x16 __attribute__((ext_vector_type(16)));
typedef short s16x4 __attribute__((ext_vector_type(4)));

constexpr int T_TOK = 16384, DM = 1024, NIN = 3592, PW = 3584;
constexpr int NEXP = 256, LIST_CAP = 16384;
constexpr int PC_Z = 0, PC_XBC = 512, PC_Q = 1536, PC_F = 2048, PC_I = 2560, PC_G = 3072;
#define ALPHA_F 1.189207115002721f
#define LN_EPS_F 1e-5f
#define RMS_EPS_F 1e-6f

constexpr size_t MiB = 1u << 20;
constexpr size_t WS_CTL = 0, CTL_ZERO_BYTES = 1 * MiB;
constexpr size_t WS_WIN_T = 2 * MiB, WS_WOUT_T = 9 * MiB, WS_W3_T = 11 * MiB, WS_WDS_T = 13 * MiB, WS_DTRAW = 14 * MiB;
constexpr size_t WS_TOKE = 15 * MiB, WS_TOKPOS = 15 * MiB + 512 * 1024, WS_TOKGATE = 16 * MiB;
constexpr size_t WS_LISTS = 17 * MiB, WS_LOGITS = 33 * MiB, WS_HS = 49 * MiB, WS_YS = 57 * MiB, WS_H1 = 89 * MiB, WS_H1B = 153 * MiB;
constexpr size_t WS_WGU_T = 185 * MiB, WS_WD_T = 441 * MiB;
constexpr size_t WS_X0 = 569 * MiB;
constexpr size_t WS_XB = WS_X0, WS_P = WS_X0 + 32 * MiB, WS_MIX = WS_X0 + 144 * MiB;
constexpr size_t WS_NXBC = WS_X0 + 176 * MiB, WS_NFGK = WS_X0 + 240 * MiB, WS_NQS = WS_X0 + 272 * MiB, WS_NYSSD = WS_X0 + 304 * MiB, WS_NOH = WS_X0 + 336 * MiB, WS_NDTB = WS_X0 + 368 * MiB;
constexpr size_t WS_SSTATE = WS_X0 + 176 * MiB, WS_SPREV = WS_X0 + 208 * MiB, WS_HKV = WS_X0 + 224 * MiB, WS_HSPREV = WS_X0 + 288 * MiB;
constexpr size_t WS_CDECAY = WS_X0 + 320 * MiB, WS_HDECAY = WS_X0 + 320 * MiB + 64 * 1024;
constexpr size_t WS_H = WS_X0, WS_YB = WS_X0 + 65 * MiB;
constexpr size_t WS_END = WS_X0 + 369 * MiB;
constexpr int CW_BAR = 4096;
constexpr int CW_COUNTS = 16384, CNT_STRIDE = 64;

constexpr int RING_BYTES = 131072;
constexpr int LDS_BYTES = 163840;
constexpr int LDS_MISC = LDS_BYTES - 4096;
constexpr int LDS_PREF = LDS_MISC + 256;
constexpr int LDS_OFFS = LDS_PREF + 1040;
constexpr int LDS_CNT = LDS_OFFS + 1040;
constexpr int LDS_PHASE_BYTES = LDS_MISC;

__device__ __forceinline__ int lane_id() { int l; asm volatile("v_mbcnt_lo_u32_b32 %0, -1, 0\n\tv_mbcnt_hi_u32_b32 %0, -1, %0" : "=v"(l)); return l; }
__device__ __forceinline__ float siluf(float x) { return x / (1.0f + __expf(-x)); }
__device__ __forceinline__ float sigmf(float x) { return 1.0f / (1.0f + __expf(-x)); }
__device__ __forceinline__ float wave_sum(float v) {
#pragma unroll
  for (int o = 1; o < 64; o <<= 1) v += __shfl_xor(v, o);
  return v;
}
__device__ __forceinline__ unsigned cvt_pk_bf16(float lo, float hi) { unsigned r; asm volatile("v_cvt_pk_bf16_f32 %0, %1, %2" : "=v"(r) : "v"(lo), "v"(hi)); return r; }
#define YB_SCALE 64.0f
__device__ __forceinline__ unsigned pk4_fp8(const f32x4 v) {
    const float a = fminf(fmaxf(v[0], -440.f), 440.f), b = fminf(fmaxf(v[1], -440.f), 440.f), c = fminf(fmaxf(v[2], -440.f), 440.f), d = fminf(fmaxf(v[3], -440.f), 440.f);
    int w = 0; w = __builtin_amdgcn_cvt_pk_fp8_f32(a, b, w, false); w = __builtin_amdgcn_cvt_pk_fp8_f32(c, d, w, true); return (unsigned)w; }
__device__ __forceinline__ f32x4 un4_fp8(const unsigned w) { return (f32x4){__builtin_amdgcn_cvt_f32_fp8((int)w, 0), __builtin_amdgcn_cvt_f32_fp8((int)w, 1), __builtin_amdgcn_cvt_f32_fp8((int)w, 2), __builtin_amdgcn_cvt_f32_fp8((int)w, 3)}; }
__device__ __forceinline__ float bf2f(unsigned b) { return __uint_as_float(b << 16); }
__device__ __forceinline__ float bflo(unsigned w) { return __uint_as_float(w << 16); }
__device__ __forceinline__ float bfhi(unsigned w) { return __uint_as_float(w & 0xffff0000u); }

#define XB_TMO      128
#define XB_XCNT(j)  (256  + 64 * (j))
#define XB_XSUB(j)  (1280 + 64 * (j))
#define XB_XGEN(j)  (2304 + 64 * (j))
#define XB_TOP      3328
#define XB_TOPGEN   3392
#define XCD_BAR_WORDS 3456
#define XB_SPIN_CAP (1u << 18)
__device__ __forceinline__ unsigned xb_ld(unsigned* p)              { return __hip_atomic_load(p, __ATOMIC_RELAXED, __HIP_MEMORY_SCOPE_AGENT); }
__device__ __forceinline__ unsigned xb_add(unsigned* p, unsigned v) { return __hip_atomic_fetch_add(p, v, __ATOMIC_RELAXED, __HIP_MEMORY_SCOPE_AGENT); }
__device__ __forceinline__ unsigned xb_xcc_id() { return (unsigned)__builtin_amdgcn_s_getreg((3 << 11) | 20) & 0xFu; }
#define XB_SPIN(cond, bar) do { unsigned _sp = 0; while (cond) { __builtin_amdgcn_s_sleep(1); \
    if ((++_sp & 255u) == 0u) { if (xb_ld(&(bar)[XB_TMO])) break; if (_sp > XB_SPIN_CAP) { atomicAdd(&(bar)[XB_TMO], 1u); break; } } } } while (0)
struct XcdBarrier { unsigned* bar; unsigned x; volatile LAS unsigned* st; int wave; };
__device__ __forceinline__ XcdBarrier xcd_barrier_post(unsigned* bar, volatile LAS unsigned* st, int wave) {
    XcdBarrier b; b.bar = bar; b.x = xb_xcc_id(); b.st = st; b.wave = wave;
    if (wave == 0 && lane_id() == 0) (void)xb_add(&bar[XB_XCNT(b.x)], 1u);
    return b;
}
__device__ __forceinline__ void xcd_barrier_complete(unsigned* bar, unsigned x, unsigned& nloc, unsigned& nx) {
    const unsigned G = gridDim.x * gridDim.y * gridDim.z;
    unsigned sum, cnt, mine, sp = 0u;
    for (;;) {
        sum = 0u; cnt = 0u; mine = 0u;
#pragma unroll
        for (unsigned j = 0; j < 16; ++j) { const unsigned c = xb_ld(&bar[XB_XCNT(j)]); sum += c; cnt += (c > 0u) ? 1u : 0u; mine = (j == x) ? c : mine; }
        if (sum == G) break;
        __builtin_amdgcn_s_sleep(1);
        if ((++sp & 255u) == 0u) { if (xb_ld(&bar[XB_TMO])) break; if (sp > XB_SPIN_CAP) { atomicAdd(&bar[XB_TMO], 1u); break; } }
    }
    nloc = mine > 0u ? mine : 1u; nx = cnt > 0u ? cnt : 1u;
}
__device__ __forceinline__ void xcd_barrier(const XcdBarrier& b) {
    asm volatile("s_waitcnt vmcnt(0)" ::: "memory");
    __syncthreads();
    if (b.wave == 0 && lane_id() == 0) {
        unsigned* bar = b.bar;
        __builtin_amdgcn_s_waitcnt(0);
        unsigned nloc = b.st[0], nx = b.st[1];
        if (nloc == 0u) { xcd_barrier_complete(bar, b.x, nloc, nx); b.st[0] = nloc; b.st[1] = nx; }
        const unsigned old = xb_add(&bar[XB_XSUB(b.x)], 1u);
        const unsigned gen = old / nloc;
        if (old + 1u == (gen + 1u) * nloc) {
            __builtin_amdgcn_fence(__ATOMIC_RELEASE, "agent");
            asm volatile("s_waitcnt vmcnt(0)" ::: "memory");
            const unsigned og = xb_add(&bar[XB_TOP], 1u);
            const unsigned tg = og / nx;
            if (og + 1u == (tg + 1u) * nx) xb_add(&bar[XB_TOPGEN], 1u);
            else XB_SPIN(xb_ld(&bar[XB_TOPGEN]) == tg, bar);
            __builtin_amdgcn_fence(__ATOMIC_ACQUIRE, "agent");
            xb_add(&bar[XB_XGEN(b.x)], 1u);
            asm volatile("s_waitcnt vmcnt(0)" ::: "memory");
        } else {
            XB_SPIN(xb_ld(&bar[XB_XGEN(b.x)]) == gen, bar);
            __builtin_amdgcn_fence(__ATOMIC_ACQUIRE, "agent");
            asm volatile("s_waitcnt vmcnt(0)" ::: "memory");
        }
    }
    __syncthreads();
}

namespace pg8 {
constexpr int BM = 256, BK = 64, HALF = 128, HTB = HALF * BK * 2, STAGE_BYTES = 8 * HTB, NXCD = 8, WGM = 8;
__host__ __device__ __forceinline__ int lds_byte(int r, int c) { const int st = (r >> 4) * 2 + (c >> 5), rr = r & 15, cc = c & 31, ob = rr * 64 + cc * 2; return st * 1024 + (ob ^ (((ob >> 9) & 1) << 5)); }
__host__ __device__ __forceinline__ void stage_rc(int b, int& R, int& C) { const int st = b / 1024, sb = b % 1024, swz = sb ^ (((sb >> 9) & 1) << 5); R = (st >> 1) * 16 + swz / 64; C = (st & 1) * 32 + (swz % 64) / 2; }
__host__ __device__ __forceinline__ int perm32(int rho) { const int n = rho >> 4, i = rho & 15; return 8 * (i >> 2) + 4 * n + (i & 3); }

struct Unit { const char* A; const char* B; int pm, pn, rows, e, slot0, mt; };

struct DenseSched {
    static constexpr bool PER_UNIT_VOFF = false;
    const char* A; const char* B; int K, nM, nN, nwg, G, c;
    __device__ void init(const void* A_, const void* B_, int M, int N, int K_, int G_, int c_) { A = (const char*)A_; B = (const char*)B_; K = K_; nM = M / BM; nN = N / BM; nwg = nM * nN; G = G_; c = c_; }
    __device__ __forceinline__ bool next(int i, Unit& u) const {
        const int L = i * G + c; if (L >= nwg) return false;
        int wgid = L; { const int q = nwg / NXCD, r = nwg % NXCD, xcd = wgid % NXCD, off = wgid / NXCD; wgid = (xcd < r ? xcd * (q + 1) : r * (q + 1) + (xcd - r) * q) + off; }
        const int nig = WGM * nN, gid = wgid / nig, fm = gid * WGM, gsz = (nM - fm) < WGM ? (nM - fm) : WGM;
        u.pm = fm + ((wgid % nig) % gsz); u.pn = (wgid % nig) / gsz; u.rows = 256; u.e = 0; u.slot0 = 0; u.mt = 0;
        u.A = A + (size_t)u.pm * BM * K * 2; u.B = B + (size_t)u.pn * BM * K * 2; return true;
    }
    __device__ __forceinline__ void voff(const Unit&, const int (&sR)[2], const int (&sC)[2], unsigned (&v)[2][2]) const {
#pragma unroll
        for (int h = 0; h < 2; ++h)
#pragma unroll
            for (int i = 0; i < 2; ++i) v[h][i] = (unsigned)((h * HALF + sR[i]) * K + sC[i]) * 2u;
    }
};

template <bool GATHER> struct ExpertSched {
    static constexpr bool PER_UNIT_VOFF = GATHER;
    static constexpr int K = GATHER ? 1024 : 256, NT = GATHER ? 2 : 4;
    static constexpr unsigned WSTRIDE = GATHER ? 512u * 1024u * 2u : 1024u * 256u * 2u;
    LAS unsigned char* lds;
    const int* lists; const char* A; const char* W; int U, G, c;
    __device__ __forceinline__ bool next(int i, Unit& u) const {
        int L = i * G + c; if (L >= U) return false;
        { const int q = U / NXCD, r = U % NXCD, xcd = L % NXCD, off = L / NXCD; L = (xcd < r ? xcd * (q + 1) : r * (q + 1) + (xcd - r) * q) + off; }
        const LAS int* pref = (const LAS int*)(lds + LDS_PREF);
        int lo = 0, hi = NEXP;
        while (hi - lo > 1) { const int mid = (lo + hi) >> 1; const int pv = __builtin_amdgcn_readfirstlane(pref[mid]); if (NT * pv <= L) lo = mid; else hi = mid; }
        const int e = lo, p0 = __builtin_amdgcn_readfirstlane(pref[e]), p1 = __builtin_amdgcn_readfirstlane(pref[e + 1]), tiles = p1 - p0, r = L - NT * p0;
        u.e = e; u.pn = r / tiles; u.mt = r % tiles; u.pm = 0;
        const int n = __builtin_amdgcn_readfirstlane(((const LAS int*)(lds + LDS_CNT))[e]); u.rows = (n - u.mt * 256) < 256 ? (n - u.mt * 256) : 256;
        u.slot0 = __builtin_amdgcn_readfirstlane(((const LAS int*)(lds + LDS_OFFS))[e]) + u.mt * 256;
        u.A = GATHER ? A : A + (size_t)u.slot0 * (K * 2); u.B = W + (size_t)e * WSTRIDE + (size_t)u.pn * (BM * K * 2); return true;
    }
    __device__ __forceinline__ void voff(const Unit& u, const int (&sR)[2], const int (&sC)[2], unsigned (&v)[2][2]) const {
#pragma unroll
        for (int h = 0; h < 2; ++h)
#pragma unroll
            for (int i = 0; i < 2; ++i) {
                const int r = h * HALF + sR[i];
                if (GATHER) { int tok = 0; if (r < u.rows) tok = lists[(size_t)u.e * LIST_CAP + u.mt * 256 + r] >> 3; v[h][i] = (unsigned)(tok * K + sC[i]) * 2u; }
                else v[h][i] = (unsigned)(r * K + sC[i]) * 2u;
            }
    }
};

template <class Epi, class Sched, bool ALIGN_EPI>
__device__ __forceinline__ void gemm_phase(LAS unsigned char* lds, const int K, const Sched& S, const Epi& E, const int wid) {
    const int lane = lane_id(), tid = wid * 64 + lane, wr = wid >> 2, wc = wid & 3, fr = lane & 15, fq = lane >> 4;
    const int nt = K / BK;
    int sR[2], sC[2]; unsigned voffB[2];
#pragma unroll
    for (int i = 0; i < 2; ++i) { stage_rc(tid * 16 + i * 8192, sR[i], sC[i]); const int Rb = Epi::PERM ? ((sR[i] & ~31) + perm32(sR[i] & 31)) : sR[i]; voffB[i] = (unsigned)(Rb * K + sC[i]) * 2u; }
    const size_t kstep = (size_t)(BK * 2);
    const size_t hstep = (size_t)HALF * K * 2;
    const unsigned ldsw = (unsigned)wid * 1024u;
    const int aoff = lds_byte(wr * 64 + fr, fq * 8), boff = lds_byte(wc * 32 + fr, fq * 8);
#define PG8_SA(b, h) (((b) * 2 + (h)) * HTB)
#define PG8_SB(b, h) ((4 + (b) * 2 + (h)) * HTB)
#define PG8_STAGE(bufoff, gbase, voff) do { _Pragma("unroll") for (int _i = 0; _i < 2; ++_i) \
        __builtin_amdgcn_global_load_lds((const unsigned*)((const char*)(gbase) + (voff)[_i]), (LAS unsigned*)(lds + (bufoff) + ldsw + _i * 8192), 16, 0, 0); } while (0)
#define PG8_STAGE_A(bufoff, gbase, h, vset) do { if constexpr (Sched::PER_UNIT_VOFF) { PG8_STAGE(bufoff, gbase, (vset)[h]); } else { PG8_STAGE(bufoff, (gbase) + (h) * hstep, vc[0]); } } while (0)
#define PG8_LDA(dst, b, h) do { _Pragma("unroll") for (int m = 0; m < 4; ++m) _Pragma("unroll") for (int k = 0; k < 2; ++k) dst[m][k] = *(const LAS bf16x8*)(lds + PG8_SA(b, h) + aoff + m * 2048 + k * 1024); } while (0)
#define PG8_LDB(dst, b, h) do { _Pragma("unroll") for (int n = 0; n < 2; ++n) _Pragma("unroll") for (int k = 0; k < 2; ++k) dst[n][k] = *(const LAS bf16x8*)(lds + PG8_SB(b, h) + boff + n * 2048 + k * 1024); } while (0)
#define PG8_MMA(ai, bj, At, Bt) do { __builtin_amdgcn_s_setprio(1); _Pragma("unroll") for (int m = 0; m < 4; ++m) _Pragma("unroll") for (int n = 0; n < 2; ++n) _Pragma("unroll") for (int k = 0; k < 2; ++k) \
        acc[ai][bj][m][n] = __builtin_amdgcn_mfma_f32_16x16x32_bf16(Bt[n][k], At[m][k], acc[ai][bj][m][n], 0, 0, 0); __builtin_amdgcn_s_setprio(0); } while (0)
#define PG8_WAIT_V(n) asm volatile("s_waitcnt vmcnt(" #n ")" ::: "memory")
#define PG8_WAIT_L(n) asm volatile("s_waitcnt lgkmcnt(" #n ")" ::: "memory")
#define PG8_BAR __builtin_amdgcn_s_barrier()
#define PG8_SCHED __builtin_amdgcn_sched_barrier(0)
    Unit cur, nxt; int ui = 0;
    if (!S.next(0, cur)) return;
    unsigned vc[2][2], vn[2][2];
    S.voff(cur, sR, sC, vc);
    f32x4 acc[2][2][4][2];
#pragma unroll
    for (int a = 0; a < 2; ++a)
#pragma unroll
        for (int b = 0; b < 2; ++b)
#pragma unroll
            for (int m = 0; m < 4; ++m)
#pragma unroll
                for (int n = 0; n < 2; ++n) acc[a][b][m][n] = (f32x4){0.f, 0.f, 0.f, 0.f};
    bf16x8 At[4][2], B0[2][2], B1[2][2];
    const char* cA = cur.A; const char* cB = cur.B;
    PG8_STAGE(PG8_SB(0, 0), cB, voffB); PG8_STAGE(PG8_SB(0, 1), cB + hstep, voffB); PG8_STAGE_A(PG8_SA(0, 0), cA, 0, vc); PG8_STAGE_A(PG8_SA(0, 1), cA, 1, vc);
    if (wr == 1) PG8_BAR;
    PG8_WAIT_V(2); PG8_BAR;
    PG8_STAGE(PG8_SB(1, 0), cB + kstep, voffB); PG8_STAGE_A(PG8_SA(1, 0), cA + kstep, 0, vc); PG8_STAGE(PG8_SB(1, 1), cB + hstep + kstep, voffB);
    PG8_WAIT_V(6); PG8_BAR;
    for (;;) {
        const bool has_next = S.next(ui + 1, nxt);
        if constexpr (Sched::PER_UNIT_VOFF) {
            if (has_next) S.voff(nxt, sR, sC, vn);
            else {
#pragma unroll
                for (int h = 0; h < 2; ++h)
#pragma unroll
                    for (int i = 0; i < 2; ++i) vn[h][i] = vc[h][i];
            }
        }
        const char* nA = has_next ? nxt.A : cA; const char* nB = has_next ? nxt.B : cB;
        for (int t = 0; t < nt; t += 2) {
            const bool last = (t == nt - 2);
            const char* a1 = cA + (size_t)(t + 1) * kstep;
            const char* a2 = last ? nA : cA + (size_t)(t + 2) * kstep; const char* b2 = last ? nB : cB + (size_t)(t + 2) * kstep;
            const char* a3 = a2 + kstep; const char* b3 = b2 + kstep;
            unsigned v2[2][2];
#pragma unroll
            for (int h = 0; h < 2; ++h)
#pragma unroll
                for (int i = 0; i < 2; ++i) v2[h][i] = (Sched::PER_UNIT_VOFF && last) ? vn[h][i] : vc[h][i];
            PG8_LDB(B0, 0, 0); PG8_LDB(B1, 0, 1); PG8_SCHED; PG8_LDA(At, 0, 0); PG8_STAGE_A(PG8_SA(1, 1), a1, 1, vc);
            PG8_WAIT_V(8); PG8_WAIT_L(0); PG8_BAR; PG8_MMA(0, 0, At, B0); PG8_MMA(0, 1, At, B1); PG8_BAR; PG8_SCHED;
            PG8_LDA(At, 0, 1); PG8_STAGE(PG8_SB(0, 0), b2, voffB); PG8_STAGE(PG8_SB(0, 1), b2 + hstep, voffB); PG8_STAGE_A(PG8_SA(0, 0), a2, 0, v2);
            PG8_WAIT_V(8); PG8_WAIT_L(0); PG8_BAR; PG8_MMA(1, 0, At, B0); PG8_MMA(1, 1, At, B1); PG8_BAR; PG8_SCHED;
            PG8_LDB(B0, 1, 0); PG8_LDB(B1, 1, 1); PG8_SCHED; PG8_LDA(At, 1, 0); PG8_STAGE_A(PG8_SA(0, 1), a2, 1, v2);
            PG8_WAIT_V(8); PG8_WAIT_L(0); PG8_BAR; PG8_MMA(0, 0, At, B0); PG8_MMA(0, 1, At, B1); PG8_BAR; PG8_SCHED;
            PG8_LDA(At, 1, 1); PG8_STAGE(PG8_SB(1, 0), b3, voffB); PG8_STAGE(PG8_SB(1, 1), b3 + hstep, voffB); PG8_STAGE_A(PG8_SA(1, 0), a3, 0, v2);
            PG8_WAIT_V(8); PG8_WAIT_L(0); PG8_BAR; PG8_MMA(1, 0, At, B0); PG8_MMA(1, 1, At, B1); PG8_BAR; PG8_SCHED;
        }
        if constexpr (ALIGN_EPI) { if (wr == 0) PG8_BAR; }
        E(acc, cur, wr, wc, fr, fq);
        if (!has_next) break;
#pragma unroll
        for (int a = 0; a < 2; ++a)
#pragma unroll
            for (int b = 0; b < 2; ++b)
#pragma unroll
                for (int m = 0; m < 4; ++m)
#pragma unroll
                    for (int n = 0; n < 2; ++n) acc[a][b][m][n] = (f32x4){0.f, 0.f, 0.f, 0.f};
        cur = nxt; cA = nA; cB = nB; ++ui;
        if constexpr (Sched::PER_UNIT_VOFF) {
#pragma unroll
            for (int h = 0; h < 2; ++h)
#pragma unroll
                for (int i = 0; i < 2; ++i) vc[h][i] = vn[h][i];
        }
        if constexpr (ALIGN_EPI) { if (wr == 1) PG8_BAR; }
    }
    PG8_WAIT_V(0);
    if constexpr (!ALIGN_EPI) { if (wr == 0) PG8_BAR; }
    PG8_BAR;
#undef PG8_SA
#undef PG8_SB
#undef PG8_STAGE
#undef PG8_LDA
#undef PG8_STAGE_A
#undef PG8_LDB
#undef PG8_MMA
#undef PG8_WAIT_V
#undef PG8_WAIT_L
#undef PG8_BAR
#undef PG8_SCHED
}

struct EpiP {
    static constexpr bool PERM = true;
    bf16_t* O; int ldc;
    __device__ __forceinline__ void operator()(const f32x4 (&acc)[2][2][4][2], const Unit& u, int wr, int wc, int fr, int fq) const {
        const int row0 = u.pm * BM + wr * 64 + fr, col0 = u.pn * BM + wc * 32 + 8 * fq;
#pragma unroll
        for (int ai = 0; ai < 2; ++ai)
#pragma unroll
            for (int m = 0; m < 4; ++m) { bf16_t* rowp = O + (size_t)(row0 + ai * HALF + m * 16) * ldc + col0;
#pragma unroll
                for (int bj = 0; bj < 2; ++bj) { const f32x4 v0 = acc[ai][bj][m][0], v1 = acc[ai][bj][m][1];
                    u32x4 w; w.x = cvt_pk_bf16(v0[0], v0[1]); w.y = cvt_pk_bf16(v0[2], v0[3]); w.z = cvt_pk_bf16(v1[0], v1[1]); w.w = cvt_pk_bf16(v1[2], v1[3]);
                    *(u32x4*)(rowp + bj * HALF) = w; } }
    }
};
struct EpiU {
    static constexpr bool PERM = false;
    float* U; const float* X;
    __device__ __forceinline__ void operator()(const f32x4 (&acc)[2][2][4][2], const Unit& u, int wr, int wc, int fr, int fq) const {
        const int row0 = u.pm * BM + wr * 64 + fr, col0 = u.pn * BM + wc * 32 + 4 * fq;
#pragma unroll
        for (int ai = 0; ai < 2; ++ai)
#pragma unroll
            for (int m = 0; m < 4; ++m) { const size_t ro = (size_t)(row0 + ai * HALF + m * 16) * DM + col0;
#pragma unroll
                for (int bj = 0; bj < 2; ++bj)
#pragma unroll
                    for (int n = 0; n < 2; ++n) { const f32x4 xv = *(const f32x4*)(X + ro + bj * HALF + n * 16);
                        *(f32x4*)(U + ro + bj * HALF + n * 16) = xv * ALPHA_F + acc[ai][bj][m][n]; } }
    }
};
struct Epi3 {
    static constexpr bool PERM = true;
    float* LG; bf16_t* HS;
    __device__ __forceinline__ void operator()(const f32x4 (&acc)[2][2][4][2], const Unit& u, int wr, int wc, int fr, int fq) const {
        const int row0 = u.pm * BM + wr * 64 + fr;
        if (u.pn == 0) {
#pragma unroll
            for (int ai = 0; ai < 2; ++ai)
#pragma unroll
                for (int m = 0; m < 4; ++m) { float* rowp = LG + (size_t)(row0 + ai * HALF + m * 16) * 256 + wc * 32 + 8 * fq;
#pragma unroll
                    for (int bj = 0; bj < 2; ++bj)
#pragma unroll
                        for (int n = 0; n < 2; ++n) *(f32x4*)(rowp + bj * HALF + 4 * n) = acc[ai][bj][m][n]; }
        } else {
            const int hc0 = (u.pn - 1) * 128 + wc * 32 + 8 * fq;
#pragma unroll
            for (int ai = 0; ai < 2; ++ai)
#pragma unroll
                for (int m = 0; m < 4; ++m) { bf16_t* rowp = HS + (size_t)(row0 + ai * HALF + m * 16) * 256 + hc0;
                    float h[8];
#pragma unroll
                    for (int n = 0; n < 2; ++n)
#pragma unroll
                        for (int j = 0; j < 4; ++j) h[n * 4 + j] = siluf(acc[ai][0][m][n][j]) * acc[ai][1][m][n][j];
                    u32x4 w; w.x = cvt_pk_bf16(h[0], h[1]); w.y = cvt_pk_bf16(h[2], h[3]); w.z = cvt_pk_bf16(h[4], h[5]); w.w = cvt_pk_bf16(h[6], h[7]);
                    *(u32x4*)rowp = w; }
        }
    }
};
struct EpiH {
    static constexpr bool PERM = true;
    bf16_t* H;
    __device__ __forceinline__ void operator()(const f32x4 (&acc)[2][2][4][2], const Unit& u, int wr, int wc, int fr, int fq) const {
        const int hc0 = u.pn * 128 + wc * 32 + 8 * fq;
#pragma unroll
        for (int ai = 0; ai < 2; ++ai)
#pragma unroll
            for (int m = 0; m < 4; ++m) { const int r = ai * HALF + wr * 64 + m * 16 + fr;
                if (r < u.rows) { bf16_t* rowp = H + (size_t)(u.slot0 + r) * 256 + hc0;
                    float h[8];
#pragma unroll
                    for (int n = 0; n < 2; ++n)
#pragma unroll
                        for (int j = 0; j < 4; ++j) h[n * 4 + j] = siluf(acc[ai][0][m][n][j]) * acc[ai][1][m][n][j];
                    u32x4 w; w.x = cvt_pk_bf16(h[0], h[1]); w.y = cvt_pk_bf16(h[2], h[3]); w.z = cvt_pk_bf16(h[4], h[5]); w.w = cvt_pk_bf16(h[6], h[7]);
                    *(u32x4*)rowp = w; } }
    }
};
struct EpiYb {
    static constexpr bool PERM = true;
    bf16_t* YB; const int* lists; const float* tok_gate;
    __device__ __forceinline__ void operator()(const f32x4 (&acc)[2][2][4][2], const Unit& u, int wr, int wc, int fr, int fq) const {
        const int col0 = u.pn * BM + wc * 32 + 8 * fq;
#pragma unroll
        for (int ai = 0; ai < 2; ++ai)
#pragma unroll
            for (int m = 0; m < 4; ++m) { const int r = ai * HALF + wr * 64 + m * 16 + fr;
                if (r < u.rows) { const float g = tok_gate[lists[(size_t)u.e * LIST_CAP + u.mt * 256 + r]];
                    bf16_t* rowp = YB + (size_t)(u.slot0 + r) * 1024 + col0;
#pragma unroll
                    for (int bj = 0; bj < 2; ++bj) { const f32x4 v0 = acc[ai][bj][m][0] * g, v1 = acc[ai][bj][m][1] * g;
                        u32x4 w; w.x = cvt_pk_bf16(v0[0], v0[1]); w.y = cvt_pk_bf16(v0[2], v0[3]); w.z = cvt_pk_bf16(v1[0], v1[1]); w.w = cvt_pk_bf16(v1[2], v1[3]);
                        *(u32x4*)(rowp + bj * HALF) = w; } } }
    }
};
}

template <int OFF> __device__ __forceinline__ unsigned long long karg_u64() { unsigned long long v;
    asm volatile("s_load_dwordx2 %0, %1, %2\n\ts_waitcnt lgkmcnt(0)" : "=s"(v) : "s"(__builtin_amdgcn_kernarg_segment_ptr()), "i"(OFF)); return v; }
#define KARG_IN(k) ((const float*)karg_u64<8 * (k)>())
#define KARG_OUT() ((float*)karg_u64<184>())
struct Args { const float* in[23]; float* out; unsigned char* ws; int ph_lo, ph_hi, mode, li; };
struct Frame { LAS unsigned char* lds; int wave, G, vcu; unsigned char* ws; unsigned* ctl; };
#define F_LANE lane_id()
#define F_TID (F.wave * 64 + lane_id())
constexpr int NPH = 12;

__device__ __forceinline__ void transpose_item(const float* W, int ldw, int c0, int k0, bf16_t* WT, int K, int row0, LAS float* scr, int lane) {
#pragma unroll 8
    for (int i = 0; i < 32; ++i) { const int kk = 2 * i + (lane >> 5); scr[kk * 33 + (lane & 31)] = W[(size_t)(k0 + kk) * ldw + c0 + (lane & 31)]; }
    asm volatile("s_waitcnt lgkmcnt(0)" ::: "memory");
    const int c = lane & 7;
#pragma unroll
    for (int j = 0; j < 4; ++j) { const int n = (lane >> 3) + 8 * j; const LAS float* s = scr + (8 * c) * 33 + n;
        u32x4 o; o.x = cvt_pk_bf16(s[0 * 33], s[1 * 33]); o.y = cvt_pk_bf16(s[2 * 33], s[3 * 33]); o.z = cvt_pk_bf16(s[4 * 33], s[5 * 33]); o.w = cvt_pk_bf16(s[6 * 33], s[7 * 33]);
        *(u32x4*)(WT + (size_t)(row0 + n) * K + k0 + 8 * c) = o; }
    asm volatile("s_waitcnt lgkmcnt(0)" ::: "memory");
}

__device__ __forceinline__ void gu_item(const float* Wg, const float* Wu, bf16_t* WT, int item, LAS float* scr, int lane) {
    const int kb = item >> 4, nb = item & 15, row0 = nb * 32, pn = row0 >> 8, half = (row0 >> 7) & 1, r0 = row0 & 127;
    transpose_item(half ? Wu : Wg, 256, pn * 128 + r0, kb * 64, WT, 1024, row0, scr, lane);
}

__device__ __forceinline__ void phase_prep(const Frame& F, const Args& a) {
    LAS float* scr = (LAS float*)(F.lds + F.wave * 16384);
    const int gw = F.vcu * 8 + F.wave, NGW = F.G * 8;
    unsigned char* ws = F.ws;
    bf16_t* Win_t = (bf16_t*)(ws + WS_WIN_T); bf16_t* Wout_t = (bf16_t*)(ws + WS_WOUT_T); bf16_t* W3_t = (bf16_t*)(ws + WS_W3_T); bf16_t* Wds_t = (bf16_t*)(ws + WS_WDS_T);
    bf16_t* Wgu_t = (bf16_t*)(ws + WS_WGU_T); bf16_t* Wd_t = (bf16_t*)(ws + WS_WD_T);
    const float* w_in = KARG_IN(1); const float* w_out = KARG_IN(10); const float* w_router = KARG_IN(13);
    const float* wge = KARG_IN(15); const float* wue = KARG_IN(16); const float* wde = KARG_IN(17);
    const float* wgs = KARG_IN(18); const float* wus = KARG_IN(19); const float* wds = KARG_IN(20);
    constexpr int I_IN = 16 * (PW / 32), I_OUT = 16 * 32, I_R = 16 * 8, I_S = 16 * 16, I_DS = 4 * 32, I_EGU = 16 * 16, I_ED = 4 * 32;
#if defined(MK_OLD_EXPERTS)
    constexpr int NITEMS = I_IN + I_OUT + I_R + I_S + I_DS + NEXP * (I_EGU + I_ED);
#else
    constexpr int NITEMS = I_IN + I_OUT + I_R + I_S + I_DS;
#endif
    for (int it = gw; it < NITEMS; it += NGW) {
        int r = it;
        if (r < I_IN) { const int kb = r / (PW / 32), nb = r % (PW / 32), row0 = nb * 32; const int c0 = row0 < 1536 ? row0 : row0 + 8;
            transpose_item(w_in, NIN, c0, kb * 64, Win_t, 1024, row0, scr, F_LANE); continue; } r -= I_IN;
        if (r < I_OUT) { transpose_item(w_out, 1024, (r & 31) * 32, (r >> 5) * 64, Wout_t, 1024, (r & 31) * 32, scr, F_LANE); continue; } r -= I_OUT;
        if (r < I_R) { transpose_item(w_router, 256, (r & 7) * 32, (r >> 3) * 64, W3_t, 1024, (r & 7) * 32, scr, F_LANE); continue; } r -= I_R;
        if (r < I_S) { gu_item(wgs, wus, W3_t + (size_t)256 * 1024, r, scr, F_LANE); continue; } r -= I_S;
        if (r < I_DS) { transpose_item(wds, 1024, (r & 31) * 32, (r >> 5) * 64, Wds_t, 256, (r & 31) * 32, scr, F_LANE); continue; } r -= I_DS;
        const int e = r / (I_EGU + I_ED), q = r % (I_EGU + I_ED);
        if (q < I_EGU) gu_item(wge + (size_t)e * 1024 * 256, wue + (size_t)e * 1024 * 256, Wgu_t + (size_t)e * 512 * 1024, q, scr, F_LANE);
        else { const int qq = q - I_EGU; transpose_item(wde + (size_t)e * 256 * 1024, 1024, (qq & 31) * 32, (qq >> 5) * 64, Wd_t + (size_t)e * 1024 * 256, 256, (qq & 31) * 32, scr, F_LANE); }
    }
    const float* x = KARG_IN(0); bf16_t* xb = (bf16_t*)(ws + WS_XB); float* dtraw = (float*)(ws + WS_DTRAW);
    float wdt[16][8];
#pragma unroll
    for (int j = 0; j < 16; ++j) { const int k = (j < 8 ? 8 * F_LANE + j : 512 + 8 * F_LANE + (j - 8));
#pragma unroll
        for (int h = 0; h < 8; ++h) wdt[j][h] = w_in[(size_t)k * NIN + 1536 + h]; }
    f32x4 n0, n1, n2, n3;
    { const float* xr = x + (size_t)(gw < T_TOK ? gw : 0) * DM; n0 = *(const f32x4*)(xr + 8 * F_LANE); n1 = *(const f32x4*)(xr + 8 * F_LANE + 4); n2 = *(const f32x4*)(xr + 512 + 8 * F_LANE); n3 = *(const f32x4*)(xr + 512 + 8 * F_LANE + 4); }
    for (int t = gw; t < T_TOK; t += NGW) {
        const f32x4 a0 = n0, a1 = n1, b0 = n2, b1 = n3;
        { const int tn = t + NGW < T_TOK ? t + NGW : t; const float* xr = x + (size_t)tn * DM;
          n0 = *(const f32x4*)(xr + 8 * F_LANE); n1 = *(const f32x4*)(xr + 8 * F_LANE + 4); n2 = *(const f32x4*)(xr + 512 + 8 * F_LANE); n3 = *(const f32x4*)(xr + 512 + 8 * F_LANE + 4); }
        u32x4 w0; w0.x = cvt_pk_bf16(a0[0], a0[1]); w0.y = cvt_pk_bf16(a0[2], a0[3]); w0.z = cvt_pk_bf16(a1[0], a1[1]); w0.w = cvt_pk_bf16(a1[2], a1[3]);
        u32x4 w1; w1.x = cvt_pk_bf16(b0[0], b0[1]); w1.y = cvt_pk_bf16(b0[2], b0[3]); w1.z = cvt_pk_bf16(b1[0], b1[1]); w1.w = cvt_pk_bf16(b1[2], b1[3]);
        *(u32x4*)(xb + (size_t)t * DM + 8 * F_LANE) = w0; *(u32x4*)(xb + (size_t)t * DM + 512 + 8 * F_LANE) = w1;
        const float xv[16] = {a0[0], a0[1], a0[2], a0[3], a1[0], a1[1], a1[2], a1[3], b0[0], b0[1], b0[2], b0[3], b1[0], b1[1], b1[2], b1[3]};
        float d[8];
#pragma unroll
        for (int h = 0; h < 8; ++h) { float sm = 0.f;
#pragma unroll
            for (int j = 0; j < 16; ++j) sm = fmaf(xv[j], wdt[j][h], sm);
            d[h] = wave_sum(sm); }
        if (F_LANE == 0) { *(f32x4*)(dtraw + t * 8) = (f32x4){d[0], d[1], d[2], d[3]}; *(f32x4*)(dtraw + t * 8 + 4) = (f32x4){d[4], d[5], d[6], d[7]}; }
    }
}

__device__ __forceinline__ void phase_ln1(const Frame& F, const Args& a) {
    const int gw = F.vcu * 8 + F.wave, NGW = F.G * 8;
    float* h1 = (float*)(F.ws + WS_H1); bf16_t* h1b = (bf16_t*)(F.ws + WS_H1B);
    const float* g = KARG_IN(11); const float* b = KARG_IN(12);
    const int c0 = 8 * F_LANE;
    f32x4 gv[4], bv[4];
    gv[0] = *(const f32x4*)(g + c0); gv[1] = *(const f32x4*)(g + c0 + 4); gv[2] = *(const f32x4*)(g + 512 + c0); gv[3] = *(const f32x4*)(g + 512 + c0 + 4);
    bv[0] = *(const f32x4*)(b + c0); bv[1] = *(const f32x4*)(b + c0 + 4); bv[2] = *(const f32x4*)(b + 512 + c0); bv[3] = *(const f32x4*)(b + 512 + c0 + 4);
    for (int t = gw; t < T_TOK; t += NGW) {
        float* r = h1 + (size_t)t * DM;
        f32x4 v[4]; v[0] = *(const f32x4*)(r + c0); v[1] = *(const f32x4*)(r + c0 + 4); v[2] = *(const f32x4*)(r + 512 + c0); v[3] = *(const f32x4*)(r + 512 + c0 + 4);
        float s = 0.f;
#pragma unroll
        for (int j = 0; j < 4; ++j) s += (v[j][0] + v[j][1]) + (v[j][2] + v[j][3]);
        const float mu = wave_sum(s) * (1.0f / 1024.0f);
        float q = 0.f;
#pragma unroll
        for (int j = 0; j < 4; ++j) { v[j] = v[j] - mu; q += (v[j][0] * v[j][0] + v[j][1] * v[j][1]) + (v[j][2] * v[j][2] + v[j][3] * v[j][3]); }
        const float rs = rsqrtf(wave_sum(q) * (1.0f / 1024.0f) + LN_EPS_F);
#pragma unroll
        for (int j = 0; j < 4; ++j) v[j] = v[j] * rs * gv[j] + bv[j];
        u32x4 w0; w0.x = cvt_pk_bf16(v[0][0], v[0][1]); w0.y = cvt_pk_bf16(v[0][2], v[0][3]); w0.z = cvt_pk_bf16(v[1][0], v[1][1]); w0.w = cvt_pk_bf16(v[1][2], v[1][3]);
        u32x4 w1; w1.x = cvt_pk_bf16(v[2][0], v[2][1]); w1.y = cvt_pk_bf16(v[2][2], v[2][3]); w1.z = cvt_pk_bf16(v[3][0], v[3][1]); w1.w = cvt_pk_bf16(v[3][2], v[3][3]);
        *(u32x4*)(h1b + (size_t)t * DM + c0) = w0; *(u32x4*)(h1b + (size_t)t * DM + 512 + c0) = w1;
    }
}

__device__ __forceinline__ void phase_route(const Frame& F, const Args& a) {
    const int gw = F.vcu * 8 + F.wave, NGW = F.G * 8, lane = F_LANE;
    const float* logits = (const float*)(F.ws + WS_LOGITS); const float* rbias = KARG_IN(14);
    int* counts = (int*)(F.ctl + CW_COUNTS); int* tok_e = (int*)(F.ws + WS_TOKE); int* tok_pos = (int*)(F.ws + WS_TOKPOS); float* tok_gate = (float*)(F.ws + WS_TOKGATE);
    int* lists = (int*)(F.ws + WS_LISTS);
    const f32x4 rb = *(const f32x4*)(rbias + lane * 4);
    f32x4 lgn = *(const f32x4*)(logits + (size_t)(gw < T_TOK ? gw : 0) * 256 + lane * 4);
    for (int t = gw; t < T_TOK; t += NGW) {
        const f32x4 lg = lgn;
        { const int tn = t + NGW < T_TOK ? t + NGW : t; lgn = *(const f32x4*)(logits + (size_t)tn * 256 + lane * 4); }
        float sc[4] = {sigmf(lg[0]), sigmf(lg[1]), sigmf(lg[2]), sigmf(lg[3])};
        float bs[4] = {sc[0] + rb[0], sc[1] + rb[1], sc[2] + rb[2], sc[3] + rb[3]};
        float m1 = fmaxf(bs[0], bs[1]), m2 = fminf(bs[0], bs[1]);
        { const float n1 = fmaxf(bs[2], bs[3]), n2 = fminf(bs[2], bs[3]);
          const float a1 = fmaxf(m1, n1), a2 = fmaxf(fminf(m1, n1), fmaxf(m2, n2)); m1 = a1; m2 = a2; }
#pragma unroll
        for (int o = 1; o < 8; o <<= 1) {
            const float n1 = __shfl_xor(m1, o), n2 = __shfl_xor(m2, o);
            const float a1 = fmaxf(m1, n1), a2 = fmaxf(fminf(m1, n1), fmaxf(m2, n2)); m1 = a1; m2 = a2;
        }
        const float gs = m1 + m2; const int mygrp = lane >> 3; int rank = 0;
#pragma unroll
        for (int gI = 0; gI < 8; ++gI) { const float og = __shfl(gs, gI * 8); rank += (og > gs || (og == gs && gI < mygrp)) ? 1 : 0; }
        const bool sel = rank < 4;
        float cand[4];
#pragma unroll
        for (int j = 0; j < 4; ++j) cand[j] = sel ? bs[j] : -INFINITY;
        int my_e = -1; float my_s = 0.f; float gsum = 0.f;
#pragma unroll 1
        for (int k = 0; k < 8; ++k) {
            float bv = cand[0]; int bi = 0;
#pragma unroll
            for (int j = 1; j < 4; ++j) if (cand[j] > bv) { bv = cand[j]; bi = j; }
            int be = lane * 4 + bi;
#pragma unroll
            for (int o = 1; o < 64; o <<= 1) {
                const float ov = __shfl_xor(bv, o); const int oe = __shfl_xor(be, o);
                if (ov > bv || (ov == bv && oe < be)) { bv = ov; be = oe; }
            }
            const int wj = be & 3;
            const float mysc = wj == 0 ? sc[0] : wj == 1 ? sc[1] : wj == 2 ? sc[2] : sc[3];
            const float wsc = __shfl(mysc, be >> 2);
            if (lane == (be >> 2)) {
#pragma unroll
                for (int j = 0; j < 4; ++j) if (j == wj) cand[j] = -INFINITY;
            }
            gsum += wsc;
            if (lane == k) { my_e = be; my_s = wsc; }
        }
        if (lane < 8) {
            const float gate = my_s / gsum * 2.5f;
            const int pos = atomicAdd(&counts[my_e * CNT_STRIDE], 1);
            tok_e[t * 8 + lane] = my_e; tok_pos[t * 8 + lane] = pos; tok_gate[t * 8 + lane] = gate;
            lists[(size_t)my_e * LIST_CAP + pos] = t * 8 + lane;
        }
    }
}

__device__ __forceinline__ void build_tables(const Frame& F) {
    const int* counts = (const int*)(F.ctl + CW_COUNTS);
    LAS int* pref = (LAS int*)(F.lds + LDS_PREF); LAS int* offs = (LAS int*)(F.lds + LDS_OFFS); LAS int* cnt = (LAS int*)(F.lds + LDS_CNT);
    LAS int* wt = (LAS int*)(F.lds);
    const int tid = F_TID, lane = tid & 63;
    __syncthreads();
    int n = 0, nt = 0, in_ = 0, it_ = 0;
    if (F.wave < 4) {
        n = __hip_atomic_load(&counts[tid * CNT_STRIDE], __ATOMIC_RELAXED, __HIP_MEMORY_SCOPE_AGENT); nt = (n + 255) >> 8; in_ = n; it_ = nt;
#pragma unroll
        for (int o = 1; o < 64; o <<= 1) { const int a = __shfl_up(in_, o), b = __shfl_up(it_, o); if (lane >= o) { in_ += a; it_ += b; } }
        if (lane == 63) { wt[F.wave] = in_; wt[4 + F.wave] = it_; }
    }
    __syncthreads();
    if (F.wave < 4) {
        for (int w = 0; w < F.wave; ++w) { in_ += wt[w]; it_ += wt[4 + w]; }
        cnt[tid] = n; offs[tid] = in_ - n; pref[tid] = it_ - nt;
        if (tid == NEXP - 1) { offs[NEXP] = in_; pref[NEXP] = it_; }
    }
    __syncthreads();
}

__device__ __forceinline__ void phase_final(const Frame& F, const Args& a) {
    const int gw = F.vcu * 8 + F.wave, NGW = F.G * 8;
    const float* h1 = (const float*)(F.ws + WS_H1); const bf16_t* ys = (const bf16_t*)(F.ws + WS_YS); const bf16_t* yb = (const bf16_t*)(F.ws + WS_YB);
    const int* tok_e = (const int*)(F.ws + WS_TOKE); const int* tok_pos = (const int*)(F.ws + WS_TOKPOS);
    const LAS int* offs = (const LAS int*)(F.lds + LDS_OFFS);
    const float* g = KARG_IN(21); const float* b = KARG_IN(22); float* out = KARG_OUT();
    const int c0 = 8 * F_LANE;
    f32x4 gv[4], bv[4];
    gv[0] = *(const f32x4*)(g + c0); gv[1] = *(const f32x4*)(g + c0 + 4); gv[2] = *(const f32x4*)(g + 512 + c0); gv[3] = *(const f32x4*)(g + 512 + c0 + 4);
    bv[0] = *(const f32x4*)(b + c0); bv[1] = *(const f32x4*)(b + c0 + 4); bv[2] = *(const f32x4*)(b + 512 + c0); bv[3] = *(const f32x4*)(b + 512 + c0 + 4);
    const int lane8 = F_LANE;
    const bf16_t* h1b = (const bf16_t*)(F.ws + WS_H1B); const unsigned char* yb8 = (const unsigned char*)(F.ws + WS_YB);
    int ekn = 0, pkn = 0;
    if (gw < T_TOK && lane8 < 8) { ekn = tok_e[gw * 8 + lane8]; pkn = tok_pos[gw * 8 + lane8]; }
    for (int t = gw; t < T_TOK; t += NGW) {
        const int myrow = lane8 < 8 ? offs[ekn] + pkn : 0;
        const u32x4 r0 = *(const u32x4*)(h1b + (size_t)t * DM + c0), r1 = *(const u32x4*)(h1b + (size_t)t * DM + 512 + c0);
        const u32x4 s0 = *(const u32x4*)(ys + (size_t)t * DM + c0), s1 = *(const u32x4*)(ys + (size_t)t * DM + 512 + c0);
        u32x2 W[8][2];
#pragma unroll
        for (int k = 0; k < 8; ++k) { const unsigned char* src = yb8 + (size_t)__shfl(myrow, k) * 1024; W[k][0] = *(const u32x2*)(src + c0); W[k][1] = *(const u32x2*)(src + 512 + c0); }
        { const int tn = t + NGW; if (tn < T_TOK && lane8 < 8) { ekn = tok_e[tn * 8 + lane8]; pkn = tok_pos[tn * 8 + lane8]; } }
        f32x4 v[4], y[4];
        v[0] = (f32x4){bflo(r0.x), bfhi(r0.x), bflo(r0.y), bfhi(r0.y)}; v[1] = (f32x4){bflo(r0.z), bfhi(r0.z), bflo(r0.w), bfhi(r0.w)};
        v[2] = (f32x4){bflo(r1.x), bfhi(r1.x), bflo(r1.y), bfhi(r1.y)}; v[3] = (f32x4){bflo(r1.z), bfhi(r1.z), bflo(r1.w), bfhi(r1.w)};
#pragma unroll
        for (int j = 0; j < 4; ++j) { v[j] = v[j] * ALPHA_F; y[j] = (f32x4){0.f, 0.f, 0.f, 0.f}; }
        v[0] = v[0] + (f32x4){bflo(s0.x), bfhi(s0.x), bflo(s0.y), bfhi(s0.y)}; v[1] = v[1] + (f32x4){bflo(s0.z), bfhi(s0.z), bflo(s0.w), bfhi(s0.w)};
        v[2] = v[2] + (f32x4){bflo(s1.x), bfhi(s1.x), bflo(s1.y), bfhi(s1.y)}; v[3] = v[3] + (f32x4){bflo(s1.z), bfhi(s1.z), bflo(s1.w), bfhi(s1.w)};
#pragma unroll
        for (int k = 0; k < 8; ++k) { y[0] = y[0] + un4_fp8(W[k][0].x); y[1] = y[1] + un4_fp8(W[k][0].y); y[2] = y[2] + un4_fp8(W[k][1].x); y[3] = y[3] + un4_fp8(W[k][1].y); }
#pragma unroll
        for (int j = 0; j < 4; ++j) v[j] = v[j] + y[j] * (1.0f / YB_SCALE);
        float s = 0.f;
#pragma unroll
        for (int j = 0; j < 4; ++j) s += (v[j][0] + v[j][1]) + (v[j][2] + v[j][3]);
        const float mu = wave_sum(s) * (1.0f / 1024.0f);
        float q = 0.f;
#pragma unroll
        for (int j = 0; j < 4; ++j) { v[j] = v[j] - mu; q += (v[j][0] * v[j][0] + v[j][1] * v[j][1]) + (v[j][2] * v[j][2] + v[j][3] * v[j][3]); }
        const float rs = rsqrtf(wave_sum(q) * (1.0f / 1024.0f) + LN_EPS_F);
        float* o = out + (size_t)t * DM;
#pragma unroll
        for (int j = 0; j < 4; ++j) v[j] = v[j] * rs * gv[j] + bv[j];
        *(f32x4*)(o + c0) = v[0]; *(f32x4*)(o + c0 + 4) = v[1]; *(f32x4*)(o + 512 + c0) = v[2]; *(f32x4*)(o + 512 + c0 + 4) = v[3];
    }
}


namespace xk {
constexpr int B_IMG = 16384, A_SLOT = 16384, L_B0 = 0, L_A0 = 4 * B_IMG, L_GATE = 8 * 16384;
typedef __amdgpu_buffer_rsrc_t rsrc_t;
__device__ __forceinline__ rsrc_t make_rsrc(const void* p) { return __builtin_amdgcn_make_buffer_rsrc((void*)p, 0, 0x7fffffff, 0x00020000); }
__device__ __forceinline__ u32x4 make_srd(const void* p) { const unsigned long long v = (unsigned long long)p; u32x4 d;
    d.x = (unsigned)__builtin_amdgcn_readfirstlane((int)(unsigned)v); d.y = (unsigned)__builtin_amdgcn_readfirstlane((int)(unsigned)(v >> 32)) & 0xffffu; d.z = 0x7fffffffu; d.w = 0x00020000u; return d; }
__device__ __forceinline__ void dma16(const u32x4 srd, unsigned voff, int soff, unsigned lds_addr) {
    asm volatile("s_mov_b32 m0, %0\n\ts_nop 0\n\tbuffer_load_dwordx4 %1, %2, %3 offen lds" :: "s"(lds_addr), "v"(voff), "s"(srd), "s"(soff) : "m0", "memory");
}
__device__ __forceinline__ void a_piece_rc(int b, int& R, int& C) { const int st = b >> 10, sb = b & 1023, ob = sb ^ (((sb >> 9) & 1) << 5); R = st * 16 + (ob >> 6); C = (ob & 63) >> 1; }
struct PassDesc { u32x4 ra; unsigned aoff[2]; rsrc_t rb0, rb1; int bcol, ncol; unsigned boff; int nh; bool preloaded, chain; };
typedef f32x4 Acc[2][4][2][2];

template <bool GU> __device__ __forceinline__ void kloop(LAS unsigned char* lds, const PassDesc& P, const int wid, const int lane, const int bir, Acc& acc, f32x4 (&Br)[4][4]) {
    const int wr = wid >> 2, wc = wid & 3, fr = lane & 15, fq = lane >> 4, hl = lane >> 5;
    const int KB = GU ? 32 * 256 * 4 : 32 * 1024 * 4;
#define XK_DMAA(hh, slot) do { _Pragma("unroll") for (int _i = 0; _i < 2; ++_i) dma16(P.ra, P.aoff[_i], (hh) * 64, (unsigned)(size_t)(lds + L_A0 + (slot) * A_SLOT + _i * 8192 + wid * 1024)); } while (0)
#define XK_LOADB(col, hh, st) do { _Pragma("unroll") for (int _i = 0; _i < 4; ++_i) { \
            const u32x4 _v = GU ? __builtin_amdgcn_raw_buffer_load_b128((_i >> 1) ? P.rb1 : P.rb0, P.boff, (col) + (hh) * KB + (_i & 1) * (2 * 256 * 4), 0) \
                                : __builtin_amdgcn_raw_buffer_load_b128(P.rb0, P.boff, (col) + (hh) * KB + _i * (1024 * 4), 0); \
            Br[st][_i] = __builtin_bit_cast(f32x4, _v); } } while (0)
    const unsigned swg = (unsigned)(((wid >> 1) & 1) << 4);
    unsigned bw0 = (unsigned)(size_t)(lds + L_B0) + (GU ? (4 * wid + hl) * 512 + (bir ^ (hl << 7) ^ swg) : 4 * wid * 512 + (bir ^ swg));
    const int q = (lane & 15) >> 2, p = lane & 3;
    unsigned br0 = (unsigned)(size_t)(lds + L_B0) + (8 * fq + q) * 512 + ((128 * wc + 32 * p) ^ ((q & 1) << 7) ^ (((q >> 1) & 1) << 3) ^ ((fq & 1) << 4));
    const LAS unsigned char* arp = lds + L_A0 + (wr * 4) * 1024 + ((fr * 64 + 16 * fq) ^ ((fr >> 3) << 5));
#define XK_WRITEB(st, img) do { _Pragma("unroll") for (int _i = 0; _i < 4; ++_i) { u32x2 _w; _w.x = cvt_pk_bf16(Br[st][_i][0], Br[st][_i][1]); _w.y = cvt_pk_bf16(Br[st][_i][2], Br[st][_i][3]); \
        if (GU) *(LAS u32x2*)(size_t)((bw0 ^ (unsigned)(((_i >> 1) << 4) | ((_i & 1) << 3))) + (img) * B_IMG + 2 * (_i & 1) * 512) = _w; \
        else *(LAS u32x2*)(size_t)((bw0 ^ (unsigned)(((_i & 1) << 7) | (((_i >> 1) & 1) << 3))) + (img) * B_IMG + _i * 512) = _w; } } while (0)
#define XK_FRAGS(slot, img) do { \
        _Pragma("unroll") for (int gI = 0; gI < 2; ++gI) _Pragma("unroll") for (int nn = 0; nn < 2; ++nn) { \
            const LAS unsigned char* _a = (const LAS unsigned char*)(size_t)((br0 ^ (unsigned)(16 * gI + 8 * nn)) + (img) * B_IMG); \
            const s16x4 _lo = __builtin_amdgcn_ds_read_tr16_b64_v4i16((LAS s16x4*)_a), _hi = __builtin_amdgcn_ds_read_tr16_b64_v4i16((LAS s16x4*)(_a + 2048)); \
            wf[gI][nn] = (bf16x8){_lo[0], _lo[1], _lo[2], _lo[3], _hi[0], _hi[1], _hi[2], _hi[3]}; } \
        _Pragma("unroll") for (int ai = 0; ai < 2; ++ai) _Pragma("unroll") for (int m = 0; m < 4; ++m) xf[ai][m] = *(const LAS bf16x8*)(arp + (slot) * A_SLOT + (8 * ai + m) * 1024); } while (0)
#define XK_MMA() do { __builtin_amdgcn_s_setprio(1); \
        _Pragma("unroll") for (int ai = 0; ai < 2; ++ai) _Pragma("unroll") for (int m = 0; m < 4; ++m) _Pragma("unroll") for (int gI = 0; gI < 2; ++gI) _Pragma("unroll") for (int nn = 0; nn < 2; ++nn) \
            acc[ai][m][gI][nn] = __builtin_amdgcn_mfma_f32_16x16x32_bf16(wf[gI][nn], xf[ai][m], acc[ai][m][gI][nn], 0, 0, 0); \
        __builtin_amdgcn_s_setprio(0); } while (0)
    bf16x8 wf[2][2], xf[2][4];
    const int nh = P.nh;
    if (!P.preloaded) {
        XK_LOADB(P.bcol, 0, 0); XK_LOADB(P.bcol, 1, 1); XK_LOADB(P.bcol, 2, 2); XK_DMAA(0, 0); XK_DMAA(1, 1);
        XK_WRITEB(0, 0);
        asm volatile("s_waitcnt vmcnt(0)" ::: "memory");
        __syncthreads();
    }
    const int tcol = P.chain ? P.ncol : P.bcol;
    if (wid >= 4) __builtin_amdgcn_s_barrier();
#define XK_ITER(j) do { const int _h = hb + (j); asm volatile("" : "+v"(bw0), "+v"(br0));     \
        { const bool _in2 = _h + 2 < nh; XK_DMAA(_in2 ? _h + 2 : _h + 2 - nh, ((j) + 2) & 3); \
          const bool _in3 = _h + 3 < nh; XK_LOADB(_in3 ? P.bcol : tcol, _in3 ? _h + 3 : _h + 3 - nh, ((j) + 3) & 3); } \
        XK_WRITEB(((j) + 1) & 3, ((j) + 1) & 3); \
        XK_FRAGS((j), (j));        \
        asm volatile("s_waitcnt vmcnt(10)" ::: "memory");     \
        asm volatile("s_waitcnt lgkmcnt(0)" ::: "memory"); __builtin_amdgcn_sched_barrier(0); __builtin_amdgcn_s_barrier(); __builtin_amdgcn_sched_barrier(0); \
        XK_MMA(); \
        __builtin_amdgcn_sched_barrier(0); __builtin_amdgcn_s_barrier(); __builtin_amdgcn_sched_barrier(0); } while (0)
    for (int hb = 0; hb < nh; hb += 4) { XK_ITER(0); XK_ITER(1); XK_ITER(2); XK_ITER(3); }
    if (wid < 4) __builtin_amdgcn_s_barrier();
#undef XK_ITER
#undef XK_DMAA
#undef XK_LOADB
#undef XK_WRITEB
#undef XK_FRAGS
#undef XK_MMA
}
}

__device__ __forceinline__ void phase_experts(const Frame& F, const Args& a, const int mode) {
    build_tables(F);
    const int wid = F.wave, wr = wid >> 2, wc = wid & 3;
    const LAS int* pref = (const LAS int*)(F.lds + LDS_PREF);
    const int U = __builtin_amdgcn_readfirstlane(pref[NEXP]);
    const int* lists = (const int*)(F.ws + WS_LISTS); const float* tok_gate = (const float*)(F.ws + WS_TOKGATE);
    const char* h1b = (const char*)(F.ws + WS_H1B); bf16_t* H = (bf16_t*)(F.ws + WS_H); bf16_t* YB = (bf16_t*)(F.ws + WS_YB);
    f32x4 Br[4][4];
    for (int ui = 0;; ++ui) {
        int L = ui * F.G + blockIdx.x; if (L >= U) break;
        { const int qq = U / 8, rr = U % 8, xcd = L % 8, off = L / 8; L = (xcd < rr ? xcd * (qq + 1) : rr * (qq + 1) + (xcd - rr) * qq) + off; }
        int lo = 0, hi = NEXP;
        while (hi - lo > 1) { const int mid = (lo + hi) >> 1; const int pv = __builtin_amdgcn_readfirstlane(pref[mid]); if (pv <= L) lo = mid; else hi = mid; }
        const int e = lo, mt = L - __builtin_amdgcn_readfirstlane(pref[e]);
        const int n = __builtin_amdgcn_readfirstlane(((const LAS int*)(F.lds + LDS_CNT))[e]);
        const int rows = (n - mt * 256) < 256 ? (n - mt * 256) : 256;
        const int slot0 = __builtin_amdgcn_readfirstlane(((const LAS int*)(F.lds + LDS_OFFS))[e]) + mt * 256;
        const int* lst = lists + (size_t)e * LIST_CAP + mt * 256;
        { const int t = wid * 64 + lane_id();
          if (t < 256) ((LAS float*)(F.lds + xk::L_GATE))[t] = t < rows ? tok_gate[lst[t]] : 0.f; }
        const int ew = (mode & 1) ? 0 : e;
        const float* Wg = KARG_IN(15) + (size_t)ew * 1024 * 256; const float* Wu = KARG_IN(16) + (size_t)ew * 1024 * 256; const float* Wd = KARG_IN(17) + (size_t)ew * 256 * 1024;
        {
            xk::PassDesc P; P.ra = xk::make_srd(h1b);
            { const int lane = lane_id(), tid = wid * 64 + lane;
#pragma unroll
              for (int i = 0; i < 2; ++i) { int R, C; xk::a_piece_rc(tid * 16 + i * 8192, R, C); int tok = 0; if (R < rows) tok = lst[R] >> 3; if (mode & 2) tok = (slot0 + R) & 16383; P.aoff[i] = (unsigned)(tok * 1024 + C) * 2u; }
              P.boff = (unsigned)((4 * wid + (lane >> 5)) * 256 + 4 * (lane & 31)) * 4u; }
            P.nh = 32; P.rb0 = xk::make_rsrc(Wg); P.rb1 = xk::make_rsrc(Wu);
#pragma unroll 1
            for (int pn = 0; pn < 2; ++pn) {
                P.bcol = pn * 128 * 4; P.ncol = 128 * 4;
                P.preloaded = pn == 1; P.chain = pn == 0;
                xk::Acc acc;
#pragma unroll
                for (int ai = 0; ai < 2; ++ai)
#pragma unroll
                    for (int m = 0; m < 4; ++m)
#pragma unroll
                        for (int gI = 0; gI < 2; ++gI)
#pragma unroll
                            for (int nn = 0; nn < 2; ++nn) acc[ai][m][gI][nn] = (f32x4){0.f, 0.f, 0.f, 0.f};
                { const int lane = lane_id(); xk::kloop<true>(F.lds, P, wid, lane, 128 * ((lane & 31) >> 3) + 32 * (((lane & 31) >> 1) & 3) + 8 * (lane & 1), acc, Br); }
                const int lane = lane_id(), fr = lane & 15, fq = lane >> 4;
                const xk::rsrc_t rH = xk::make_rsrc(H + (size_t)slot0 * 256);
#pragma unroll
                for (int ai = 0; ai < 2; ++ai)
#pragma unroll
                    for (int m = 0; m < 4; ++m) { const int r = ai * 128 + wr * 64 + m * 16 + fr;
                        if (r < rows && !(mode & 4) && !(mode & 16)) { float h[8];
#pragma unroll
                            for (int nn = 0; nn < 2; ++nn)
#pragma unroll
                                for (int j = 0; j < 4; ++j) h[nn * 4 + j] = siluf(acc[ai][m][0][nn][j]) * acc[ai][m][1][nn][j];
                            u32x4 w; w.x = cvt_pk_bf16(h[0], h[1]); w.y = cvt_pk_bf16(h[2], h[3]); w.z = cvt_pk_bf16(h[4], h[5]); w.w = cvt_pk_bf16(h[6], h[7]);
                            __builtin_amdgcn_raw_buffer_store_b128(w, rH, (unsigned)(r * 256 + pn * 128 + wc * 32 + 8 * fq) * 2u, 0, 0); } }
            }
        }
        asm volatile("s_waitcnt vmcnt(0)" ::: "memory");
        __syncthreads();
        {
            xk::PassDesc P; P.ra = xk::make_srd(H + (size_t)slot0 * 256);
            { const int lane = lane_id(), tid = wid * 64 + lane;
#pragma unroll
              for (int i = 0; i < 2; ++i) { int R, C; xk::a_piece_rc(tid * 16 + i * 8192, R, C); P.aoff[i] = (unsigned)(R * 256 + C) * 2u; }
              P.boff = (unsigned)(4 * wid * 1024 + 4 * lane) * 4u; }
            P.nh = 8; P.rb0 = xk::make_rsrc(Wd); P.rb1 = P.rb0;
#pragma unroll 1
            for (int pn = 0; pn < 4; ++pn) {
                P.bcol = pn * 256 * 4; P.ncol = (pn + 1) * 256 * 4;
                P.preloaded = pn > 0; P.chain = pn < 3;
                xk::Acc acc;
#pragma unroll
                for (int ai = 0; ai < 2; ++ai)
#pragma unroll
                    for (int m = 0; m < 4; ++m)
#pragma unroll
                        for (int gI = 0; gI < 2; ++gI)
#pragma unroll
                            for (int nn = 0; nn < 2; ++nn) acc[ai][m][gI][nn] = (f32x4){0.f, 0.f, 0.f, 0.f};
                { const int lane = lane_id(); xk::kloop<false>(F.lds, P, wid, lane, 8 * lane, acc, Br); }
                const int lane = lane_id(), fr = lane & 15, fq = lane >> 4;
                const xk::rsrc_t rY = xk::make_rsrc((const unsigned char*)YB + (size_t)slot0 * 1024);
#pragma unroll
                for (int ai = 0; ai < 2; ++ai)
#pragma unroll
                    for (int m = 0; m < 4; ++m) { const int r = ai * 128 + wr * 64 + m * 16 + fr;
                        if (r < rows && !(mode & 4) && !(mode & 8)) { const float g = ((const LAS float*)(F.lds + xk::L_GATE))[r] * YB_SCALE;
                            u32x4 w; w.x = pk4_fp8(acc[ai][m][0][0] * g); w.y = pk4_fp8(acc[ai][m][0][1] * g); w.z = pk4_fp8(acc[ai][m][1][0] * g); w.w = pk4_fp8(acc[ai][m][1][1] * g);
                            __builtin_amdgcn_raw_buffer_store_b128(w, rY, (unsigned)(r * 1024 + pn * 256 + 64 * wc + 16 * fq), 0, 0); } }
            }
        }
        __syncthreads();
    }
}

__device__ __forceinline__ float ldp(const bf16_t* p, size_t t, int c) { return bf2f(p[t * PW + c]); }
__device__ __forceinline__ void phase_m1(const Frame& F, const Args& a) {
  const bf16_t* p = (const bf16_t*)(F.ws + WS_P); const float* dtraw = (const float*)(F.ws + WS_DTRAW);
  const float* conv_w = KARG_IN(2); const float* conv_b = KARG_IN(3); const float* dt_bias = KARG_IN(4); const float* lb_logits = KARG_IN(8);
  float* xbc = (float*)(F.ws + WS_NXBC); float* fgk = (float*)(F.ws + WS_NFGK); float* qs = (float*)(F.ws + WS_NQS); float* dtb = (float*)(F.ws + WS_NDTB);
  const int tid = F_TID;
  for (int t = blockIdx.x; t < T_TOK; t += F.G) {
    for (int c = tid; c < 1024; c += 512) {
      float acc = conv_b[c];
#pragma unroll
      for (int j = 0; j < 4; ++j) { const int tt = t - 3 + j; if (tt >= 0) acc = fmaf(conv_w[j * 1024 + c], ldp(p, tt, PC_XBC + c), acc); }
      xbc[(size_t)t * 1024 + c] = siluf(acc);
    }
    { const int c = tid;
      const float l0 = lb_logits[c], l1 = lb_logits[512 + c];
      const float mx = fmaxf(l0, l1);
      const float e0 = expf(l0 - mx), e1 = expf(l1 - mx);
      const float lb = e0 / (e0 + e1);
      const float f = ldp(p, t, PC_F + c);
      fgk[(size_t)t * 512 + c] = lb + (1.0f - lb) * (1.0f / (1.0f + expf(-f)));
      const float q = ldp(p, t, PC_Q + c);
      qs[(size_t)t * 512 + c] = q / (1.0f + expf(-q)); }
    if (tid < 8) { const float v = dtraw[t * 8 + tid] + dt_bias[tid]; dtb[t * 8 + tid] = v > 20.f ? v : log1pf(expf(v)); }
  }
}
__device__ __forceinline__ void phase_m2(const Frame& F, const Args& a) {
  const int item = F.wave * F.G + blockIdx.x, lane = F_LANE;
  const float* xbc = (const float*)(F.ws + WS_NXBC); const float* dtb = (const float*)(F.ws + WS_NDTB);
  const float* fgk = (const float*)(F.ws + WS_NFGK); const float* qs = (const float*)(F.ws + WS_NQS); const bf16_t* p = (const bf16_t*)(F.ws + WS_P);
  float* y_ssd = (float*)(F.ws + WS_NYSSD); float* o_h = (float*)(F.ws + WS_NOH);
  if (item < 512) {
    const int h = item >> 6, pp = item & 63, g = h >> 2;
    const float aa = -expf(KARG_IN(5)[h]), D = KARG_IN(6)[h];
    float h0 = 0.f, h1 = 0.f;
    const float* xp = xbc + h * 64 + pp; const float* Bp = xbc + 512 + g * 128 + lane; const float* Cp = xbc + 768 + g * 128 + lane;
    for (int t0 = 0; t0 < T_TOK; t0 += 8) {
      float Bv0[8], Bv1[8], Cv0[8], Cv1[8], xv[8], dv[8];
#pragma unroll
      for (int i = 0; i < 8; ++i) { const size_t o = (size_t)(t0 + i) * 1024;
        Bv0[i] = Bp[o]; Bv1[i] = Bp[o + 64]; Cv0[i] = Cp[o]; Cv1[i] = Cp[o + 64]; xv[i] = xp[o]; dv[i] = dtb[(t0 + i) * 8 + h]; }
#pragma unroll
      for (int i = 0; i < 8; ++i) {
        const float dA = expf(dv[i] * aa), dx = dv[i] * xv[i];
        h0 = fmaf(dA, h0, dx * Bv0[i]); h1 = fmaf(dA, h1, dx * Bv1[i]);
        float part = wave_sum(Cv0[i] * h0 + Cv1[i] * h1);
        if (lane == 0) y_ssd[(size_t)(t0 + i) * 512 + h * 64 + pp] = part + D * xv[i];
      }
    }
  } else if (item < 1024) {
    const int it = item - 512, h = it >> 7, e = it & 127;
    float S0 = 0.f, S1 = 0.f;
    const float* fp = fgk + h * 128 + lane; const float* qp = qs + h * 128 + lane;
    for (int t0 = 0; t0 < T_TOK; t0 += 8) {
      float f0[8], f1[8], q0[8], q1[8], iv[8];
#pragma unroll
      for (int i = 0; i < 8; ++i) { const size_t o = (size_t)(t0 + i) * 512;
        f0[i] = fp[o]; f1[i] = fp[o + 64]; q0[i] = qp[o]; q1[i] = qp[o + 64]; iv[i] = ldp(p, t0 + i, PC_I + h * 128 + e); }
#pragma unroll
      for (int i = 0; i < 8; ++i) {
        S0 = fmaf(f0[i], S0, (1.0f - f0[i]) * iv[i]); S1 = fmaf(f1[i], S1, (1.0f - f1[i]) * iv[i]);
        float part = wave_sum(q0[i] * S0 + q1[i] * S1);
        if (lane == 0) o_h[(size_t)(t0 + i) * 512 + h * 128 + e] = part;
      }
    }
  }
}
__device__ __forceinline__ void phase_m3(const Frame& F, const Args& a) {
  const int gw = F.vcu * 8 + F.wave, NGW = F.G * 8, lane = F_LANE;
  const float* y_ssd = (const float*)(F.ws + WS_NYSSD); const float* o_h = (const float*)(F.ws + WS_NOH); const bf16_t* p = (const bf16_t*)(F.ws + WS_P);
  const float* snw = KARG_IN(7); const float* hnw = KARG_IN(9); bf16_t* mix = (bf16_t*)(F.ws + WS_MIX);
  for (int idx = gw; idx < T_TOK * 2; idx += NGW) {
    const int t = idx >> 1, g = idx & 1;
    float v[4]; float ss = 0.f;
#pragma unroll
    for (int j = 0; j < 4; ++j) { const int c = g * 256 + lane + 64 * j; v[j] = y_ssd[(size_t)t * 512 + c] * siluf(ldp(p, t, PC_Z + c)); ss += v[j] * v[j]; }
    ss = wave_sum(ss);
    const float r = rsqrtf(ss * (1.0f / 256.0f) + RMS_EPS_F);
#pragma unroll
    for (int j = 0; j < 4; ++j) { const int c = g * 256 + lane + 64 * j; mix[(size_t)t * 1024 + c] = (bf16_t)(cvt_pk_bf16(v[j] * r * snw[c], 0.f) & 0xffffu); }
  }
  for (int idx = gw; idx < T_TOK * 4; idx += NGW) {
    const int t = idx >> 2, h = idx & 3;
    float v[2]; float ss = 0.f;
#pragma unroll
    for (int j = 0; j < 2; ++j) { const int c = h * 128 + lane + 64 * j; v[j] = o_h[(size_t)t * 512 + c]; ss += v[j] * v[j]; }
    ss = wave_sum(ss);
    const float r = rsqrtf(ss * (1.0f / 128.0f) + RMS_EPS_F);
#pragma unroll
    for (int j = 0; j < 2; ++j) { const int c = h * 128 + lane + 64 * j;
      mix[(size_t)t * 1024 + 512 + c] = (bf16_t)(cvt_pk_bf16(v[j] * r * hnw[c] * siluf(ldp(p, t, PC_G + c)), 0.f) & 0xffffu); }
  }
}


#define MFMA32(a, b, c) __builtin_amdgcn_mfma_f32_32x32x16_bf16((a), (b), (c), 0, 0, 0)
__device__ __forceinline__ int drow(int r, int lane) { return (r & 3) + 8 * (r >> 2) + 4 * (lane >> 5); }
__device__ __forceinline__ bf16x8 frag_row(const LAS unsigned char* base, int pitch, int row0, int k0, int lane) {
    return *(const LAS bf16x8*)(base + (row0 + (lane & 31)) * pitch + (k0 + 8 * (lane >> 5)) * 2);
}
template <bool PERM> __device__ __forceinline__ bf16x8 frag_tr(const LAS unsigned char* base, int pitch, int k0, int col0, int lane) {
    const int h = lane >> 5, blk = (lane >> 4) & 1, q = (lane & 15) >> 2, p = lane & 3;
    const LAS unsigned char* a0 = base + (k0 + (PERM ? 4 : 8) * h + q) * pitch + (col0 + 16 * blk + 4 * p) * 2;
    const s16x4 lo = __builtin_amdgcn_ds_read_tr16_b64_v4i16((LAS s16x4*)a0);
    const s16x4 hi = __builtin_amdgcn_ds_read_tr16_b64_v4i16((LAS s16x4*)(a0 + (PERM ? 8 : 4) * pitch));
    return (bf16x8){lo[0], lo[1], lo[2], lo[3], hi[0], hi[1], hi[2], hi[3]};
}
__device__ __forceinline__ bf16x8 acc_frag(const f32x16& x, int s) {
    u32x4 w; w.x = cvt_pk_bf16(x[8 * s + 0], x[8 * s + 1]); w.y = cvt_pk_bf16(x[8 * s + 2], x[8 * s + 3]); w.z = cvt_pk_bf16(x[8 * s + 4], x[8 * s + 5]); w.w = cvt_pk_bf16(x[8 * s + 6], x[8 * s + 7]);
    return __builtin_bit_cast(bf16x8, w);
}
__device__ __forceinline__ float softplusf(float v) { return v > 20.f ? v : log1pf(__expf(v)); }
__device__ __forceinline__ unsigned short f2bf1(float v) { return (unsigned short)(cvt_pk_bf16(v, 0.f) & 0xffffu); }
__device__ __forceinline__ float half_sum(float v) {
#pragma unroll
    for (int o = 1; o < 32; o <<= 1) v += __shfl_xor(v, o);
    return v;
}

constexpr int SX_PITCH = 576, SB_TR_PITCH = 320, SB_ROW_PITCH = 272;
constexpr int SL_X = 0, SL_B = 128 * SX_PITCH  , SL_C = SL_B + 128 * SB_TR_PITCH  ;
constexpr int SL_DT = 151552, SL_ACUM = SL_DT + 2048, SL_SSQ = SL_ACUM + 2048;
static_assert(SL_C + 128 * SB_ROW_PITCH <= SL_DT && SL_SSQ + 1024 <= LDS_PHASE_BYTES, "SSD LDS map");
constexpr int HL_QD = 0, HL_QP = 64 * 272, HL_KP = 2 * 64 * 272, HL_V = 3 * 64 * 272  , HL_KD = HL_V + 64 * 320  , HL_SEG = HL_KD + 64 * 320  , HL_SSQ = HL_SEG + 4096;
static_assert(HL_SSQ + 1024 <= LDS_PHASE_BYTES, "HGRN LDS map");

__device__ __forceinline__ void ssd_dt_acum(const Frame& F, const Args& a, int c, int g) {
    if (F.wave < 4) {
        const int hh = g * 4 + F.wave, lane = F_LANE; const float* dtraw = (const float*)(F.ws + WS_DTRAW);
        const float bias = KARG_IN(4)[hh], aa = -__expf(KARG_IN(5)[hh]);
        const int t = c * 128 + 2 * lane;
        const float d0 = softplusf(dtraw[(size_t)t * 8 + hh] + bias), d1 = softplusf(dtraw[(size_t)(t + 1) * 8 + hh] + bias);
        const float a0 = d0 * aa, a1 = d1 * aa;
        float incl = a0 + a1;
#pragma unroll
        for (int o = 1; o < 64; o <<= 1) { const float v = __shfl_up(incl, o); if (lane >= o) incl += v; }
        LAS float* dts = (LAS float*)(F.lds + SL_DT) + F.wave * 128; LAS float* acs = (LAS float*)(F.lds + SL_ACUM) + F.wave * 128;
        dts[2 * lane] = d0; dts[2 * lane + 1] = d1; acs[2 * lane] = incl - a1; acs[2 * lane + 1] = incl;
    }
}
__device__ __forceinline__ void ssd_conv_item(const Frame& F, const Args& a, int c, int src_ch, int seg, int hl, int mode, LAS unsigned char* dst, int pitch, int dst_col) {
    const bf16_t* p = (const bf16_t*)(F.ws + WS_P) + PC_XBC + src_ch;
    const float* cw = KARG_IN(2) + src_ch; const float* cb = KARG_IN(3) + src_ch;
    float w[4][8], bias[8];
#pragma unroll
    for (int j = 0; j < 4; ++j) { const f32x4 x0 = *(const f32x4*)(cw + j * 1024), x1 = *(const f32x4*)(cw + j * 1024 + 4);
        w[j][0] = x0[0]; w[j][1] = x0[1]; w[j][2] = x0[2]; w[j][3] = x0[3]; w[j][4] = x1[0]; w[j][5] = x1[1]; w[j][6] = x1[2]; w[j][7] = x1[3]; }
    { const f32x4 x0 = *(const f32x4*)cb, x1 = *(const f32x4*)(cb + 4); bias[0] = x0[0]; bias[1] = x0[1]; bias[2] = x0[2]; bias[3] = x0[3]; bias[4] = x1[0]; bias[5] = x1[1]; bias[6] = x1[2]; bias[7] = x1[3]; }
    const int l0 = seg * 16, t0 = c * 128 + l0;
    u32x4 rw[19];
#pragma unroll
    for (int j = 0; j < 19; ++j) { const int tt = t0 - 3 + j; rw[j] = tt >= 0 ? *(const u32x4*)(p + (size_t)tt * PW) : (u32x4){0u, 0u, 0u, 0u}; }
    const LAS float* dts = (const LAS float*)(F.lds + SL_DT) + hl * 128; const LAS float* acs = (const LAS float*)(F.lds + SL_ACUM) + hl * 128;
    const float alast = acs[127];
#pragma unroll
    for (int i = 0; i < 16; ++i) {
        float v[8];
#pragma unroll
        for (int k = 0; k < 4; ++k) {
            const unsigned r0 = rw[i][k], r1 = rw[i + 1][k], r2 = rw[i + 2][k], r3 = rw[i + 3][k];
            v[2 * k] = siluf(fmaf(w[3][2 * k], bflo(r3), fmaf(w[2][2 * k], bflo(r2), fmaf(w[1][2 * k], bflo(r1), fmaf(w[0][2 * k], bflo(r0), bias[2 * k])))));
            v[2 * k + 1] = siluf(fmaf(w[3][2 * k + 1], bfhi(r3), fmaf(w[2][2 * k + 1], bfhi(r2), fmaf(w[1][2 * k + 1], bfhi(r1), fmaf(w[0][2 * k + 1], bfhi(r0), bias[2 * k + 1])))));
        }
        float sc = 1.f;
        if (mode >= 1) sc = dts[l0 + i];
        if (mode == 2) sc *= __expf(alast - acs[l0 + i]);
        u32x4 o; o.x = cvt_pk_bf16(v[0] * sc, v[1] * sc); o.y = cvt_pk_bf16(v[2] * sc, v[3] * sc); o.z = cvt_pk_bf16(v[4] * sc, v[5] * sc); o.w = cvt_pk_bf16(v[6] * sc, v[7] * sc);
        *(LAS u32x4*)(dst + (l0 + i) * pitch + dst_col * 2) = o;
    }
}

__device__ __forceinline__ void ssd_states_unit(const Frame& F, const Args& a, int c, int g) {
    const int tid = F_TID, lane = F_LANE;
    __syncthreads();
    ssd_dt_acum(F, a, c, g);
    __syncthreads();
    { const int cg = tid & 63, seg = tid >> 6; const bool isx = cg < 32;
      if (cg < 48) ssd_conv_item(F, a, c, isx ? g * 256 + cg * 8 : 512 + g * 128 + (cg - 32) * 8, seg, isx ? (cg >> 3) : 0, isx ? 2 : 0,
                                 F.lds + (isx ? SL_X : SL_B), isx ? SX_PITCH : SB_TR_PITCH, isx ? cg * 8 : (cg - 32) * 8); }
    __syncthreads();
    const int hl = F.wave >> 1, pt = F.wave & 1, hh = g * 4 + hl;
    f32x16 S[4];
#pragma unroll
    for (int nt = 0; nt < 4; ++nt)
#pragma unroll
        for (int r = 0; r < 16; ++r) S[nt][r] = 0.f;
#pragma unroll 2
    for (int ks = 0; ks < 8; ++ks) {
        const bf16x8 A = frag_tr<false>(F.lds + SL_X, SX_PITCH, 16 * ks, hl * 64 + 32 * pt, lane);
#pragma unroll
        for (int nt = 0; nt < 4; ++nt) { const bf16x8 B = frag_tr<false>(F.lds + SL_B, SB_TR_PITCH, 16 * ks, 32 * nt, lane); S[nt] = MFMA32(A, B, S[nt]); }
    }
    float* st = (float*)(F.ws + WS_SSTATE) + ((size_t)(c * 8 + hh) * 64 + 32 * pt) * 128;
#pragma unroll
    for (int nt = 0; nt < 4; ++nt)
#pragma unroll
        for (int r = 0; r < 16; ++r) st[(size_t)drow(r, lane) * 128 + 32 * nt + (lane & 31)] = S[nt][r];
    if (tid < 4) ((float*)(F.ws + WS_CDECAY))[c * 8 + g * 4 + tid] = __expf(((const LAS float*)(F.lds + SL_ACUM))[tid * 128 + 127]);
}

__device__ __forceinline__ void ssd_out_unit(const Frame& F, const Args& a, int c, int g) {
    const int lane = F_LANE;
    __syncthreads();
    ssd_dt_acum(F, a, c, g);
    __syncthreads();
    { const int tid = F_TID, cg = tid & 63, seg = tid >> 6; const bool isx = cg < 32, isb = cg < 48;
      ssd_conv_item(F, a, c, isx ? g * 256 + cg * 8 : (isb ? 512 + g * 128 + (cg - 32) * 8 : 768 + g * 128 + (cg - 48) * 8), seg, isx ? (cg >> 3) : 0, isx ? 1 : 0,
                    F.lds + (isx ? SL_X : (isb ? SL_B : SL_C)), isx ? SX_PITCH : SB_ROW_PITCH, isx ? cg * 8 : (isb ? (cg - 32) * 8 : (cg - 48) * 8)); }
    __syncthreads();
    const int lt = F.wave >> 1, hp = F.wave & 1;
    const int lcol = 32 * lt + (lane & 31);
    f32x16 acc[2][2];
#pragma unroll
    for (int hi = 0; hi < 2; ++hi)
#pragma unroll
        for (int pt = 0; pt < 2; ++pt)
#pragma unroll
            for (int r = 0; r < 16; ++r) acc[hi][pt][r] = 0.f;
#pragma unroll
    for (int hi = 0; hi < 2; ++hi) {
        const int hl = hp * 2 + hi, hh = g * 4 + hl;
        const bf16_t* sp = (const bf16_t*)(F.ws + WS_SPREV) + (size_t)(c * 8 + hh) * 64 * 128 + (size_t)(lane & 31) * 128 + 8 * (lane >> 5);
        bf16x8 Bsv[2][8];
#pragma unroll
        for (int pt = 0; pt < 2; ++pt)
#pragma unroll
            for (int ks = 0; ks < 8; ++ks) Bsv[pt][ks] = *(const bf16x8*)(sp + (size_t)(32 * pt) * 128 + 16 * ks);
#pragma unroll
        for (int ks = 0; ks < 8; ++ks) {
            const bf16x8 A = frag_row(F.lds + SL_C, SB_ROW_PITCH, 32 * lt, 16 * ks, lane);
#pragma unroll
            for (int pt = 0; pt < 2; ++pt) acc[hi][pt] = MFMA32(A, Bsv[pt][ks], acc[hi][pt]);
        }
        const LAS float* acs = (const LAS float*)(F.lds + SL_ACUM) + hl * 128;
#pragma unroll
        for (int r = 0; r < 16; ++r) { const float e = __expf(acs[32 * lt + drow(r, lane)]); acc[hi][0][r] *= e; acc[hi][1][r] *= e; }
    }
#pragma unroll 1
    for (int st = 0; st <= lt; ++st) {
        f32x16 GT;
#pragma unroll
        for (int r = 0; r < 16; ++r) GT[r] = 0.f;
#pragma unroll 2
        for (int ks = 0; ks < 8; ++ks) {
            const bf16x8 A = frag_row(F.lds + SL_B, SB_ROW_PITCH, 32 * st, 16 * ks, lane), B = frag_row(F.lds + SL_C, SB_ROW_PITCH, 32 * lt, 16 * ks, lane);
            GT = MFMA32(A, B, GT);
        }
#pragma unroll
        for (int hi = 0; hi < 2; ++hi) {
            const int hl = hp * 2 + hi, hh = g * 4 + hl;
            const LAS float* dts = (const LAS float*)(F.lds + SL_DT) + hl * 128; const LAS float* acs = (const LAS float*)(F.lds + SL_ACUM) + hl * 128;
            const float al = acs[lcol], dsk = KARG_IN(6)[hh] / dts[lcol];
            f32x16 M;
#pragma unroll
            for (int r = 0; r < 16; ++r) { const int srow = 32 * st + drow(r, lane);
                float v = srow <= lcol ? GT[r] * __expf(al - acs[srow]) : 0.f;
                if (srow == lcol) v += dsk;
                M[r] = v; }
#pragma unroll
            for (int s2 = 0; s2 < 2; ++s2) { const bf16x8 A = acc_frag(M, s2);
#pragma unroll
                for (int pt = 0; pt < 2; ++pt) { const bf16x8 B = frag_tr<true>(F.lds + SL_X, SX_PITCH, 32 * st + 16 * s2, hl * 64 + 32 * pt, lane); acc[hi][pt] = MFMA32(A, B, acc[hi][pt]); } }
        }
    }
    float ssq[16];
#pragma unroll
    for (int r = 0; r < 16; ++r) ssq[r] = 0.f;
    {
        const bf16_t* pz = (const bf16_t*)(F.ws + WS_P) + (size_t)(c * 128 + 32 * lt) * PW + PC_Z + g * 256 + hp * 128 + (lane & 31);
#pragma unroll
        for (int hi = 0; hi < 2; ++hi)
#pragma unroll
            for (int pt = 0; pt < 2; ++pt)
#pragma unroll
                for (int r = 0; r < 16; ++r) { const float z = bf2f(pz[(size_t)drow(r, lane) * PW + hi * 64 + 32 * pt]);
                    const float y = acc[hi][pt][r] * siluf(z); acc[hi][pt][r] = y; ssq[r] += y * y; }
    }
    LAS float* ssqs = (LAS float*)(F.lds + SL_SSQ);
#pragma unroll
    for (int r = 0; r < 16; ++r) { const float sm = half_sum(ssq[r]); if ((lane & 31) == 0) ssqs[F.wave * 32 + drow(r, lane)] = sm; }
    __syncthreads();
    const float* nw = KARG_IN(7) + g * 256 + hp * 128 + (lane & 31);
#pragma unroll
    for (int r = 0; r < 16; ++r) { const int row = drow(r, lane);
        const float rs = rsqrtf((ssqs[F.wave * 32 + row] + ssqs[(F.wave ^ 1) * 32 + row]) * (1.0f / 256.0f) + RMS_EPS_F);
#pragma unroll
        for (int hi = 0; hi < 2; ++hi)
#pragma unroll
            for (int pt = 0; pt < 2; ++pt) *(LAS unsigned short*)(F.lds + SL_X + (32 * lt + row) * 528 + (hp * 128 + hi * 64 + 32 * pt + (lane & 31)) * 2) = f2bf1(acc[hi][pt][r] * rs * nw[hi * 64 + 32 * pt]); }
    __syncthreads();
    { const int tid = F_TID; bf16_t* mo = (bf16_t*)(F.ws + WS_MIX) + (size_t)(c * 128) * DM + g * 256;
#pragma unroll
      for (int i = 0; i < 8; ++i) { const int pc = tid + 512 * i, row = pc >> 5, ch = (pc & 31) * 8;
          *(u32x4*)(mo + (size_t)row * DM + ch) = *(const LAS u32x4*)(F.lds + SL_X + row * 528 + ch * 2); } }
}

struct HgrnLocal { float fg[8][2], cum[8][2], qv[8][2], iv[8][2], tot[2], mid[2]; };
struct HgrnRaw { unsigned fw[8], iw[8], qw[8]; };
template <bool NEEDQ> __device__ __forceinline__ void hgrn_fetch(const Frame& F, int c, int h, HgrnRaw& R) {
    const int tid = F_TID, cp = tid & 63, seg = tid >> 6, d0 = 2 * cp;
    const bf16_t* p = (const bf16_t*)(F.ws + WS_P) + (size_t)(c * 64 + seg * 8) * PW + h * 128 + d0;
#pragma unroll
    for (int i = 0; i < 8; ++i) { R.fw[i] = *(const unsigned*)(p + (size_t)i * PW + PC_F); R.iw[i] = *(const unsigned*)(p + (size_t)i * PW + PC_I);
        if (NEEDQ) R.qw[i] = *(const unsigned*)(p + (size_t)i * PW + PC_Q); }
}
template <bool NEEDQ> __device__ __forceinline__ void hgrn_load(const Frame& F, const Args& a, int h, const HgrnRaw& R, HgrnLocal& L) {
    const int tid = F_TID, cp = tid & 63, seg = tid >> 6, d0 = 2 * cp;
    float lb[2];
#pragma unroll
    for (int j = 0; j < 2; ++j) { const float l0 = KARG_IN(8)[h * 128 + d0 + j], l1 = KARG_IN(8)[512 + h * 128 + d0 + j]; const float mx = fmaxf(l0, l1), e0 = __expf(l0 - mx), e1 = __expf(l1 - mx); lb[j] = e0 / (e0 + e1); }
    float run[2] = {0.f, 0.f};
#pragma unroll
    for (int i = 0; i < 8; ++i) {
        const unsigned fw = R.fw[i], iw = R.iw[i];
        const float fr[2] = {bflo(fw), bfhi(fw)};
        L.iv[i][0] = bflo(iw); L.iv[i][1] = bfhi(iw);
        if (NEEDQ) { const unsigned qw = R.qw[i]; L.qv[i][0] = siluf(bflo(qw)); L.qv[i][1] = siluf(bfhi(qw)); }
#pragma unroll
        for (int j = 0; j < 2; ++j) { const float fg = lb[j] + (1.0f - lb[j]) * sigmf(fr[j]); L.fg[i][j] = fg; run[j] += __logf(fg); L.cum[i][j] = run[j]; }
    }
    LAS float* segs = (LAS float*)(F.lds + HL_SEG);
    segs[seg * 128 + d0] = run[0]; segs[seg * 128 + d0 + 1] = run[1];
    __syncthreads();
    float pre[2] = {0.f, 0.f}, tot[2] = {0.f, 0.f}, mid[2] = {0.f, 0.f};
#pragma unroll
    for (int s2 = 0; s2 < 8; ++s2) {
#pragma unroll
        for (int j = 0; j < 2; ++j) { const float v = segs[s2 * 128 + d0 + j]; tot[j] += v; if (s2 < seg) pre[j] += v; if (s2 < 4) mid[j] += v; }
    }
#pragma unroll
    for (int i = 0; i < 8; ++i)
#pragma unroll
        for (int j = 0; j < 2; ++j) L.cum[i][j] += pre[j];
    L.tot[0] = tot[0]; L.tot[1] = tot[1]; L.mid[0] = mid[0]; L.mid[1] = mid[1];
}

__device__ __forceinline__ void hgrn_states_unit(const Frame& F, const Args& a, int c, int h, const HgrnRaw& R) {
    const int tid = F_TID, lane = F_LANE, cp = tid & 63, seg = tid >> 6, d0 = 2 * cp;
    __syncthreads();
    HgrnLocal L; hgrn_load<false>(F, a, h, R, L);
#pragma unroll
    for (int i = 0; i < 8; ++i) { const int t = seg * 8 + i;
        *(LAS unsigned*)(F.lds + HL_KD + t * 320 + d0 * 2) = cvt_pk_bf16((1.0f - L.fg[i][0]) * __expf(L.tot[0] - L.cum[i][0]), (1.0f - L.fg[i][1]) * __expf(L.tot[1] - L.cum[i][1]));
        *(LAS unsigned*)(F.lds + HL_V + t * 320 + d0 * 2) = cvt_pk_bf16(L.iv[i][0], L.iv[i][1]); }
    if (seg == 0) { float* hd = (float*)(F.ws + WS_HDECAY) + (size_t)(c * 4 + h) * 128 + d0; hd[0] = __expf(L.tot[0]); hd[1] = __expf(L.tot[1]); }
    __syncthreads();
    const int et = F.wave >> 1, dh = F.wave & 1;
    f32x16 acc[2];
#pragma unroll
    for (int dj = 0; dj < 2; ++dj)
#pragma unroll
        for (int r = 0; r < 16; ++r) acc[dj][r] = 0.f;
#pragma unroll
    for (int ks = 0; ks < 4; ++ks) {
        const bf16x8 A = frag_tr<false>(F.lds + HL_V, 320, 16 * ks, 32 * et, lane);
#pragma unroll
        for (int dj = 0; dj < 2; ++dj) { const bf16x8 B = frag_tr<false>(F.lds + HL_KD, 320, 16 * ks, 32 * (2 * dh + dj), lane); acc[dj] = MFMA32(A, B, acc[dj]); }
    }
    float* kv = (float*)(F.ws + WS_HKV) + ((size_t)(c * 4 + h) * 128 + 32 * et) * 128;
#pragma unroll
    for (int dj = 0; dj < 2; ++dj)
#pragma unroll
        for (int r = 0; r < 16; ++r) kv[(size_t)drow(r, lane) * 128 + 32 * (2 * dh + dj) + (lane & 31)] = acc[dj][r];
}

__device__ __forceinline__ void hgrn_out_unit(const Frame& F, const Args& a, int c, int h, const HgrnRaw& R) {
    const int tid = F_TID, lane = F_LANE, cp = tid & 63, seg = tid >> 6, d0 = 2 * cp;
    const int tt = F.wave >> 2, et = F.wave & 3;
    bf16x8 Bs[8];
    { const bf16_t* sp = (const bf16_t*)(F.ws + WS_HSPREV) + ((size_t)(c * 4 + h) * 128 + 32 * et) * 128 + (size_t)(lane & 31) * 128 + 8 * (lane >> 5);
#pragma unroll
      for (int ks = 0; ks < 8; ++ks) Bs[ks] = *(const bf16x8*)(sp + 16 * ks); }
    const int e = 32 * et + (lane & 31);
    unsigned short gv[16];
    { const bf16_t* pg = (const bf16_t*)(F.ws + WS_P) + (size_t)(c * 64 + 32 * tt) * PW + PC_G + h * 128 + e;
#pragma unroll
      for (int r = 0; r < 16; ++r) gv[r] = pg[(size_t)drow(r, lane) * PW]; }
    const float nw = KARG_IN(9)[h * 128 + e];
    __syncthreads();
    HgrnLocal L; hgrn_load<true>(F, a, h, R, L);
#pragma unroll
    for (int i = 0; i < 8; ++i) { const int t = seg * 8 + i;
        float qd[2], qp[2], kp[2];
#pragma unroll
        for (int j = 0; j < 2; ++j) { qd[j] = L.qv[i][j] * __expf(L.cum[i][j]); qp[j] = L.qv[i][j] * __expf(L.cum[i][j] - L.mid[j]); kp[j] = (1.0f - L.fg[i][j]) * __expf(L.mid[j] - L.cum[i][j]); }
        *(LAS unsigned*)(F.lds + HL_QD + t * 272 + d0 * 2) = cvt_pk_bf16(qd[0], qd[1]);
        *(LAS unsigned*)(F.lds + HL_QP + t * 272 + d0 * 2) = cvt_pk_bf16(qp[0], qp[1]);
        *(LAS unsigned*)(F.lds + HL_KP + t * 272 + d0 * 2) = cvt_pk_bf16(kp[0], kp[1]);
        *(LAS unsigned*)(F.lds + HL_V + t * 320 + d0 * 2) = cvt_pk_bf16(L.iv[i][0], L.iv[i][1]); }
    __syncthreads();
    f32x16 acc;
#pragma unroll
    for (int r = 0; r < 16; ++r) acc[r] = 0.f;
#pragma unroll
    for (int ks = 0; ks < 8; ++ks) { const bf16x8 A = frag_row(F.lds + HL_QD, 272, 32 * tt, 16 * ks, lane); acc = MFMA32(A, Bs[ks], acc); }
    const int tcol = 32 * tt + (lane & 31);
#pragma unroll
    for (int st = 0; st < 2; ++st) {
        if (st <= tt) {
            f32x16 X;
#pragma unroll
            for (int r = 0; r < 16; ++r) X[r] = 0.f;
#pragma unroll 2
            for (int ks = 0; ks < 8; ++ks) { const bf16x8 A = frag_row(F.lds + HL_KP, 272, 32 * st, 16 * ks, lane), B = frag_row(F.lds + HL_QP, 272, 32 * tt, 16 * ks, lane); X = MFMA32(A, B, X); }
#pragma unroll
            for (int r = 0; r < 16; ++r) X[r] = (32 * st + drow(r, lane) <= tcol) ? X[r] : 0.f;
#pragma unroll
            for (int s2 = 0; s2 < 2; ++s2) { const bf16x8 A = acc_frag(X, s2), B = frag_tr<true>(F.lds + HL_V, 320, 32 * st + 16 * s2, 32 * et, lane); acc = MFMA32(A, B, acc); }
        }
    }
    LAS float* ssqs = (LAS float*)(F.lds + HL_SSQ);
#pragma unroll
    for (int r = 0; r < 16; ++r) { const float sm = half_sum(acc[r] * acc[r]); if ((lane & 31) == 0) ssqs[F.wave * 32 + drow(r, lane)] = sm; }
    __syncthreads();
#pragma unroll
    for (int r = 0; r < 16; ++r) { const int row = drow(r, lane);
        const float ss = ssqs[(tt * 4 + 0) * 32 + row] + ssqs[(tt * 4 + 1) * 32 + row] + ssqs[(tt * 4 + 2) * 32 + row] + ssqs[(tt * 4 + 3) * 32 + row];
        const float rs = rsqrtf(ss * (1.0f / 128.0f) + RMS_EPS_F);
        *(LAS unsigned short*)(F.lds + HL_QD + (32 * tt + row) * 272 + e * 2) = f2bf1(acc[r] * rs * nw * siluf(bf2f(gv[r]))); }
    __syncthreads();
    { bf16_t* mo = (bf16_t*)(F.ws + WS_MIX) + (size_t)(c * 64) * DM + 512 + h * 128;
#pragma unroll
      for (int i = 0; i < 2; ++i) { const int pc = tid + 512 * i, row = pc >> 4, ch = (pc & 15) * 8;
          *(u32x4*)(mo + (size_t)row * DM + ch) = *(const LAS u32x4*)(F.lds + HL_QD + row * 272 + ch * 2); } }
}

__device__ __forceinline__ void phase_mix_states(const Frame& F, const Args& a, const int mode) {
    if (!(mode & 1)) for (int u = blockIdx.x; u < 256; u += F.G) ssd_states_unit(F, a, u >> 1, u & 1);
    if (!(mode & 2)) {
        HgrnRaw Ra, Rb; int u = blockIdx.x;
        if (u < 1024) hgrn_fetch<false>(F, u >> 2, u & 3, Ra);
        while (u < 1024) {
            int un = u + F.G; if (un < 1024) hgrn_fetch<false>(F, un >> 2, un & 3, Rb);
            hgrn_states_unit(F, a, u >> 2, u & 3, Ra); u = un; if (u >= 1024) break;
            un = u + F.G; if (un < 1024) hgrn_fetch<false>(F, un >> 2, un & 3, Ra);
            hgrn_states_unit(F, a, u >> 2, u & 3, Rb); u = un;
        }
    }
}
__device__ __forceinline__ void phase_mix_out(const Frame& F, const Args& a, const int mode) {
    if (!(mode & 1)) for (int u = blockIdx.x; u < 256; u += F.G) ssd_out_unit(F, a, u >> 1, u & 1);
    if (!(mode & 2)) {
        HgrnRaw Ra, Rb; int u = blockIdx.x;
        if (u < 1024) hgrn_fetch<true>(F, u >> 2, u & 3, Ra);
        while (u < 1024) {
            int un = u + F.G; if (un < 1024) hgrn_fetch<true>(F, un >> 2, un & 3, Rb);
            hgrn_out_unit(F, a, u >> 2, u & 3, Ra); u = un; if (u >= 1024) break;
            un = u + F.G; if (un < 1024) hgrn_fetch<true>(F, un >> 2, un & 3, Ra);
            hgrn_out_unit(F, a, u >> 2, u & 3, Rb); u = un;
        }
    }
}
__device__ __forceinline__ void phase_mix_scan(const Frame& F, const Args& a) {
    const int gt = blockIdx.x * 512 + F_TID;
    if (blockIdx.x < 128 || F.G < 256) {
        for (int idx = gt; idx < 65536; idx += (F.G < 256 ? F.G : 128) * 512) {
            const int hh = idx >> 13; const float* st = (const float*)(F.ws + WS_SSTATE) + idx; const float* cd = (const float*)(F.ws + WS_CDECAY) + hh;
            bf16_t* sp = (bf16_t*)(F.ws + WS_SPREV) + idx; float S = 0.f;
            for (int c0 = 0; c0 < 128; c0 += 16) { float v[16], d[16];
#pragma unroll
                for (int i = 0; i < 16; ++i) { v[i] = st[(size_t)(c0 + i) * 65536]; d[i] = cd[(c0 + i) * 8]; }
#pragma unroll
                for (int i = 0; i < 16; ++i) { sp[(size_t)(c0 + i) * 65536] = f2bf1(S); S = fmaf(S, d[i], v[i]); } }
        }
    }
    if (blockIdx.x >= 128 || F.G < 256) {
        const int gt2 = F.G < 256 ? gt : gt - 128 * 512;
        for (int idx = gt2; idx < 65536; idx += (F.G < 256 ? F.G : 128) * 512) {
            const int h = idx >> 14, d = idx & 127; const float* kv = (const float*)(F.ws + WS_HKV) + idx; const float* hd = (const float*)(F.ws + WS_HDECAY) + h * 128 + d;
            bf16_t* sp = (bf16_t*)(F.ws + WS_HSPREV) + idx; float S = 0.f;
            for (int c0 = 0; c0 < 256; c0 += 16) { float v[16], dd[16];
#pragma unroll
                for (int i = 0; i < 16; ++i) { v[i] = kv[(size_t)(c0 + i) * 65536]; dd[i] = hd[(size_t)(c0 + i) * 512]; }
#pragma unroll
                for (int i = 0; i < 16; ++i) { sp[(size_t)(c0 + i) * 65536] = f2bf1(S); S = fmaf(S, dd[i], v[i]); } }
        }
    }
}

__global__ void __launch_bounds__(512, 2) mk_fwd(Args args) {
    extern __shared__ __attribute__((aligned(16))) unsigned char lds_raw[];
    Frame F;
    F.lds = (LAS unsigned char*)lds_raw;
    F.wave = __builtin_amdgcn_readfirstlane(threadIdx.x >> 6);
    F.G = gridDim.x; { const int bx = blockIdx.x; F.vcu = (F.G % 8 == 0) ? (bx % 8) * (F.G / 8) + bx / 8 : bx; }
    F.ws = args.ws; F.ctl = (unsigned*)(args.ws + WS_CTL);
    volatile LAS unsigned* MISC = (volatile LAS unsigned*)(F.lds + LDS_MISC);
    if (F_TID < 64) MISC[F_TID] = 0u;
    __syncthreads();
    const bool use_bar = (args.ph_hi - args.ph_lo) > 1;
    XcdBarrier bar; bar.bar = F.ctl + CW_BAR + args.li * XCD_BAR_WORDS; bar.x = 0; bar.st = MISC + 8; bar.wave = F.wave;
    if (use_bar) bar = xcd_barrier_post(F.ctl + CW_BAR + args.li * XCD_BAR_WORDS, MISC + 8, F.wave);
#define PH(k) (args.ph_lo <= (k) && (k) < args.ph_hi)
#define SEAM(k) do { if (use_bar && (k) + 1 < args.ph_hi && (k) >= args.ph_lo) xcd_barrier(bar); } while (0)
    unsigned char* ws = F.ws;
    if (PH(0)) phase_prep(F, args);
    SEAM(0);
    if (PH(1)) {
        pg8::DenseSched S; S.init(ws + WS_XB, ws + WS_WIN_T, T_TOK, 3072, 1024, F.G, blockIdx.x);
        pg8::EpiP E; E.O = (bf16_t*)(ws + WS_P); E.ldc = PW;
        pg8::gemm_phase<pg8::EpiP, pg8::DenseSched, true>(F.lds, 1024, S, E, F.wave);
    }
    SEAM(1);
#if defined(MK_NAIVE_MIX)
    if (PH(2)) phase_m1(F, args);
    SEAM(2);
    if (PH(3)) phase_m2(F, args);
    SEAM(3);
    if (PH(4)) phase_m3(F, args);
#else
    if (PH(2)) phase_mix_states(F, args, args.mode);
    SEAM(2);
    if (PH(3)) {
        phase_mix_scan(F, args);
        if (blockIdx.x < 128 && F.G >= 256) {
            __syncthreads();
            pg8::DenseSched S; S.init(ws + WS_XB, ws + WS_WIN_T + (size_t)3072 * 1024 * 2, T_TOK, 512, 1024, 128, blockIdx.x);
            pg8::EpiP E; E.O = (bf16_t*)(ws + WS_P) + 3072; E.ldc = PW;
            pg8::gemm_phase<pg8::EpiP, pg8::DenseSched, true>(F.lds, 1024, S, E, F.wave);
        } else if (F.G < 256) {
            __syncthreads();
            pg8::DenseSched S; S.init(ws + WS_XB, ws + WS_WIN_T + (size_t)3072 * 1024 * 2, T_TOK, 512, 1024, F.G, blockIdx.x);
            pg8::EpiP E; E.O = (bf16_t*)(ws + WS_P) + 3072; E.ldc = PW;
            pg8::gemm_phase<pg8::EpiP, pg8::DenseSched, true>(F.lds, 1024, S, E, F.wave);
        }
    }
    SEAM(3);
    if (PH(4)) phase_mix_out(F, args, args.mode);
#endif
    SEAM(4);
    if (PH(5)) {
        pg8::DenseSched S; S.init(ws + WS_MIX, ws + WS_WOUT_T, T_TOK, 1024, 1024, F.G, blockIdx.x);
        pg8::EpiU E; E.U = (float*)(ws + WS_H1); E.X = KARG_IN(0);
        pg8::gemm_phase<pg8::EpiU, pg8::DenseSched, false>(F.lds, 1024, S, E, F.wave);
    }
    SEAM(5);
    if (PH(6)) phase_ln1(F, args);
    SEAM(6);
    if (PH(7)) {
        pg8::DenseSched S; S.init(ws + WS_H1B, ws + WS_W3_T, T_TOK, 768, 1024, F.G, blockIdx.x);
        pg8::Epi3 E; E.LG = (float*)(ws + WS_LOGITS); E.HS = (bf16_t*)(ws + WS_HS);
        pg8::gemm_phase<pg8::Epi3, pg8::DenseSched, false>(F.lds, 1024, S, E, F.wave);
    }
    SEAM(7);
    if (PH(8)) {
        phase_route(F, args);
        pg8::DenseSched S; S.init(ws + WS_HS, ws + WS_WDS_T, T_TOK, 1024, 256, F.G, blockIdx.x);
        pg8::EpiP E; E.O = (bf16_t*)(ws + WS_YS); E.ldc = 1024;
        pg8::gemm_phase<pg8::EpiP, pg8::DenseSched, false>(F.lds, 256, S, E, F.wave);
    }
    SEAM(8);
#if defined(MK_OLD_EXPERTS)
    if (PH(9)) {
        build_tables(F);
        pg8::ExpertSched<true> S; S.lds = F.lds;
        S.lists = (const int*)(ws + WS_LISTS); S.A = (const char*)(ws + WS_H1B); S.W = (const char*)(ws + WS_WGU_T);
        S.U = 2 * __builtin_amdgcn_readfirstlane(((const LAS int*)(F.lds + LDS_PREF))[NEXP]); S.G = F.G; S.c = blockIdx.x;
        pg8::EpiH E; E.H = (bf16_t*)(ws + WS_H);
        pg8::gemm_phase<pg8::EpiH, pg8::ExpertSched<true>, true>(F.lds, 1024, S, E, F.wave);
    }
    SEAM(9);
    if (PH(10)) {
        build_tables(F);
        pg8::ExpertSched<false> S; S.lds = F.lds;
        S.lists = (const int*)(ws + WS_LISTS); S.A = (const char*)(ws + WS_H); S.W = (const char*)(ws + WS_WD_T);
        S.U = 4 * __builtin_amdgcn_readfirstlane(((const LAS int*)(F.lds + LDS_PREF))[NEXP]); S.G = F.G; S.c = blockIdx.x;
        pg8::EpiYb E; E.YB = (bf16_t*)(ws + WS_YB); E.lists = (const int*)(ws + WS_LISTS); E.tok_gate = (const float*)(ws + WS_TOKGATE);
        pg8::gemm_phase<pg8::EpiYb, pg8::ExpertSched<false>, true>(F.lds, 256, S, E, F.wave);
    }
    SEAM(10);
#else
    if (PH(9)) phase_experts(F, args, args.mode);
    SEAM(9);
#endif
    if (PH(11)) { build_tables(F); phase_final(F, args); }
}

extern "C" void kernel_launch(void* const* d_in, const int* in_sizes, int n_in, void* d_out, int out_size, void* d_ws, size_t ws_size, hipStream_t stream) {
    static int grid = 0;
    if (grid == 0) {
        int dev = 0, cus = 0;
        if (hipGetDevice(&dev) != hipSuccess || hipDeviceGetAttribute(&cus, hipDeviceAttributeMultiprocessorCount, dev) != hipSuccess) { fprintf(stderr, "device query failed\n"); grid = -1; return; }
        if (hipFuncSetAttribute((const void*)mk_fwd, hipFuncAttributeMaxDynamicSharedMemorySize, LDS_BYTES) != hipSuccess) { fprintf(stderr, "hipFuncSetAttribute failed\n"); grid = -1; return; }
        if (ws_size < WS_END) { fprintf(stderr, "workspace too small: %zu < %zu\n", ws_size, (size_t)WS_END); grid = -1; return; }
        (void)hipGetLastError();
        grid = cus;
    }
    if (grid < 0) return;
    unsigned char* ws = (unsigned char*)d_ws;
    (void)hipMemsetAsync(ws + WS_CTL, 0, CTL_ZERO_BYTES, stream);
    Args a{};
    for (int i = 0; i < 23; ++i) a.in[i] = (const float*)d_in[i];
    a.out = (float*)d_out; a.ws = ws;
    auto launch = [&](int lo, int hi) { a.ph_lo = lo; a.ph_hi = hi; hipLaunchKernelGGL(mk_fwd, dim3(grid), dim3(512), LDS_BYTES, stream, a); };
#if defined(MK_PER_PHASE)
    for (int ph = 0; ph < NPH; ++ph) launch(ph, ph + 1);
#else
    launch(0, NPH);
#endif
}
```

```cpp
#include <hip/hip_runtime.h>
#include <stdint.h>
#include <cstdio>

#define GAS __attribute__((address_space(1)))
#define LAS __attribute__((address_space(3)))
typedef unsigned short bf16_t;
typedef short bf16x8 __attribute__((ext_vector_type(8)));
typedef float f32x4 __attribute__((ext_vector_type(4)));
typedef unsigned u32x4 __attribute__((ext_vector_type(4)));
typedef unsigned u32x2 __attribute__((ext_vector_type(2)));
typedef float f32x16 __attribute__((ext_vector_type(16)));
typedef short s16x4 __attribute__((ext_vector_type(4)));

constexpr int T_TOK = 16384, DM = 1024, NIN = 3592, PW = 3584;
constexpr int NEXP = 256, LIST_CAP = 16384;
constexpr int PC_Z = 0, PC_XBC = 512, PC_Q = 1536, PC_F = 2048, PC_I = 2560, PC_G = 3072;
#define ALPHA_F 1.189207115002721f
#define LN_EPS_F 1e-5f
#define RMS_EPS_F 1e-6f

constexpr size_t MiB = 1u << 20;
constexpr size_t WS_CTL = 0, CTL_ZERO_BYTES = 1 * MiB;
constexpr size_t WS_WIN_T = 2 * MiB, WS_WOUT_T = 9 * MiB, WS_W3_T = 11 * MiB, WS_WDS_T = 13 * MiB, WS_DTRAW = 14 * MiB;
constexpr size_t WS_TOKE = 15 * MiB, WS_TOKPOS = 15 * MiB + 512 * 1024, WS_TOKGATE = 16 * MiB;
constexpr size_t WS_LISTS = 17 * MiB, WS_LOGITS = 33 * MiB, WS_HS = 49 * MiB, WS_YS = 57 * MiB, WS_H1 = 89 * MiB, WS_H1B = 153 * MiB;
constexpr size_t WS_WGU_T = 185 * MiB, WS_WD_T = 441 * MiB;
constexpr size_t WS_X0 = 569 * MiB;
constexpr size_t WS_XB = WS_X0, WS_P = WS_X0 + 32 * MiB, WS_MIX = WS_X0 + 144 * MiB;
constexpr size_t WS_NXBC = WS_X0 + 176 * MiB, WS_NFGK = WS_X0 + 240 * MiB, WS_NQS = WS_X0 + 272 * MiB, WS_NYSSD = WS_X0 + 304 * MiB, WS_NOH = WS_X0 + 336 * MiB, WS_NDTB = WS_X0 + 368 * MiB;
constexpr size_t WS_SSTATE = WS_X0 + 176 * MiB, WS_SPREV = WS_X0 + 208 * MiB, WS_HKV = WS_X0 + 224 * MiB, WS_HSPREV = WS_X0 + 288 * MiB;
constexpr size_t WS_CDECAY = WS_X0 + 320 * MiB, WS_HDECAY = WS_X0 + 320 * MiB + 64 * 1024;
constexpr size_t WS_H = WS_X0, WS_YB = WS_X0 + 65 * MiB;
constexpr size_t WS_END = WS_X0 + 369 * MiB;
constexpr int CW_BAR = 4096;
constexpr int CW_COUNTS = 16384, CNT_STRIDE = 64;

constexpr int RING_BYTES = 131072;
constexpr int LDS_BYTES = 163840;
constexpr int LDS_MISC = LDS_BYTES - 4096;
constexpr int LDS_PREF = LDS_MISC + 256;
constexpr int LDS_OFFS = LDS_PREF + 1040;
constexpr int LDS_CNT = LDS_OFFS + 1040;
constexpr int LDS_PHASE_BYTES = LDS_MISC;

__device__ __forceinline__ int lane_id() { int l; asm volatile("v_mbcnt_lo_u32_b32 %0, -1, 0\n\tv_mbcnt_hi_u32_b32 %0, -1, %0" : "=v"(l)); return l; }
__device__ __forceinline__ float siluf(float x) { return x / (1.0f + __expf(-x)); }
__device__ __forceinline__ float sigmf(float x) { return 1.0f / (1.0f + __expf(-x)); }
__device__ __forceinline__ float wave_sum(float v) {
#pragma unroll
  for (int o = 1; o < 64; o <<= 1) v += __shfl_xor(v, o);
  return v;
}
__device__ __forceinline__ unsigned cvt_pk_bf16(float lo, float hi) { unsigned r; asm volatile("v_cvt_pk_bf16_f32 %0, %1, %2" : "=v"(r) : "v"(lo), "v"(hi)); return r; }
#define YB_SCALE 64.0f
__device__ __forceinline__ unsigned pk4_fp8(const f32x4 v) {
    const float a = fminf(fmaxf(v[0], -440.f), 440.f), b = fminf(fmaxf(v[1], -440.f), 440.f), c = fminf(fmaxf(v[2], -440.f), 440.f), d = fminf(fmaxf(v[3], -440.f), 440.f);
    int w = 0; w = __builtin_amdgcn_cvt_pk_fp8_f32(a, b, w, false); w = __builtin_amdgcn_cvt_pk_fp8_f32(c, d, w, true); return (unsigned)w; }
__device__ __forceinline__ f32x4 un4_fp8(const unsigned w) { return (f32x4){__builtin_amdgcn_cvt_f32_fp8((int)w, 0), __builtin_amdgcn_cvt_f32_fp8((int)w, 1), __builtin_amdgcn_cvt_f32_fp8((int)w, 2), __builtin_amdgcn_cvt_f32_fp8((int)w, 3)}; }
__device__ __forceinline__ float bf2f(unsigned b) { return __uint_as_float(b << 16); }
__device__ __forceinline__ float bflo(unsigned w) { return __uint_as_float(w << 16); }
__device__ __forceinline__ float bfhi(unsigned w) { return __uint_as_float(w & 0xffff0000u); }

#define XB_TMO      128
#define XB_XCNT(j)  (256  + 64 * (j))
#define XB_XSUB(j)  (1280 + 64 * (j))
#define XB_XGEN(j)  (2304 + 64 * (j))
#define XB_TOP      3328
#define XB_TOPGEN   3392
#define XCD_BAR_WORDS 3456
#define XB_SPIN_CAP (1u << 18)
__device__ __forceinline__ unsigned xb_ld(unsigned* p)              { return __hip_atomic_load(p, __ATOMIC_RELAXED, __HIP_MEMORY_SCOPE_AGENT); }
__device__ __forceinline__ unsigned xb_add(unsigned* p, unsigned v) { return __hip_atomic_fetch_add(p, v, __ATOMIC_RELAXED, __HIP_MEMORY_SCOPE_AGENT); }
__device__ __forceinline__ unsigned xb_xcc_id() { return (unsigned)__builtin_amdgcn_s_getreg((3 << 11) | 20) & 0xFu; }
#define XB_SPIN(cond, bar) do { unsigned _sp = 0; while (cond) { __builtin_amdgcn_s_sleep(1); \
    if ((++_sp & 255u) == 0u) { if (xb_ld(&(bar)[XB_TMO])) break; if (_sp > XB_SPIN_CAP) { atomicAdd(&(bar)[XB_TMO], 1u); break; } } } } while (0)
struct XcdBarrier { unsigned* bar; unsigned x; volatile LAS unsigned* st; int wave; };
__device__ __forceinline__ XcdBarrier xcd_barrier_post(unsigned* bar, volatile LAS unsigned* st, int wave) {
    XcdBarrier b; b.bar = bar; b.x = xb_xcc_id(); b.st = st; b.wave = wave;
    if (wave == 0 && lane_id() == 0) (void)xb_add(&bar[XB_XCNT(b.x)], 1u);
    return b;
}
__device__ __forceinline__ void xcd_barrier_complete(unsigned* bar, unsigned x, unsigned& nloc, unsigned& nx) {
    const unsigned G = gridDim.x * gridDim.y * gridDim.z;
    unsigned sum, cnt, mine, sp = 0u;
    for (;;) {
        sum = 0u; cnt = 0u; mine = 0u;
#pragma unroll
        for (unsigned j = 0; j < 16; ++j) { const unsigned c = xb_ld(&bar[XB_XCNT(j)]); sum += c; cnt += (c > 0u) ? 1u : 0u; mine = (j == x) ? c : mine; }
        if (sum == G) break;
        __builtin_amdgcn_s_sleep(1);
        if ((++sp & 255u) == 0u) { if (xb_ld(&bar[XB_TMO])) break; if (sp > XB_SPIN_CAP) { atomicAdd(&bar[XB_TMO], 1u); break; } }
    }
    nloc = mine > 0u ? mine : 1u; nx = cnt > 0u ? cnt : 1u;
}
__device__ __forceinline__ void xcd_barrier(const XcdBarrier& b) {
    asm volatile("s_waitcnt vmcnt(0)" ::: "memory");
    __syncthreads();
    if (b.wave == 0 && lane_id() == 0) {
        unsigned* bar = b.bar;
        __builtin_amdgcn_s_waitcnt(0);
        unsigned nloc = b.st[0], nx = b.st[1];
        if (nloc == 0u) { xcd_barrier_complete(bar, b.x, nloc, nx); b.st[0] = nloc; b.st[1] = nx; }
        const unsigned old = xb_add(&bar[XB_XSUB(b.x)], 1u);
        const unsigned gen = old / nloc;
        if (old + 1u == (gen + 1u) * nloc) {
            __builtin_amdgcn_fence(__ATOMIC_RELEASE, "agent");
            asm volatile("s_waitcnt vmcnt(0)" ::: "memory");
            const unsigned og = xb_add(&bar[XB_TOP], 1u);
            const unsigned tg = og / nx;
            if (og + 1u == (tg + 1u) * nx) xb_add(&bar[XB_TOPGEN], 1u);
            else XB_SPIN(xb_ld(&bar[XB_TOPGEN]) == tg, bar);
            __builtin_amdgcn_fence(__ATOMIC_ACQUIRE, "agent");
            xb_add(&bar[XB_XGEN(b.x)], 1u);
            asm volatile("s_waitcnt vmcnt(0)" ::: "memory");
        } else {
            XB_SPIN(xb_ld(&bar[XB_XGEN(b.x)]) == gen, bar);
            __builtin_amdgcn_fence(__ATOMIC_ACQUIRE, "agent");
            asm volatile("s_waitcnt vmcnt(0)" ::: "memory");
        }
    }
    __syncthreads();
}

namespace pg8 {
constexpr int BM = 256, BK = 64, HALF = 128, HTB = HALF * BK * 2, STAGE_BYTES = 8 * HTB, NXCD = 8, WGM = 8;
__host__ __device__ __forceinline__ int lds_byte(int r, int c) { const int st = (r >> 4) * 2 + (c >> 5), rr = r & 15, cc = c & 31, ob = rr * 64 + cc * 2; return st * 1024 + (ob ^ (((ob >> 9) & 1) << 5)); }
__host__ __device__ __forceinline__ void stage_rc(int b, int& R, int& C) { const int st = b / 1024, sb = b % 1024, swz = sb ^ (((sb >> 9) & 1) << 5); R = (st >> 1) * 16 + swz / 64; C = (st & 1) * 32 + (swz % 64) / 2; }
__host__ __device__ __forceinline__ int perm32(int rho) { const int n = rho >> 4, i = rho & 15; return 8 * (i >> 2) + 4 * n + (i & 3); }

struct Unit { const char* A; const char* B; int pm, pn, rows, e, slot0, mt; };

struct DenseSched {
    static constexpr bool PER_UNIT_VOFF = false;
    const char* A; const char* B; int K, nM, nN, nwg, G, c;
    __device__ void init(const void* A_, const void* B_, int M, int N, int K_, int G_, int c_) { A = (const char*)A_; B = (const char*)B_; K = K_; nM = M / BM; nN = N / BM; nwg = nM * nN; G = G_; c = c_; }
    __device__ __forceinline__ bool next(int i, Unit& u) const {
        const int L = i * G + c; if (L >= nwg) return false;
        int wgid = L; { const int q = nwg / NXCD, r = nwg % NXCD, xcd = wgid % NXCD, off = wgid / NXCD; wgid = (xcd < r ? xcd * (q + 1) : r * (q + 1) + (xcd - r) * q) + off; }
        const int nig = WGM * nN, gid = wgid / nig, fm = gid * WGM, gsz = (nM - fm) < WGM ? (nM - fm) : WGM;
        u.pm = fm + ((wgid % nig) % gsz); u.pn = (wgid % nig) / gsz; u.rows = 256; u.e = 0; u.slot0 = 0; u.mt = 0;
        u.A = A + (size_t)u.pm * BM * K * 2; u.B = B + (size_t)u.pn * BM * K * 2; return true;
    }
    __device__ __forceinline__ void voff(const Unit&, const int (&sR)[2], const int (&sC)[2], unsigned (&v)[2][2]) const {
#pragma unroll
        for (int h = 0; h < 2; ++h)
#pragma unroll
            for (int i = 0; i < 2; ++i) v[h][i] = (unsigned)((h * HALF + sR[i]) * K + sC[i]) * 2u;
    }
};

template <bool GATHER> struct ExpertSched {
    static constexpr bool PER_UNIT_VOFF = GATHER;
    static constexpr int K = GATHER ? 1024 : 256, NT = GATHER ? 2 : 4;
    static constexpr unsigned WSTRIDE = GATHER ? 512u * 1024u * 2u : 1024u * 256u * 2u;
    LAS unsigned char* lds;
    const int* lists; const char* A; const char* W; int U, G, c;
    __device__ __forceinline__ bool next(int i, Unit& u) const {
        int L = i * G + c; if (L >= U) return false;
        { const int q = U / NXCD, r = U % NXCD, xcd = L % NXCD, off = L / NXCD; L = (xcd < r ? xcd * (q + 1) : r * (q + 1) + (xcd - r) * q) + off; }
        const LAS int* pref = (const LAS int*)(lds + LDS_PREF);
        int lo = 0, hi = NEXP;
        while (hi - lo > 1) { const int mid = (lo + hi) >> 1; const int pv = __builtin_amdgcn_readfirstlane(pref[mid]); if (NT * pv <= L) lo = mid; else hi = mid; }
        const int e = lo, p0 = __builtin_amdgcn_readfirstlane(pref[e]), p1 = __builtin_amdgcn_readfirstlane(pref[e + 1]), tiles = p1 - p0, r = L - NT * p0;
        u.e = e; u.pn = r / tiles; u.mt = r % tiles; u.pm = 0;
        const int n = __builtin_amdgcn_readfirstlane(((const LAS int*)(lds + LDS_CNT))[e]); u.rows = (n - u.mt * 256) < 256 ? (n - u.mt * 256) : 256;
        u.slot0 = __builtin_amdgcn_readfirstlane(((const LAS int*)(lds + LDS_OFFS))[e]) + u.mt * 256;
        u.A = GATHER ? A : A + (size_t)u.slot0 * (K * 2); u.B = W + (size_t)e * WSTRIDE + (size_t)u.pn * (BM * K * 2); return true;
    }
    __device__ __forceinline__ void voff(const Unit& u, const int (&sR)[2], const int (&sC)[2], unsigned (&v)[2][2]) const {
#pragma unroll
        for (int h = 0; h < 2; ++h)
#pragma unroll
            for (int i = 0; i < 2; ++i) {
                const int r = h * HALF + sR[i];
                if (GATHER) { int tok = 0; if (r < u.rows) tok = lists[(size_t)u.e * LIST_CAP + u.mt * 256 + r] >> 3; v[h][i] = (unsigned)(tok * K + sC[i]) * 2u; }
                else v[h][i] = (unsigned)(r * K + sC[i]) * 2u;
            }
    }
};

template <class Epi, class Sched, bool ALIGN_EPI>
__device__ __forceinline__ void gemm_phase(LAS unsigned char* lds, const int K, const Sched& S, const Epi& E, const int wid) {
    const int lane = lane_id(), tid = wid * 64 + lane, wr = wid >> 2, wc = wid & 3, fr = lane & 15, fq = lane >> 4;
    const int nt = K / BK;
    int sR[2], sC[2]; unsigned voffB[2];
#pragma unroll
    for (int i = 0; i < 2; ++i) { stage_rc(tid * 16 + i * 8192, sR[i], sC[i]); const int Rb = Epi::PERM ? ((sR[i] & ~31) + perm32(sR[i] & 31)) : sR[i]; voffB[i] = (unsigned)(Rb * K + sC[i]) * 2u; }
    const size_t kstep = (size_t)(BK * 2);
    const size_t hstep = (size_t)HALF * K * 2;
    const unsigned ldsw = (unsigned)wid * 1024u;
    const int aoff = lds_byte(wr * 64 + fr, fq * 8), boff = lds_byte(wc * 32 + fr, fq * 8);
#define PG8_SA(b, h) (((b) * 2 + (h)) * HTB)
#define PG8_SB(b, h) ((4 + (b) * 2 + (h)) * HTB)
#define PG8_STAGE(bufoff, gbase, voff) do { _Pragma("unroll") for (int _i = 0; _i < 2; ++_i) \
        __builtin_amdgcn_global_load_lds((const unsigned*)((const char*)(gbase) + (voff)[_i]), (LAS unsigned*)(lds + (bufoff) + ldsw + _i * 8192), 16, 0, 0); } while (0)
#define PG8_STAGE_A(bufoff, gbase, h, vset) do { if constexpr (Sched::PER_UNIT_VOFF) { PG8_STAGE(bufoff, gbase, (vset)[h]); } else { PG8_STAGE(bufoff, (gbase) + (h) * hstep, vc[0]); } } while (0)
#define PG8_LDA(dst, b, h) do { _Pragma("unroll") for (int m = 0; m < 4; ++m) _Pragma("unroll") for (int k = 0; k < 2; ++k) dst[m][k] = *(const LAS bf16x8*)(lds + PG8_SA(b, h) + aoff + m * 2048 + k * 1024); } while (0)
#define PG8_LDB(dst, b, h) do { _Pragma("unroll") for (int n = 0; n < 2; ++n) _Pragma("unroll") for (int k = 0; k < 2; ++k) dst[n][k] = *(const LAS bf16x8*)(lds + PG8_SB(b, h) + boff + n * 2048 + k * 1024); } while (0)
#define PG8_MMA(ai, bj, At, Bt) do { __builtin_amdgcn_s_setprio(1); _Pragma("unroll") for (int m = 0; m < 4; ++m) _Pragma("unroll") for (int n = 0; n < 2; ++n) _Pragma("unroll") for (int k = 0; k < 2; ++k) \
        acc[ai][bj][m][n] = __builtin_amdgcn_mfma_f32_16x16x32_bf16(Bt[n][k], At[m][k], acc[ai][bj][m][n], 0, 0, 0); __builtin_amdgcn_s_setprio(0); } while (0)
#define PG8_WAIT_V(n) asm volatile("s_waitcnt vmcnt(" #n ")" ::: "memory")
#define PG8_WAIT_L(n) asm volatile("s_waitcnt lgkmcnt(" #n ")" ::: "memory")
#define PG8_BAR __builtin_amdgcn_s_barrier()
#define PG8_SCHED __builtin_amdgcn_sched_barrier(0)
    Unit cur, nxt; int ui = 0;
    if (!S.next(0, cur)) return;
    unsigned vc[2][2], vn[2][2];
    S.voff(cur, sR, sC, vc);
    f32x4 acc[2][2][4][2];
#pragma unroll
    for (int a = 0; a < 2; ++a)
#pragma unroll
        for (int b = 0; b < 2; ++b)
#pragma unroll
            for (int m = 0; m < 4; ++m)
#pragma unroll
                for (int n = 0; n < 2; ++n) acc[a][b][m][n] = (f32x4){0.f, 0.f, 0.f, 0.f};
    bf16x8 At[4][2], B0[2][2], B1[2][2];
    const char* cA = cur.A; const char* cB = cur.B;
    PG8_STAGE(PG8_SB(0, 0), cB, voffB); PG8_STAGE(PG8_SB(0, 1), cB + hstep, voffB); PG8_STAGE_A(PG8_SA(0, 0), cA, 0, vc); PG8_STAGE_A(PG8_SA(0, 1), cA, 1, vc);
    if (wr == 1) PG8_BAR;
    PG8_WAIT_V(2); PG8_BAR;
    PG8_STAGE(PG8_SB(1, 0), cB + kstep, voffB); PG8_STAGE_A(PG8_SA(1, 0), cA + kstep, 0, vc); PG8_STAGE(PG8_SB(1, 1), cB + hstep + kstep, voffB);
    PG8_WAIT_V(6); PG8_BAR;
    for (;;) {
        const bool has_next = S.next(ui + 1, nxt);
        if constexpr (Sched::PER_UNIT_VOFF) {
            if (has_next) S.voff(nxt, sR, sC, vn);
            else {
#pragma unroll
                for (int h = 0; h < 2; ++h)
#pragma unroll
                    for (int i = 0; i < 2; ++i) vn[h][i] = vc[h][i];
            }
        }
        const char* nA = has_next ? nxt.A : cA; const char* nB = has_next ? nxt.B : cB;
        for (int t = 0; t < nt; t += 2) {
            const bool last = (t == nt - 2);
            const char* a1 = cA + (size_t)(t + 1) * kstep;
            const char* a2 = last ? nA : cA + (size_t)(t + 2) * kstep; const char* b2 = last ? nB : cB + (size_t)(t + 2) * kstep;
            const char* a3 = a2 + kstep; const char* b3 = b2 + kstep;
            unsigned v2[2][2];
#pragma unroll
            for (int h = 0; h < 2; ++h)
#pragma unroll
                for (int i = 0; i < 2; ++i) v2[h][i] = (Sched::PER_UNIT_VOFF && last) ? vn[h][i] : vc[h][i];
            PG8_LDB(B0, 0, 0); PG8_LDB(B1, 0, 1); PG8_SCHED; PG8_LDA(At, 0, 0); PG8_STAGE_A(PG8_SA(1, 1), a1, 1, vc);
            PG8_WAIT_V(8); PG8_WAIT_L(0); PG8_BAR; PG8_MMA(0, 0, At, B0); PG8_MMA(0, 1, At, B1); PG8_BAR; PG8_SCHED;
            PG8_LDA(At, 0, 1); PG8_STAGE(PG8_SB(0, 0), b2, voffB); PG8_STAGE(PG8_SB(0, 1), b2 + hstep, voffB); PG8_STAGE_A(PG8_SA(0, 0), a2, 0, v2);
            PG8_WAIT_V(8); PG8_WAIT_L(0); PG8_BAR; PG8_MMA(1, 0, At, B0); PG8_MMA(1, 1, At, B1); PG8_BAR; PG8_SCHED;
            PG8_LDB(B0, 1, 0); PG8_LDB(B1, 1, 1); PG8_SCHED; PG8_LDA(At, 1, 0); PG8_STAGE_A(PG8_SA(0, 1), a2, 1, v2);
            PG8_WAIT_V(8); PG8_WAIT_L(0); PG8_BAR; PG8_MMA(0, 0, At, B0); PG8_MMA(0, 1, At, B1); PG8_BAR; PG8_SCHED;
            PG8_LDA(At, 1, 1); PG8_STAGE(PG8_SB(1, 0), b3, voffB); PG8_STAGE(PG8_SB(1, 1), b3 + hstep, voffB); PG8_STAGE_A(PG8_SA(1, 0), a3, 0, v2);
            PG8_WAIT_V(8); PG8_WAIT_L(0); PG8_BAR; PG8_MMA(1, 0, At, B0); PG8_MMA(1, 1, At, B1); PG8_BAR; PG8_SCHED;
        }
        if constexpr (ALIGN_EPI) { if (wr == 0) PG8_BAR; }
        E(acc, cur, wr, wc, fr, fq);
        if (!has_next) break;
#pragma unroll
        for (int a = 0; a < 2; ++a)
#pragma unroll
            for (int b = 0; b < 2; ++b)
#pragma unroll
                for (int m = 0; m < 4; ++m)
#pragma unroll
                    for (int n = 0; n < 2; ++n) acc[a][b][m][n] = (f32x4){0.f, 0.f, 0.f, 0.f};
        cur = nxt; cA = nA; cB = nB; ++ui;
        if constexpr (Sched::PER_UNIT_VOFF) {
#pragma unroll
            for (int h = 0; h < 2; ++h)
#pragma unroll
                for (int i = 0; i < 2; ++i) vc[h][i] = vn[h][i];
        }
        if constexpr (ALIGN_EPI) { if (wr == 1) PG8_BAR; }
    }
    PG8_WAIT_V(0);
    if constexpr (!ALIGN_EPI) { if (wr == 0) PG8_BAR; }
    PG8_BAR;
#undef PG8_SA
#undef PG8_SB
#undef PG8_STAGE
#undef PG8_LDA
#undef PG8_STAGE_A
#undef PG8_LDB
#undef PG8_MMA
#undef PG8_WAIT_V
#undef PG8_WAIT_L
#undef PG8_BAR
#undef PG8_SCHED
}

struct EpiP {
    static constexpr bool PERM = true;
    bf16_t* O; int ldc;
    __device__ __forceinline__ void operator()(const f32x4 (&acc)[2][2][4][2], const Unit& u, int wr, int wc, int fr, int fq) const {
        const int row0 = u.pm * BM + wr * 64 + fr, col0 = u.pn * BM + wc * 32 + 8 * fq;
#pragma unroll
        for (int ai = 0; ai < 2; ++ai)
#pragma unroll
            for (int m = 0; m < 4; ++m) { bf16_t* rowp = O + (size_t)(row0 + ai * HALF + m * 16) * ldc + col0;
#pragma unroll
                for (int bj = 0; bj < 2; ++bj) { const f32x4 v0 = acc[ai][bj][m][0], v1 = acc[ai][bj][m][1];
                    u32x4 w; w.x = cvt_pk_bf16(v0[0], v0[1]); w.y = cvt_pk_bf16(v0[2], v0[3]); w.z = cvt_pk_bf16(v1[0], v1[1]); w.w = cvt_pk_bf16(v1[2], v1[3]);
                    *(u32x4*)(rowp + bj * HALF) = w; } }
    }
};
struct EpiU {
    static constexpr bool PERM = false;
    float* U; const float* X;
    __device__ __forceinline__ void operator()(const f32x4 (&acc)[2][2][4][2], const Unit& u, int wr, int wc, int fr, int fq) const {
        const int row0 = u.pm * BM + wr * 64 + fr, col0 = u.pn * BM + wc * 32 + 4 * fq;
#pragma unroll
        for (int ai = 0; ai < 2; ++ai)
#pragma unroll
            for (int m = 0; m < 4; ++m) { const size_t ro = (size_t)(row0 + ai * HALF + m * 16) * DM + col0;
#pragma unroll
                for (int bj = 0; bj < 2; ++bj)
#pragma unroll
                    for (int n = 0; n < 2; ++n) { const f32x4 xv = *(const f32x4*)(X + ro + bj * HALF + n * 16);
                        *(f32x4*)(U + ro + bj * HALF + n * 16) = xv * ALPHA_F + acc[ai][bj][m][n]; } }
    }
};
struct Epi3 {
    static constexpr bool PERM = true;
    float* LG; bf16_t* HS;
    __device__ __forceinline__ void operator()(const f32x4 (&acc)[2][2][4][2], const Unit& u, int wr, int wc, int fr, int fq) const {
        const int row0 = u.pm * BM + wr * 64 + fr;
        if (u.pn == 0) {
#pragma unroll
            for (int ai = 0; ai < 2; ++ai)
#pragma unroll
                for (int m = 0; m < 4; ++m) { float* rowp = LG + (size_t)(row0 + ai * HALF + m * 16) * 256 + wc * 32 + 8 * fq;
#pragma unroll
                    for (int bj = 0; bj < 2; ++bj)
#pragma unroll
                        for (int n = 0; n < 2; ++n) *(f32x4*)(rowp + bj * HALF + 4 * n) = acc[ai][bj][m][n]; }
        } else {
            const int hc0 = (u.pn - 1) * 128 + wc * 32 + 8 * fq;
#pragma unroll
            for (int ai = 0; ai < 2; ++ai)
#pragma unroll
                for (int m = 0; m < 4; ++m) { bf16_t* rowp = HS + (size_t)(row0 + ai * HALF + m * 16) * 256 + hc0;
                    float h[8];
#pragma unroll
                    for (int n = 0; n < 2; ++n)
#pragma unroll
                        for (int j = 0; j < 4; ++j) h[n * 4 + j] = siluf(acc[ai][0][m][n][j]) * acc[ai][1][m][n][j];
                    u32x4 w; w.x = cvt_pk_bf16(h[0], h[1]); w.y = cvt_pk_bf16(h[2], h[3]); w.z = cvt_pk_bf16(h[4], h[5]); w.w = cvt_pk_bf16(h[6], h[7]);
                    *(u32x4*)rowp = w; }
        }
    }
};
struct EpiH {
    static constexpr bool PERM = true;
    bf16_t* H;
    __device__ __forceinline__ void operator()(const f32x4 (&acc)[2][2][4][2], const Unit& u, int wr, int wc, int fr, int fq) const {
        const int hc0 = u.pn * 128 + wc * 32 + 8 * fq;
#pragma unroll
        for (int ai = 0; ai < 2; ++ai)
#pragma unroll
            for (int m = 0; m < 4; ++m) { const int r = ai * HALF + wr * 64 + m * 16 + fr;
                if (r < u.rows) { bf16_t* rowp = H + (size_t)(u.slot0 + r) * 256 + hc0;
                    float h[8];
#pragma unroll
                    for (int n = 0; n < 2; ++n)
#pragma unroll
                        for (int j = 0; j < 4; ++j) h[n * 4 + j] = siluf(acc[ai][0][m][n][j]) * acc[ai][1][m][n][j];
                    u32x4 w; w.x = cvt_pk_bf16(h[0], h[1]); w.y = cvt_pk_bf16(h[2], h[3]); w.z = cvt_pk_bf16(h[4], h[5]); w.w = cvt_pk_bf16(h[6], h[7]);
                    *(u32x4*)rowp = w; } }
    }
};
struct EpiYb {
    static constexpr bool PERM = true;
    bf16_t* YB; const int* lists; const float* tok_gate;
    __device__ __forceinline__ void operator()(const f32x4 (&acc)[2][2][4][2], const Unit& u, int wr, int wc, int fr, int fq) const {
        const int col0 = u.pn * BM + wc * 32 + 8 * fq;
#pragma unroll
        for (int ai = 0; ai < 2; ++ai)
#pragma unroll
            for (int m = 0; m < 4; ++m) { const int r = ai * HALF + wr * 64 + m * 16 + fr;
                if (r < u.rows) { const float g = tok_gate[lists[(size_t)u.e * LIST_CAP + u.mt * 256 + r]];
                    bf16_t* rowp = YB + (size_t)(u.slot0 + r) * 1024 + col0;
#pragma unroll
                    for (int bj = 0; bj < 2; ++bj) { const f32x4 v0 = acc[ai][bj][m][0] * g, v1 = acc[ai][bj][m][1] * g;
                        u32x4 w; w.x = cvt_pk_bf16(v0[0], v0[1]); w.y = cvt_pk_bf16(v0[2], v0[3]); w.z = cvt_pk_bf16(v1[0], v1[1]); w.w = cvt_pk_bf16(v1[2], v1[3]);
                        *(u32x4*)(rowp + bj * HALF) = w; } } }
    }
};
}

template <int OFF> __device__ __forceinline__ unsigned long long karg_u64() { unsigned long long v;
    asm volatile("s_load_dwordx2 %0, %1, %2\n\ts_waitcnt lgkmcnt(0)" : "=s"(v) : "s"(__builtin_amdgcn_kernarg_segment_ptr()), "i"(OFF)); return v; }
#define KARG_IN(k) ((const float*)karg_u64<8 * (k)>())
#define KARG_OUT() ((float*)karg_u64<184>())
struct Args { const float* in[23]; float* out; unsigned char* ws; int ph_lo, ph_hi, mode, li; };
struct Frame { LAS unsigned char* lds; int wave, G, vcu; unsigned char* ws; unsigned* ctl; };
#define F_LANE lane_id()
#define F_TID (F.wave * 64 + lane_id())
constexpr int NPH = 12;

__device__ __forceinline__ void transpose_item(const float* W, int ldw, int c0, int k0, bf16_t* WT, int K, int row0, LAS float* scr, int lane) {
#pragma unroll 8
    for (int i = 0; i < 32; ++i) { const int kk = 2 * i + (lane >> 5); scr[kk * 33 + (lane & 31)] = W[(size_t)(k0 + kk) * ldw + c0 + (lane & 31)]; }
    asm volatile("s_waitcnt lgkmcnt(0)" ::: "memory");
    const int c = lane & 7;
#pragma unroll
    for (int j = 0; j < 4; ++j) { const int n = (lane >> 3) + 8 * j; const LAS float* s = scr + (8 * c) * 33 + n;
        u32x4 o; o.x = cvt_pk_bf16(s[0 * 33], s[1 * 33]); o.y = cvt_pk_bf16(s[2 * 33], s[3 * 33]); o.z = cvt_pk_bf16(s[4 * 33], s[5 * 33]); o.w = cvt_pk_bf16(s[6 * 33], s[7 * 33]);
        *(u32x4*)(WT + (size_t)(row0 + n) * K + k0 + 8 * c) = o; }
    asm volatile("s_waitcnt lgkmcnt(0)" ::: "memory");
}

__device__ __forceinline__ void gu_item(const float* Wg, const float* Wu, bf16_t* WT, int item, LAS float* scr, int lane) {
    const int kb = item >> 4, nb = item & 15, row0 = nb * 32, pn = row0 >> 8, half = (row0 >> 7) & 1, r0 = row0 & 127;
    transpose_item(half ? Wu : Wg, 256, pn * 128 + r0, kb * 64, WT, 1024, row0, scr, lane);
}

__device__ __forceinline__ void phase_prep(const Frame& F, const Args& a) {
    float wdt[16][8];
    { const float* w_in0 = KARG_IN(1); const int tid = F_TID;
      __syncthreads();
#pragma unroll
      for (int i = 0; i < 2; ++i) { const int k = tid + 512 * i; const float* src = w_in0 + (size_t)k * NIN + 1536;
          *(LAS f32x4*)(F.lds + k * 32) = *(const f32x4*)src; *(LAS f32x4*)(F.lds + k * 32 + 16) = *(const f32x4*)(src + 4); }
      __syncthreads();
#pragma unroll
      for (int j = 0; j < 16; ++j) { const int k = (j < 8 ? 8 * F_LANE + j : 512 + 8 * F_LANE + (j - 8));
          const f32x4 lo = *(const LAS f32x4*)(F.lds + k * 32), hi = *(const LAS f32x4*)(F.lds + k * 32 + 16);
          wdt[j][0] = lo[0]; wdt[j][1] = lo[1]; wdt[j][2] = lo[2]; wdt[j][3] = lo[3]; wdt[j][4] = hi[0]; wdt[j][5] = hi[1]; wdt[j][6] = hi[2]; wdt[j][7] = hi[3]; }
      __syncthreads(); }
    LAS float* scr = (LAS float*)(F.lds + F.wave * 16384);
    const int gw = F.vcu * 8 + F.wave, NGW = F.G * 8;
    unsigned char* ws = F.ws;
    bf16_t* Win_t = (bf16_t*)(ws + WS_WIN_T); bf16_t* Wout_t = (bf16_t*)(ws + WS_WOUT_T); bf16_t* W3_t = (bf16_t*)(ws + WS_W3_T); bf16_t* Wds_t = (bf16_t*)(ws + WS_WDS_T);
    bf16_t* Wgu_t = (bf16_t*)(ws + WS_WGU_T); bf16_t* Wd_t = (bf16_t*)(ws + WS_WD_T);
    const float* w_in = KARG_IN(1); const float* w_out = KARG_IN(10); const float* w_router = KARG_IN(13);
    const float* wge = KARG_IN(15); const float* wue = KARG_IN(16); const float* wde = KARG_IN(17);
    const float* wgs = KARG_IN(18); const float* wus = KARG_IN(19); const float* wds = KARG_IN(20);
    constexpr int I_IN = 16 * (PW / 32), I_OUT = 16 * 32, I_R = 16 * 8, I_S = 16 * 16, I_DS = 4 * 32, I_EGU = 16 * 16, I_ED = 4 * 32;
#if defined(MK_OLD_EXPERTS)
    constexpr int NITEMS = I_IN + I_OUT + I_R + I_S + I_DS + NEXP * (I_EGU + I_ED);
#else
    constexpr int NITEMS = I_IN + I_OUT + I_R + I_S + I_DS;
#endif
    for (int it = gw; it < NITEMS; it += NGW) {
        int r = it;
        if (r < I_IN) { const int kb = r / (PW / 32), nb = r % (PW / 32), row0 = nb * 32; const int c0 = row0 < 1536 ? row0 : row0 + 8;
            transpose_item(w_in, NIN, c0, kb * 64, Win_t, 1024, row0, scr, F_LANE); continue; } r -= I_IN;
        if (r < I_OUT) { transpose_item(w_out, 1024, (r & 31) * 32, (r >> 5) * 64, Wout_t, 1024, (r & 31) * 32, scr, F_LANE); continue; } r -= I_OUT;
        if (r < I_R) { transpose_item(w_router, 256, (r & 7) * 32, (r >> 3) * 64, W3_t, 1024, (r & 7) * 32, scr, F_LANE); continue; } r -= I_R;
        if (r < I_S) { gu_item(wgs, wus, W3_t + (size_t)256 * 1024, r, scr, F_LANE); continue; } r -= I_S;
        if (r < I_DS) { transpose_item(wds, 1024, (r & 31) * 32, (r >> 5) * 64, Wds_t, 256, (r & 31) * 32, scr, F_LANE); continue; } r -= I_DS;
        const int e = r / (I_EGU + I_ED), q = r % (I_EGU + I_ED);
        if (q < I_EGU) gu_item(wge + (size_t)e * 1024 * 256, wue + (size_t)e * 1024 * 256, Wgu_t + (size_t)e * 512 * 1024, q, scr, F_LANE);
        else { const int qq = q - I_EGU; transpose_item(wde + (size_t)e * 256 * 1024, 1024, (qq & 31) * 32, (qq >> 5) * 64, Wd_t + (size_t)e * 1024 * 256, 256, (qq & 31) * 32, scr, F_LANE); }
    }
    const float* x = KARG_IN(0); bf16_t* xb = (bf16_t*)(ws + WS_XB); float* dtraw = (float*)(ws + WS_DTRAW);
    f32x4 n0, n1, n2, n3;
    { const float* xr = x + (size_t)(gw < T_TOK ? gw : 0) * DM; n0 = *(const f32x4*)(xr + 8 * F_LANE); n1 = *(const f32x4*)(xr + 8 * F_LANE + 4); n2 = *(const f32x4*)(xr + 512 + 8 * F_LANE); n3 = *(const f32x4*)(xr + 512 + 8 * F_LANE + 4); }
    for (int t = gw; t < T_TOK; t += NGW) {
        const f32x4 a0 = n0, a1 = n1, b0 = n2, b1 = n3;
        { const int tn = t + NGW < T_TOK ? t + NGW : t; const float* xr = x + (size_t)tn * DM;
          n0 = *(const f32x4*)(xr + 8 * F_LANE); n1 = *(const f32x4*)(xr + 8 * F_LANE + 4); n2 = *(const f32x4*)(xr + 512 + 8 * F_LANE); n3 = *(const f32x4*)(xr + 512 + 8 * F_LANE + 4); }
        u32x4 w0; w0.x = cvt_pk_bf16(a0[0], a0[1]); w0.y = cvt_pk_bf16(a0[2], a0[3]); w0.z = cvt_pk_bf16(a1[0], a1[1]); w0.w = cvt_pk_bf16(a1[2], a1[3]);
        u32x4 w1; w1.x = cvt_pk_bf16(b0[0], b0[1]); w1.y = cvt_pk_bf16(b0[2], b0[3]); w1.z = cvt_pk_bf16(b1[0], b1[1]); w1.w = cvt_pk_bf16(b1[2], b1[3]);
        *(u32x4*)(xb + (size_t)t * DM + 8 * F_LANE) = w0; *(u32x4*)(xb + (size_t)t * DM + 512 + 8 * F_LANE) = w1;
        const float xv[16] = {a0[0], a0[1], a0[2], a0[3], a1[0], a1[1], a1[2], a1[3], b0[0], b0[1], b0[2], b0[3], b1[0], b1[1], b1[2], b1[3]};
        float d[8];
#pragma unroll
        for (int h = 0; h < 8; ++h) { float sm = 0.f;
#pragma unroll
            for (int j = 0; j < 16; ++j) sm = fmaf(xv[j], wdt[j][h], sm);
            d[h] = wave_sum(sm); }
        if (F_LANE == 0) { *(f32x4*)(dtraw + t * 8) = (f32x4){d[0], d[1], d[2], d[3]}; *(f32x4*)(dtraw + t * 8 + 4) = (f32x4){d[4], d[5], d[6], d[7]}; }
    }
}

__device__ __forceinline__ void phase_ln1(const Frame& F, const Args& a) {
    const int gw = F.vcu * 8 + F.wave, NGW = F.G * 8;
    float* h1 = (float*)(F.ws + WS_H1); bf16_t* h1b = (bf16_t*)(F.ws + WS_H1B);
    const float* g = KARG_IN(11); const float* b = KARG_IN(12);
    const int c0 = 8 * F_LANE;
    f32x4 gv[4], bv[4];
    gv[0] = *(const f32x4*)(g + c0); gv[1] = *(const f32x4*)(g + c0 + 4); gv[2] = *(const f32x4*)(g + 512 + c0); gv[3] = *(const f32x4*)(g + 512 + c0 + 4);
    bv[0] = *(const f32x4*)(b + c0); bv[1] = *(const f32x4*)(b + c0 + 4); bv[2] = *(const f32x4*)(b + 512 + c0); bv[3] = *(const f32x4*)(b + 512 + c0 + 4);
    for (int t = gw; t < T_TOK; t += NGW) {
        float* r = h1 + (size_t)t * DM;
        f32x4 v[4]; v[0] = *(const f32x4*)(r + c0); v[1] = *(const f32x4*)(r + c0 + 4); v[2] = *(const f32x4*)(r + 512 + c0); v[3] = *(const f32x4*)(r + 512 + c0 + 4);
        float s = 0.f;
#pragma unroll
        for (int j = 0; j < 4; ++j) s += (v[j][0] + v[j][1]) + (v[j][2] + v[j][3]);
        const float mu = wave_sum(s) * (1.0f / 1024.0f);
        float q = 0.f;
#pragma unroll
        for (int j = 0; j < 4; ++j) { v[j] = v[j] - mu; q += (v[j][0] * v[j][0] + v[j][1] * v[j][1]) + (v[j][2] * v[j][2] + v[j][3] * v[j][3]); }
        const float rs = rsqrtf(wave_sum(q) * (1.0f / 1024.0f) + LN_EPS_F);
#pragma unroll
        for (int j = 0; j < 4; ++j) v[j] = v[j] * rs * gv[j] + bv[j];
        u32x4 w0; w0.x = cvt_pk_bf16(v[0][0], v[0][1]); w0.y = cvt_pk_bf16(v[0][2], v[0][3]); w0.z = cvt_pk_bf16(v[1][0], v[1][1]); w0.w = cvt_pk_bf16(v[1][2], v[1][3]);
        u32x4 w1; w1.x = cvt_pk_bf16(v[2][0], v[2][1]); w1.y = cvt_pk_bf16(v[2][2], v[2][3]); w1.z = cvt_pk_bf16(v[3][0], v[3][1]); w1.w = cvt_pk_bf16(v[3][2], v[3][3]);
        *(u32x4*)(h1b + (size_t)t * DM + c0) = w0; *(u32x4*)(h1b + (size_t)t * DM + 512 + c0) = w1;
    }
}

__device__ __forceinline__ void phase_route(const Frame& F, const Args& a) {
    const int gw = F.vcu * 8 + F.wave, NGW = F.G * 8, lane = F_LANE;
    const float* logits = (const float*)(F.ws + WS_LOGITS); const float* rbias = KARG_IN(14);
    int* counts = (int*)(F.ctl + CW_COUNTS); int* tok_e = (int*)(F.ws + WS_TOKE); int* tok_pos = (int*)(F.ws + WS_TOKPOS); float* tok_gate = (float*)(F.ws + WS_TOKGATE);
    int* lists = (int*)(F.ws + WS_LISTS);
    const f32x4 rb = *(const f32x4*)(rbias + lane * 4);
    f32x4 lgn = *(const f32x4*)(logits + (size_t)(gw < T_TOK ? gw : 0) * 256 + lane * 4);
    for (int t = gw; t < T_TOK; t += NGW) {
        const f32x4 lg = lgn;
        { const int tn = t + NGW < T_TOK ? t + NGW : t; lgn = *(const f32x4*)(logits + (size_t)tn * 256 + lane * 4); }
        float sc[4] = {sigmf(lg[0]), sigmf(lg[1]), sigmf(lg[2]), sigmf(lg[3])};
        float bs[4] = {sc[0] + rb[0], sc[1] + rb[1], sc[2] + rb[2], sc[3] + rb[3]};
        float m1 = fmaxf(bs[0], bs[1]), m2 = fminf(bs[0], bs[1]);
        { const float n1 = fmaxf(bs[2], bs[3]), n2 = fminf(bs[2], bs[3]);
          const float a1 = fmaxf(m1, n1), a2 = fmaxf(fminf(m1, n1), fmaxf(m2, n2)); m1 = a1; m2 = a2; }
#pragma unroll
        for (int o = 1; o < 8; o <<= 1) {
            const float n1 = __shfl_xor(m1, o), n2 = __shfl_xor(m2, o);
            const float a1 = fmaxf(m1, n1), a2 = fmaxf(fminf(m1, n1), fmaxf(m2, n2)); m1 = a1; m2 = a2;
        }
        const float gs = m1 + m2; const int mygrp = lane >> 3; int rank = 0;
#pragma unroll
        for (int gI = 0; gI < 8; ++gI) { const float og = __shfl(gs, gI * 8); rank += (og > gs || (og == gs && gI < mygrp)) ? 1 : 0; }
        const bool sel = rank < 4;
        float cand[4];
#pragma unroll
        for (int j = 0; j < 4; ++j) cand[j] = sel ? bs[j] : -INFINITY;
        int my_e = -1; float my_s = 0.f; float gsum = 0.f;
#pragma unroll 1
        for (int k = 0; k < 8; ++k) {
            float bv = cand[0]; int bi = 0;
#pragma unroll
            for (int j = 1; j < 4; ++j) if (cand[j] > bv) { bv = cand[j]; bi = j; }
            int be = lane * 4 + bi;
#pragma unroll
            for (int o = 1; o < 64; o <<= 1) {
                const float ov = __shfl_xor(bv, o); const int oe = __shfl_xor(be, o);
                if (ov > bv || (ov == bv && oe < be)) { bv = ov; be = oe; }
            }
            const int wj = be & 3;
            const float mysc = wj == 0 ? sc[0] : wj == 1 ? sc[1] : wj == 2 ? sc[2] : sc[3];
            const float wsc = __shfl(mysc, be >> 2);
            if (lane == (be >> 2)) {
#pragma unroll
                for (int j = 0; j < 4; ++j) if (j == wj) cand[j] = -INFINITY;
            }
            gsum += wsc;
            if (lane == k) { my_e = be; my_s = wsc; }
        }
        if (lane < 8) {
            const float gate = my_s / gsum * 2.5f;
            const int pos = atomicAdd(&counts[my_e * CNT_STRIDE], 1);
            tok_e[t * 8 + lane] = my_e; tok_pos[t * 8 + lane] = pos; tok_gate[t * 8 + lane] = gate;
            lists[(size_t)my_e * LIST_CAP + pos] = t * 8 + lane;
        }
    }
}

__device__ __forceinline__ void build_tables(const Frame& F) {
    const int* counts = (const int*)(F.ctl + CW_COUNTS);
    LAS int* pref = (LAS int*)(F.lds + LDS_PREF); LAS int* offs = (LAS int*)(F.lds + LDS_OFFS); LAS int* cnt = (LAS int*)(F.lds + LDS_CNT);
    LAS int* wt = (LAS int*)(F.lds);
    const int tid = F_TID, lane = tid & 63;
    __syncthreads();
    int n = 0, nt = 0, in_ = 0, it_ = 0;
    if (F.wave < 4) {
        n = __hip_atomic_load(&counts[tid * CNT_STRIDE], __ATOMIC_RELAXED, __HIP_MEMORY_SCOPE_AGENT); nt = (n + 255) >> 8; in_ = n; it_ = nt;
#pragma unroll
        for (int o = 1; o < 64; o <<= 1) { const int a = __shfl_up(in_, o), b = __shfl_up(it_, o); if (lane >= o) { in_ += a; it_ += b; } }
        if (lane == 63) { wt[F.wave] = in_; wt[4 + F.wave] = it_; }
    }
    __syncthreads();
    if (F.wave < 4) {
        for (int w = 0; w < F.wave; ++w) { in_ += wt[w]; it_ += wt[4 + w]; }
        cnt[tid] = n; offs[tid] = in_ - n; pref[tid] = it_ - nt;
        if (tid == NEXP - 1) { offs[NEXP] = in_; pref[NEXP] = it_; }
    }
    __syncthreads();
}

__device__ __forceinline__ void phase_final(const Frame& F, const Args& a) {
    const int gw = F.vcu * 8 + F.wave, NGW = F.G * 8;
    const float* h1 = (const float*)(F.ws + WS_H1); const bf16_t* ys = (const bf16_t*)(F.ws + WS_YS); const bf16_t* yb = (const bf16_t*)(F.ws + WS_YB);
    const int* tok_e = (const int*)(F.ws + WS_TOKE); const int* tok_pos = (const int*)(F.ws + WS_TOKPOS);
    const LAS int* offs = (const LAS int*)(F.lds + LDS_OFFS);
    const float* g = KARG_IN(21); const float* b = KARG_IN(22); float* out = KARG_OUT();
    const int c0 = 8 * F_LANE;
    f32x4 gv[4], bv[4];
    gv[0] = *(const f32x4*)(g + c0); gv[1] = *(const f32x4*)(g + c0 + 4); gv[2] = *(const f32x4*)(g + 512 + c0); gv[3] = *(const f32x4*)(g + 512 + c0 + 4);
    bv[0] = *(const f32x4*)(b + c0); bv[1] = *(const f32x4*)(b + c0 + 4); bv[2] = *(const f32x4*)(b + 512 + c0); bv[3] = *(const f32x4*)(b + 512 + c0 + 4);
    const int lane8 = F_LANE;
    const bf16_t* h1b = (const bf16_t*)(F.ws + WS_H1B); const unsigned char* yb8 = (const unsigned char*)(F.ws + WS_YB);
    int ekn = 0, pkn = 0;
    if (gw < T_TOK && lane8 < 8) { ekn = tok_e[gw * 8 + lane8]; pkn = tok_pos[gw * 8 + lane8]; }
    for (int t = gw; t < T_TOK; t += NGW) {
        const int myrow = lane8 < 8 ? offs[ekn] + pkn : 0;
        const u32x4 r0 = *(const u32x4*)(h1b + (size_t)t * DM + c0), r1 = *(const u32x4*)(h1b + (size_t)t * DM + 512 + c0);
        const u32x4 s0 = *(const u32x4*)(ys + (size_t)t * DM + c0), s1 = *(const u32x4*)(ys + (size_t)t * DM + 512 + c0);
        u32x2 W[8][2];
#pragma unroll
        for (int k = 0; k < 8; ++k) { const unsigned char* src = yb8 + (size_t)__shfl(myrow, k) * 1024; W[k][0] = *(const u32x2*)(src + c0); W[k][1] = *(const u32x2*)(src + 512 + c0); }
        { const int tn = t + NGW; if (tn < T_TOK && lane8 < 8) { ekn = tok_e[tn * 8 + lane8]; pkn = tok_pos[tn * 8 + lane8]; } }
        f32x4 v[4], y[4];
        v[0] = (f32x4){bflo(r0.x), bfhi(r0.x), bflo(r0.y), bfhi(r0.y)}; v[1] = (f32x4){bflo(r0.z), bfhi(r0.z), bflo(r0.w), bfhi(r0.w)};
        v[2] = (f32x4){bflo(r1.x), bfhi(r1.x), bflo(r1.y), bfhi(r1.y)}; v[3] = (f32x4){bflo(r1.z), bfhi(r1.z), bflo(r1.w), bfhi(r1.w)};
#pragma unroll
        for (int j = 0; j < 4; ++j) { v[j] = v[j] * ALPHA_F; y[j] = (f32x4){0.f, 0.f, 0.f, 0.f}; }
        v[0] = v[0] + (f32x4){bflo(s0.x), bfhi(s0.x), bflo(s0.y), bfhi(s0.y)}; v[1] = v[1] + (f32x4){bflo(s0.z), bfhi(s0.z), bflo(s0.w), bfhi(s0.w)};
        v[2] = v[2] + (f32x4){bflo(s1.x), bfhi(s1.x), bflo(s1.y), bfhi(s1.y)}; v[3] = v[3] + (f32x4){bflo(s1.z), bfhi(s1.z), bflo(s1.w), bfhi(s1.w)};
#pragma unroll
        for (int k = 0; k < 8; ++k) { y[0] = y[0] + un4_fp8(W[k][0].x); y[1] = y[1] + un4_fp8(W[k][0].y); y[2] = y[2] + un4_fp8(W[k][1].x); y[3] = y[3] + un4_fp8(W[k][1].y); }
#pragma unroll
        for (int j = 0; j < 4; ++j) v[j] = v[j] + y[j] * (1.0f / YB_SCALE);
        float s = 0.f;
#pragma unroll
        for (int j = 0; j < 4; ++j) s += (v[j][0] + v[j][1]) + (v[j][2] + v[j][3]);
        const float mu = wave_sum(s) * (1.0f / 1024.0f);
        float q = 0.f;
#pragma unroll
        for (int j = 0; j < 4; ++j) { v[j] = v[j] - mu; q += (v[j][0] * v[j][0] + v[j][1] * v[j][1]) + (v[j][2] * v[j][2] + v[j][3] * v[j][3]); }
        const float rs = rsqrtf(wave_sum(q) * (1.0f / 1024.0f) + LN_EPS_F);
        float* o = out + (size_t)t * DM;
#pragma unroll
        for (int j = 0; j < 4; ++j) v[j] = v[j] * rs * gv[j] + bv[j];
        *(f32x4*)(o + c0) = v[0]; *(f32x4*)(o + c0 + 4) = v[1]; *(f32x4*)(o + 512 + c0) = v[2]; *(f32x4*)(o + 512 + c0 + 4) = v[3];
    }
}


namespace xk {
constexpr int B_IMG = 16384, A_SLOT = 16384, L_B0 = 0, L_A0 = 4 * B_IMG, L_GATE = 8 * 16384;
typedef __amdgpu_buffer_rsrc_t rsrc_t;
__device__ __forceinline__ rsrc_t make_rsrc(const void* p) { return __builtin_amdgcn_make_buffer_rsrc((void*)p, 0, 0x7fffffff, 0x00020000); }
__device__ __forceinline__ u32x4 make_srd(const void* p) { const unsigned long long v = (unsigned long long)p; u32x4 d;
    d.x = (unsigned)__builtin_amdgcn_readfirstlane((int)(unsigned)v); d.y = (unsigned)__builtin_amdgcn_readfirstlane((int)(unsigned)(v >> 32)) & 0xffffu; d.z = 0x7fffffffu; d.w = 0x00020000u; return d; }
__device__ __forceinline__ void dma16(const u32x4 srd, unsigned voff, int soff, unsigned lds_addr) {
    asm volatile("s_mov_b32 m0, %0\n\ts_nop 0\n\tbuffer_load_dwordx4 %1, %2, %3 offen lds" :: "s"(lds_addr), "v"(voff), "s"(srd), "s"(soff) : "m0", "memory");
}
__device__ __forceinline__ void a_piece_rc(int b, int& R, int& C) { const int st = b >> 10, sb = b & 1023, ob = sb ^ (((sb >> 9) & 1) << 5); R = st * 16 + (ob >> 6); C = (ob & 63) >> 1; }
struct PassDesc { u32x4 ra; unsigned aoff[2]; rsrc_t rb0, rb1; int bcol, ncol; unsigned boff; int nh; bool preloaded, chain; };
typedef f32x4 Acc[2][4][2][2];

template <bool GU> __device__ __forceinline__ void kloop(LAS unsigned char* lds, const PassDesc& P, const int wid, const int lane, const int bir, Acc& acc, f32x4 (&Br)[4][4]) {
    const int wr = wid >> 2, wc = wid & 3, fr = lane & 15, fq = lane >> 4, hl = lane >> 5;
    const int KB = GU ? 32 * 256 * 4 : 32 * 1024 * 4;
#define XK_DMAA(hh, slot) do { _Pragma("unroll") for (int _i = 0; _i < 2; ++_i) dma16(P.ra, P.aoff[_i], (hh) * 64, (unsigned)(size_t)(lds + L_A0 + (slot) * A_SLOT + _i * 8192 + wid * 1024)); } while (0)
#define XK_LOADB(col, hh, st) do { _Pragma("unroll") for (int _i = 0; _i < 4; ++_i) { \
            const u32x4 _v = GU ? __builtin_amdgcn_raw_buffer_load_b128((_i >> 1) ? P.rb1 : P.rb0, P.boff, (col) + (hh) * KB + (_i & 1) * (2 * 256 * 4), 0) \
                                : __builtin_amdgcn_raw_buffer_load_b128(P.rb0, P.boff, (col) + (hh) * KB + _i * (1024 * 4), 0); \
            Br[st][_i] = __builtin_bit_cast(f32x4, _v); } } while (0)
    const unsigned swg = (unsigned)(((wid >> 1) & 1) << 4);
    unsigned bw0 = (unsigned)(size_t)(lds + L_B0) + (GU ? (4 * wid + hl) * 512 + (bir ^ (hl << 7) ^ swg) : 4 * wid * 512 + (bir ^ swg));
    const int q = (lane & 15) >> 2, p = lane & 3;
    unsigned br0 = (unsigned)(size_t)(lds + L_B0) + (8 * fq + q) * 512 + ((128 * wc + 32 * p) ^ ((q & 1) << 7) ^ (((q >> 1) & 1) << 3) ^ ((fq & 1) << 4));
    const LAS unsigned char* arp = lds + L_A0 + (wr * 4) * 1024 + ((fr * 64 + 16 * fq) ^ ((fr >> 3) << 5));
#define XK_WRITEB(st, img) do { _Pragma("unroll") for (int _i = 0; _i < 4; ++_i) { u32x2 _w; _w.x = cvt_pk_bf16(Br[st][_i][0], Br[st][_i][1]); _w.y = cvt_pk_bf16(Br[st][_i][2], Br[st][_i][3]); \
        if (GU) *(LAS u32x2*)(size_t)((bw0 ^ (unsigned)(((_i >> 1) << 4) | ((_i & 1) << 3))) + (img) * B_IMG + 2 * (_i & 1) * 512) = _w; \
        else *(LAS u32x2*)(size_t)((bw0 ^ (unsigned)(((_i & 1) << 7) | (((_i >> 1) & 1) << 3))) + (img) * B_IMG + _i * 512) = _w; } } while (0)
#define XK_FRAGS(slot, img) do { \
        _Pragma("unroll") for (int gI = 0; gI < 2; ++gI) _Pragma("unroll") for (int nn = 0; nn < 2; ++nn) { \
            const LAS unsigned char* _a = (const LAS unsigned char*)(size_t)((br0 ^ (unsigned)(16 * gI + 8 * nn)) + (img) * B_IMG); \
            const s16x4 _lo = __builtin_amdgcn_ds_read_tr16_b64_v4i16((LAS s16x4*)_a), _hi = __builtin_amdgcn_ds_read_tr16_b64_v4i16((LAS s16x4*)(_a + 2048)); \
            wf[gI][nn] = (bf16x8){_lo[0], _lo[1], _lo[2], _lo[3], _hi[0], _hi[1], _hi[2], _hi[3]}; } \
        _Pragma("unroll") for (int ai = 0; ai < 2; ++ai) _Pragma("unroll") for (int m = 0; m < 4; ++m) xf[ai][m] = *(const LAS bf16x8*)(arp + (slot) * A_SLOT + (8 * ai + m) * 1024); } while (0)
#define XK_MMA() do { __builtin_amdgcn_s_setprio(1); \
        _Pragma("unroll") for (int ai = 0; ai < 2; ++ai) _Pragma("unroll") for (int m = 0; m < 4; ++m) _Pragma("unroll") for (int gI = 0; gI < 2; ++gI) _Pragma("unroll") for (int nn = 0; nn < 2; ++nn) \
            acc[ai][m][gI][nn] = __builtin_amdgcn_mfma_f32_16x16x32_bf16(wf[gI][nn], xf[ai][m], acc[ai][m][gI][nn], 0, 0, 0); \
        __builtin_amdgcn_s_setprio(0); } while (0)
    bf16x8 wf[2][2], xf[2][4];
    const int nh = P.nh;
    if (!P.preloaded) {
        XK_LOADB(P.bcol, 0, 0); XK_LOADB(P.bcol, 1, 1); XK_LOADB(P.bcol, 2, 2); XK_DMAA(0, 0); XK_DMAA(1, 1);
        XK_WRITEB(0, 0);
        asm volatile("s_waitcnt vmcnt(0)" ::: "memory");
        __syncthreads();
    }
    const int tcol = P.chain ? P.ncol : P.bcol;
    if (wid >= 4) __builtin_amdgcn_s_barrier();
#define XK_ITER(j) do { const int _h = hb + (j); asm volatile("" : "+v"(bw0), "+v"(br0));     \
        { const bool _in2 = _h + 2 < nh; XK_DMAA(_in2 ? _h + 2 : _h + 2 - nh, ((j) + 2) & 3); \
          const bool _in3 = _h + 3 < nh; XK_LOADB(_in3 ? P.bcol : tcol, _in3 ? _h + 3 : _h + 3 - nh, ((j) + 3) & 3); } \
        XK_WRITEB(((j) + 1) & 3, ((j) + 1) & 3); \
        XK_FRAGS((j), (j));        \
        asm volatile("s_waitcnt vmcnt(10)" ::: "memory");     \
        asm volatile("s_waitcnt lgkmcnt(0)" ::: "memory"); __builtin_amdgcn_sched_barrier(0); __builtin_amdgcn_s_barrier(); __builtin_amdgcn_sched_barrier(0); \
        XK_MMA(); \
        __builtin_amdgcn_sched_barrier(0); __builtin_amdgcn_s_barrier(); __builtin_amdgcn_sched_barrier(0); } while (0)
    for (int hb = 0; hb < nh; hb += 4) { XK_ITER(0); XK_ITER(1); XK_ITER(2); XK_ITER(3); }
    if (wid < 4) __builtin_amdgcn_s_barrier();
#undef XK_ITER
#undef XK_DMAA
#undef XK_LOADB
#undef XK_WRITEB
#undef XK_FRAGS
#undef XK_MMA
}
}

__device__ __forceinline__ void phase_experts(const Frame& F, const Args& a, const int mode) {
    build_tables(F);
    const int wid = F.wave, wr = wid >> 2, wc = wid & 3;
    const LAS int* pref = (const LAS int*)(F.lds + LDS_PREF);
    const int U = __builtin_amdgcn_readfirstlane(pref[NEXP]);
    const int* lists = (const int*)(F.ws + WS_LISTS); const float* tok_gate = (const float*)(F.ws + WS_TOKGATE);
    const char* h1b = (const char*)(F.ws + WS_H1B); bf16_t* H = (bf16_t*)(F.ws + WS_H); bf16_t* YB = (bf16_t*)(F.ws + WS_YB);
    f32x4 Br[4][4];
    for (int ui = 0;; ++ui) {
        int L = ui * F.G + blockIdx.x; if (L >= U) break;
        { const int qq = U / 8, rr = U % 8, xcd = L % 8, off = L / 8; L = (xcd < rr ? xcd * (qq + 1) : rr * (qq + 1) + (xcd - rr) * qq) + off; }
        int lo = 0, hi = NEXP;
        while (hi - lo > 1) { const int mid = (lo + hi) >> 1; const int pv = __builtin_amdgcn_readfirstlane(pref[mid]); if (pv <= L) lo = mid; else hi = mid; }
        const int e = lo, mt = L - __builtin_amdgcn_readfirstlane(pref[e]);
        const int n = __builtin_amdgcn_readfirstlane(((const LAS int*)(F.lds + LDS_CNT))[e]);
        const int rows = (n - mt * 256) < 256 ? (n - mt * 256) : 256;
        const int slot0 = __builtin_amdgcn_readfirstlane(((const LAS int*)(F.lds + LDS_OFFS))[e]) + mt * 256;
        const int* lst = lists + (size_t)e * LIST_CAP + mt * 256;
        const int ew = (mode & 1) ? 0 : e;
        const float* Wg = KARG_IN(15) + (size_t)ew * 1024 * 256; const float* Wu = KARG_IN(16) + (size_t)ew * 1024 * 256; const float* Wd = KARG_IN(17) + (size_t)ew * 256 * 1024;
        {
            xk::PassDesc P; P.ra = xk::make_srd(h1b);
            { const int lane = lane_id(), tid = wid * 64 + lane;
#pragma unroll
              for (int i = 0; i < 2; ++i) { int R, C; xk::a_piece_rc(tid * 16 + i * 8192, R, C); int tok = 0; if (R < rows) tok = lst[R] >> 3; if (mode & 2) tok = (slot0 + R) & 16383; P.aoff[i] = (unsigned)(tok * 1024 + C) * 2u; }
              P.boff = (unsigned)((4 * wid + (lane >> 5)) * 256 + 4 * (lane & 31)) * 4u; }
            P.nh = 32; P.rb0 = xk::make_rsrc(Wg); P.rb1 = xk::make_rsrc(Wu);
#pragma unroll 1
            for (int pn = 0; pn < 2; ++pn) {
                P.bcol = pn * 128 * 4; P.ncol = 128 * 4;
                P.preloaded = pn == 1; P.chain = pn == 0;
                xk::Acc acc;
#pragma unroll
                for (int ai = 0; ai < 2; ++ai)
#pragma unroll
                    for (int m = 0; m < 4; ++m)
#pragma unroll
                        for (int gI = 0; gI < 2; ++gI)
#pragma unroll
                            for (int nn = 0; nn < 2; ++nn) acc[ai][m][gI][nn] = (f32x4){0.f, 0.f, 0.f, 0.f};
                { const int lane = lane_id(); xk::kloop<true>(F.lds, P, wid, lane, 128 * ((lane & 31) >> 3) + 32 * (((lane & 31) >> 1) & 3) + 8 * (lane & 1), acc, Br); }
                const int lane = lane_id(), fr = lane & 15, fq = lane >> 4;
                const xk::rsrc_t rH = xk::make_rsrc(H + (size_t)slot0 * 256);
#pragma unroll
                for (int ai = 0; ai < 2; ++ai)
#pragma unroll
                    for (int m = 0; m < 4; ++m) { const int r = ai * 128 + wr * 64 + m * 16 + fr;
                        if (r < rows && !(mode & 4) && !(mode & 16)) { float h[8];
#pragma unroll
                            for (int nn = 0; nn < 2; ++nn)
#pragma unroll
                                for (int j = 0; j < 4; ++j) h[nn * 4 + j] = siluf(acc[ai][m][0][nn][j]) * acc[ai][m][1][nn][j];
                            u32x4 w; w.x = cvt_pk_bf16(h[0], h[1]); w.y = cvt_pk_bf16(h[2], h[3]); w.z = cvt_pk_bf16(h[4], h[5]); w.w = cvt_pk_bf16(h[6], h[7]);
                            __builtin_amdgcn_raw_buffer_store_b128(w, rH, (unsigned)(r * 256 + pn * 128 + wc * 32 + 8 * fq) * 2u, 0, 0); } }
            }
        }
        { const int t = wid * 64 + lane_id();
          if (t < 256) ((LAS float*)(F.lds + xk::L_GATE))[t] = t < rows ? tok_gate[lst[t]] : 0.f; }
        asm volatile("s_waitcnt vmcnt(0)" ::: "memory");
        __syncthreads();
        {
            xk::PassDesc P; P.ra = xk::make_srd(H + (size_t)slot0 * 256);
            { const int lane = lane_id(), tid = wid * 64 + lane;
#pragma unroll
              for (int i = 0; i < 2; ++i) { int R, C; xk::a_piece_rc(tid * 16 + i * 8192, R, C); P.aoff[i] = (unsigned)(R * 256 + C) * 2u; }
              P.boff = (unsigned)(4 * wid * 1024 + 4 * lane) * 4u; }
            P.nh = 8; P.rb0 = xk::make_rsrc(Wd); P.rb1 = P.rb0;
#pragma unroll 1
            for (int pn = 0; pn < 4; ++pn) {
                P.bcol = pn * 256 * 4; P.ncol = (pn + 1) * 256 * 4;
                P.preloaded = pn > 0; P.chain = pn < 3;
                xk::Acc acc;
#pragma unroll
                for (int ai = 0; ai < 2; ++ai)
#pragma unroll
                    for (int m = 0; m < 4; ++m)
#pragma unroll
                        for (int gI = 0; gI < 2; ++gI)
#pragma unroll
                            for (int nn = 0; nn < 2; ++nn) acc[ai][m][gI][nn] = (f32x4){0.f, 0.f, 0.f, 0.f};
                { const int lane = lane_id(); xk::kloop<false>(F.lds, P, wid, lane, 8 * lane, acc, Br); }
                const int lane = lane_id(), fr = lane & 15, fq = lane >> 4;
                const xk::rsrc_t rY = xk::make_rsrc((const unsigned char*)YB + (size_t)slot0 * 1024);
#pragma unroll
                for (int ai = 0; ai < 2; ++ai)
#pragma unroll
                    for (int m = 0; m < 4; ++m) { const int r = ai * 128 + wr * 64 + m * 16 + fr;
                        if (r < rows && !(mode & 4) && !(mode & 8)) { const float g = ((const LAS float*)(F.lds + xk::L_GATE))[r] * YB_SCALE;
                            u32x4 w; w.x = pk4_fp8(acc[ai][m][0][0] * g); w.y = pk4_fp8(acc[ai][m][0][1] * g); w.z = pk4_fp8(acc[ai][m][1][0] * g); w.w = pk4_fp8(acc[ai][m][1][1] * g);
                            __builtin_amdgcn_raw_buffer_store_b128(w, rY, (unsigned)(r * 1024 + pn * 256 + 64 * wc + 16 * fq), 0, 0); } }
            }
        }
        __syncthreads();
    }
}

__device__ __forceinline__ float ldp(const bf16_t* p, size_t t, int c) { return bf2f(p[t * PW + c]); }
__device__ __forceinline__ void phase_m1(const Frame& F, const Args& a) {
  const bf16_t* p = (const bf16_t*)(F.ws + WS_P); const float* dtraw = (const float*)(F.ws + WS_DTRAW);
  const float* conv_w = KARG_IN(2); const float* conv_b = KARG_IN(3); const float* dt_bias = KARG_IN(4); const float* lb_logits = KARG_IN(8);
  float* xbc = (float*)(F.ws + WS_NXBC); float* fgk = (float*)(F.ws + WS_NFGK); float* qs = (float*)(F.ws + WS_NQS); float* dtb = (float*)(F.ws + WS_NDTB);
  const int tid = F_TID;
  for (int t = blockIdx.x; t < T_TOK; t += F.G) {
    for (int c = tid; c < 1024; c += 512) {
      float acc = conv_b[c];
#pragma unroll
      for (int j = 0; j < 4; ++j) { const int tt = t - 3 + j; if (tt >= 0) acc = fmaf(conv_w[j * 1024 + c], ldp(p, tt, PC_XBC + c), acc); }
      xbc[(size_t)t * 1024 + c] = siluf(acc);
    }
    { const int c = tid;
      const float l0 = lb_logits[c], l1 = lb_logits[512 + c];
      const float mx = fmaxf(l0, l1);
      const float e0 = expf(l0 - mx), e1 = expf(l1 - mx);
      const float lb = e0 / (e0 + e1);
      const float f = ldp(p, t, PC_F + c);
      fgk[(size_t)t * 512 + c] = lb + (1.0f - lb) * (1.0f / (1.0f + expf(-f)));
      const float q = ldp(p, t, PC_Q + c);
      qs[(size_t)t * 512 + c] = q / (1.0f + expf(-q)); }
    if (tid < 8) { const float v = dtraw[t * 8 + tid] + dt_bias[tid]; dtb[t * 8 + tid] = v > 20.f ? v : log1pf(expf(v)); }
  }
}
__device__ __forceinline__ void phase_m2(const Frame& F, const Args& a) {
  const int item = F.wave * F.G + blockIdx.x, lane = F_LANE;
  const float* xbc = (const float*)(F.ws + WS_NXBC); const float* dtb = (const float*)(F.ws + WS_NDTB);
  const float* fgk = (const float*)(F.ws + WS_NFGK); const float* qs = (const float*)(F.ws + WS_NQS); const bf16_t* p = (const bf16_t*)(F.ws + WS_P);
  float* y_ssd = (float*)(F.ws + WS_NYSSD); float* o_h = (float*)(F.ws + WS_NOH);
  if (item < 512) {
    const int h = item >> 6, pp = item & 63, g = h >> 2;
    const float aa = -expf(KARG_IN(5)[h]), D = KARG_IN(6)[h];
    float h0 = 0.f, h1 = 0.f;
    const float* xp = xbc + h * 64 + pp; const float* Bp = xbc + 512 + g * 128 + lane; const float* Cp = xbc + 768 + g * 128 + lane;
    for (int t0 = 0; t0 < T_TOK; t0 += 8) {
      float Bv0[8], Bv1[8], Cv0[8], Cv1[8], xv[8], dv[8];
#pragma unroll
      for (int i = 0; i < 8; ++i) { const size_t o = (size_t)(t0 + i) * 1024;
        Bv0[i] = Bp[o]; Bv1[i] = Bp[o + 64]; Cv0[i] = Cp[o]; Cv1[i] = Cp[o + 64]; xv[i] = xp[o]; dv[i] = dtb[(t0 + i) * 8 + h]; }
#pragma unroll
      for (int i = 0; i < 8; ++i) {
        const float dA = expf(dv[i] * aa), dx = dv[i] * xv[i];
        h0 = fmaf(dA, h0, dx * Bv0[i]); h1 = fmaf(dA, h1, dx * Bv1[i]);
        float part = wave_sum(Cv0[i] * h0 + Cv1[i] * h1);
        if (lane == 0) y_ssd[(size_t)(t0 + i) * 512 + h * 64 + pp] = part + D * xv[i];
      }
    }
  } else if (item < 1024) {
    const int it = item - 512, h = it >> 7, e = it & 127;
    float S0 = 0.f, S1 = 0.f;
    const float* fp = fgk + h * 128 + lane; const float* qp = qs + h * 128 + lane;
    for (int t0 = 0; t0 < T_TOK; t0 += 8) {
      float f0[8], f1[8], q0[8], q1[8], iv[8];
#pragma unroll
      for (int i = 0; i < 8; ++i) { const size_t o = (size_t)(t0 + i) * 512;
        f0[i] = fp[o]; f1[i] = fp[o + 64]; q0[i] = qp[o]; q1[i] = qp[o + 64]; iv[i] = ldp(p, t0 + i, PC_I + h * 128 + e); }
#pragma unroll
      for (int i = 0; i < 8; ++i) {
        S0 = fmaf(f0[i], S0, (1.0f - f0[i]) * iv[i]); S1 = fmaf(f1[i], S1, (1.0f - f1[i]) * iv[i]);
        float part = wave_sum(q0[i] * S0 + q1[i] * S1);
        if (lane == 0) o_h[(size_t)(t0 + i) * 512 + h * 128 + e] = part;
      }
    }
  }
}
__device__ __forceinline__ void phase_m3(const Frame& F, const Args& a) {
  const int gw = F.vcu * 8 + F.wave, NGW = F.G * 8, lane = F_LANE;
  const float* y_ssd = (const float*)(F.ws + WS_NYSSD); const float* o_h = (const float*)(F.ws + WS_NOH); const bf16_t* p = (const bf16_t*)(F.ws + WS_P);
  const float* snw = KARG_IN(7); const float* hnw = KARG_IN(9); bf16_t* mix = (bf16_t*)(F.ws + WS_MIX);
  for (int idx = gw; idx < T_TOK * 2; idx += NGW) {
    const int t = idx >> 1, g = idx & 1;
    float v[4]; float ss = 0.f;
#pragma unroll
    for (int j = 0; j < 4; ++j) { const int c = g * 256 + lane + 64 * j; v[j] = y_ssd[(size_t)t * 512 + c] * siluf(ldp(p, t, PC_Z + c)); ss += v[j] * v[j]; }
    ss = wave_sum(ss);
    const float r = rsqrtf(ss * (1.0f / 256.0f) + RMS_EPS_F);
#pragma unroll
    for (int j = 0; j < 4; ++j) { const int c = g * 256 + lane + 64 * j; mix[(size_t)t * 1024 + c] = (bf16_t)(cvt_pk_bf16(v[j] * r * snw[c], 0.f) & 0xffffu); }
  }
  for (int idx = gw; idx < T_TOK * 4; idx += NGW) {
    const int t = idx >> 2, h = idx & 3;
    float v[2]; float ss = 0.f;
#pragma unroll
    for (int j = 0; j < 2; ++j) { const int c = h * 128 + lane + 64 * j; v[j] = o_h[(size_t)t * 512 + c]; ss += v[j] * v[j]; }
    ss = wave_sum(ss);
    const float r = rsqrtf(ss * (1.0f / 128.0f) + RMS_EPS_F);
#pragma unroll
    for (int j = 0; j < 2; ++j) { const int c = h * 128 + lane + 64 * j;
      mix[(size_t)t * 1024 + 512 + c] = (bf16_t)(cvt_pk_bf16(v[j] * r * hnw[c] * siluf(ldp(p, t, PC_G + c)), 0.f) & 0xffffu); }
  }
}


#define MFMA32(a, b, c) __builtin_amdgcn_mfma_f32_32x32x16_bf16((a), (b), (c), 0, 0, 0)
__device__ __forceinline__ int drow(int r, int lane) { return (r & 3) + 8 * (r >> 2) + 4 * (lane >> 5); }
__device__ __forceinline__ bf16x8 frag_row(const LAS unsigned char* base, int pitch, int row0, int k0, int lane) {
    return *(const LAS bf16x8*)(base + (row0 + (lane & 31)) * pitch + (k0 + 8 * (lane >> 5)) * 2);
}
template <bool PERM> __device__ __forceinline__ bf16x8 frag_tr(const LAS unsigned char* base, int pitch, int k0, int col0, int lane) {
    const int h = lane >> 5, blk = (lane >> 4) & 1, q = (lane & 15) >> 2, p = lane & 3;
    const LAS unsigned char* a0 = base + (k0 + (PERM ? 4 : 8) * h + q) * pitch + (col0 + 16 * blk + 4 * p) * 2;
    const s16x4 lo = __builtin_amdgcn_ds_read_tr16_b64_v4i16((LAS s16x4*)a0);
    const s16x4 hi = __builtin_amdgcn_ds_read_tr16_b64_v4i16((LAS s16x4*)(a0 + (PERM ? 8 : 4) * pitch));
    return (bf16x8){lo[0], lo[1], lo[2], lo[3], hi[0], hi[1], hi[2], hi[3]};
}
__device__ __forceinline__ bf16x8 acc_frag(const f32x16& x, int s) {
    u32x4 w; w.x = cvt_pk_bf16(x[8 * s + 0], x[8 * s + 1]); w.y = cvt_pk_bf16(x[8 * s + 2], x[8 * s + 3]); w.z = cvt_pk_bf16(x[8 * s + 4], x[8 * s + 5]); w.w = cvt_pk_bf16(x[8 * s + 6], x[8 * s + 7]);
    return __builtin_bit_cast(bf16x8, w);
}
__device__ __forceinline__ float softplusf(float v) { return v > 20.f ? v : log1pf(__expf(v)); }
__device__ __forceinline__ unsigned short f2bf1(float v) { return (unsigned short)(cvt_pk_bf16(v, 0.f) & 0xffffu); }
__device__ __forceinline__ float half_sum(float v) {
#pragma unroll
    for (int o = 1; o < 32; o <<= 1) v += __shfl_xor(v, o);
    return v;
}

constexpr int SX_PITCH = 576, SB_TR_PITCH = 320, SB_ROW_PITCH = 272;
constexpr int SL_X = 0, SL_B = 128 * SX_PITCH  , SL_C = SL_B + 128 * SB_TR_PITCH  ;
constexpr int SL_DT = 151552, SL_ACUM = SL_DT + 2048, SL_SSQ = SL_ACUM + 2048;
static_assert(SL_C + 128 * SB_ROW_PITCH <= SL_DT && SL_SSQ + 1024 <= LDS_PHASE_BYTES, "SSD LDS map");
constexpr int HL_QD = 0, HL_QP = 64 * 272, HL_KP = 2 * 64 * 272, HL_V = 3 * 64 * 272  , HL_KD = HL_V + 64 * 320  , HL_SEG = HL_KD + 64 * 320  , HL_SSQ = HL_SEG + 4096;
static_assert(HL_SSQ + 1024 <= LDS_PHASE_BYTES, "HGRN LDS map");

__device__ __forceinline__ void ssd_dt_acum(const Frame& F, const Args& a, int c, int g) {
    if (F.wave < 4) {
        const int hh = g * 4 + F.wave, lane = F_LANE; const float* dtraw = (const float*)(F.ws + WS_DTRAW);
        const float bias = KARG_IN(4)[hh], aa = -__expf(KARG_IN(5)[hh]);
        const int t = c * 128 + 2 * lane;
        const float d0 = softplusf(dtraw[(size_t)t * 8 + hh] + bias), d1 = softplusf(dtraw[(size_t)(t + 1) * 8 + hh] + bias);
        const float a0 = d0 * aa, a1 = d1 * aa;
        float incl = a0 + a1;
#pragma unroll
        for (int o = 1; o < 64; o <<= 1) { const float v = __shfl_up(incl, o); if (lane >= o) incl += v; }
        LAS float* dts = (LAS float*)(F.lds + SL_DT) + F.wave * 128; LAS float* acs = (LAS float*)(F.lds + SL_ACUM) + F.wave * 128;
        dts[2 * lane] = d0; dts[2 * lane + 1] = d1; acs[2 * lane] = incl - a1; acs[2 * lane + 1] = incl;
    }
}
__device__ __forceinline__ void ssd_conv_item(const Frame& F, const Args& a, int c, int src_ch, int seg, int hl, int mode, LAS unsigned char* dst, int pitch, int dst_col) {
    const bf16_t* p = (const bf16_t*)(F.ws + WS_P) + PC_XBC + src_ch;
    const float* cw = KARG_IN(2) + src_ch; const float* cb = KARG_IN(3) + src_ch;
    float w[4][8], bias[8];
#pragma unroll
    for (int j = 0; j < 4; ++j) { const f32x4 x0 = *(const f32x4*)(cw + j * 1024), x1 = *(const f32x4*)(cw + j * 1024 + 4);
        w[j][0] = x0[0]; w[j][1] = x0[1]; w[j][2] = x0[2]; w[j][3] = x0[3]; w[j][4] = x1[0]; w[j][5] = x1[1]; w[j][6] = x1[2]; w[j][7] = x1[3]; }
    { const f32x4 x0 = *(const f32x4*)cb, x1 = *(const f32x4*)(cb + 4); bias[0] = x0[0]; bias[1] = x0[1]; bias[2] = x0[2]; bias[3] = x0[3]; bias[4] = x1[0]; bias[5] = x1[1]; bias[6] = x1[2]; bias[7] = x1[3]; }
    const int l0 = seg * 16, t0 = c * 128 + l0;
    u32x4 rw[19];
#pragma unroll
    for (int j = 0; j < 19; ++j) { const int tt = t0 - 3 + j; rw[j] = tt >= 0 ? *(const u32x4*)(p + (size_t)tt * PW) : (u32x4){0u, 0u, 0u, 0u}; }
    const LAS float* dts = (const LAS float*)(F.lds + SL_DT) + hl * 128; const LAS float* acs = (const LAS float*)(F.lds + SL_ACUM) + hl * 128;
    const float alast = acs[127];
#pragma unroll
    for (int i = 0; i < 16; ++i) {
        float v[8];
#pragma unroll
        for (int k = 0; k < 4; ++k) {
            const unsigned r0 = rw[i][k], r1 = rw[i + 1][k], r2 = rw[i + 2][k], r3 = rw[i + 3][k];
            v[2 * k] = siluf(fmaf(w[3][2 * k], bflo(r3), fmaf(w[2][2 * k], bflo(r2), fmaf(w[1][2 * k], bflo(r1), fmaf(w[0][2 * k], bflo(r0), bias[2 * k])))));
            v[2 * k + 1] = siluf(fmaf(w[3][2 * k + 1], bfhi(r3), fmaf(w[2][2 * k + 1], bfhi(r2), fmaf(w[1][2 * k + 1], bfhi(r1), fmaf(w[0][2 * k + 1], bfhi(r0), bias[2 * k + 1])))));
        }
        float sc = 1.f;
        if (mode >= 1) sc = dts[l0 + i];
        if (mode == 2) sc *= __expf(alast - acs[l0 + i]);
        u32x4 o; o.x = cvt_pk_bf16(v[0] * sc, v[1] * sc); o.y = cvt_pk_bf16(v[2] * sc, v[3] * sc); o.z = cvt_pk_bf16(v[4] * sc, v[5] * sc); o.w = cvt_pk_bf16(v[6] * sc, v[7] * sc);
        *(LAS u32x4*)(dst + (l0 + i) * pitch + dst_col * 2) = o;
    }
}

__device__ __forceinline__ void ssd_states_unit(const Frame& F, const Args& a, int c, int g) {
    const int tid = F_TID, lane = F_LANE;
    __syncthreads();
    ssd_dt_acum(F, a, c, g);
    __syncthreads();
    { const int cg = tid & 63, seg = tid >> 6; const bool isx = cg < 32;
      if (cg < 48) ssd_conv_item(F, a, c, isx ? g * 256 + cg * 8 : 512 + g * 128 + (cg - 32) * 8, seg, isx ? (cg >> 3) : 0, isx ? 2 : 0,
                                 F.lds + (isx ? SL_X : SL_B), isx ? SX_PITCH : SB_TR_PITCH, isx ? cg * 8 : (cg - 32) * 8); }
    __syncthreads();
    const int hl = F.wave >> 1, pt = F.wave & 1, hh = g * 4 + hl;
    f32x16 S[4];
#pragma unroll
    for (int nt = 0; nt < 4; ++nt)
#pragma unroll
        for (int r = 0; r < 16; ++r) S[nt][r] = 0.f;
#pragma unroll 2
    for (int ks = 0; ks < 8; ++ks) {
        const bf16x8 A = frag_tr<false>(F.lds + SL_X, SX_PITCH, 16 * ks, hl * 64 + 32 * pt, lane);
#pragma unroll
        for (int nt = 0; nt < 4; ++nt) { const bf16x8 B = frag_tr<false>(F.lds + SL_B, SB_TR_PITCH, 16 * ks, 32 * nt, lane); S[nt] = MFMA32(A, B, S[nt]); }
    }
    float* st = (float*)(F.ws + WS_SSTATE) + ((size_t)(c * 8 + hh) * 64 + 32 * pt) * 128;
#pragma unroll
    for (int nt = 0; nt < 4; ++nt)
#pragma unroll
        for (int r = 0; r < 16; ++r) st[(size_t)drow(r, lane) * 128 + 32 * nt + (lane & 31)] = S[nt][r];
    if (tid < 4) ((float*)(F.ws + WS_CDECAY))[c * 8 + g * 4 + tid] = __expf(((const LAS float*)(F.lds + SL_ACUM))[tid * 128 + 127]);
}

__device__ __forceinline__ void ssd_out_unit(const Frame& F, const Args& a, int c, int g) {
    const int lane = F_LANE;
    __syncthreads();
    ssd_dt_acum(F, a, c, g);
    __syncthreads();
    { const int tid = F_TID, cg = tid & 63, seg = tid >> 6; const bool isx = cg < 32, isb = cg < 48;
      ssd_conv_item(F, a, c, isx ? g * 256 + cg * 8 : (isb ? 512 + g * 128 + (cg - 32) * 8 : 768 + g * 128 + (cg - 48) * 8), seg, isx ? (cg >> 3) : 0, isx ? 1 : 0,
                    F.lds + (isx ? SL_X : (isb ? SL_B : SL_C)), isx ? SX_PITCH : SB_ROW_PITCH, isx ? cg * 8 : (isb ? (cg - 32) * 8 : (cg - 48) * 8)); }
    __syncthreads();
    const int lt = F.wave >> 1, hp = F.wave & 1;
    const int lcol = 32 * lt + (lane & 31);
    f32x16 acc[2][2];
#pragma unroll
    for (int hi = 0; hi < 2; ++hi)
#pragma unroll
        for (int pt = 0; pt < 2; ++pt)
#pragma unroll
            for (int r = 0; r < 16; ++r) acc[hi][pt][r] = 0.f;
#pragma unroll
    for (int hi = 0; hi < 2; ++hi) {
        const int hl = hp * 2 + hi, hh = g * 4 + hl;
        const bf16_t* sp = (const bf16_t*)(F.ws + WS_SPREV) + (size_t)(c * 8 + hh) * 64 * 128 + (size_t)(lane & 31) * 128 + 8 * (lane >> 5);
        bf16x8 Bsv[2][8];
#pragma unroll
        for (int pt = 0; pt < 2; ++pt)
#pragma unroll
            for (int ks = 0; ks < 8; ++ks) Bsv[pt][ks] = *(const bf16x8*)(sp + (size_t)(32 * pt) * 128 + 16 * ks);
#pragma unroll
        for (int ks = 0; ks < 8; ++ks) {
            const bf16x8 A = frag_row(F.lds + SL_C, SB_ROW_PITCH, 32 * lt, 16 * ks, lane);
#pragma unroll
            for (int pt = 0; pt < 2; ++pt) acc[hi][pt] = MFMA32(A, Bsv[pt][ks], acc[hi][pt]);
        }
        const LAS float* acs = (const LAS float*)(F.lds + SL_ACUM) + hl * 128;
#pragma unroll
        for (int r = 0; r < 16; ++r) { const float e = __expf(acs[32 * lt + drow(r, lane)]); acc[hi][0][r] *= e; acc[hi][1][r] *= e; }
    }
    float dskip[2]; { const float* dsp = KARG_IN(6); dskip[0] = dsp[g * 4 + hp * 2]; dskip[1] = dsp[g * 4 + hp * 2 + 1]; }
#pragma unroll 1
    for (int st = 0; st <= lt; ++st) {
        f32x16 GT;
#pragma unroll
        for (int r = 0; r < 16; ++r) GT[r] = 0.f;
#pragma unroll 2
        for (int ks = 0; ks < 8; ++ks) {
            const bf16x8 A = frag_row(F.lds + SL_B, SB_ROW_PITCH, 32 * st, 16 * ks, lane), B = frag_row(F.lds + SL_C, SB_ROW_PITCH, 32 * lt, 16 * ks, lane);
            GT = MFMA32(A, B, GT);
        }
#pragma unroll
        for (int hi = 0; hi < 2; ++hi) {
            const int hl = hp * 2 + hi, hh = g * 4 + hl;
            const LAS float* dts = (const LAS float*)(F.lds + SL_DT) + hl * 128; const LAS float* acs = (const LAS float*)(F.lds + SL_ACUM) + hl * 128;
            const float al = acs[lcol], dsk = dskip[hi] / dts[lcol];
            f32x16 M;
#pragma unroll
            for (int r = 0; r < 16; ++r) { const int srow = 32 * st + drow(r, lane);
                float v = srow <= lcol ? GT[r] * __expf(al - acs[srow]) : 0.f;
                if (srow == lcol) v += dsk;
                M[r] = v; }
#pragma unroll
            for (int s2 = 0; s2 < 2; ++s2) { const bf16x8 A = acc_frag(M, s2);
#pragma unroll
                for (int pt = 0; pt < 2; ++pt) { const bf16x8 B = frag_tr<true>(F.lds + SL_X, SX_PITCH, 32 * st + 16 * s2, hl * 64 + 32 * pt, lane); acc[hi][pt] = MFMA32(A, B, acc[hi][pt]); } }
        }
    }
    float ssq[16];
#pragma unroll
    for (int r = 0; r < 16; ++r) ssq[r] = 0.f;
    {
        const bf16_t* pz = (const bf16_t*)(F.ws + WS_P) + (size_t)(c * 128 + 32 * lt) * PW + PC_Z + g * 256 + hp * 128 + (lane & 31);
#pragma unroll
        for (int hi = 0; hi < 2; ++hi)
#pragma unroll
            for (int pt = 0; pt < 2; ++pt)
#pragma unroll
                for (int r = 0; r < 16; ++r) { const float z = bf2f(pz[(size_t)drow(r, lane) * PW + hi * 64 + 32 * pt]);
                    const float y = acc[hi][pt][r] * siluf(z); acc[hi][pt][r] = y; ssq[r] += y * y; }
    }
    LAS float* ssqs = (LAS float*)(F.lds + SL_SSQ);
#pragma unroll
    for (int r = 0; r < 16; ++r) { const float sm = half_sum(ssq[r]); if ((lane & 31) == 0) ssqs[F.wave * 32 + drow(r, lane)] = sm; }
    __syncthreads();
    const float* nw = KARG_IN(7) + g * 256 + hp * 128 + (lane & 31);
#pragma unroll
    for (int r = 0; r < 16; ++r) { const int row = drow(r, lane);
        const float rs = rsqrtf((ssqs[F.wave * 32 + row] + ssqs[(F.wave ^ 1) * 32 + row]) * (1.0f / 256.0f) + RMS_EPS_F);
#pragma unroll
        for (int hi = 0; hi < 2; ++hi)
#pragma unroll
            for (int pt = 0; pt < 2; ++pt) *(LAS unsigned short*)(F.lds + SL_X + (32 * lt + row) * 528 + (hp * 128 + hi * 64 + 32 * pt + (lane & 31)) * 2) = f2bf1(acc[hi][pt][r] * rs * nw[hi * 64 + 32 * pt]); }
    __syncthreads();
    { const int tid = F_TID; bf16_t* mo = (bf16_t*)(F.ws + WS_MIX) + (size_t)(c * 128) * DM + g * 256;
#pragma unroll
      for (int i = 0; i < 8; ++i) { const int pc = tid + 512 * i, row = pc >> 5, ch = (pc & 31) * 8;
          *(u32x4*)(mo + (size_t)row * DM + ch) = *(const LAS u32x4*)(F.lds + SL_X + row * 528 + ch * 2); } }
}

struct HgrnLocal { float fg[8][2], cum[8][2], qv[8][2], iv[8][2], tot[2], mid[2]; };
struct HgrnRaw { unsigned fw[8], iw[8], qw[8]; };
template <bool NEEDQ> __device__ __forceinline__ void hgrn_fetch(const Frame& F, int c, int h, HgrnRaw& R) {
    const int tid = F_TID, cp = tid & 63, seg = tid >> 6, d0 = 2 * cp;
    const bf16_t* p = (const bf16_t*)(F.ws + WS_P) + (size_t)(c * 64 + seg * 8) * PW + h * 128 + d0;
#pragma unroll
    for (int i = 0; i < 8; ++i) { R.fw[i] = *(const unsigned*)(p + (size_t)i * PW + PC_F); R.iw[i] = *(const unsigned*)(p + (size_t)i * PW + PC_I);
        if (NEEDQ) R.qw[i] = *(const unsigned*)(p + (size_t)i * PW + PC_Q); }
}
__device__ __forceinline__ void hgrn_lb(const Frame& F, int h, float (&lb)[2]) {
    const int d0 = 2 * (F_TID & 63); const float* lg = KARG_IN(8);
#pragma unroll
    for (int j = 0; j < 2; ++j) { const float l0 = lg[h * 128 + d0 + j], l1 = lg[512 + h * 128 + d0 + j]; const float mx = fmaxf(l0, l1), e0 = __expf(l0 - mx), e1 = __expf(l1 - mx); lb[j] = e0 / (e0 + e1); }
}
template <bool NEEDQ> __device__ __forceinline__ void hgrn_load(const Frame& F, const Args& a, int h, const HgrnRaw& R, HgrnLocal& L, const float (&lb)[2]) {
    const int tid = F_TID, cp = tid & 63, seg = tid >> 6, d0 = 2 * cp;
    float run[2] = {0.f, 0.f};
#pragma unroll
    for (int i = 0; i < 8; ++i) {
        const unsigned fw = R.fw[i], iw = R.iw[i];
        const float fr[2] = {bflo(fw), bfhi(fw)};
        L.iv[i][0] = bflo(iw); L.iv[i][1] = bfhi(iw);
        if (NEEDQ) { const unsigned qw = R.qw[i]; L.qv[i][0] = siluf(bflo(qw)); L.qv[i][1] = siluf(bfhi(qw)); }
#pragma unroll
        for (int j = 0; j < 2; ++j) { const float fg = lb[j] + (1.0f - lb[j]) * sigmf(fr[j]); L.fg[i][j] = fg; run[j] += __logf(fg); L.cum[i][j] = run[j]; }
    }
    LAS float* segs = (LAS float*)(F.lds + HL_SEG);
    segs[seg * 128 + d0] = run[0]; segs[seg * 128 + d0 + 1] = run[1];
    __syncthreads();
    float pre[2] = {0.f, 0.f}, tot[2] = {0.f, 0.f}, mid[2] = {0.f, 0.f};
#pragma unroll
    for (int s2 = 0; s2 < 8; ++s2) {
#pragma unroll
        for (int j = 0; j < 2; ++j) { const float v = segs[s2 * 128 + d0 + j]; tot[j] += v; if (s2 < seg) pre[j] += v; if (s2 < 4) mid[j] += v; }
    }
#pragma unroll
    for (int i = 0; i < 8; ++i)
#pragma unroll
        for (int j = 0; j < 2; ++j) L.cum[i][j] += pre[j];
    L.tot[0] = tot[0]; L.tot[1] = tot[1]; L.mid[0] = mid[0]; L.mid[1] = mid[1];
}

__device__ __forceinline__ void hgrn_states_unit(const Frame& F, const Args& a, int c, int h, const HgrnRaw& R, const float (&lb)[2]) {
    const int tid = F_TID, lane = F_LANE, cp = tid & 63, seg = tid >> 6, d0 = 2 * cp;
    __syncthreads();
    HgrnLocal L; hgrn_load<false>(F, a, h, R, L, lb);
#pragma unroll
    for (int i = 0; i < 8; ++i) { const int t = seg * 8 + i;
        *(LAS unsigned*)(F.lds + HL_KD + t * 320 + d0 * 2) = cvt_pk_bf16((1.0f - L.fg[i][0]) * __expf(L.tot[0] - L.cum[i][0]), (1.0f - L.fg[i][1]) * __expf(L.tot[1] - L.cum[i][1]));
        *(LAS unsigned*)(F.lds + HL_V + t * 320 + d0 * 2) = cvt_pk_bf16(L.iv[i][0], L.iv[i][1]); }
    if (seg == 0) { float* hd = (float*)(F.ws + WS_HDECAY) + (size_t)(c * 4 + h) * 128 + d0; hd[0] = __expf(L.tot[0]); hd[1] = __expf(L.tot[1]); }
    __syncthreads();
    const int et = F.wave >> 1, dh = F.wave & 1;
    f32x16 acc[2];
#pragma unroll
    for (int dj = 0; dj < 2; ++dj)
#pragma unroll
        for (int r = 0; r < 16; ++r) acc[dj][r] = 0.f;
#pragma unroll
    for (int ks = 0; ks < 4; ++ks) {
        const bf16x8 A = frag_tr<false>(F.lds + HL_V, 320, 16 * ks, 32 * et, lane);
#pragma unroll
        for (int dj = 0; dj < 2; ++dj) { const bf16x8 B = frag_tr<false>(F.lds + HL_KD, 320, 16 * ks, 32 * (2 * dh + dj), lane); acc[dj] = MFMA32(A, B, acc[dj]); }
    }
    float* kv = (float*)(F.ws + WS_HKV) + ((size_t)(c * 4 + h) * 128 + 32 * et) * 128;
#pragma unroll
    for (int dj = 0; dj < 2; ++dj)
#pragma unroll
        for (int r = 0; r < 16; ++r) kv[(size_t)drow(r, lane) * 128 + 32 * (2 * dh + dj) + (lane & 31)] = acc[dj][r];
}

__device__ __forceinline__ void hgrn_out_unit(const Frame& F, const Args& a, int c, int h, const HgrnRaw& R, const float (&lb)[2]) {
    const int tid = F_TID, lane = F_LANE, cp = tid & 63, seg = tid >> 6, d0 = 2 * cp;
    const int tt = F.wave >> 2, et = F.wave & 3;
    bf16x8 Bs[8];
    { const bf16_t* sp = (const bf16_t*)(F.ws + WS_HSPREV) + ((size_t)(c * 4 + h) * 128 + 32 * et) * 128 + (size_t)(lane & 31) * 128 + 8 * (lane >> 5);
#pragma unroll
      for (int ks = 0; ks < 8; ++ks) Bs[ks] = *(const bf16x8*)(sp + 16 * ks); }
    const int e = 32 * et + (lane & 31);
    unsigned short gv[16];
    { const bf16_t* pg = (const bf16_t*)(F.ws + WS_P) + (size_t)(c * 64 + 32 * tt) * PW + PC_G + h * 128 + e;
#pragma unroll
      for (int r = 0; r < 16; ++r) gv[r] = pg[(size_t)drow(r, lane) * PW]; }
    const float nw = KARG_IN(9)[h * 128 + e];
    __syncthreads();
    HgrnLocal L; hgrn_load<true>(F, a, h, R, L, lb);
#pragma unroll
    for (int i = 0; i < 8; ++i) { const int t = seg * 8 + i;
        float qd[2], qp[2], kp[2];
#pragma unroll
        for (int j = 0; j < 2; ++j) { qd[j] = L.qv[i][j] * __expf(L.cum[i][j]); qp[j] = L.qv[i][j] * __expf(L.cum[i][j] - L.mid[j]); kp[j] = (1.0f - L.fg[i][j]) * __expf(L.mid[j] - L.cum[i][j]); }
        *(LAS unsigned*)(F.lds + HL_QD + t * 272 + d0 * 2) = cvt_pk_bf16(qd[0], qd[1]);
        *(LAS unsigned*)(F.lds + HL_QP + t * 272 + d0 * 2) = cvt_pk_bf16(qp[0], qp[1]);
        *(LAS unsigned*)(F.lds + HL_KP + t * 272 + d0 * 2) = cvt_pk_bf16(kp[0], kp[1]);
        *(LAS unsigned*)(F.lds + HL_V + t * 320 + d0 * 2) = cvt_pk_bf16(L.iv[i][0], L.iv[i][1]); }
    __syncthreads();
    f32x16 acc;
#pragma unroll
    for (int r = 0; r < 16; ++r) acc[r] = 0.f;
#pragma unroll
    for (int ks = 0; ks < 8; ++ks) { const bf16x8 A = frag_row(F.lds + HL_QD, 272, 32 * tt, 16 * ks, lane); acc = MFMA32(A, Bs[ks], acc); }
    const int tcol = 32 * tt + (lane & 31);
#pragma unroll
    for (int st = 0; st < 2; ++st) {
        if (st <= tt) {
            f32x16 X;
#pragma unroll
            for (int r = 0; r < 16; ++r) X[r] = 0.f;
#pragma unroll 2
            for (int ks = 0; ks < 8; ++ks) { const bf16x8 A = frag_row(F.lds + HL_KP, 272, 32 * st, 16 * ks, lane), B = frag_row(F.lds + HL_QP, 272, 32 * tt, 16 * ks, lane); X = MFMA32(A, B, X); }
#pragma unroll
            for (int r = 0; r < 16; ++r) X[r] = (32 * st + drow(r, lane) <= tcol) ? X[r] : 0.f;
#pragma unroll
            for (int s2 = 0; s2 < 2; ++s2) { const bf16x8 A = acc_frag(X, s2), B = frag_tr<true>(F.lds + HL_V, 320, 32 * st + 16 * s2, 32 * et, lane); acc = MFMA32(A, B, acc); }
        }
    }
    LAS float* ssqs = (LAS float*)(F.lds + HL_SSQ);
#pragma unroll
    for (int r = 0; r < 16; ++r) { const float sm = half_sum(acc[r] * acc[r]); if ((lane & 31) == 0) ssqs[F.wave * 32 + drow(r, lane)] = sm; }
    __syncthreads();
#pragma unroll
    for (int r = 0; r < 16; ++r) { const int row = drow(r, lane);
        const float ss = ssqs[(tt * 4 + 0) * 32 + row] + ssqs[(tt * 4 + 1) * 32 + row] + ssqs[(tt * 4 + 2) * 32 + row] + ssqs[(tt * 4 + 3) * 32 + row];
        const float rs = rsqrtf(ss * (1.0f / 128.0f) + RMS_EPS_F);
        *(LAS unsigned short*)(F.lds + HL_QD + (32 * tt + row) * 272 + e * 2) = f2bf1(acc[r] * rs * nw * siluf(bf2f(gv[r]))); }
    __syncthreads();
    { bf16_t* mo = (bf16_t*)(F.ws + WS_MIX) + (size_t)(c * 64) * DM + 512 + h * 128;
#pragma unroll
      for (int i = 0; i < 2; ++i) { const int pc = tid + 512 * i, row = pc >> 4, ch = (pc & 15) * 8;
          *(u32x4*)(mo + (size_t)row * DM + ch) = *(const LAS u32x4*)(F.lds + HL_QD + row * 272 + ch * 2); } }
}

__device__ __forceinline__ void phase_mix_states(const Frame& F, const Args& a, const int mode) {
    if (!(mode & 1)) for (int u = blockIdx.x; u < 256; u += F.G) ssd_states_unit(F, a, u >> 1, u & 1);
    if (!(mode & 2)) {
        HgrnRaw Ra, Rb; int u = blockIdx.x; float lb[2]; int hcur = -1;
        if (u < 1024) hgrn_fetch<false>(F, u >> 2, u & 3, Ra);
        while (u < 1024) {
            int un = u + F.G; if (un < 1024) hgrn_fetch<false>(F, un >> 2, un & 3, Rb);
            if ((u & 3) != hcur) { hcur = u & 3; hgrn_lb(F, hcur, lb); }
            hgrn_states_unit(F, a, u >> 2, u & 3, Ra, lb); u = un; if (u >= 1024) break;
            un = u + F.G; if (un < 1024) hgrn_fetch<false>(F, un >> 2, un & 3, Ra);
            if ((u & 3) != hcur) { hcur = u & 3; hgrn_lb(F, hcur, lb); }
            hgrn_states_unit(F, a, u >> 2, u & 3, Rb, lb); u = un;
        }
    }
}
__device__ __forceinline__ void phase_mix_out(const Frame& F, const Args& a, const int mode) {
    if (!(mode & 1)) for (int u = blockIdx.x; u < 256; u += F.G) ssd_out_unit(F, a, u >> 1, u & 1);
    if (!(mode & 2)) {
        HgrnRaw Ra, Rb; int u = blockIdx.x; float lb[2]; int hcur = -1;
        if (u < 1024) hgrn_fetch<true>(F, u >> 2, u & 3, Ra);
        while (u < 1024) {
            int un = u + F.G; if (un < 1024) hgrn_fetch<true>(F, un >> 2, un & 3, Rb);
            if ((u & 3) != hcur) { hcur = u & 3; hgrn_lb(F, hcur, lb); }
            hgrn_out_unit(F, a, u >> 2, u & 3, Ra, lb); u = un; if (u >= 1024) break;
            un = u + F.G; if (un < 1024) hgrn_fetch<true>(F, un >> 2, un & 3, Ra);
            if ((u & 3) != hcur) { hcur = u & 3; hgrn_lb(F, hcur, lb); }
            hgrn_out_unit(F, a, u >> 2, u & 3, Rb, lb); u = un;
        }
    }
}
__device__ __forceinline__ void phase_mix_scan(const Frame& F, const Args& a) {
    const int gt = blockIdx.x * 512 + F_TID;
    if (blockIdx.x < 128 || F.G < 256) {
        for (int idx = gt; idx < 65536; idx += (F.G < 256 ? F.G : 128) * 512) {
            const int hh = idx >> 13; const float* st = (const float*)(F.ws + WS_SSTATE) + idx; const float* cd = (const float*)(F.ws + WS_CDECAY) + hh;
            bf16_t* sp = (bf16_t*)(F.ws + WS_SPREV) + idx; float S = 0.f;
            for (int c0 = 0; c0 < 128; c0 += 16) { float v[16], d[16];
#pragma unroll
                for (int i = 0; i < 16; ++i) { v[i] = st[(size_t)(c0 + i) * 65536]; d[i] = cd[(c0 + i) * 8]; }
#pragma unroll
                for (int i = 0; i < 16; ++i) { sp[(size_t)(c0 + i) * 65536] = f2bf1(S); S = fmaf(S, d[i], v[i]); } }
        }
    }
    if (blockIdx.x >= 128 || F.G < 256) {
        const int gt2 = F.G < 256 ? gt : gt - 128 * 512;
        for (int idx = gt2; idx < 65536; idx += (F.G < 256 ? F.G : 128) * 512) {
            const int h = idx >> 14, d = idx & 127; const float* kv = (const float*)(F.ws + WS_HKV) + idx; const float* hd = (const float*)(F.ws + WS_HDECAY) + h * 128 + d;
            bf16_t* sp = (bf16_t*)(F.ws + WS_HSPREV) + idx; float S = 0.f;
            for (int c0 = 0; c0 < 256; c0 += 16) { float v[16], dd[16];
#pragma unroll
                for (int i = 0; i < 16; ++i) { v[i] = kv[(size_t)(c0 + i) * 65536]; dd[i] = hd[(size_t)(c0 + i) * 512]; }
#pragma unroll
                for (int i = 0; i < 16; ++i) { sp[(size_t)(c0 + i) * 65536] = f2bf1(S); S = fmaf(S, dd[i], v[i]); } }
        }
    }
}

__global__ void __launch_bounds__(512, 2) mk_fwd(Args args) {
    extern __shared__ __attribute__((aligned(16))) unsigned char lds_raw[];
    Frame F;
    F.lds = (LAS unsigned char*)lds_raw;
    F.wave = __builtin_amdgcn_readfirstlane(threadIdx.x >> 6);
    F.G = gridDim.x; { const int bx = blockIdx.x; F.vcu = (F.G % 8 == 0) ? (bx % 8) * (F.G / 8) + bx / 8 : bx; }
    F.ws = args.ws; F.ctl = (unsigned*)(args.ws + WS_CTL);
    volatile LAS unsigned* MISC = (volatile LAS unsigned*)(F.lds + LDS_MISC);
    if (F_TID < 64) MISC[F_TID] = 0u;
    __syncthreads();
    const bool use_bar = (args.ph_hi - args.ph_lo) > 1;
    XcdBarrier bar; bar.bar = F.ctl + CW_BAR + args.li * XCD_BAR_WORDS; bar.x = 0; bar.st = MISC + 8; bar.wave = F.wave;
    if (use_bar) bar = xcd_barrier_post(F.ctl + CW_BAR + args.li * XCD_BAR_WORDS, MISC + 8, F.wave);
#define PH(k) (args.ph_lo <= (k) && (k) < args.ph_hi)
#define SEAM(k) do { if (use_bar && (k) + 1 < args.ph_hi && (k) >= args.ph_lo) xcd_barrier(bar); } while (0)
    unsigned char* ws = F.ws;
    if (PH(0)) phase_prep(F, args);
    SEAM(0);
    if (PH(1)) {
        pg8::DenseSched S; S.init(ws + WS_XB, ws + WS_WIN_T, T_TOK, 3072, 1024, F.G, blockIdx.x);
        pg8::EpiP E; E.O = (bf16_t*)(ws + WS_P); E.ldc = PW;
        pg8::gemm_phase<pg8::EpiP, pg8::DenseSched, true>(F.lds, 1024, S, E, F.wave);
    }
    SEAM(1);
#if defined(MK_NAIVE_MIX)
    if (PH(2)) phase_m1(F, args);
    SEAM(2);
    if (PH(3)) phase_m2(F, args);
    SEAM(3);
    if (PH(4)) phase_m3(F, args);
#else
    if (PH(2)) phase_mix_states(F, args, args.mode);
    SEAM(2);
    if (PH(3)) {
        phase_mix_scan(F, args);
        if (blockIdx.x < 128 && F.G >= 256) {
            __syncthreads();
            pg8::DenseSched S; S.init(ws + WS_XB, ws + WS_WIN_T + (size_t)3072 * 1024 * 2, T_TOK, 512, 1024, 128, blockIdx.x);
            pg8::EpiP E; E.O = (bf16_t*)(ws + WS_P) + 3072; E.ldc = PW;
            pg8::gemm_phase<pg8::EpiP, pg8::DenseSched, true>(F.lds, 1024, S, E, F.wave);
        } else if (F.G < 256) {
            __syncthreads();
            pg8::DenseSched S; S.init(ws + WS_XB, ws + WS_WIN_T + (size_t)3072 * 1024 * 2, T_TOK, 512, 1024, F.G, blockIdx.x);
            pg8::EpiP E; E.O = (bf16_t*)(ws + WS_P) + 3072; E.ldc = PW;
            pg8::gemm_phase<pg8::EpiP, pg8::DenseSched, true>(F.lds, 1024, S, E, F.wave);
        }
    }
    SEAM(3);
    if (PH(4)) phase_mix_out(F, args, args.mode);
#endif
    SEAM(4);
    if (PH(5)) {
        pg8::DenseSched S; S.init(ws + WS_MIX, ws + WS_WOUT_T, T_TOK, 1024, 1024, F.G, blockIdx.x);
        pg8::EpiU E; E.U = (float*)(ws + WS_H1); E.X = KARG_IN(0);
        pg8::gemm_phase<pg8::EpiU, pg8::DenseSched, false>(F.lds, 1024, S, E, F.wave);
    }
    SEAM(5);
    if (PH(6)) phase_ln1(F, args);
    SEAM(6);
    if (PH(7)) {
        pg8::DenseSched S; S.init(ws + WS_H1B, ws + WS_W3_T, T_TOK, 768, 1024, F.G, blockIdx.x);
        pg8::Epi3 E; E.LG = (float*)(ws + WS_LOGITS); E.HS = (bf16_t*)(ws + WS_HS);
        pg8::gemm_phase<pg8::Epi3, pg8::DenseSched, false>(F.lds, 1024, S, E, F.wave);
    }
    SEAM(7);
    if (PH(8)) {
        phase_route(F, args);
        pg8::DenseSched S; S.init(ws + WS_HS, ws + WS_WDS_T, T_TOK, 1024, 256, F.G, blockIdx.x);
        pg8::EpiP E; E.O = (bf16_t*)(ws + WS_YS); E.ldc = 1024;
        pg8::gemm_phase<pg8::EpiP, pg8::DenseSched, false>(F.lds, 256, S, E, F.wave);
    }
    SEAM(8);
#if defined(MK_OLD_EXPERTS)
    if (PH(9)) {
        build_tables(F);
        pg8::ExpertSched<true> S; S.lds = F.lds;
        S.lists = (const int*)(ws + WS_LISTS); S.A = (const char*)(ws + WS_H1B); S.W = (const char*)(ws + WS_WGU_T);
        S.U = 2 * __builtin_amdgcn_readfirstlane(((const LAS int*)(F.lds + LDS_PREF))[NEXP]); S.G = F.G; S.c = blockIdx.x;
        pg8::EpiH E; E.H = (bf16_t*)(ws + WS_H);
        pg8::gemm_phase<pg8::EpiH, pg8::ExpertSched<true>, true>(F.lds, 1024, S, E, F.wave);
    }
    SEAM(9);
    if (PH(10)) {
        build_tables(F);
        pg8::ExpertSched<false> S; S.lds = F.lds;
        S.lists = (const int*)(ws + WS_LISTS); S.A = (const char*)(ws + WS_H); S.W = (const char*)(ws + WS_WD_T);
        S.U = 4 * __builtin_amdgcn_readfirstlane(((const LAS int*)(F.lds + LDS_PREF))[NEXP]); S.G = F.G; S.c = blockIdx.x;
        pg8::EpiYb E; E.YB = (bf16_t*)(ws + WS_YB); E.lists = (const int*)(ws + WS_LISTS); E.tok_gate = (const float*)(ws + WS_TOKGATE);
        pg8::gemm_phase<pg8::EpiYb, pg8::ExpertSched<false>, true>(F.lds, 256, S, E, F.wave);
    }
    SEAM(10);
#else
    if (PH(9)) phase_experts(F, args, args.mode);
    SEAM(9);
#endif
    if (PH(11)) { build_tables(F); phase_final(F, args); }
}

extern "C" void kernel_launch(void* const* d_in, const int* in_sizes, int n_in, void* d_out, int out_size, void* d_ws, size_t ws_size, hipStream_t stream) {
    static int grid = 0;
    if (grid == 0) {
        int dev = 0, cus = 0;
        if (hipGetDevice(&dev) != hipSuccess || hipDeviceGetAttribute(&cus, hipDeviceAttributeMultiprocessorCount, dev) != hipSuccess) { fprintf(stderr, "device query failed\n"); grid = -1; return; }
        if (hipFuncSetAttribute((const void*)mk_fwd, hipFuncAttributeMaxDynamicSharedMemorySize, LDS_BYTES) != hipSuccess) { fprintf(stderr, "hipFuncSetAttribute failed\n"); grid = -1; return; }
        if (ws_size < WS_END) { fprintf(stderr, "workspace too small: %zu < %zu\n", ws_size, (size_t)WS_END); grid = -1; return; }
        (void)hipGetLastError();
        grid = cus;
    }
    if (grid < 0) return;
    unsigned char* ws = (unsigned char*)d_ws;
    (void)hipMemsetAsync(ws + WS_CTL, 0, CTL_ZERO_BYTES, stream);
    Args a{};
    for (int i = 0; i < 23; ++i) a.in[i] = (const float*)d_in[i];
    a.out = (float*)d_out; a.ws = ws;
    auto launch = [&](int lo, int hi) { a.ph_lo = lo; a.ph_hi = hi; hipLaunchKernelGGL(mk_fwd, dim3(grid), dim3(512), LDS_BYTES, stream, a); };
#if defined(MK_PER_PHASE)
    for (int ph = 0; ph < NPH; ++ph) launch(ph, ph + 1);
#else
    launch(0, NPH);
#endif
}
```

```cpp
#include <hip/hip_runtime.h>
#include <stdint.h>
#include <cstdio>

#define GAS __attribute__((address_space(1)))
#define LAS __attribute__((address_space(3)))
typedef unsigned short bf16_t;
typedef short bf16x8 __attribute__((ext_vector_type(8)));
typedef float f32x4 __attribute__((ext_vector_type(4)));
typedef unsigned u32x4 __attribute__((ext_vector_type(4)));
typedef unsigned u32x2 __attribute__((ext_vector_type(2)));
typedef float f32x16 __attribute__((ext_vector_type(16)));
typedef short s16x4 __attribute__((ext_vector_type(4)));

constexpr int T_TOK = 16384, DM = 1024, NIN = 3592, PW = 3584;
constexpr int NEXP = 256, LIST_CAP = 16384;
constexpr int PC_Z = 0, PC_XBC = 512, PC_Q = 1536, PC_F = 2048, PC_I = 2560, PC_G = 3072;
#define ALPHA_F 1.189207115002721f
#define LN_EPS_F 1e-5f
#define RMS_EPS_F 1e-6f

constexpr size_t MiB = 1u << 20;
constexpr size_t WS_CTL = 0, CTL_ZERO_BYTES = 1 * MiB;
constexpr size_t WS_WIN_T = 2 * MiB, WS_WOUT_T = 9 * MiB, WS_W3_T = 11 * MiB, WS_WDS_T = 13 * MiB, WS_DTRAW = 14 * MiB;
constexpr size_t WS_TOKE = 15 * MiB, WS_TOKPOS = 15 * MiB + 512 * 1024, WS_TOKGATE = 16 * MiB;
constexpr size_t WS_LISTS = 17 * MiB, WS_LOGITS = 33 * MiB, WS_HS = 49 * MiB, WS_YS = 57 * MiB, WS_H1 = 89 * MiB, WS_H1B = 153 * MiB;
constexpr size_t WS_WGU_T = 185 * MiB, WS_WD_T = 441 * MiB;
constexpr size_t WS_X0 = 569 * MiB;
constexpr size_t WS_XB = WS_X0, WS_P = WS_X0 + 32 * MiB, WS_MIX = WS_X0 + 144 * MiB;
constexpr size_t WS_NXBC = WS_X0 + 176 * MiB, WS_NFGK = WS_X0 + 240 * MiB, WS_NQS = WS_X0 + 272 * MiB, WS_NYSSD = WS_X0 + 304 * MiB, WS_NOH = WS_X0 + 336 * MiB, WS_NDTB = WS_X0 + 368 * MiB;
constexpr size_t WS_SSTATE = WS_X0 + 176 * MiB, WS_SPREV = WS_X0 + 208 * MiB, WS_HKV = WS_X0 + 224 * MiB, WS_HSPREV = WS_X0 + 288 * MiB;
constexpr size_t WS_CDECAY = WS_X0 + 320 * MiB, WS_HDECAY = WS_X0 + 320 * MiB + 64 * 1024;
constexpr size_t WS_H = WS_X0, WS_YB = WS_X0 + 65 * MiB;
constexpr size_t WS_END = WS_X0 + 369 * MiB;
constexpr int CW_BAR = 4096;
constexpr int CW_COUNTS = 16384, CNT_STRIDE = 64;

constexpr int RING_BYTES = 131072;
constexpr int LDS_BYTES = 163840;
constexpr int LDS_MISC = LDS_BYTES - 4096;
constexpr int LDS_PREF = LDS_MISC + 256;
constexpr int LDS_OFFS = LDS_PREF + 1040;
constexpr int LDS_CNT = LDS_OFFS + 1040;
constexpr int LDS_PHASE_BYTES = LDS_MISC;

__device__ __forceinline__ int lane_id() { int l; asm volatile("v_mbcnt_lo_u32_b32 %0, -1, 0\n\tv_mbcnt_hi_u32_b32 %0, -1, %0" : "=v"(l)); return l; }
__device__ __forceinline__ float siluf(float x) { return x / (1.0f + __expf(-x)); }
__device__ __forceinline__ float sigmf(float x) { return 1.0f / (1.0f + __expf(-x)); }
template <int CTRL> __device__ __forceinline__ float dpp_f(float v) { return __builtin_bit_cast(float, __builtin_amdgcn_update_dpp(0, __builtin_bit_cast(int, v), CTRL, 0xf, 0xf, true)); }
__device__ __forceinline__ float rdlane_f(float v, int l) { return __builtin_bit_cast(float, __builtin_amdgcn_readlane(__builtin_bit_cast(int, v), l)); }
__device__ __forceinline__ float wave_sum(float v) {
  v += dpp_f<0xB1>(v); v += dpp_f<0x4E>(v); v += dpp_f<0x141>(v); v += dpp_f<0x140>(v);
  return (rdlane_f(v, 0) + rdlane_f(v, 16)) + (rdlane_f(v, 32) + rdlane_f(v, 48));
}
__device__ __forceinline__ float wave_max(float v) {
  v = fmaxf(v, dpp_f<0xB1>(v)); v = fmaxf(v, dpp_f<0x4E>(v)); v = fmaxf(v, dpp_f<0x141>(v)); v = fmaxf(v, dpp_f<0x140>(v));
  return fmaxf(fmaxf(rdlane_f(v, 0), rdlane_f(v, 16)), fmaxf(rdlane_f(v, 32), rdlane_f(v, 48)));
}
__device__ __forceinline__ unsigned cvt_pk_bf16(float lo, float hi) { unsigned r; asm volatile("v_cvt_pk_bf16_f32 %0, %1, %2" : "=v"(r) : "v"(lo), "v"(hi)); return r; }
#define YB_SCALE 64.0f
__device__ __forceinline__ unsigned pk4_fp8(const f32x4 v) {
    const float a = fminf(fmaxf(v[0], -440.f), 440.f), b = fminf(fmaxf(v[1], -440.f), 440.f), c = fminf(fmaxf(v[2], -440.f), 440.f), d = fminf(fmaxf(v[3], -440.f), 440.f);
    int w = 0; w = __builtin_amdgcn_cvt_pk_fp8_f32(a, b, w, false); w = __builtin_amdgcn_cvt_pk_fp8_f32(c, d, w, true); return (unsigned)w; }
__device__ __forceinline__ f32x4 un4_fp8(const unsigned w) { return (f32x4){__builtin_amdgcn_cvt_f32_fp8((int)w, 0), __builtin_amdgcn_cvt_f32_fp8((int)w, 1), __builtin_amdgcn_cvt_f32_fp8((int)w, 2), __builtin_amdgcn_cvt_f32_fp8((int)w, 3)}; }
__device__ __forceinline__ float bf2f(unsigned b) { return __uint_as_float(b << 16); }
__device__ __forceinline__ float bflo(unsigned w) { return __uint_as_float(w << 16); }
__device__ __forceinline__ float bfhi(unsigned w) { return __uint_as_float(w & 0xffff0000u); }

#define XB_TMO      128
#define XB_XCNT(j)  (256  + 64 * (j))
#define XB_XSUB(j)  (1280 + 64 * (j))
#define XB_XGEN(j)  (2304 + 64 * (j))
#define XB_TOP      3328
#define XB_TOPGEN   3392
#define XCD_BAR_WORDS 3456
#define XB_SPIN_CAP (1u << 18)
__device__ __forceinline__ unsigned xb_ld(unsigned* p)              { return __hip_atomic_load(p, __ATOMIC_RELAXED, __HIP_MEMORY_SCOPE_AGENT); }
__device__ __forceinline__ unsigned xb_add(unsigned* p, unsigned v) { return __hip_atomic_fetch_add(p, v, __ATOMIC_RELAXED, __HIP_MEMORY_SCOPE_AGENT); }
__device__ __forceinline__ unsigned xb_xcc_id() { return (unsigned)__builtin_amdgcn_s_getreg((3 << 11) | 20) & 0xFu; }
#define XB_SPIN(cond, bar) do { unsigned _sp = 0; while (cond) { __builtin_amdgcn_s_sleep(1); \
    if ((++_sp & 255u) == 0u) { if (xb_ld(&(bar)[XB_TMO])) break; if (_sp > XB_SPIN_CAP) { atomicAdd(&(bar)[XB_TMO], 1u); break; } } } } while (0)
struct XcdBarrier { unsigned* bar; unsigned x; volatile LAS unsigned* st; int wave; };
__device__ __forceinline__ XcdBarrier xcd_barrier_post(unsigned* bar, volatile LAS unsigned* st, int wave) {
    XcdBarrier b; b.bar = bar; b.x = xb_xcc_id(); b.st = st; b.wave = wave;
    if (wave == 0 && lane_id() == 0) (void)xb_add(&bar[XB_XCNT(b.x)], 1u);
    return b;
}
__device__ __forceinline__ void xcd_barrier_complete(unsigned* bar, unsigned x, unsigned& nloc, unsigned& nx) {
    const unsigned G = gridDim.x * gridDim.y * gridDim.z;
    unsigned sum, cnt, mine, sp = 0u;
    for (;;) {
        sum = 0u; cnt = 0u; mine = 0u;
#pragma unroll
        for (unsigned j = 0; j < 16; ++j) { const unsigned c = xb_ld(&bar[XB_XCNT(j)]); sum += c; cnt += (c > 0u) ? 1u : 0u; mine = (j == x) ? c : mine; }
        if (sum == G) break;
        __builtin_amdgcn_s_sleep(1);
        if ((++sp & 255u) == 0u) { if (xb_ld(&bar[XB_TMO])) break; if (sp > XB_SPIN_CAP) { atomicAdd(&bar[XB_TMO], 1u); break; } }
    }
    nloc = mine > 0u ? mine : 1u; nx = cnt > 0u ? cnt : 1u;
}
__device__ __forceinline__ void xcd_barrier(const XcdBarrier& b) {
    asm volatile("s_waitcnt vmcnt(0)" ::: "memory");
    __syncthreads();
    if (b.wave == 0 && lane_id() == 0) {
        unsigned* bar = b.bar;
        __builtin_amdgcn_s_waitcnt(0);
        unsigned nloc = b.st[0], nx = b.st[1];
        if (nloc == 0u) { xcd_barrier_complete(bar, b.x, nloc, nx); b.st[0] = nloc; b.st[1] = nx; }
        const unsigned old = xb_add(&bar[XB_XSUB(b.x)], 1u);
        const unsigned gen = old / nloc;
        if (old + 1u == (gen + 1u) * nloc) {
            __builtin_amdgcn_fence(__ATOMIC_RELEASE, "agent");
            asm volatile("s_waitcnt vmcnt(0)" ::: "memory");
            const unsigned og = xb_add(&bar[XB_TOP], 1u);
            const unsigned tg = og / nx;
            if (og + 1u == (tg + 1u) * nx) xb_add(&bar[XB_TOPGEN], 1u);
            else XB_SPIN(xb_ld(&bar[XB_TOPGEN]) == tg, bar);
            __builtin_amdgcn_fence(__ATOMIC_ACQUIRE, "agent");
            xb_add(&bar[XB_XGEN(b.x)], 1u);
            asm volatile("s_waitcnt vmcnt(0)" ::: "memory");
        } else {
            XB_SPIN(xb_ld(&bar[XB_XGEN(b.x)]) == gen, bar);
            __builtin_amdgcn_fence(__ATOMIC_ACQUIRE, "agent");
            asm volatile("s_waitcnt vmcnt(0)" ::: "memory");
        }
    }
    __syncthreads();
}

namespace pg8 {
constexpr int BM = 256, BK = 64, HALF = 128, HTB = HALF * BK * 2, STAGE_BYTES = 8 * HTB, NXCD = 8, WGM = 8;
__host__ __device__ __forceinline__ int lds_byte(int r, int c) { const int st = (r >> 4) * 2 + (c >> 5), rr = r & 15, cc = c & 31, ob = rr * 64 + cc * 2; return st * 1024 + (ob ^ (((ob >> 9) & 1) << 5)); }
__host__ __device__ __forceinline__ void stage_rc(int b, int& R, int& C) { const int st = b / 1024, sb = b % 1024, swz = sb ^ (((sb >> 9) & 1) << 5); R = (st >> 1) * 16 + swz / 64; C = (st & 1) * 32 + (swz % 64) / 2; }
__host__ __device__ __forceinline__ int perm32(int rho) { const int n = rho >> 4, i = rho & 15; return 8 * (i >> 2) + 4 * n + (i & 3); }

struct Unit { const char* A; const char* B; int pm, pn, rows, e, slot0, mt; };

struct DenseSched {
    static constexpr bool PER_UNIT_VOFF = false;
    const char* A; const char* B; int K, nM, nN, nwg, G, c;
    __device__ void init(const void* A_, const void* B_, int M, int N, int K_, int G_, int c_) { A = (const char*)A_; B = (const char*)B_; K = K_; nM = M / BM; nN = N / BM; nwg = nM * nN; G = G_; c = c_; }
    __device__ __forceinline__ bool next(int i, Unit& u) const {
        const int L = i * G + c; if (L >= nwg) return false;
        int wgid = L; { const int q = nwg / NXCD, r = nwg % NXCD, xcd = wgid % NXCD, off = wgid / NXCD; wgid = (xcd < r ? xcd * (q + 1) : r * (q + 1) + (xcd - r) * q) + off; }
        const int nig = WGM * nN, gid = wgid / nig, fm = gid * WGM, gsz = (nM - fm) < WGM ? (nM - fm) : WGM;
        u.pm = fm + ((wgid % nig) % gsz); u.pn = (wgid % nig) / gsz; u.rows = 256; u.e = 0; u.slot0 = 0; u.mt = 0;
        u.A = A + (size_t)u.pm * BM * K * 2; u.B = B + (size_t)u.pn * BM * K * 2; return true;
    }
    __device__ __forceinline__ void voff(const Unit&, const int (&sR)[2], const int (&sC)[2], unsigned (&v)[2][2]) const {
#pragma unroll
        for (int h = 0; h < 2; ++h)
#pragma unroll
            for (int i = 0; i < 2; ++i) v[h][i] = (unsigned)((h * HALF + sR[i]) * K + sC[i]) * 2u;
    }
};

template <bool GATHER> struct ExpertSched {
    static constexpr bool PER_UNIT_VOFF = GATHER;
    static constexpr int K = GATHER ? 1024 : 256, NT = GATHER ? 2 : 4;
    static constexpr unsigned WSTRIDE = GATHER ? 512u * 1024u * 2u : 1024u * 256u * 2u;
    LAS unsigned char* lds;
    const int* lists; const char* A; const char* W; int U, G, c;
    __device__ __forceinline__ bool next(int i, Unit& u) const {
        int L = i * G + c; if (L >= U) return false;
        { const int q = U / NXCD, r = U % NXCD, xcd = L % NXCD, off = L / NXCD; L = (xcd < r ? xcd * (q + 1) : r * (q + 1) + (xcd - r) * q) + off; }
        const LAS int* pref = (const LAS int*)(lds + LDS_PREF);
        int lo = 0, hi = NEXP;
        while (hi - lo > 1) { const int mid = (lo + hi) >> 1; const int pv = __builtin_amdgcn_readfirstlane(pref[mid]); if (NT * pv <= L) lo = mid; else hi = mid; }
        const int e = lo, p0 = __builtin_amdgcn_readfirstlane(pref[e]), p1 = __builtin_amdgcn_readfirstlane(pref[e + 1]), tiles = p1 - p0, r = L - NT * p0;
        u.e = e; u.pn = r / tiles; u.mt = r % tiles; u.pm = 0;
        const int n = __builtin_amdgcn_readfirstlane(((const LAS int*)(lds + LDS_CNT))[e]); u.rows = (n - u.mt * 256) < 256 ? (n - u.mt * 256) : 256;
        u.slot0 = __builtin_amdgcn_readfirstlane(((const LAS int*)(lds + LDS_OFFS))[e]) + u.mt * 256;
        u.A = GATHER ? A : A + (size_t)u.slot0 * (K * 2); u.B = W + (size_t)e * WSTRIDE + (size_t)u.pn * (BM * K * 2); return true;
    }
    __device__ __forceinline__ void voff(const Unit& u, const int (&sR)[2], const int (&sC)[2], unsigned (&v)[2][2]) const {
#pragma unroll
        for (int h = 0; h < 2; ++h)
#pragma unroll
            for (int i = 0; i < 2; ++i) {
                const int r = h * HALF + sR[i];
                if (GATHER) { int tok = 0; if (r < u.rows) tok = lists[(size_t)u.e * LIST_CAP + u.mt * 256 + r] >> 3; v[h][i] = (unsigned)(tok * K + sC[i]) * 2u; }
                else v[h][i] = (unsigned)(r * K + sC[i]) * 2u;
            }
    }
};

template <class Epi, class Sched, bool ALIGN_EPI>
__device__ __forceinline__ void gemm_phase(LAS unsigned char* lds, const int K, const Sched& S, const Epi& E, const int wid) {
    const int lane = lane_id(), tid = wid * 64 + lane, wr = wid >> 2, wc = wid & 3, fr = lane & 15, fq = lane >> 4;
    const int nt = K / BK;
    int sR[2], sC[2]; unsigned voffB[2];
#pragma unroll
    for (int i = 0; i < 2; ++i) { stage_rc(tid * 16 + i * 8192, sR[i], sC[i]); const int Rb = Epi::PERM ? ((sR[i] & ~31) + perm32(sR[i] & 31)) : sR[i]; voffB[i] = (unsigned)(Rb * K + sC[i]) * 2u; }
    const size_t kstep = (size_t)(BK * 2);
    const size_t hstep = (size_t)HALF * K * 2;
    const unsigned ldsw = (unsigned)wid * 1024u;
    const int aoff = lds_byte(wr * 64 + fr, fq * 8), boff = lds_byte(wc * 32 + fr, fq * 8);
#define PG8_SA(b, h) (((b) * 2 + (h)) * HTB)
#define PG8_SB(b, h) ((4 + (b) * 2 + (h)) * HTB)
#define PG8_STAGE(bufoff, gbase, voff) do { _Pragma("unroll") for (int _i = 0; _i < 2; ++_i) \
        __builtin_amdgcn_global_load_lds((const unsigned*)((const char*)(gbase) + (voff)[_i]), (LAS unsigned*)(lds + (bufoff) + ldsw + _i * 8192), 16, 0, 0); } while (0)
#define PG8_STAGE_A(bufoff, gbase, h, vset) do { if constexpr (Sched::PER_UNIT_VOFF) { PG8_STAGE(bufoff, gbase, (vset)[h]); } else { PG8_STAGE(bufoff, (gbase) + (h) * hstep, vc[0]); } } while (0)
#define PG8_LDA(dst, b, h) do { _Pragma("unroll") for (int m = 0; m < 4; ++m) _Pragma("unroll") for (int k = 0; k < 2; ++k) dst[m][k] = *(const LAS bf16x8*)(lds + PG8_SA(b, h) + aoff + m * 2048 + k * 1024); } while (0)
#define PG8_LDB(dst, b, h) do { _Pragma("unroll") for (int n = 0; n < 2; ++n) _Pragma("unroll") for (int k = 0; k < 2; ++k) dst[n][k] = *(const LAS bf16x8*)(lds + PG8_SB(b, h) + boff + n * 2048 + k * 1024); } while (0)
#define PG8_MMA(ai, bj, At, Bt) do { __builtin_amdgcn_s_setprio(1); _Pragma("unroll") for (int m = 0; m < 4; ++m) _Pragma("unroll") for (int n = 0; n < 2; ++n) _Pragma("unroll") for (int k = 0; k < 2; ++k) \
        acc[ai][bj][m][n] = __builtin_amdgcn_mfma_f32_16x16x32_bf16(Bt[n][k], At[m][k], acc[ai][bj][m][n], 0, 0, 0); __builtin_amdgcn_s_setprio(0); } while (0)
#define PG8_WAIT_V(n) asm volatile("s_waitcnt vmcnt(" #n ")" ::: "memory")
#define PG8_WAIT_L(n) asm volatile("s_waitcnt lgkmcnt(" #n ")" ::: "memory")
#define PG8_BAR __builtin_amdgcn_s_barrier()
#define PG8_SCHED __builtin_amdgcn_sched_barrier(0)
    Unit cur, nxt; int ui = 0;
    if (!S.next(0, cur)) return;
    unsigned vc[2][2], vn[2][2];
    S.voff(cur, sR, sC, vc);
    f32x4 acc[2][2][4][2];
#pragma unroll
    for (int a = 0; a < 2; ++a)
#pragma unroll
        for (int b = 0; b < 2; ++b)
#pragma unroll
            for (int m = 0; m < 4; ++m)
#pragma unroll
                for (int n = 0; n < 2; ++n) acc[a][b][m][n] = (f32x4){0.f, 0.f, 0.f, 0.f};
    bf16x8 At[4][2], B0[2][2], B1[2][2];
    const char* cA = cur.A; const char* cB = cur.B;
    PG8_STAGE(PG8_SB(0, 0), cB, voffB); PG8_STAGE(PG8_SB(0, 1), cB + hstep, voffB); PG8_STAGE_A(PG8_SA(0, 0), cA, 0, vc); PG8_STAGE_A(PG8_SA(0, 1), cA, 1, vc);
    if (wr == 1) PG8_BAR;
    PG8_WAIT_V(2); PG8_BAR;
    PG8_STAGE(PG8_SB(1, 0), cB + kstep, voffB); PG8_STAGE_A(PG8_SA(1, 0), cA + kstep, 0, vc); PG8_STAGE(PG8_SB(1, 1), cB + hstep + kstep, voffB);
    PG8_WAIT_V(6); PG8_BAR;
    for (;;) {
        const bool has_next = S.next(ui + 1, nxt);
        if constexpr (Sched::PER_UNIT_VOFF) {
            if (has_next) S.voff(nxt, sR, sC, vn);
            else {
#pragma unroll
                for (int h = 0; h < 2; ++h)
#pragma unroll
                    for (int i = 0; i < 2; ++i) vn[h][i] = vc[h][i];
            }
        }
        const char* nA = has_next ? nxt.A : cA; const char* nB = has_next ? nxt.B : cB;
        for (int t = 0; t < nt; t += 2) {
            const bool last = (t == nt - 2);
            const char* a1 = cA + (size_t)(t + 1) * kstep;
            const char* a2 = last ? nA : cA + (size_t)(t + 2) * kstep; const char* b2 = last ? nB : cB + (size_t)(t + 2) * kstep;
            const char* a3 = a2 + kstep; const char* b3 = b2 + kstep;
            unsigned v2[2][2];
#pragma unroll
            for (int h = 0; h < 2; ++h)
#pragma unroll
                for (int i = 0; i < 2; ++i) v2[h][i] = (Sched::PER_UNIT_VOFF && last) ? vn[h][i] : vc[h][i];
            PG8_LDB(B0, 0, 0); PG8_LDB(B1, 0, 1); PG8_SCHED; PG8_LDA(At, 0, 0); PG8_STAGE_A(PG8_SA(1, 1), a1, 1, vc);
            PG8_WAIT_V(8); PG8_WAIT_L(0); PG8_BAR; PG8_MMA(0, 0, At, B0); PG8_MMA(0, 1, At, B1); PG8_BAR; PG8_SCHED;
            PG8_LDA(At, 0, 1); PG8_STAGE(PG8_SB(0, 0), b2, voffB); PG8_STAGE(PG8_SB(0, 1), b2 + hstep, voffB); PG8_STAGE_A(PG8_SA(0, 0), a2, 0, v2);
            PG8_WAIT_V(8); PG8_WAIT_L(0); PG8_BAR; PG8_MMA(1, 0, At, B0); PG8_MMA(1, 1, At, B1); PG8_BAR; PG8_SCHED;
            PG8_LDB(B0, 1, 0); PG8_LDB(B1, 1, 1); PG8_SCHED; PG8_LDA(At, 1, 0); PG8_STAGE_A(PG8_SA(0, 1), a2, 1, v2);
            PG8_WAIT_V(8); PG8_WAIT_L(0); PG8_BAR; PG8_MMA(0, 0, At, B0); PG8_MMA(0, 1, At, B1); PG8_BAR; PG8_SCHED;
            PG8_LDA(At, 1, 1); PG8_STAGE(PG8_SB(1, 0), b3, voffB); PG8_STAGE(PG8_SB(1, 1), b3 + hstep, voffB); PG8_STAGE_A(PG8_SA(1, 0), a3, 0, v2);
            PG8_WAIT_V(8); PG8_WAIT_L(0); PG8_BAR; PG8_MMA(1, 0, At, B0); PG8_MMA(1, 1, At, B1); PG8_BAR; PG8_SCHED;
        }
        if constexpr (ALIGN_EPI) { if (wr == 0) PG8_BAR; }
        E(acc, cur, wr, wc, fr, fq);
        if (!has_next) break;
#pragma unroll
        for (int a = 0; a < 2; ++a)
#pragma unroll
            for (int b = 0; b < 2; ++b)
#pragma unroll
                for (int m = 0; m < 4; ++m)
#pragma unroll
                    for (int n = 0; n < 2; ++n) acc[a][b][m][n] = (f32x4){0.f, 0.f, 0.f, 0.f};
        cur = nxt; cA = nA; cB = nB; ++ui;
        if constexpr (Sched::PER_UNIT_VOFF) {
#pragma unroll
            for (int h = 0; h < 2; ++h)
#pragma unroll
                for (int i = 0; i < 2; ++i) vc[h][i] = vn[h][i];
        }
        if constexpr (ALIGN_EPI) { if (wr == 1) PG8_BAR; }
    }
    PG8_WAIT_V(0);
    if constexpr (!ALIGN_EPI) { if (wr == 0) PG8_BAR; }
    PG8_BAR;
#undef PG8_SA
#undef PG8_SB
#undef PG8_STAGE
#undef PG8_LDA
#undef PG8_STAGE_A
#undef PG8_LDB
#undef PG8_MMA
#undef PG8_WAIT_V
#undef PG8_WAIT_L
#undef PG8_BAR
#undef PG8_SCHED
}

struct EpiP {
    static constexpr bool PERM = true;
    bf16_t* O; int ldc;
    __device__ __forceinline__ void operator()(const f32x4 (&acc)[2][2][4][2], const Unit& u, int wr, int wc, int fr, int fq) const {
        const int row0 = u.pm * BM + wr * 64 + fr, col0 = u.pn * BM + wc * 32 + 8 * fq;
#pragma unroll
        for (int ai = 0; ai < 2; ++ai)
#pragma unroll
            for (int m = 0; m < 4; ++m) { bf16_t* rowp = O + (size_t)(row0 + ai * HALF + m * 16) * ldc + col0;
#pragma unroll
                for (int bj = 0; bj < 2; ++bj) { const f32x4 v0 = acc[ai][bj][m][0], v1 = acc[ai][bj][m][1];
                    u32x4 w; w.x = cvt_pk_bf16(v0[0], v0[1]); w.y = cvt_pk_bf16(v0[2], v0[3]); w.z = cvt_pk_bf16(v1[0], v1[1]); w.w = cvt_pk_bf16(v1[2], v1[3]);
                    *(u32x4*)(rowp + bj * HALF) = w; } }
    }
};
struct EpiU {
    static constexpr bool PERM = false;
    float* U; const float* X;
    __device__ __forceinline__ void operator()(const f32x4 (&acc)[2][2][4][2], const Unit& u, int wr, int wc, int fr, int fq) const {
        const int row0 = u.pm * BM + wr * 64 + fr, col0 = u.pn * BM + wc * 32 + 4 * fq;
#pragma unroll
        for (int ai = 0; ai < 2; ++ai)
#pragma unroll
            for (int m = 0; m < 4; ++m) { const size_t ro = (size_t)(row0 + ai * HALF + m * 16) * DM + col0;
#pragma unroll
                for (int bj = 0; bj < 2; ++bj)
#pragma unroll
                    for (int n = 0; n < 2; ++n) { const f32x4 xv = *(const f32x4*)(X + ro + bj * HALF + n * 16);
                        *(f32x4*)(U + ro + bj * HALF + n * 16) = xv * ALPHA_F + acc[ai][bj][m][n]; } }
    }
};
struct Epi3 {
    static constexpr bool PERM = true;
    float* LG; bf16_t* HS;
    __device__ __forceinline__ void operator()(const f32x4 (&acc)[2][2][4][2], const Unit& u, int wr, int wc, int fr, int fq) const {
        const int row0 = u.pm * BM + wr * 64 + fr;
        if (u.pn == 0) {
#pragma unroll
            for (int ai = 0; ai < 2; ++ai)
#pragma unroll
                for (int m = 0; m < 4; ++m) { float* rowp = LG + (size_t)(row0 + ai * HALF + m * 16) * 256 + wc * 32 + 8 * fq;
#pragma unroll
                    for (int bj = 0; bj < 2; ++bj)
#pragma unroll
                        for (int n = 0; n < 2; ++n) *(f32x4*)(rowp + bj * HALF + 4 * n) = acc[ai][bj][m][n]; }
        } else {
            const int hc0 = (u.pn - 1) * 128 + wc * 32 + 8 * fq;
#pragma unroll
            for (int ai = 0; ai < 2; ++ai)
#pragma unroll
                for (int m = 0; m < 4; ++m) { bf16_t* rowp = HS + (size_t)(row0 + ai * HALF + m * 16) * 256 + hc0;
                    float h[8];
#pragma unroll
                    for (int n = 0; n < 2; ++n)
#pragma unroll
                        for (int j = 0; j < 4; ++j) h[n * 4 + j] = siluf(acc[ai][0][m][n][j]) * acc[ai][1][m][n][j];
                    u32x4 w; w.x = cvt_pk_bf16(h[0], h[1]); w.y = cvt_pk_bf16(h[2], h[3]); w.z = cvt_pk_bf16(h[4], h[5]); w.w = cvt_pk_bf16(h[6], h[7]);
                    *(u32x4*)rowp = w; }
        }
    }
};
struct EpiH {
    static constexpr bool PERM = true;
    bf16_t* H;
    __device__ __forceinline__ void operator()(const f32x4 (&acc)[2][2][4][2], const Unit& u, int wr, int wc, int fr, int fq) const {
        const int hc0 = u.pn * 128 + wc * 32 + 8 * fq;
#pragma unroll
        for (int ai = 0; ai < 2; ++ai)
#pragma unroll
            for (int m = 0; m < 4; ++m) { const int r = ai * HALF + wr * 64 + m * 16 + fr;
                if (r < u.rows) { bf16_t* rowp = H + (size_t)(u.slot0 + r) * 256 + hc0;
                    float h[8];
#pragma unroll
                    for (int n = 0; n < 2; ++n)
#pragma unroll
                        for (int j = 0; j < 4; ++j) h[n * 4 + j] = siluf(acc[ai][0][m][n][j]) * acc[ai][1][m][n][j];
                    u32x4 w; w.x = cvt_pk_bf16(h[0], h[1]); w.y = cvt_pk_bf16(h[2], h[3]); w.z = cvt_pk_bf16(h[4], h[5]); w.w = cvt_pk_bf16(h[6], h[7]);
                    *(u32x4*)rowp = w; } }
    }
};
struct EpiYb {
    static constexpr bool PERM = true;
    bf16_t* YB; const int* lists; const float* tok_gate;
    __device__ __forceinline__ void operator()(const f32x4 (&acc)[2][2][4][2], const Unit& u, int wr, int wc, int fr, int fq) const {
        const int col0 = u.pn * BM + wc * 32 + 8 * fq;
#pragma unroll
        for (int ai = 0; ai < 2; ++ai)
#pragma unroll
            for (int m = 0; m < 4; ++m) { const int r = ai * HALF + wr * 64 + m * 16 + fr;
                if (r < u.rows) { const float g = tok_gate[lists[(size_t)u.e * LIST_CAP + u.mt * 256 + r]];
                    bf16_t* rowp = YB + (size_t)(u.slot0 + r) * 1024 + col0;
#pragma unroll
                    for (int bj = 0; bj < 2; ++bj) { const f32x4 v0 = acc[ai][bj][m][0] * g, v1 = acc[ai][bj][m][1] * g;
                        u32x4 w; w.x = cvt_pk_bf16(v0[0], v0[1]); w.y = cvt_pk_bf16(v0[2], v0[3]); w.z = cvt_pk_bf16(v1[0], v1[1]); w.w = cvt_pk_bf16(v1[2], v1[3]);
                        *(u32x4*)(rowp + bj * HALF) = w; } } }
    }
};
}

template <int OFF> __device__ __forceinline__ unsigned long long karg_u64() { unsigned long long v;
    asm volatile("s_load_dwordx2 %0, %1, %2\n\ts_waitcnt lgkmcnt(0)" : "=s"(v) : "s"(__builtin_amdgcn_kernarg_segment_ptr()), "i"(OFF)); return v; }
#define KARG_IN(k) ((const float*)karg_u64<8 * (k)>())
#define KARG_OUT() ((float*)karg_u64<184>())
struct Args { const float* in[23]; float* out; unsigned char* ws; int ph_lo, ph_hi, mode, li; };
struct Frame { LAS unsigned char* lds; int wave, G, vcu; unsigned char* ws; unsigned* ctl; };
#define F_LANE lane_id()
#define F_TID (F.wave * 64 + lane_id())
constexpr int NPH = 12;

__device__ __forceinline__ void transpose_item(const float* W, int ldw, int c0, int k0, bf16_t* WT, int K, int row0, LAS float* scr, int lane) {
#pragma unroll 8
    for (int i = 0; i < 32; ++i) { const int kk = 2 * i + (lane >> 5); scr[kk * 33 + (lane & 31)] = W[(size_t)(k0 + kk) * ldw + c0 + (lane & 31)]; }
    asm volatile("s_waitcnt lgkmcnt(0)" ::: "memory");
    const int c = lane & 7;
#pragma unroll
    for (int j = 0; j < 4; ++j) { const int n = (lane >> 3) + 8 * j; const LAS float* s = scr + (8 * c) * 33 + n;
        u32x4 o; o.x = cvt_pk_bf16(s[0 * 33], s[1 * 33]); o.y = cvt_pk_bf16(s[2 * 33], s[3 * 33]); o.z = cvt_pk_bf16(s[4 * 33], s[5 * 33]); o.w = cvt_pk_bf16(s[6 * 33], s[7 * 33]);
        *(u32x4*)(WT + (size_t)(row0 + n) * K + k0 + 8 * c) = o; }
    asm volatile("s_waitcnt lgkmcnt(0)" ::: "memory");
}

__device__ __forceinline__ void gu_item(const float* Wg, const float* Wu, bf16_t* WT, int item, LAS float* scr, int lane) {
    const int kb = item >> 4, nb = item & 15, row0 = nb * 32, pn = row0 >> 8, half = (row0 >> 7) & 1, r0 = row0 & 127;
    transpose_item(half ? Wu : Wg, 256, pn * 128 + r0, kb * 64, WT, 1024, row0, scr, lane);
}

__device__ __forceinline__ void phase_prep(const Frame& F, const Args& a) {
    float wdt[16][8];
    { const float* w_in0 = KARG_IN(1); const int tid = F_TID;
      __syncthreads();
#pragma unroll
      for (int i = 0; i < 2; ++i) { const int k = tid + 512 * i; const float* src = w_in0 + (size_t)k * NIN + 1536;
          *(LAS f32x4*)(F.lds + k * 32) = *(const f32x4*)src; *(LAS f32x4*)(F.lds + k * 32 + 16) = *(const f32x4*)(src + 4); }
      __syncthreads();
#pragma unroll
      for (int j = 0; j < 16; ++j) { const int k = (j < 8 ? 8 * F_LANE + j : 512 + 8 * F_LANE + (j - 8));
          const f32x4 lo = *(const LAS f32x4*)(F.lds + k * 32), hi = *(const LAS f32x4*)(F.lds + k * 32 + 16);
          wdt[j][0] = lo[0]; wdt[j][1] = lo[1]; wdt[j][2] = lo[2]; wdt[j][3] = lo[3]; wdt[j][4] = hi[0]; wdt[j][5] = hi[1]; wdt[j][6] = hi[2]; wdt[j][7] = hi[3]; }
      __syncthreads(); }
    LAS float* scr = (LAS float*)(F.lds + F.wave * 16384);
    const int gw = F.vcu * 8 + F.wave, NGW = F.G * 8;
    unsigned char* ws = F.ws;
    bf16_t* Win_t = (bf16_t*)(ws + WS_WIN_T); bf16_t* Wout_t = (bf16_t*)(ws + WS_WOUT_T); bf16_t* W3_t = (bf16_t*)(ws + WS_W3_T); bf16_t* Wds_t = (bf16_t*)(ws + WS_WDS_T);
    bf16_t* Wgu_t = (bf16_t*)(ws + WS_WGU_T); bf16_t* Wd_t = (bf16_t*)(ws + WS_WD_T);
    const float* w_in = KARG_IN(1); const float* w_out = KARG_IN(10); const float* w_router = KARG_IN(13);
    const float* wge = KARG_IN(15); const float* wue = KARG_IN(16); const float* wde = KARG_IN(17);
    const float* wgs = KARG_IN(18); const float* wus = KARG_IN(19); const float* wds = KARG_IN(20);
    constexpr int I_IN = 16 * (PW / 32), I_OUT = 16 * 32, I_R = 16 * 8, I_S = 16 * 16, I_DS = 4 * 32, I_EGU = 16 * 16, I_ED = 4 * 32;
#if defined(MK_OLD_EXPERTS)
    constexpr int NITEMS = I_IN + I_OUT + I_R + I_S + I_DS + NEXP * (I_EGU + I_ED);
#else
    constexpr int NITEMS = I_IN + I_OUT + I_R + I_S + I_DS;
#endif
    for (int it = gw; it < NITEMS; it += NGW) {
        int r = it;
        if (r < I_IN) { const int kb = r / (PW / 32), nb = r % (PW / 32), row0 = nb * 32; const int c0 = row0 < 1536 ? row0 : row0 + 8;
            transpose_item(w_in, NIN, c0, kb * 64, Win_t, 1024, row0, scr, F_LANE); continue; } r -= I_IN;
        if (r < I_OUT) { transpose_item(w_out, 1024, (r & 31) * 32, (r >> 5) * 64, Wout_t, 1024, (r & 31) * 32, scr, F_LANE); continue; } r -= I_OUT;
        if (r < I_R) { transpose_item(w_router, 256, (r & 7) * 32, (r >> 3) * 64, W3_t, 1024, (r & 7) * 32, scr, F_LANE); continue; } r -= I_R;
        if (r < I_S) { gu_item(wgs, wus, W3_t + (size_t)256 * 1024, r, scr, F_LANE); continue; } r -= I_S;
        if (r < I_DS) { transpose_item(wds, 1024, (r & 31) * 32, (r >> 5) * 64, Wds_t, 256, (r & 31) * 32, scr, F_LANE); continue; } r -= I_DS;
        const int e = r / (I_EGU + I_ED), q = r % (I_EGU + I_ED);
        if (q < I_EGU) gu_item(wge + (size_t)e * 1024 * 256, wue + (size_t)e * 1024 * 256, Wgu_t + (size_t)e * 512 * 1024, q, scr, F_LANE);
        else { const int qq = q - I_EGU; transpose_item(wde + (size_t)e * 256 * 1024, 1024, (qq & 31) * 32, (qq >> 5) * 64, Wd_t + (size_t)e * 1024 * 256, 256, (qq & 31) * 32, scr, F_LANE); }
    }
    const float* x = KARG_IN(0); bf16_t* xb = (bf16_t*)(ws + WS_XB); float* dtraw = (float*)(ws + WS_DTRAW);
    f32x4 n0, n1, n2, n3;
    { const float* xr = x + (size_t)(gw < T_TOK ? gw : 0) * DM; n0 = *(const f32x4*)(xr + 8 * F_LANE); n1 = *(const f32x4*)(xr + 8 * F_LANE + 4); n2 = *(const f32x4*)(xr + 512 + 8 * F_LANE); n3 = *(const f32x4*)(xr + 512 + 8 * F_LANE + 4); }
    for (int t = gw; t < T_TOK; t += NGW) {
        const f32x4 a0 = n0, a1 = n1, b0 = n2, b1 = n3;
        { const int tn = t + NGW < T_TOK ? t + NGW : t; const float* xr = x + (size_t)tn * DM;
          n0 = *(const f32x4*)(xr + 8 * F_LANE); n1 = *(const f32x4*)(xr + 8 * F_LANE + 4); n2 = *(const f32x4*)(xr + 512 + 8 * F_LANE); n3 = *(const f32x4*)(xr + 512 + 8 * F_LANE + 4); }
        u32x4 w0; w0.x = cvt_pk_bf16(a0[0], a0[1]); w0.y = cvt_pk_bf16(a0[2], a0[3]); w0.z = cvt_pk_bf16(a1[0], a1[1]); w0.w = cvt_pk_bf16(a1[2], a1[3]);
        u32x4 w1; w1.x = cvt_pk_bf16(b0[0], b0[1]); w1.y = cvt_pk_bf16(b0[2], b0[3]); w1.z = cvt_pk_bf16(b1[0], b1[1]); w1.w = cvt_pk_bf16(b1[2], b1[3]);
        *(u32x4*)(xb + (size_t)t * DM + 8 * F_LANE) = w0; *(u32x4*)(xb + (size_t)t * DM + 512 + 8 * F_LANE) = w1;
        const float xv[16] = {a0[0], a0[1], a0[2], a0[3], a1[0], a1[1], a1[2], a1[3], b0[0], b0[1], b0[2], b0[3], b1[0], b1[1], b1[2], b1[3]};
        float d[8];
#pragma unroll
        for (int h = 0; h < 8; ++h) { float sm = 0.f;
#pragma unroll
            for (int j = 0; j < 16; ++j) sm = fmaf(xv[j], wdt[j][h], sm);
            d[h] = wave_sum(sm); }
        if (F_LANE == 0) { *(f32x4*)(dtraw + t * 8) = (f32x4){d[0], d[1], d[2], d[3]}; *(f32x4*)(dtraw + t * 8 + 4) = (f32x4){d[4], d[5], d[6], d[7]}; }
    }
}

__device__ __forceinline__ void phase_ln1(const Frame& F, const Args& a) {
    const int gw = F.vcu * 8 + F.wave, NGW = F.G * 8;
    float* h1 = (float*)(F.ws + WS_H1); bf16_t* h1b = (bf16_t*)(F.ws + WS_H1B);
    const float* g = KARG_IN(11); const float* b = KARG_IN(12);
    const int c0 = 8 * F_LANE;
    f32x4 gv[4], bv[4];
    gv[0] = *(const f32x4*)(g + c0); gv[1] = *(const f32x4*)(g + c0 + 4); gv[2] = *(const f32x4*)(g + 512 + c0); gv[3] = *(const f32x4*)(g + 512 + c0 + 4);
    bv[0] = *(const f32x4*)(b + c0); bv[1] = *(const f32x4*)(b + c0 + 4); bv[2] = *(const f32x4*)(b + 512 + c0); bv[3] = *(const f32x4*)(b + 512 + c0 + 4);
    for (int t = gw; t < T_TOK; t += NGW) {
        float* r = h1 + (size_t)t * DM;
        f32x4 v[4]; v[0] = *(const f32x4*)(r + c0); v[1] = *(const f32x4*)(r + c0 + 4); v[2] = *(const f32x4*)(r + 512 + c0); v[3] = *(const f32x4*)(r + 512 + c0 + 4);
        float s = 0.f;
#pragma unroll
        for (int j = 0; j < 4; ++j) s += (v[j][0] + v[j][1]) + (v[j][2] + v[j][3]);
        const float mu = wave_sum(s) * (1.0f / 1024.0f);
        float q = 0.f;
#pragma unroll
        for (int j = 0; j < 4; ++j) { v[j] = v[j] - mu; q += (v[j][0] * v[j][0] + v[j][1] * v[j][1]) + (v[j][2] * v[j][2] + v[j][3] * v[j][3]); }
        const float rs = rsqrtf(wave_sum(q) * (1.0f / 1024.0f) + LN_EPS_F);
#pragma unroll
        for (int j = 0; j < 4; ++j) v[j] = v[j] * rs * gv[j] + bv[j];
        u32x4 w0; w0.x = cvt_pk_bf16(v[0][0], v[0][1]); w0.y = cvt_pk_bf16(v[0][2], v[0][3]); w0.z = cvt_pk_bf16(v[1][0], v[1][1]); w0.w = cvt_pk_bf16(v[1][2], v[1][3]);
        u32x4 w1; w1.x = cvt_pk_bf16(v[2][0], v[2][1]); w1.y = cvt_pk_bf16(v[2][2], v[2][3]); w1.z = cvt_pk_bf16(v[3][0], v[3][1]); w1.w = cvt_pk_bf16(v[3][2], v[3][3]);
        *(u32x4*)(h1b + (size_t)t * DM + c0) = w0; *(u32x4*)(h1b + (size_t)t * DM + 512 + c0) = w1;
    }
}

__device__ __forceinline__ void phase_route(const Frame& F, const Args& a) {
    const int gw = F.vcu * 8 + F.wave, NGW = F.G * 8, lane = F_LANE;
    const float* logits = (const float*)(F.ws + WS_LOGITS); const float* rbias = KARG_IN(14);
    int* counts = (int*)(F.ctl + CW_COUNTS); int* tok_e = (int*)(F.ws + WS_TOKE); int* tok_pos = (int*)(F.ws + WS_TOKPOS); float* tok_gate = (float*)(F.ws + WS_TOKGATE);
    int* lists = (int*)(F.ws + WS_LISTS);
    const f32x4 rb = *(const f32x4*)(rbias + lane * 4);
    f32x4 lgn = *(const f32x4*)(logits + (size_t)(gw < T_TOK ? gw : 0) * 256 + lane * 4);
    int p_t = -1, p_e = 0, p_pos = 0;
    for (int t = gw; t < T_TOK; t += NGW) {
        const f32x4 lg = lgn;
        { const int tn = t + NGW < T_TOK ? t + NGW : t; lgn = *(const f32x4*)(logits + (size_t)tn * 256 + lane * 4); }
        float sc[4] = {sigmf(lg[0]), sigmf(lg[1]), sigmf(lg[2]), sigmf(lg[3])};
        float bs[4] = {sc[0] + rb[0], sc[1] + rb[1], sc[2] + rb[2], sc[3] + rb[3]};
        float m1 = fmaxf(bs[0], bs[1]), m2 = fminf(bs[0], bs[1]);
        { const float n1 = fmaxf(bs[2], bs[3]), n2 = fminf(bs[2], bs[3]);
          const float a1 = fmaxf(m1, n1), a2 = fmaxf(fminf(m1, n1), fmaxf(m2, n2)); m1 = a1; m2 = a2; }
        { const float n1 = dpp_f<0xB1>(m1), n2 = dpp_f<0xB1>(m2); const float a1 = fmaxf(m1, n1), a2 = fmaxf(fminf(m1, n1), fmaxf(m2, n2)); m1 = a1; m2 = a2; }
        { const float n1 = dpp_f<0x4E>(m1), n2 = dpp_f<0x4E>(m2); const float a1 = fmaxf(m1, n1), a2 = fmaxf(fminf(m1, n1), fmaxf(m2, n2)); m1 = a1; m2 = a2; }
        { const float n1 = dpp_f<0x141>(m1), n2 = dpp_f<0x141>(m2); const float a1 = fmaxf(m1, n1), a2 = fmaxf(fminf(m1, n1), fmaxf(m2, n2)); m1 = a1; m2 = a2; }
        const float gs = m1 + m2; const int mygrp = lane >> 3; int rank = 0;
#pragma unroll
        for (int gI = 0; gI < 8; ++gI) { const float og = rdlane_f(gs, gI * 8); rank += (og > gs || (og == gs && gI < mygrp)) ? 1 : 0; }
        const bool sel = rank < 4;
        float cand[4];
#pragma unroll
        for (int j = 0; j < 4; ++j) cand[j] = sel ? bs[j] : -INFINITY;
        int my_e = -1; float my_s = 0.f; float gsum = 0.f;
#pragma unroll
        for (int k = 0; k < 8; ++k) {
            const float mx = wave_max(fmaxf(fmaxf(cand[0], cand[1]), fmaxf(cand[2], cand[3])));
            int be = 1 << 20;
#pragma unroll
            for (int j = 0; j < 4; ++j) { const unsigned long long bm = __ballot(cand[j] == mx); const int ej = bm ? (__ffsll((long long)bm) - 1) * 4 + j : (1 << 20); be = ej < be ? ej : be; }
            be = __builtin_amdgcn_readfirstlane(be);
            const int wj = be & 3, bl = be >> 2;
            const float mysc = wj == 0 ? sc[0] : wj == 1 ? sc[1] : wj == 2 ? sc[2] : sc[3];
            const float wsc = rdlane_f(mysc, bl);
#pragma unroll
            for (int j = 0; j < 4; ++j) cand[j] = (lane == bl && j == wj) ? -INFINITY : cand[j];
            gsum += wsc;
            if (lane == k) { my_e = be; my_s = wsc; }
        }
        if (lane < 8) {
            if (p_t >= 0) { tok_pos[p_t * 8 + lane] = p_pos; lists[(size_t)p_e * LIST_CAP + p_pos] = p_t * 8 + lane; }
            const float gate = my_s / gsum * 2.5f;
            p_pos = atomicAdd(&counts[my_e * CNT_STRIDE], 1); p_e = my_e; p_t = t;
            tok_e[t * 8 + lane] = my_e; tok_gate[t * 8 + lane] = gate;
        }
    }
    if (lane < 8 && p_t >= 0) { tok_pos[p_t * 8 + lane] = p_pos; lists[(size_t)p_e * LIST_CAP + p_pos] = p_t * 8 + lane; }
}

__device__ __forceinline__ void build_tables(const Frame& F) {
    const int* counts = (const int*)(F.ctl + CW_COUNTS);
    LAS int* pref = (LAS int*)(F.lds + LDS_PREF); LAS int* offs = (LAS int*)(F.lds + LDS_OFFS); LAS int* cnt = (LAS int*)(F.lds + LDS_CNT);
    LAS int* wt = (LAS int*)(F.lds);
    const int tid = F_TID, lane = tid & 63;
    __syncthreads();
    int n = 0, nt = 0, in_ = 0, it_ = 0;
    if (F.wave < 4) {
        n = __hip_atomic_load(&counts[tid * CNT_STRIDE], __ATOMIC_RELAXED, __HIP_MEMORY_SCOPE_AGENT); nt = (n + 255) >> 8; in_ = n; it_ = nt;
#pragma unroll
        for (int o = 1; o < 64; o <<= 1) { const int a = __shfl_up(in_, o), b = __shfl_up(it_, o); if (lane >= o) { in_ += a; it_ += b; } }
        if (lane == 63) { wt[F.wave] = in_; wt[4 + F.wave] = it_; }
    }
    __syncthreads();
    if (F.wave < 4) {
        for (int w = 0; w < F.wave; ++w) { in_ += wt[w]; it_ += wt[4 + w]; }
        cnt[tid] = n; offs[tid] = in_ - n; pref[tid] = it_ - nt;
        if (tid == NEXP - 1) { offs[NEXP] = in_; pref[NEXP] = it_; }
    }
    __syncthreads();
}

__device__ __forceinline__ void phase_final(const Frame& F, const Args& a) {
    const int gw = F.vcu * 8 + F.wave, NGW = F.G * 8;
    const float* h1 = (const float*)(F.ws + WS_H1); const bf16_t* ys = (const bf16_t*)(F.ws + WS_YS); const bf16_t* yb = (const bf16_t*)(F.ws + WS_YB);
    const int* tok_e = (const int*)(F.ws + WS_TOKE); const int* tok_pos = (const int*)(F.ws + WS_TOKPOS);
    const LAS int* offs = (const LAS int*)(F.lds + LDS_OFFS);
    const float* g = KARG_IN(21); const float* b = KARG_IN(22); float* out = KARG_OUT();
    const int c0 = 8 * F_LANE;
    f32x4 gv[4], bv[4];
    gv[0] = *(const f32x4*)(g + c0); gv[1] = *(const f32x4*)(g + c0 + 4); gv[2] = *(const f32x4*)(g + 512 + c0); gv[3] = *(const f32x4*)(g + 512 + c0 + 4);
    bv[0] = *(const f32x4*)(b + c0); bv[1] = *(const f32x4*)(b + c0 + 4); bv[2] = *(const f32x4*)(b + 512 + c0); bv[3] = *(const f32x4*)(b + 512 + c0 + 4);
    const int lane8 = F_LANE;
    const bf16_t* h1b = (const bf16_t*)(F.ws + WS_H1B); const unsigned char* yb8 = (const unsigned char*)(F.ws + WS_YB);
    int ekn = 0, pkn = 0;
    if (gw < T_TOK && lane8 < 8) { ekn = tok_e[gw * 8 + lane8]; pkn = tok_pos[gw * 8 + lane8]; }
    for (int t = gw; t < T_TOK; t += NGW) {
        const int myrow = lane8 < 8 ? offs[ekn] + pkn : 0;
        const u32x4 r0 = *(const u32x4*)(h1b + (size_t)t * DM + c0), r1 = *(const u32x4*)(h1b + (size_t)t * DM + 512 + c0);
        const u32x4 s0 = *(const u32x4*)(ys + (size_t)t * DM + c0), s1 = *(const u32x4*)(ys + (size_t)t * DM + 512 + c0);
        u32x2 W[8][2];
#pragma unroll
        for (int k = 0; k < 8; ++k) { const unsigned char* src = yb8 + (size_t)__shfl(myrow, k) * 1024; W[k][0] = *(const u32x2*)(src + c0); W[k][1] = *(const u32x2*)(src + 512 + c0); }
        { const int tn = t + NGW; if (tn < T_TOK && lane8 < 8) { ekn = tok_e[tn * 8 + lane8]; pkn = tok_pos[tn * 8 + lane8]; } }
        f32x4 v[4], y[4];
        v[0] = (f32x4){bflo(r0.x), bfhi(r0.x), bflo(r0.y), bfhi(r0.y)}; v[1] = (f32x4){bflo(r0.z), bfhi(r0.z), bflo(r0.w), bfhi(r0.w)};
        v[2] = (f32x4){bflo(r1.x), bfhi(r1.x), bflo(r1.y), bfhi(r1.y)}; v[3] = (f32x4){bflo(r1.z), bfhi(r1.z), bflo(r1.w), bfhi(r1.w)};
#pragma unroll
        for (int j = 0; j < 4; ++j) { v[j] = v[j] * ALPHA_F; y[j] = (f32x4){0.f, 0.f, 0.f, 0.f}; }
        v[0] = v[0] + (f32x4){bflo(s0.x), bfhi(s0.x), bflo(s0.y), bfhi(s0.y)}; v[1] = v[1] + (f32x4){bflo(s0.z), bfhi(s0.z), bflo(s0.w), bfhi(s0.w)};
        v[2] = v[2] + (f32x4){bflo(s1.x), bfhi(s1.x), bflo(s1.y), bfhi(s1.y)}; v[3] = v[3] + (f32x4){bflo(s1.z), bfhi(s1.z), bflo(s1.w), bfhi(s1.w)};
#pragma unroll
        for (int k = 0; k < 8; ++k) { y[0] = y[0] + un4_fp8(W[k][0].x); y[1] = y[1] + un4_fp8(W[k][0].y); y[2] = y[2] + un4_fp8(W[k][1].x); y[3] = y[3] + un4_fp8(W[k][1].y); }
#pragma unroll
        for (int j = 0; j < 4; ++j) v[j] = v[j] + y[j] * (1.0f / YB_SCALE);
        float s = 0.f;
#pragma unroll
        for (int j = 0; j < 4; ++j) s += (v[j][0] + v[j][1]) + (v[j][2] + v[j][3]);
        const float mu = wave_sum(s) * (1.0f / 1024.0f);
        float q = 0.f;
#pragma unroll
        for (int j = 0; j < 4; ++j) { v[j] = v[j] - mu; q += (v[j][0] * v[j][0] + v[j][1] * v[j][1]) + (v[j][2] * v[j][2] + v[j][3] * v[j][3]); }
        const float rs = rsqrtf(wave_sum(q) * (1.0f / 1024.0f) + LN_EPS_F);
        float* o = out + (size_t)t * DM;
#pragma unroll
        for (int j = 0; j < 4; ++j) v[j] = v[j] * rs * gv[j] + bv[j];
        *(f32x4*)(o + c0) = v[0]; *(f32x4*)(o + c0 + 4) = v[1]; *(f32x4*)(o + 512 + c0) = v[2]; *(f32x4*)(o + 512 + c0 + 4) = v[3];
    }
}


namespace xk {
constexpr int B_IMG = 16384, A_SLOT = 16384, L_B0 = 0, L_A0 = 4 * B_IMG, L_GATE = 8 * 16384;
typedef __amdgpu_buffer_rsrc_t rsrc_t;
__device__ __forceinline__ rsrc_t make_rsrc(const void* p) { return __builtin_amdgcn_make_buffer_rsrc((void*)p, 0, 0x7fffffff, 0x00020000); }
__device__ __forceinline__ u32x4 make_srd(const void* p) { const unsigned long long v = (unsigned long long)p; u32x4 d;
    d.x = (unsigned)__builtin_amdgcn_readfirstlane((int)(unsigned)v); d.y = (unsigned)__builtin_amdgcn_readfirstlane((int)(unsigned)(v >> 32)) & 0xffffu; d.z = 0x7fffffffu; d.w = 0x00020000u; return d; }
__device__ __forceinline__ void dma16(const u32x4 srd, unsigned voff, int soff, unsigned lds_addr) {
    asm volatile("s_mov_b32 m0, %0\n\ts_nop 0\n\tbuffer_load_dwordx4 %1, %2, %3 offen lds" :: "s"(lds_addr), "v"(voff), "s"(srd), "s"(soff) : "m0", "memory");
}
__device__ __forceinline__ void a_piece_rc(int b, int& R, int& C) { const int st = b >> 10, sb = b & 1023, ob = sb ^ (((sb >> 9) & 1) << 5); R = st * 16 + (ob >> 6); C = (ob & 63) >> 1; }
struct PassDesc { u32x4 ra; unsigned aoff[2]; rsrc_t rb0, rb1; int bcol, ncol; unsigned boff; int nh; bool preloaded, chain; };
typedef f32x4 Acc[2][4][2][2];

template <bool GU> __device__ __forceinline__ void kloop(LAS unsigned char* lds, const PassDesc& P, const int wid, const int lane, const int bir, Acc& acc, f32x4 (&Br)[4][4]) {
    const int wr = wid >> 2, wc = wid & 3, fr = lane & 15, fq = lane >> 4, hl = lane >> 5;
    const int KB = GU ? 32 * 256 * 4 : 32 * 1024 * 4;
#define XK_DMAA(hh, slot) do { _Pragma("unroll") for (int _i = 0; _i < 2; ++_i) dma16(P.ra, P.aoff[_i], (hh) * 64, (unsigned)(size_t)(lds + L_A0 + (slot) * A_SLOT + _i * 8192 + wid * 1024)); } while (0)
#define XK_LOADB(col, hh, st) do { _Pragma("unroll") for (int _i = 0; _i < 4; ++_i) { \
            const u32x4 _v = GU ? __builtin_amdgcn_raw_buffer_load_b128((_i >> 1) ? P.rb1 : P.rb0, P.boff, (col) + (hh) * KB + (_i & 1) * (2 * 256 * 4), 0) \
                                : __builtin_amdgcn_raw_buffer_load_b128(P.rb0, P.boff, (col) + (hh) * KB + _i * (1024 * 4), 0); \
            Br[st][_i] = __builtin_bit_cast(f32x4, _v); } } while (0)
    const unsigned swg = (unsigned)(((wid >> 1) & 1) << 4);
    unsigned bw0 = (unsigned)(size_t)(lds + L_B0) + (GU ? (4 * wid + hl) * 512 + (bir ^ (hl << 7) ^ swg) : 4 * wid * 512 + (bir ^ swg));
    const int q = (lane & 15) >> 2, p = lane & 3;
    unsigned br0 = (unsigned)(size_t)(lds + L_B0) + (8 * fq + q) * 512 + ((128 * wc + 32 * p) ^ ((q & 1) << 7) ^ (((q >> 1) & 1) << 3) ^ ((fq & 1) << 4));
    const LAS unsigned char* arp = lds + L_A0 + (wr * 4) * 1024 + ((fr * 64 + 16 * fq) ^ ((fr >> 3) << 5));
#define XK_WRITEB(st, img) do { _Pragma("unroll") for (int _i = 0; _i < 4; ++_i) { u32x2 _w; _w.x = cvt_pk_bf16(Br[st][_i][0], Br[st][_i][1]); _w.y = cvt_pk_bf16(Br[st][_i][2], Br[st][_i][3]); \
        if (GU) *(LAS u32x2*)(size_t)((bw0 ^ (unsigned)(((_i >> 1) << 4) | ((_i & 1) << 3))) + (img) * B_IMG + 2 * (_i & 1) * 512) = _w; \
        else *(LAS u32x2*)(size_t)((bw0 ^ (unsigned)(((_i & 1) << 7) | (((_i >> 1) & 1) << 3))) + (img) * B_IMG + _i * 512) = _w; } } while (0)
#define XK_FRAGS(slot, img) do { \
        _Pragma("unroll") for (int gI = 0; gI < 2; ++gI) _Pragma("unroll") for (int nn = 0; nn < 2; ++nn) { \
            const LAS unsigned char* _a = (const LAS unsigned char*)(size_t)((br0 ^ (unsigned)(16 * gI + 8 * nn)) + (img) * B_IMG); \
            const s16x4 _lo = __builtin_amdgcn_ds_read_tr16_b64_v4i16((LAS s16x4*)_a), _hi = __builtin_amdgcn_ds_read_tr16_b64_v4i16((LAS s16x4*)(_a + 2048)); \
            wf[gI][nn] = (bf16x8){_lo[0], _lo[1], _lo[2], _lo[3], _hi[0], _hi[1], _hi[2], _hi[3]}; } \
        _Pragma("unroll") for (int ai = 0; ai < 2; ++ai) _Pragma("unroll") for (int m = 0; m < 4; ++m) xf[ai][m] = *(const LAS bf16x8*)(arp + (slot) * A_SLOT + (8 * ai + m) * 1024); } while (0)
#define XK_MMA() do { __builtin_amdgcn_s_setprio(1); \
        _Pragma("unroll") for (int ai = 0; ai < 2; ++ai) _Pragma("unroll") for (int m = 0; m < 4; ++m) _Pragma("unroll") for (int gI = 0; gI < 2; ++gI) _Pragma("unroll") for (int nn = 0; nn < 2; ++nn) \
            acc[ai][m][gI][nn] = __builtin_amdgcn_mfma_f32_16x16x32_bf16(wf[gI][nn], xf[ai][m], acc[ai][m][gI][nn], 0, 0, 0); \
        __builtin_amdgcn_s_setprio(0); } while (0)
    bf16x8 wf[2][2], xf[2][4];
    const int nh = P.nh;
    if (!P.preloaded) {
        XK_LOADB(P.bcol, 0, 0); XK_LOADB(P.bcol, 1, 1); XK_LOADB(P.bcol, 2, 2); XK_DMAA(0, 0); XK_DMAA(1, 1);
        XK_WRITEB(0, 0);
        asm volatile("s_waitcnt vmcnt(0)" ::: "memory");
        __syncthreads();
    }
    const int tcol = P.chain ? P.ncol : P.bcol;
    if (wid >= 4) __builtin_amdgcn_s_barrier();
#define XK_ITER(j) do { const int _h = hb + (j); asm volatile("" : "+v"(bw0), "+v"(br0));     \
        { const bool _in2 = _h + 2 < nh; XK_DMAA(_in2 ? _h + 2 : _h + 2 - nh, ((j) + 2) & 3); \
          const bool _in3 = _h + 3 < nh; XK_LOADB(_in3 ? P.bcol : tcol, _in3 ? _h + 3 : _h + 3 - nh, ((j) + 3) & 3); } \
        XK_WRITEB(((j) + 1) & 3, ((j) + 1) & 3); \
        XK_FRAGS((j), (j));        \
        asm volatile("s_waitcnt vmcnt(10)" ::: "memory");     \
        asm volatile("s_waitcnt lgkmcnt(0)" ::: "memory"); __builtin_amdgcn_sched_barrier(0); __builtin_amdgcn_s_barrier(); __builtin_amdgcn_sched_barrier(0); \
        XK_MMA(); \
        __builtin_amdgcn_sched_barrier(0); __builtin_amdgcn_s_barrier(); __builtin_amdgcn_sched_barrier(0); } while (0)
    for (int hb = 0; hb < nh; hb += 4) { XK_ITER(0); XK_ITER(1); XK_ITER(2); XK_ITER(3); }
    if (wid < 4) __builtin_amdgcn_s_barrier();
#undef XK_ITER
#undef XK_DMAA
#undef XK_LOADB
#undef XK_WRITEB
#undef XK_FRAGS
#undef XK_MMA
}
}

__device__ __forceinline__ void phase_experts(const Frame& F, const Args& a, const int mode) {
    build_tables(F);
    const int wid = F.wave, wr = wid >> 2, wc = wid & 3;
    const LAS int* pref = (const LAS int*)(F.lds + LDS_PREF);
    const int U = __builtin_amdgcn_readfirstlane(pref[NEXP]);
    const int* lists = (const int*)(F.ws + WS_LISTS); const float* tok_gate = (const float*)(F.ws + WS_TOKGATE);
    const char* h1b = (const char*)(F.ws + WS_H1B); bf16_t* H = (bf16_t*)(F.ws + WS_H); bf16_t* YB = (bf16_t*)(F.ws + WS_YB);
    f32x4 Br[4][4];
    for (int ui = 0;; ++ui) {
        int L = ui * F.G + blockIdx.x; if (L >= U) break;
        { const int qq = U / 8, rr = U % 8, xcd = L % 8, off = L / 8; L = (xcd < rr ? xcd * (qq + 1) : rr * (qq + 1) + (xcd - rr) * qq) + off; }
        int lo = 0, hi = NEXP;
        while (hi - lo > 1) { const int mid = (lo + hi) >> 1; const int pv = __builtin_amdgcn_readfirstlane(pref[mid]); if (pv <= L) lo = mid; else hi = mid; }
        const int e = lo, mt = L - __builtin_amdgcn_readfirstlane(pref[e]);
        const int n = __builtin_amdgcn_readfirstlane(((const LAS int*)(F.lds + LDS_CNT))[e]);
        const int rows = (n - mt * 256) < 256 ? (n - mt * 256) : 256;
        const int slot0 = __builtin_amdgcn_readfirstlane(((const LAS int*)(F.lds + LDS_OFFS))[e]) + mt * 256;
        const int* lst = lists + (size_t)e * LIST_CAP + mt * 256;
        const int ew = (mode & 1) ? 0 : e;
        const float* Wg = KARG_IN(15) + (size_t)ew * 1024 * 256; const float* Wu = KARG_IN(16) + (size_t)ew * 1024 * 256; const float* Wd = KARG_IN(17) + (size_t)ew * 256 * 1024;
        {
            xk::PassDesc P; P.ra = xk::make_srd(h1b);
            { const int lane = lane_id(), tid = wid * 64 + lane;
#pragma unroll
              for (int i = 0; i < 2; ++i) { int R, C; xk::a_piece_rc(tid * 16 + i * 8192, R, C); int tok = 0; if (R < rows) tok = lst[R] >> 3; if (mode & 2) tok = (slot0 + R) & 16383; P.aoff[i] = (unsigned)(tok * 1024 + C) * 2u; }
              P.boff = (unsigned)((4 * wid + (lane >> 5)) * 256 + 4 * (lane & 31)) * 4u; }
            P.nh = 32; P.rb0 = xk::make_rsrc(Wg); P.rb1 = xk::make_rsrc(Wu);
#pragma unroll 1
            for (int pn = 0; pn < 2; ++pn) {
                P.bcol = pn * 128 * 4; P.ncol = 128 * 4;
                P.preloaded = pn == 1; P.chain = pn == 0;
                xk::Acc acc;
#pragma unroll
                for (int ai = 0; ai < 2; ++ai)
#pragma unroll
                    for (int m = 0; m < 4; ++m)
#pragma unroll
                        for (int gI = 0; gI < 2; ++gI)
#pragma unroll
                            for (int nn = 0; nn < 2; ++nn) acc[ai][m][gI][nn] = (f32x4){0.f, 0.f, 0.f, 0.f};
                { const int lane = lane_id(); xk::kloop<true>(F.lds, P, wid, lane, 128 * ((lane & 31) >> 3) + 32 * (((lane & 31) >> 1) & 3) + 8 * (lane & 1), acc, Br); }
                const int lane = lane_id(), fr = lane & 15, fq = lane >> 4;
                const xk::rsrc_t rH = xk::make_rsrc(H + (size_t)slot0 * 256);
#pragma unroll
                for (int ai = 0; ai < 2; ++ai)
#pragma unroll
                    for (int m = 0; m < 4; ++m) { const int r = ai * 128 + wr * 64 + m * 16 + fr;
                        if (r < rows && !(mode & 4) && !(mode & 16)) { float h[8];
#pragma unroll
                            for (int nn = 0; nn < 2; ++nn)
#pragma unroll
                                for (int j = 0; j < 4; ++j) h[nn * 4 + j] = siluf(acc[ai][m][0][nn][j]) * acc[ai][m][1][nn][j];
                            u32x4 w; w.x = cvt_pk_bf16(h[0], h[1]); w.y = cvt_pk_bf16(h[2], h[3]); w.z = cvt_pk_bf16(h[4], h[5]); w.w = cvt_pk_bf16(h[6], h[7]);
                            __builtin_amdgcn_raw_buffer_store_b128(w, rH, (unsigned)(r * 256 + pn * 128 + wc * 32 + 8 * fq) * 2u, 0, 0); } }
            }
        }
        { const int t = wid * 64 + lane_id();
          if (t < 256) ((LAS float*)(F.lds + xk::L_GATE))[t] = t < rows ? tok_gate[lst[t]] : 0.f; }
        asm volatile("s_waitcnt vmcnt(0)" ::: "memory");
        __syncthreads();
        {
            xk::PassDesc P; P.ra = xk::make_srd(H + (size_t)slot0 * 256);
            { const int lane = lane_id(), tid = wid * 64 + lane;
#pragma unroll
              for (int i = 0; i < 2; ++i) { int R, C; xk::a_piece_rc(tid * 16 + i * 8192, R, C); P.aoff[i] = (unsigned)(R * 256 + C) * 2u; }
              P.boff = (unsigned)(4 * wid * 1024 + 4 * lane) * 4u; }
            P.nh = 8; P.rb0 = xk::make_rsrc(Wd); P.rb1 = P.rb0;
#pragma unroll 1
            for (int pn = 0; pn < 4; ++pn) {
                P.bcol = pn * 256 * 4; P.ncol = (pn + 1) * 256 * 4;
                P.preloaded = pn > 0; P.chain = pn < 3;
                xk::Acc acc;
#pragma unroll
                for (int ai = 0; ai < 2; ++ai)
#pragma unroll
                    for (int m = 0; m < 4; ++m)
#pragma unroll
                        for (int gI = 0; gI < 2; ++gI)
#pragma unroll
                            for (int nn = 0; nn < 2; ++nn) acc[ai][m][gI][nn] = (f32x4){0.f, 0.f, 0.f, 0.f};
                { const int lane = lane_id(); xk::kloop<false>(F.lds, P, wid, lane, 8 * lane, acc, Br); }
                const int lane = lane_id(), fr = lane & 15, fq = lane >> 4;
                const xk::rsrc_t rY = xk::make_rsrc((const unsigned char*)YB + (size_t)slot0 * 1024);
#pragma unroll
                for (int ai = 0; ai < 2; ++ai)
#pragma unroll
                    for (int m = 0; m < 4; ++m) { const int r = ai * 128 + wr * 64 + m * 16 + fr;
                        if (r < rows && !(mode & 4) && !(mode & 8)) { const float g = ((const LAS float*)(F.lds + xk::L_GATE))[r] * YB_SCALE;
                            u32x4 w; w.x = pk4_fp8(acc[ai][m][0][0] * g); w.y = pk4_fp8(acc[ai][m][0][1] * g); w.z = pk4_fp8(acc[ai][m][1][0] * g); w.w = pk4_fp8(acc[ai][m][1][1] * g);
                            __builtin_amdgcn_raw_buffer_store_b128(w, rY, (unsigned)(r * 1024 + pn * 256 + 64 * wc + 16 * fq), 0, 0); } }
            }
        }
        __syncthreads();
    }
}

__device__ __forceinline__ float ldp(const bf16_t* p, size_t t, int c) { return bf2f(p[t * PW + c]); }
__device__ __forceinline__ void phase_m1(const Frame& F, const Args& a) {
  const bf16_t* p = (const bf16_t*)(F.ws + WS_P); const float* dtraw = (const float*)(F.ws + WS_DTRAW);
  const float* conv_w = KARG_IN(2); const float* conv_b = KARG_IN(3); const float* dt_bias = KARG_IN(4); const float* lb_logits = KARG_IN(8);
  float* xbc = (float*)(F.ws + WS_NXBC); float* fgk = (float*)(F.ws + WS_NFGK); float* qs = (float*)(F.ws + WS_NQS); float* dtb = (float*)(F.ws + WS_NDTB);
  const int tid = F_TID;
  for (int t = blockIdx.x; t < T_TOK; t += F.G) {
    for (int c = tid; c < 1024; c += 512) {
      float acc = conv_b[c];
#pragma unroll
      for (int j = 0; j < 4; ++j) { const int tt = t - 3 + j; if (tt >= 0) acc = fmaf(conv_w[j * 1024 + c], ldp(p, tt, PC_XBC + c), acc); }
      xbc[(size_t)t * 1024 + c] = siluf(acc);
    }
    { const int c = tid;
      const float l0 = lb_logits[c], l1 = lb_logits[512 + c];
      const float mx = fmaxf(l0, l1);
      const float e0 = expf(l0 - mx), e1 = expf(l1 - mx);
      const float lb = e0 / (e0 + e1);
      const float f = ldp(p, t, PC_F + c);
      fgk[(size_t)t * 512 + c] = lb + (1.0f - lb) * (1.0f / (1.0f + expf(-f)));
      const float q = ldp(p, t, PC_Q + c);
      qs[(size_t)t * 512 + c] = q / (1.0f + expf(-q)); }
    if (tid < 8) { const float v = dtraw[t * 8 + tid] + dt_bias[tid]; dtb[t * 8 + tid] = v > 20.f ? v : log1pf(expf(v)); }
  }
}
__device__ __forceinline__ void phase_m2(const Frame& F, const Args& a) {
  const int item = F.wave * F.G + blockIdx.x, lane = F_LANE;
  const float* xbc = (const float*)(F.ws + WS_NXBC); const float* dtb = (const float*)(F.ws + WS_NDTB);
  const float* fgk = (const float*)(F.ws + WS_NFGK); const float* qs = (const float*)(F.ws + WS_NQS); const bf16_t* p = (const bf16_t*)(F.ws + WS_P);
  float* y_ssd = (float*)(F.ws + WS_NYSSD); float* o_h = (float*)(F.ws + WS_NOH);
  if (item < 512) {
    const int h = item >> 6, pp = item & 63, g = h >> 2;
    const float aa = -expf(KARG_IN(5)[h]), D = KARG_IN(6)[h];
    float h0 = 0.f, h1 = 0.f;
    const float* xp = xbc + h * 64 + pp; const float* Bp = xbc + 512 + g * 128 + lane; const float* Cp = xbc + 768 + g * 128 + lane;
    for (int t0 = 0; t0 < T_TOK; t0 += 8) {
      float Bv0[8], Bv1[8], Cv0[8], Cv1[8], xv[8], dv[8];
#pragma unroll
      for (int i = 0; i < 8; ++i) { const size_t o = (size_t)(t0 + i) * 1024;
        Bv0[i] = Bp[o]; Bv1[i] = Bp[o + 64]; Cv0[i] = Cp[o]; Cv1[i] = Cp[o + 64]; xv[i] = xp[o]; dv[i] = dtb[(t0 + i) * 8 + h]; }
#pragma unroll
      for (int i = 0; i < 8; ++i) {
        const float dA = expf(dv[i] * aa), dx = dv[i] * xv[i];
        h0 = fmaf(dA, h0, dx * Bv0[i]); h1 = fmaf(dA, h1, dx * Bv1[i]);
        float part = wave_sum(Cv0[i] * h0 + Cv1[i] * h1);
        if (lane == 0) y_ssd[(size_t)(t0 + i) * 512 + h * 64 + pp] = part + D * xv[i];
      }
    }
  } else if (item < 1024) {
    const int it = item - 512, h = it >> 7, e = it & 127;
    float S0 = 0.f, S1 = 0.f;
    const float* fp = fgk + h * 128 + lane; const float* qp = qs + h * 128 + lane;
    for (int t0 = 0; t0 < T_TOK; t0 += 8) {
      float f0[8], f1[8], q0[8], q1[8], iv[8];
#pragma unroll
      for (int i = 0; i < 8; ++i) { const size_t o = (size_t)(t0 + i) * 512;
        f0[i] = fp[o]; f1[i] = fp[o + 64]; q0[i] = qp[o]; q1[i] = qp[o + 64]; iv[i] = ldp(p, t0 + i, PC_I + h * 128 + e); }
#pragma unroll
      for (int i = 0; i < 8; ++i) {
        S0 = fmaf(f0[i], S0, (1.0f - f0[i]) * iv[i]); S1 = fmaf(f1[i], S1, (1.0f - f1[i]) * iv[i]);
        float part = wave_sum(q0[i] * S0 + q1[i] * S1);
        if (lane == 0) o_h[(size_t)(t0 + i) * 512 + h * 128 + e] = part;
      }
    }
  }
}
__device__ __forceinline__ void phase_m3(const Frame& F, const Args& a) {
  const int gw = F.vcu * 8 + F.wave, NGW = F.G * 8, lane = F_LANE;
  const float* y_ssd = (const float*)(F.ws + WS_NYSSD); const float* o_h = (const float*)(F.ws + WS_NOH); const bf16_t* p = (const bf16_t*)(F.ws + WS_P);
  const float* snw = KARG_IN(7); const float* hnw = KARG_IN(9); bf16_t* mix = (bf16_t*)(F.ws + WS_MIX);
  for (int idx = gw; idx < T_TOK * 2; idx += NGW) {
    const int t = idx >> 1, g = idx & 1;
    float v[4]; float ss = 0.f;
#pragma unroll
    for (int j = 0; j < 4; ++j) { const int c = g * 256 + lane + 64 * j; v[j] = y_ssd[(size_t)t * 512 + c] * siluf(ldp(p, t, PC_Z + c)); ss += v[j] * v[j]; }
    ss = wave_sum(ss);
    const float r = rsqrtf(ss * (1.0f / 256.0f) + RMS_EPS_F);
#pragma unroll
    for (int j = 0; j < 4; ++j) { const int c = g * 256 + lane + 64 * j; mix[(size_t)t * 1024 + c] = (bf16_t)(cvt_pk_bf16(v[j] * r * snw[c], 0.f) & 0xffffu); }
  }
  for (int idx = gw; idx < T_TOK * 4; idx += NGW) {
    const int t = idx >> 2, h = idx & 3;
    float v[2]; float ss = 0.f;
#pragma unroll
    for (int j = 0; j < 2; ++j) { const int c = h * 128 + lane + 64 * j; v[j] = o_h[(size_t)t * 512 + c]; ss += v[j] * v[j]; }
    ss = wave_sum(ss);
    const float r = rsqrtf(ss * (1.0f / 128.0f) + RMS_EPS_F);
#pragma unroll
    for (int j = 0; j < 2; ++j) { const int c = h * 128 + lane + 64 * j;
      mix[(size_t)t * 1024 + 512 + c] = (bf16_t)(cvt_pk_bf16(v[j] * r * hnw[c] * siluf(ldp(p, t, PC_G + c)), 0.f) & 0xffffu); }
  }
}


#define MFMA32(a, b, c) __builtin_amdgcn_mfma_f32_32x32x16_bf16((a), (b), (c), 0, 0, 0)
__device__ __forceinline__ int drow(int r, int lane) { return (r & 3) + 8 * (r >> 2) + 4 * (lane >> 5); }
__device__ __forceinline__ bf16x8 frag_row(const LAS unsigned char* base, int pitch, int row0, int k0, int lane) {
    return *(const LAS bf16x8*)(base + (row0 + (lane & 31)) * pitch + (k0 + 8 * (lane >> 5)) * 2);
}
template <bool PERM> __device__ __forceinline__ bf16x8 frag_tr(const LAS unsigned char* base, int pitch, int k0, int col0, int lane) {
    const int h = lane >> 5, blk = (lane >> 4) & 1, q = (lane & 15) >> 2, p = lane & 3;
    const LAS unsigned char* a0 = base + (k0 + (PERM ? 4 : 8) * h + q) * pitch + (col0 + 16 * blk + 4 * p) * 2;
    const s16x4 lo = __builtin_amdgcn_ds_read_tr16_b64_v4i16((LAS s16x4*)a0);
    const s16x4 hi = __builtin_amdgcn_ds_read_tr16_b64_v4i16((LAS s16x4*)(a0 + (PERM ? 8 : 4) * pitch));
    return (bf16x8){lo[0], lo[1], lo[2], lo[3], hi[0], hi[1], hi[2], hi[3]};
}
__device__ __forceinline__ bf16x8 acc_frag(const f32x16& x, int s) {
    u32x4 w; w.x = cvt_pk_bf16(x[8 * s + 0], x[8 * s + 1]); w.y = cvt_pk_bf16(x[8 * s + 2], x[8 * s + 3]); w.z = cvt_pk_bf16(x[8 * s + 4], x[8 * s + 5]); w.w = cvt_pk_bf16(x[8 * s + 6], x[8 * s + 7]);
    return __builtin_bit_cast(bf16x8, w);
}
__device__ __forceinline__ float softplusf(float v) { return v > 20.f ? v : log1pf(__expf(v)); }
__device__ __forceinline__ unsigned short f2bf1(float v) { return (unsigned short)(cvt_pk_bf16(v, 0.f) & 0xffffu); }
__device__ __forceinline__ float half_sum(float v) {
#pragma unroll
    for (int o = 1; o < 32; o <<= 1) v += __shfl_xor(v, o);
    return v;
}

constexpr int SX_PITCH = 576, SB_TR_PITCH = 320, SB_ROW_PITCH = 272;
constexpr int SL_X = 0, SL_B = 128 * SX_PITCH  , SL_C = SL_B + 128 * SB_TR_PITCH  ;
constexpr int SL_DT = 151552, SL_ACUM = SL_DT + 2048, SL_SSQ = SL_ACUM + 2048;
static_assert(SL_C + 128 * SB_ROW_PITCH <= SL_DT && SL_SSQ + 1024 <= LDS_PHASE_BYTES, "SSD LDS map");
constexpr int HL_QD = 0, HL_QP = 64 * 272, HL_KP = 2 * 64 * 272, HL_V = 3 * 64 * 272  , HL_KD = HL_V + 64 * 320  , HL_SEG = HL_KD + 64 * 320  , HL_SSQ = HL_SEG + 4096;
static_assert(HL_SSQ + 1024 <= LDS_PHASE_BYTES, "HGRN LDS map");

__device__ __forceinline__ void ssd_dt_acum(const Frame& F, const Args& a, int c, int g) {
    if (F.wave < 4) {
        const int hh = g * 4 + F.wave, lane = F_LANE; const float* dtraw = (const float*)(F.ws + WS_DTRAW);
        const float bias = KARG_IN(4)[hh], aa = -__expf(KARG_IN(5)[hh]);
        const int t = c * 128 + 2 * lane;
        const float d0 = softplusf(dtraw[(size_t)t * 8 + hh] + bias), d1 = softplusf(dtraw[(size_t)(t + 1) * 8 + hh] + bias);
        const float a0 = d0 * aa, a1 = d1 * aa;
        float incl = a0 + a1;
#pragma unroll
        for (int o = 1; o < 64; o <<= 1) { const float v = __shfl_up(incl, o); if (lane >= o) incl += v; }
        LAS float* dts = (LAS float*)(F.lds + SL_DT) + F.wave * 128; LAS float* acs = (LAS float*)(F.lds + SL_ACUM) + F.wave * 128;
        dts[2 * lane] = d0; dts[2 * lane + 1] = d1; acs[2 * lane] = incl - a1; acs[2 * lane + 1] = incl;
    }
}
__device__ __forceinline__ void ssd_conv_item(const Frame& F, const Args& a, int c, int src_ch, int seg, int hl, int mode, LAS unsigned char* dst, int pitch, int dst_col) {
    const bf16_t* p = (const bf16_t*)(F.ws + WS_P) + PC_XBC + src_ch;
    const float* cw = KARG_IN(2) + src_ch; const float* cb = KARG_IN(3) + src_ch;
    float w[4][8], bias[8];
#pragma unroll
    for (int j = 0; j < 4; ++j) { const f32x4 x0 = *(const f32x4*)(cw + j * 1024), x1 = *(const f32x4*)(cw + j * 1024 + 4);
        w[j][0] = x0[0]; w[j][1] = x0[1]; w[j][2] = x0[2]; w[j][3] = x0[3]; w[j][4] = x1[0]; w[j][5] = x1[1]; w[j][6] = x1[2]; w[j][7] = x1[3]; }
    { const f32x4 x0 = *(const f32x4*)cb, x1 = *(const f32x4*)(cb + 4); bias[0] = x0[0]; bias[1] = x0[1]; bias[2] = x0[2]; bias[3] = x0[3]; bias[4] = x1[0]; bias[5] = x1[1]; bias[6] = x1[2]; bias[7] = x1[3]; }
    const int l0 = seg * 16, t0 = c * 128 + l0;
    u32x4 rw[19];
#pragma unroll
    for (int j = 0; j < 19; ++j) { const int tt = t0 - 3 + j; rw[j] = tt >= 0 ? *(const u32x4*)(p + (size_t)tt * PW) : (u32x4){0u, 0u, 0u, 0u}; }
    const LAS float* dts = (const LAS float*)(F.lds + SL_DT) + hl * 128; const LAS float* acs = (const LAS float*)(F.lds + SL_ACUM) + hl * 128;
    const float alast = acs[127];
#pragma unroll
    for (int i = 0; i < 16; ++i) {
        float v[8];
#pragma unroll
        for (int k = 0; k < 4; ++k) {
            const unsigned r0 = rw[i][k], r1 = rw[i + 1][k], r2 = rw[i + 2][k], r3 = rw[i + 3][k];
            v[2 * k] = siluf(fmaf(w[3][2 * k], bflo(r3), fmaf(w[2][2 * k], bflo(r2), fmaf(w[1][2 * k], bflo(r1), fmaf(w[0][2 * k], bflo(r0), bias[2 * k])))));
            v[2 * k + 1] = siluf(fmaf(w[3][2 * k + 1], bfhi(r3), fmaf(w[2][2 * k + 1], bfhi(r2), fmaf(w[1][2 * k + 1], bfhi(r1), fmaf(w[0][2 * k + 1], bfhi(r0), bias[2 * k + 1])))));
        }
        float sc = 1.f;
        if (mode >= 1) sc = dts[l0 + i];
        if (mode == 2) sc *= __expf(alast - acs[l0 + i]);
        u32x4 o; o.x = cvt_pk_bf16(v[0] * sc, v[1] * sc); o.y = cvt_pk_bf16(v[2] * sc, v[3] * sc); o.z = cvt_pk_bf16(v[4] * sc, v[5] * sc); o.w = cvt_pk_bf16(v[6] * sc, v[7] * sc);
        *(LAS u32x4*)(dst + (l0 + i) * pitch + dst_col * 2) = o;
    }
}

__device__ __forceinline__ void ssd_states_unit(const Frame& F, const Args& a, int c, int g) {
    const int tid = F_TID, lane = F_LANE;
    __syncthreads();
    ssd_dt_acum(F, a, c, g);
    __syncthreads();
    { const int cg = tid & 63, seg = tid >> 6; const bool isx = cg < 32;
      if (cg < 48) ssd_conv_item(F, a, c, isx ? g * 256 + cg * 8 : 512 + g * 128 + (cg - 32) * 8, seg, isx ? (cg >> 3) : 0, isx ? 2 : 0,
                                 F.lds + (isx ? SL_X : SL_B), isx ? SX_PITCH : SB_TR_PITCH, isx ? cg * 8 : (cg - 32) * 8); }
    __syncthreads();
    const int hl = F.wave >> 1, pt = F.wave & 1, hh = g * 4 + hl;
    f32x16 S[4];
#pragma unroll
    for (int nt = 0; nt < 4; ++nt)
#pragma unroll
        for (int r = 0; r < 16; ++r) S[nt][r] = 0.f;
#pragma unroll 2
    for (int ks = 0; ks < 8; ++ks) {
        const bf16x8 A = frag_tr<false>(F.lds + SL_X, SX_PITCH, 16 * ks, hl * 64 + 32 * pt, lane);
#pragma unroll
        for (int nt = 0; nt < 4; ++nt) { const bf16x8 B = frag_tr<false>(F.lds + SL_B, SB_TR_PITCH, 16 * ks, 32 * nt, lane); S[nt] = MFMA32(A, B, S[nt]); }
    }
    float* st = (float*)(F.ws + WS_SSTATE) + ((size_t)(c * 8 + hh) * 64 + 32 * pt) * 128;
#pragma unroll
    for (int nt = 0; nt < 4; ++nt)
#pragma unroll
        for (int r = 0; r < 16; ++r) st[(size_t)drow(r, lane) * 128 + 32 * nt + (lane & 31)] = S[nt][r];
    if (tid < 4) ((float*)(F.ws + WS_CDECAY))[c * 8 + g * 4 + tid] = __expf(((const LAS float*)(F.lds + SL_ACUM))[tid * 128 + 127]);
}

__device__ __forceinline__ void ssd_out_unit(const Frame& F, const Args& a, int c, int g) {
    const int lane = F_LANE;
    __syncthreads();
    ssd_dt_acum(F, a, c, g);
    __syncthreads();
    { const int tid = F_TID, cg = tid & 63, seg = tid >> 6; const bool isx = cg < 32, isb = cg < 48;
      ssd_conv_item(F, a, c, isx ? g * 256 + cg * 8 : (isb ? 512 + g * 128 + (cg - 32) * 8 : 768 + g * 128 + (cg - 48) * 8), seg, isx ? (cg >> 3) : 0, isx ? 1 : 0,
                    F.lds + (isx ? SL_X : (isb ? SL_B : SL_C)), isx ? SX_PITCH : SB_ROW_PITCH, isx ? cg * 8 : (isb ? (cg - 32) * 8 : (cg - 48) * 8)); }
    __syncthreads();
    const int lt = F.wave >> 1, hp = F.wave & 1;
    const int lcol = 32 * lt + (lane & 31);
    f32x16 acc[2][2];
#pragma unroll
    for (int hi = 0; hi < 2; ++hi)
#pragma unroll
        for (int pt = 0; pt < 2; ++pt)
#pragma unroll
            for (int r = 0; r < 16; ++r) acc[hi][pt][r] = 0.f;
#pragma unroll
    for (int hi = 0; hi < 2; ++hi) {
        const int hl = hp * 2 + hi, hh = g * 4 + hl;
        const bf16_t* sp = (const bf16_t*)(F.ws + WS_SPREV) + (size_t)(c * 8 + hh) * 64 * 128 + (size_t)(lane & 31) * 128 + 8 * (lane >> 5);
        bf16x8 Bsv[2][8];
#pragma unroll
        for (int pt = 0; pt < 2; ++pt)
#pragma unroll
            for (int ks = 0; ks < 8; ++ks) Bsv[pt][ks] = *(const bf16x8*)(sp + (size_t)(32 * pt) * 128 + 16 * ks);
#pragma unroll
        for (int ks = 0; ks < 8; ++ks) {
            const bf16x8 A = frag_row(F.lds + SL_C, SB_ROW_PITCH, 32 * lt, 16 * ks, lane);
#pragma unroll
            for (int pt = 0; pt < 2; ++pt) acc[hi][pt] = MFMA32(A, Bsv[pt][ks], acc[hi][pt]);
        }
        const LAS float* acs = (const LAS float*)(F.lds + SL_ACUM) + hl * 128;
#pragma unroll
        for (int r = 0; r < 16; ++r) { const float e = __expf(acs[32 * lt + drow(r, lane)]); acc[hi][0][r] *= e; acc[hi][1][r] *= e; }
    }
    float dskip[2]; { const float* dsp = KARG_IN(6); dskip[0] = dsp[g * 4 + hp * 2]; dskip[1] = dsp[g * 4 + hp * 2 + 1]; }
#pragma unroll 1
    for (int st = 0; st <= lt; ++st) {
        f32x16 GT;
#pragma unroll
        for (int r = 0; r < 16; ++r) GT[r] = 0.f;
#pragma unroll 2
        for (int ks = 0; ks < 8; ++ks) {
            const bf16x8 A = frag_row(F.lds + SL_B, SB_ROW_PITCH, 32 * st, 16 * ks, lane), B = frag_row(F.lds + SL_C, SB_ROW_PITCH, 32 * lt, 16 * ks, lane);
            GT = MFMA32(A, B, GT);
        }
#pragma unroll
        for (int hi = 0; hi < 2; ++hi) {
            const int hl = hp * 2 + hi, hh = g * 4 + hl;
            const LAS float* dts = (const LAS float*)(F.lds + SL_DT) + hl * 128; const LAS float* acs = (const LAS float*)(F.lds + SL_ACUM) + hl * 128;
            const float al = acs[lcol], dsk = dskip[hi] / dts[lcol];
            f32x16 M;
#pragma unroll
            for (int r = 0; r < 16; ++r) { const int srow = 32 * st + drow(r, lane);
                float v = srow <= lcol ? GT[r] * __expf(al - acs[srow]) : 0.f;
                if (srow == lcol) v += dsk;
                M[r] = v; }
#pragma unroll
            for (int s2 = 0; s2 < 2; ++s2) { const bf16x8 A = acc_frag(M, s2);
#pragma unroll
                for (int pt = 0; pt < 2; ++pt) { const bf16x8 B = frag_tr<true>(F.lds + SL_X, SX_PITCH, 32 * st + 16 * s2, hl * 64 + 32 * pt, lane); acc[hi][pt] = MFMA32(A, B, acc[hi][pt]); } }
        }
    }
    float ssq[16];
#pragma unroll
    for (int r = 0; r < 16; ++r) ssq[r] = 0.f;
    {
        const bf16_t* pz = (const bf16_t*)(F.ws + WS_P) + (size_t)(c * 128 + 32 * lt) * PW + PC_Z + g * 256 + hp * 128 + (lane & 31);
#pragma unroll
        for (int hi = 0; hi < 2; ++hi)
#pragma unroll
            for (int pt = 0; pt < 2; ++pt)
#pragma unroll
                for (int r = 0; r < 16; ++r) { const float z = bf2f(pz[(size_t)drow(r, lane) * PW + hi * 64 + 32 * pt]);
                    const float y = acc[hi][pt][r] * siluf(z); acc[hi][pt][r] = y; ssq[r] += y * y; }
    }
    LAS float* ssqs = (LAS float*)(F.lds + SL_SSQ);
#pragma unroll
    for (int r = 0; r < 16; ++r) { const float sm = half_sum(ssq[r]); if ((lane & 31) == 0) ssqs[F.wave * 32 + drow(r, lane)] = sm; }
    __syncthreads();
    const float* nw = KARG_IN(7) + g * 256 + hp * 128 + (lane & 31);
#pragma unroll
    for (int r = 0; r < 16; ++r) { const int row = drow(r, lane);
        const float rs = rsqrtf((ssqs[F.wave * 32 + row] + ssqs[(F.wave ^ 1) * 32 + row]) * (1.0f / 256.0f) + RMS_EPS_F);
#pragma unroll
        for (int hi = 0; hi < 2; ++hi)
#pragma unroll
            for (int pt = 0; pt < 2; ++pt) *(LAS unsigned short*)(F.lds + SL_X + (32 * lt + row) * 528 + (hp * 128 + hi * 64 + 32 * pt + (lane & 31)) * 2) = f2bf1(acc[hi][pt][r] * rs * nw[hi * 64 + 32 * pt]); }
    __syncthreads();
    { const int tid = F_TID; bf16_t* mo = (bf16_t*)(F.ws + WS_MIX) + (size_t)(c * 128) * DM + g * 256;
#pragma unroll
      for (int i = 0; i < 8; ++i) { const int pc = tid + 512 * i, row = pc >> 5, ch = (pc & 31) * 8;
          *(u32x4*)(mo + (size_t)row * DM + ch) = *(const LAS u32x4*)(F.lds + SL_X + row * 528 + ch * 2); } }
}

struct HgrnLocal { float fg[8][2], cum[8][2], qv[8][2], iv[8][2], tot[2], mid[2]; };
struct HgrnRaw { unsigned fw[8], iw[8], qw[8]; };
template <bool NEEDQ> __device__ __forceinline__ void hgrn_fetch(const Frame& F, int c, int h, HgrnRaw& R) {
    const int tid = F_TID, cp = tid & 63, seg = tid >> 6, d0 = 2 * cp;
    const bf16_t* p = (const bf16_t*)(F.ws + WS_P) + (size_t)(c * 64 + seg * 8) * PW + h * 128 + d0;
#pragma unroll
    for (int i = 0; i < 8; ++i) { R.fw[i] = *(const unsigned*)(p + (size_t)i * PW + PC_F); R.iw[i] = *(const unsigned*)(p + (size_t)i * PW + PC_I);
        if (NEEDQ) R.qw[i] = *(const unsigned*)(p + (size_t)i * PW + PC_Q); }
}
__device__ __forceinline__ void hgrn_lb(const Frame& F, int h, float (&lb)[2]) {
    const int d0 = 2 * (F_TID & 63); const float* lg = KARG_IN(8);
#pragma unroll
    for (int j = 0; j < 2; ++j) { const float l0 = lg[h * 128 + d0 + j], l1 = lg[512 + h * 128 + d0 + j]; const float mx = fmaxf(l0, l1), e0 = __expf(l0 - mx), e1 = __expf(l1 - mx); lb[j] = e0 / (e0 + e1); }
}
template <bool NEEDQ> __device__ __forceinline__ void hgrn_load(const Frame& F, const Args& a, int h, const HgrnRaw& R, HgrnLocal& L, const float (&lb)[2]) {
    const int tid = F_TID, cp = tid & 63, seg = tid >> 6, d0 = 2 * cp;
    float run[2] = {0.f, 0.f};
#pragma unroll
    for (int i = 0; i < 8; ++i) {
        const unsigned fw = R.fw[i], iw = R.iw[i];
        const float fr[2] = {bflo(fw), bfhi(fw)};
        L.iv[i][0] = bflo(iw); L.iv[i][1] = bfhi(iw);
        if (NEEDQ) { const unsigned qw = R.qw[i]; L.qv[i][0] = siluf(bflo(qw)); L.qv[i][1] = siluf(bfhi(qw)); }
#pragma unroll
        for (int j = 0; j < 2; ++j) { const float fg = lb[j] + (1.0f - lb[j]) * sigmf(fr[j]); L.fg[i][j] = fg; run[j] += __logf(fg); L.cum[i][j] = run[j]; }
    }
    LAS float* segs = (LAS float*)(F.lds + HL_SEG);
    segs[seg * 128 + d0] = run[0]; segs[seg * 128 + d0 + 1] = run[1];
    __syncthreads();
    float pre[2] = {0.f, 0.f}, tot[2] = {0.f, 0.f}, mid[2] = {0.f, 0.f};
#pragma unroll
    for (int s2 = 0; s2 < 8; ++s2) {
#pragma unroll
        for (int j = 0; j < 2; ++j) { const float v = segs[s2 * 128 + d0 + j]; tot[j] += v; if (s2 < seg) pre[j] += v; if (s2 < 4) mid[j] += v; }
    }
#pragma unroll
    for (int i = 0; i < 8; ++i)
#pragma unroll
        for (int j = 0; j < 2; ++j) L.cum[i][j] += pre[j];
    L.tot[0] = tot[0]; L.tot[1] = tot[1]; L.mid[0] = mid[0]; L.mid[1] = mid[1];
}

__device__ __forceinline__ void hgrn_states_unit(const Frame& F, const Args& a, int c, int h, const HgrnRaw& R, const float (&lb)[2]) {
    const int tid = F_TID, lane = F_LANE, cp = tid & 63, seg = tid >> 6, d0 = 2 * cp;
    __syncthreads();
    HgrnLocal L; hgrn_load<false>(F, a, h, R, L, lb);
#pragma unroll
    for (int i = 0; i < 8; ++i) { const int t = seg * 8 + i;
        *(LAS unsigned*)(F.lds + HL_KD + t * 320 + d0 * 2) = cvt_pk_bf16((1.0f - L.fg[i][0]) * __expf(L.tot[0] - L.cum[i][0]), (1.0f - L.fg[i][1]) * __expf(L.tot[1] - L.cum[i][1]));
        *(LAS unsigned*)(F.lds + HL_V + t * 320 + d0 * 2) = cvt_pk_bf16(L.iv[i][0], L.iv[i][1]); }
    if (seg == 0) { float* hd = (float*)(F.ws + WS_HDECAY) + (size_t)(c * 4 + h) * 128 + d0; hd[0] = __expf(L.tot[0]); hd[1] = __expf(L.tot[1]); }
    __syncthreads();
    const int et = F.wave >> 1, dh = F.wave & 1;
    f32x16 acc[2];
#pragma unroll
    for (int dj = 0; dj < 2; ++dj)
#pragma unroll
        for (int r = 0; r < 16; ++r) acc[dj][r] = 0.f;
#pragma unroll
    for (int ks = 0; ks < 4; ++ks) {
        const bf16x8 A = frag_tr<false>(F.lds + HL_V, 320, 16 * ks, 32 * et, lane);
#pragma unroll
        for (int dj = 0; dj < 2; ++dj) { const bf16x8 B = frag_tr<false>(F.lds + HL_KD, 320, 16 * ks, 32 * (2 * dh + dj), lane); acc[dj] = MFMA32(A, B, acc[dj]); }
    }
    float* kv = (float*)(F.ws + WS_HKV) + ((size_t)(c * 4 + h) * 128 + 32 * et) * 128;
#pragma unroll
    for (int dj = 0; dj < 2; ++dj)
#pragma unroll
        for (int r = 0; r < 16; ++r) kv[(size_t)drow(r, lane) * 128 + 32 * (2 * dh + dj) + (lane & 31)] = acc[dj][r];
}

__device__ __forceinline__ void hgrn_out_unit(const Frame& F, const Args& a, int c, int h, const HgrnRaw& R, const float (&lb)[2]) {
    const int tid = F_TID, lane = F_LANE, cp = tid & 63, seg = tid >> 6, d0 = 2 * cp;
    const int tt = F.wave >> 2, et = F.wave & 3;
    bf16x8 Bs[8];
    { const bf16_t* sp = (const bf16_t*)(F.ws + WS_HSPREV) + ((size_t)(c * 4 + h) * 128 + 32 * et) * 128 + (size_t)(lane & 31) * 128 + 8 * (lane >> 5);
#pragma unroll
      for (int ks = 0; ks < 8; ++ks) Bs[ks] = *(const bf16x8*)(sp + 16 * ks); }
    const int e = 32 * et + (lane & 31);
    unsigned short gv[16];
    { const bf16_t* pg = (const bf16_t*)(F.ws + WS_P) + (size_t)(c * 64 + 32 * tt) * PW + PC_G + h * 128 + e;
#pragma unroll
      for (int r = 0; r < 16; ++r) gv[r] = pg[(size_t)drow(r, lane) * PW]; }
    const float nw = KARG_IN(9)[h * 128 + e];
    __syncthreads();
    HgrnLocal L; hgrn_load<true>(F, a, h, R, L, lb);
#pragma unroll
    for (int i = 0; i < 8; ++i) { const int t = seg * 8 + i;
        float qd[2], qp[2], kp[2];
#pragma unroll
        for (int j = 0; j < 2; ++j) { qd[j] = L.qv[i][j] * __expf(L.cum[i][j]); qp[j] = L.qv[i][j] * __expf(L.cum[i][j] - L.mid[j]); kp[j] = (1.0f - L.fg[i][j]) * __expf(L.mid[j] - L.cum[i][j]); }
        *(LAS unsigned*)(F.lds + HL_QD + t * 272 + d0 * 2) = cvt_pk_bf16(qd[0], qd[1]);
        *(LAS unsigned*)(F.lds + HL_QP + t * 272 + d0 * 2) = cvt_pk_bf16(qp[0], qp[1]);
        *(LAS unsigned*)(F.lds + HL_KP + t * 272 + d0 * 2) = cvt_pk_bf16(kp[0], kp[1]);
        *(LAS unsigned*)(F.lds + HL_V + t * 320 + d0 * 2) = cvt_pk_bf16(L.iv[i][0], L.iv[i][1]); }
    __syncthreads();
    f32x16 acc;
#pragma unroll
    for (int r = 0; r < 16; ++r) acc[r] = 0.f;
#pragma unroll
    for (int ks = 0; ks < 8; ++ks) { const bf16x8 A = frag_row(F.lds + HL_QD, 272, 32 * tt, 16 * ks, lane); acc = MFMA32(A, Bs[ks], acc); }
    const int tcol = 32 * tt + (lane & 31);
#pragma unroll
    for (int st = 0; st < 2; ++st) {
        if (st <= tt) {
            f32x16 X;
#pragma unroll
            for (int r = 0; r < 16; ++r) X[r] = 0.f;
#pragma unroll 2
            for (int ks = 0; ks < 8; ++ks) { const bf16x8 A = frag_row(F.lds + HL_KP, 272, 32 * st, 16 * ks, lane), B = frag_row(F.lds + HL_QP, 272, 32 * tt, 16 * ks, lane); X = MFMA32(A, B, X); }
#pragma unroll
            for (int r = 0; r < 16; ++r) X[r] = (32 * st + drow(r, lane) <= tcol) ? X[r] : 0.f;
#pragma unroll
            for (int s2 = 0; s2 < 2; ++s2) { const bf16x8 A = acc_frag(X, s2), B = frag_tr<true>(F.lds + HL_V, 320, 32 * st + 16 * s2, 32 * et, lane); acc = MFMA32(A, B, acc); }
        }
    }
    LAS float* ssqs = (LAS float*)(F.lds + HL_SSQ);
#pragma unroll
    for (int r = 0; r < 16; ++r) { const float sm = half_sum(acc[r] * acc[r]); if ((lane & 31) == 0) ssqs[F.wave * 32 + drow(r, lane)] = sm; }
    __syncthreads();
#pragma unroll
    for (int r = 0; r < 16; ++r) { const int row = drow(r, lane);
        const float ss = ssqs[(tt * 4 + 0) * 32 + row] + ssqs[(tt * 4 + 1) * 32 + row] + ssqs[(tt * 4 + 2) * 32 + row] + ssqs[(tt * 4 + 3) * 32 + row];
        const float rs = rsqrtf(ss * (1.0f / 128.0f) + RMS_EPS_F);
        *(LAS unsigned short*)(F.lds + HL_QD + (32 * tt + row) * 272 + e * 2) = f2bf1(acc[r] * rs * nw * siluf(bf2f(gv[r]))); }
    __syncthreads();
    { bf16_t* mo = (bf16_t*)(F.ws + WS_MIX) + (size_t)(c * 64) * DM + 512 + h * 128;
#pragma unroll
      for (int i = 0; i < 2; ++i) { const int pc = tid + 512 * i, row = pc >> 4, ch = (pc & 15) * 8;
          *(u32x4*)(mo + (size_t)row * DM + ch) = *(const LAS u32x4*)(F.lds + HL_QD + row * 272 + ch * 2); } }
}

__device__ __forceinline__ void phase_mix_states(const Frame& F, const Args& a, const int mode) {
    if (!(mode & 1)) for (int u = blockIdx.x; u < 256; u += F.G) ssd_states_unit(F, a, u >> 1, u & 1);
    if (!(mode & 2)) {
        HgrnRaw Ra, Rb; int u = blockIdx.x; float lb[2]; int hcur = -1;
        if (u < 1024) hgrn_fetch<false>(F, u >> 2, u & 3, Ra);
        while (u < 1024) {
            int un = u + F.G; if (un < 1024) hgrn_fetch<false>(F, un >> 2, un & 3, Rb);
            if ((u & 3) != hcur) { hcur = u & 3; hgrn_lb(F, hcur, lb); }
            hgrn_states_unit(F, a, u >> 2, u & 3, Ra, lb); u = un; if (u >= 1024) break;
            un = u + F.G; if (un < 1024) hgrn_fetch<false>(F, un >> 2, un & 3, Ra);
            if ((u & 3) != hcur) { hcur = u & 3; hgrn_lb(F, hcur, lb); }
            hgrn_states_unit(F, a, u >> 2, u & 3, Rb, lb); u = un;
        }
    }
}
__device__ __forceinline__ void phase_mix_out(const Frame& F, const Args& a, const int mode) {
    if (!(mode & 1)) for (int u = blockIdx.x; u < 256; u += F.G) ssd_out_unit(F, a, u >> 1, u & 1);
    if (!(mode & 2)) {
        HgrnRaw Ra, Rb; int u = blockIdx.x; float lb[2]; int hcur = -1;
        if (u < 1024) hgrn_fetch<true>(F, u >> 2, u & 3, Ra);
        while (u < 1024) {
            int un = u + F.G; if (un < 1024) hgrn_fetch<true>(F, un >> 2, un & 3, Rb);
            if ((u & 3) != hcur) { hcur = u & 3; hgrn_lb(F, hcur, lb); }
            hgrn_out_unit(F, a, u >> 2, u & 3, Ra, lb); u = un; if (u >= 1024) break;
            un = u + F.G; if (un < 1024) hgrn_fetch<true>(F, un >> 2, un & 3, Ra);
            if ((u & 3) != hcur) { hcur = u & 3; hgrn_lb(F, hcur, lb); }
            hgrn_out_unit(F, a, u >> 2, u & 3, Rb, lb); u = un;
        }
    }
}
__device__ __forceinline__ void phase_mix_scan(const Frame& F, const Args& a) {
    const int gt = blockIdx.x * 512 + F_TID;
    if (blockIdx.x < 128 || F.G < 256) {
        for (int idx = gt; idx < 65536; idx += (F.G < 256 ? F.G : 128) * 512) {
            const int hh = idx >> 13; const float* st = (const float*)(F.ws + WS_SSTATE) + idx; const float* cd = (const float*)(F.ws + WS_CDECAY) + hh;
            bf16_t* sp = (bf16_t*)(F.ws + WS_SPREV) + idx; float S = 0.f;
            for (int c0 = 0; c0 < 128; c0 += 16) { float v[16], d[16];
#pragma unroll
                for (int i = 0; i < 16; ++i) { v[i] = st[(size_t)(c0 + i) * 65536]; d[i] = cd[(c0 + i) * 8]; }
#pragma unroll
                for (int i = 0; i < 16; ++i) { sp[(size_t)(c0 + i) * 65536] = f2bf1(S); S = fmaf(S, d[i], v[i]); } }
        }
    }
    if (blockIdx.x >= 128 || F.G < 256) {
        const int gt2 = F.G < 256 ? gt : gt - 128 * 512;
        for (int idx = gt2; idx < 65536; idx += (F.G < 256 ? F.G : 128) * 512) {
            const int h = idx >> 14, d = idx & 127; const float* kv = (const float*)(F.ws + WS_HKV) + idx; const float* hd = (const float*)(F.ws + WS_HDECAY) + h * 128 + d;
            bf16_t* sp = (bf16_t*)(F.ws + WS_HSPREV) + idx; float S = 0.f;
            for (int c0 = 0; c0 < 256; c0 += 16) { float v[16], dd[16];
#pragma unroll
                for (int i = 0; i < 16; ++i) { v[i] = kv[(size_t)(c0 + i) * 65536]; dd[i] = hd[(size_t)(c0 + i) * 512]; }
#pragma unroll
                for (int i = 0; i < 16; ++i) { sp[(size_t)(c0 + i) * 65536] = f2bf1(S); S = fmaf(S, dd[i], v[i]); } }
        }
    }
}

__global__ void __launch_bounds__(512, 2) mk_fwd(Args args) {
    extern __shared__ __attribute__((aligned(16))) unsigned char lds_raw[];
    Frame F;
    F.lds = (LAS unsigned char*)lds_raw;
    F.wave = __builtin_amdgcn_readfirstlane(threadIdx.x >> 6);
    F.G = gridDim.x; { const int bx = blockIdx.x; F.vcu = (F.G % 8 == 0) ? (bx % 8) * (F.G / 8) + bx / 8 : bx; }
    F.ws = args.ws; F.ctl = (unsigned*)(args.ws + WS_CTL);
    volatile LAS unsigned* MISC = (volatile LAS unsigned*)(F.lds + LDS_MISC);
    if (F_TID < 64) MISC[F_TID] = 0u;
    __syncthreads();
    const bool use_bar = (args.ph_hi - args.ph_lo) > 1;
    XcdBarrier bar; bar.bar = F.ctl + CW_BAR + args.li * XCD_BAR_WORDS; bar.x = 0; bar.st = MISC + 8; bar.wave = F.wave;
    if (use_bar) bar = xcd_barrier_post(F.ctl + CW_BAR + args.li * XCD_BAR_WORDS, MISC + 8, F.wave);
#define PH(k) (args.ph_lo <= (k) && (k) < args.ph_hi)
#define SEAM(k) do { if (use_bar && (k) + 1 < args.ph_hi && (k) >= args.ph_lo) xcd_barrier(bar); } while (0)
    unsigned char* ws = F.ws;
    if (PH(0)) phase_prep(F, args);
    SEAM(0);
    if (PH(1)) {
        pg8::DenseSched S; S.init(ws + WS_XB, ws + WS_WIN_T, T_TOK, 3072, 1024, F.G, blockIdx.x);
        pg8::EpiP E; E.O = (bf16_t*)(ws + WS_P); E.ldc = PW;
        pg8::gemm_phase<pg8::EpiP, pg8::DenseSched, true>(F.lds, 1024, S, E, F.wave);
    }
    SEAM(1);
#if defined(MK_NAIVE_MIX)
    if (PH(2)) phase_m1(F, args);
    SEAM(2);
    if (PH(3)) phase_m2(F, args);
    SEAM(3);
    if (PH(4)) phase_m3(F, args);
#else
    if (PH(2)) phase_mix_states(F, args, args.mode);
    SEAM(2);
    if (PH(3)) {
        phase_mix_scan(F, args);
        if (blockIdx.x < 128 && F.G >= 256) {
            __syncthreads();
            pg8::DenseSched S; S.init(ws + WS_XB, ws + WS_WIN_T + (size_t)3072 * 1024 * 2, T_TOK, 512, 1024, 128, blockIdx.x);
            pg8::EpiP E; E.O = (bf16_t*)(ws + WS_P) + 3072; E.ldc = PW;
            pg8::gemm_phase<pg8::EpiP, pg8::DenseSched, true>(F.lds, 1024, S, E, F.wave);
        } else if (F.G < 256) {
            __syncthreads();
            pg8::DenseSched S; S.init(ws + WS_XB, ws + WS_WIN_T + (size_t)3072 * 1024 * 2, T_TOK, 512, 1024, F.G, blockIdx.x);
            pg8::EpiP E; E.O = (bf16_t*)(ws + WS_P) + 3072; E.ldc = PW;
            pg8::gemm_phase<pg8::EpiP, pg8::DenseSched, true>(F.lds, 1024, S, E, F.wave);
        }
    }
    SEAM(3);
    if (PH(4)) phase_mix_out(F, args, args.mode);
#endif
    SEAM(4);
    if (PH(5)) {
        pg8::DenseSched S; S.init(ws + WS_MIX, ws + WS_WOUT_T, T_TOK, 1024, 1024, F.G, blockIdx.x);
        pg8::EpiU E; E.U = (float*)(ws + WS_H1); E.X = KARG_IN(0);
        pg8::gemm_phase<pg8::EpiU, pg8::DenseSched, false>(F.lds, 1024, S, E, F.wave);
    }
    SEAM(5);
    if (PH(6)) phase_ln1(F, args);
    SEAM(6);
    if (PH(7)) {
        pg8::DenseSched S; S.init(ws + WS_H1B, ws + WS_W3_T, T_TOK, 768, 1024, F.G, blockIdx.x);
        pg8::Epi3 E; E.LG = (float*)(ws + WS_LOGITS); E.HS = (bf16_t*)(ws + WS_HS);
        pg8::gemm_phase<pg8::Epi3, pg8::DenseSched, false>(F.lds, 1024, S, E, F.wave);
    }
    SEAM(7);
    if (PH(8)) {
        if (!(args.mode & 32)) phase_route(F, args);
        if (!(args.mode & 64)) {
        pg8::DenseSched S; S.init(ws + WS_HS, ws + WS_WDS_T, T_TOK, 1024, 256, F.G, blockIdx.x);
        pg8::EpiP E; E.O = (bf16_t*)(ws + WS_YS); E.ldc = 1024;
        pg8::gemm_phase<pg8::EpiP, pg8::DenseSched, false>(F.lds, 256, S, E, F.wave); }
    }
    SEAM(8);
#if defined(MK_OLD_EXPERTS)
    if (PH(9)) {
        build_tables(F);
        pg8::ExpertSched<true> S; S.lds = F.lds;
        S.lists = (const int*)(ws + WS_LISTS); S.A = (const char*)(ws + WS_H1B); S.W = (const char*)(ws + WS_WGU_T);
        S.U = 2 * __builtin_amdgcn_readfirstlane(((const LAS int*)(F.lds + LDS_PREF))[NEXP]); S.G = F.G; S.c = blockIdx.x;
        pg8::EpiH E; E.H = (bf16_t*)(ws + WS_H);
        pg8::gemm_phase<pg8::EpiH, pg8::ExpertSched<true>, true>(F.lds, 1024, S, E, F.wave);
    }
    SEAM(9);
    if (PH(10)) {
        build_tables(F);
        pg8::ExpertSched<false> S; S.lds = F.lds;
        S.lists = (const int*)(ws + WS_LISTS); S.A = (const char*)(ws + WS_H); S.W = (const char*)(ws + WS_WD_T);
        S.U = 4 * __builtin_amdgcn_readfirstlane(((const LAS int*)(F.lds + LDS_PREF))[NEXP]); S.G = F.G; S.c = blockIdx.x;
        pg8::EpiYb E; E.YB = (bf16_t*)(ws + WS_YB); E.lists = (const int*)(ws + WS_LISTS); E.tok_gate = (const float*)(ws + WS_TOKGATE);
        pg8::gemm_phase<pg8::EpiYb, pg8::ExpertSched<false>, true>(F.lds, 256, S, E, F.wave);
    }
    SEAM(10);
#else
    if (PH(9)) phase_experts(F, args, args.mode);
    SEAM(9);
#endif
    if (PH(11)) { build_tables(F); phase_final(F, args); }
}

extern "C" void kernel_launch(void* const* d_in, const int* in_sizes, int n_in, void* d_out, int out_size, void* d_ws, size_t ws_size, hipStream_t stream) {
    static int grid = 0;
    if (grid == 0) {
        int dev = 0, cus = 0;
        if (hipGetDevice(&dev) != hipSuccess || hipDeviceGetAttribute(&cus, hipDeviceAttributeMultiprocessorCount, dev) != hipSuccess) { fprintf(stderr, "device query failed\n"); grid = -1; return; }
        if (hipFuncSetAttribute((const void*)mk_fwd, hipFuncAttributeMaxDynamicSharedMemorySize, LDS_BYTES) != hipSuccess) { fprintf(stderr, "hipFuncSetAttribute failed\n"); grid = -1; return; }
        if (ws_size < WS_END) { fprintf(stderr, "workspace too small: %zu < %zu\n", ws_size, (size_t)WS_END); grid = -1; return; }
        (void)hipGetLastError();
        grid = cus;
    }
    if (grid < 0) return;
    unsigned char* ws = (unsigned char*)d_ws;
    (void)hipMemsetAsync(ws + WS_CTL, 0, CTL_ZERO_BYTES, stream);
    Args a{};
    for (int i = 0; i < 23; ++i) a.in[i] = (const float*)d_in[i];
    a.out = (float*)d_out; a.ws = ws;
    auto launch = [&](int lo, int hi) { a.ph_lo = lo; a.ph_hi = hi; hipLaunchKernelGGL(mk_fwd, dim3(grid), dim3(512), LDS_BYTES, stream, a); };
#if defined(MK_PER_PHASE)
    for (int ph = 0; ph < NPH; ++ph) launch(ph, ph + 1);
#else
    launch(0, NPH);
#endif
}
```

```cpp
#include <hip/hip_runtime.h>
#include <stdint.h>
#include <cstdio>

#define GAS __attribute__((address_space(1)))
#define LAS __attribute__((address_space(3)))
typedef unsigned short bf16_t;
typedef short bf16x8 __attribute__((ext_vector_type(8)));
typedef float f32x4 __attribute__((ext_vector_type(4)));
typedef unsigned u32x4 __attribute__((ext_vector_type(4)));
typedef unsigned u32x2 __attribute__((ext_vector_type(2)));
typedef float f32x16 __attribute__((ext_vector_type(16)));
typedef short s16x4 __attribute__((ext_vector_type(4)));

constexpr int T_TOK = 16384, DM = 1024, NIN = 3592, PW = 3584;
constexpr int NEXP = 256, LIST_CAP = 16384;
constexpr int PC_Z = 0, PC_XBC = 512, PC_Q = 1536, PC_F = 2048, PC_I = 2560, PC_G = 3072;
#define ALPHA_F 1.189207115002721f
#define LN_EPS_F 1e-5f
#define RMS_EPS_F 1e-6f

constexpr size_t MiB = 1u << 20;
constexpr size_t WS_CTL = 0, CTL_ZERO_BYTES = 1 * MiB;
constexpr size_t WS_WIN_T = 2 * MiB, WS_WOUT_T = 9 * MiB, WS_W3_T = 11 * MiB, WS_WDS_T = 13 * MiB, WS_DTRAW = 14 * MiB;
constexpr size_t WS_TOKE = 15 * MiB, WS_TOKPOS = 15 * MiB + 512 * 1024, WS_TOKGATE = 16 * MiB;
constexpr size_t WS_LISTS = 17 * MiB, WS_LOGITS = 33 * MiB, WS_HS = 49 * MiB, WS_YS = 57 * MiB, WS_H1 = 89 * MiB, WS_H1B = 153 * MiB;
constexpr size_t WS_WGU_T = 185 * MiB, WS_WD_T = 441 * MiB;
constexpr size_t WS_X0 = 569 * MiB;
constexpr size_t WS_XB = WS_X0, WS_P = WS_X0 + 32 * MiB, WS_MIX = WS_X0 + 144 * MiB;
constexpr size_t WS_NXBC = WS_X0 + 176 * MiB, WS_NFGK = WS_X0 + 240 * MiB, WS_NQS = WS_X0 + 272 * MiB, WS_NYSSD = WS_X0 + 304 * MiB, WS_NOH = WS_X0 + 336 * MiB, WS_NDTB = WS_X0 + 368 * MiB;
constexpr size_t WS_SSTATE = WS_X0 + 176 * MiB, WS_SPREV = WS_X0 + 208 * MiB, WS_HKV = WS_X0 + 224 * MiB, WS_HSPREV = WS_X0 + 288 * MiB;
constexpr size_t WS_CDECAY = WS_X0 + 320 * MiB, WS_HDECAY = WS_X0 + 320 * MiB + 64 * 1024;
constexpr size_t WS_H = WS_X0, WS_YB = WS_X0 + 65 * MiB;
constexpr size_t WS_END = WS_X0 + 369 * MiB;
constexpr int CW_BAR = 4096;
constexpr int CW_COUNTS = 16384, CNT_STRIDE = 64;

constexpr int RING_BYTES = 131072;
constexpr int LDS_BYTES = 163840;
constexpr int LDS_MISC = LDS_BYTES - 4096;
constexpr int LDS_PREF = LDS_MISC + 256;
constexpr int LDS_OFFS = LDS_PREF + 1040;
constexpr int LDS_CNT = LDS_OFFS + 1040;
constexpr int LDS_PHASE_BYTES = LDS_MISC;

__device__ __forceinline__ int lane_id() { int l; asm volatile("v_mbcnt_lo_u32_b32 %0, -1, 0\n\tv_mbcnt_hi_u32_b32 %0, -1, %0" : "=v"(l)); return l; }
__device__ __forceinline__ float siluf(float x) { return x * __builtin_amdgcn_rcpf(1.0f + __expf(-x)); }
__device__ __forceinline__ float sigmf(float x) { return __builtin_amdgcn_rcpf(1.0f + __expf(-x)); }
template <int CTRL> __device__ __forceinline__ float dpp_f(float v) { return __builtin_bit_cast(float, __builtin_amdgcn_update_dpp(0, __builtin_bit_cast(int, v), CTRL, 0xf, 0xf, true)); }
__device__ __forceinline__ float rdlane_f(float v, int l) { return __builtin_bit_cast(float, __builtin_amdgcn_readlane(__builtin_bit_cast(int, v), l)); }
__device__ __forceinline__ float wave_sum(float v) {
  v += dpp_f<0xB1>(v); v += dpp_f<0x4E>(v); v += dpp_f<0x141>(v); v += dpp_f<0x140>(v);
  return (rdlane_f(v, 0) + rdlane_f(v, 16)) + (rdlane_f(v, 32) + rdlane_f(v, 48));
}
__device__ __forceinline__ float wave_max(float v) {
  v = fmaxf(v, dpp_f<0xB1>(v)); v = fmaxf(v, dpp_f<0x4E>(v)); v = fmaxf(v, dpp_f<0x141>(v)); v = fmaxf(v, dpp_f<0x140>(v));
  return fmaxf(fmaxf(rdlane_f(v, 0), rdlane_f(v, 16)), fmaxf(rdlane_f(v, 32), rdlane_f(v, 48)));
}
__device__ __forceinline__ unsigned cvt_pk_bf16(float lo, float hi) { unsigned r; asm volatile("v_cvt_pk_bf16_f32 %0, %1, %2" : "=v"(r) : "v"(lo), "v"(hi)); return r; }
#define YB_SCALE 64.0f
__device__ __forceinline__ unsigned pk4_fp8(const f32x4 v) {
    const float a = fminf(fmaxf(v[0], -440.f), 440.f), b = fminf(fmaxf(v[1], -440.f), 440.f), c = fminf(fmaxf(v[2], -440.f), 440.f), d = fminf(fmaxf(v[3], -440.f), 440.f);
    int w = 0; w = __builtin_amdgcn_cvt_pk_fp8_f32(a, b, w, false); w = __builtin_amdgcn_cvt_pk_fp8_f32(c, d, w, true); return (unsigned)w; }
__device__ __forceinline__ f32x4 un4_fp8(const unsigned w) { return (f32x4){__builtin_amdgcn_cvt_f32_fp8((int)w, 0), __builtin_amdgcn_cvt_f32_fp8((int)w, 1), __builtin_amdgcn_cvt_f32_fp8((int)w, 2), __builtin_amdgcn_cvt_f32_fp8((int)w, 3)}; }
__device__ __forceinline__ float bf2f(unsigned b) { return __uint_as_float(b << 16); }
__device__ __forceinline__ float bflo(unsigned w) { return __uint_as_float(w << 16); }
__device__ __forceinline__ float bfhi(unsigned w) { return __uint_as_float(w & 0xffff0000u); }

#define XB_TMO      128
#define XB_XCNT(j)  (256  + 64 * (j))
#define XB_XSUB(j)  (1280 + 64 * (j))
#define XB_XGEN(j)  (2304 + 64 * (j))
#define XB_TOP      3328
#define XB_TOPGEN   3392
#define XCD_BAR_WORDS 3456
#define XB_SPIN_CAP (1u << 18)
__device__ __forceinline__ unsigned xb_ld(unsigned* p)              { return __hip_atomic_load(p, __ATOMIC_RELAXED, __HIP_MEMORY_SCOPE_AGENT); }
__device__ __forceinline__ unsigned xb_add(unsigned* p, unsigned v) { return __hip_atomic_fetch_add(p, v, __ATOMIC_RELAXED, __HIP_MEMORY_SCOPE_AGENT); }
__device__ __forceinline__ unsigned xb_xcc_id() { return (unsigned)__builtin_amdgcn_s_getreg((3 << 11) | 20) & 0xFu; }
#define XB_SPIN(cond, bar) do { unsigned _sp = 0; while (cond) { __builtin_amdgcn_s_sleep(1); \
    if ((++_sp & 255u) == 0u) { if (xb_ld(&(bar)[XB_TMO])) break; if (_sp > XB_SPIN_CAP) { atomicAdd(&(bar)[XB_TMO], 1u); break; } } } } while (0)
struct XcdBarrier { unsigned* bar; unsigned x; volatile LAS unsigned* st; int wave; };
__device__ __forceinline__ XcdBarrier xcd_barrier_post(unsigned* bar, volatile LAS unsigned* st, int wave) {
    XcdBarrier b; b.bar = bar; b.x = xb_xcc_id(); b.st = st; b.wave = wave;
    if (wave == 0 && lane_id() == 0) (void)xb_add(&bar[XB_XCNT(b.x)], 1u);
    return b;
}
__device__ __forceinline__ void xcd_barrier_complete(unsigned* bar, unsigned x, unsigned& nloc, unsigned& nx) {
    const unsigned G = gridDim.x * gridDim.y * gridDim.z;
    unsigned sum, cnt, mine, sp = 0u;
    for (;;) {
        sum = 0u; cnt = 0u; mine = 0u;
#pragma unroll
        for (unsigned j = 0; j < 16; ++j) { const unsigned c = xb_ld(&bar[XB_XCNT(j)]); sum += c; cnt += (c > 0u) ? 1u : 0u; mine = (j == x) ? c : mine; }
        if (sum == G) break;
        __builtin_amdgcn_s_sleep(1);
        if ((++sp & 255u) == 0u) { if (xb_ld(&bar[XB_TMO])) break; if (sp > XB_SPIN_CAP) { atomicAdd(&bar[XB_TMO], 1u); break; } }
    }
    nloc = mine > 0u ? mine : 1u; nx = cnt > 0u ? cnt : 1u;
}
__device__ __forceinline__ void xcd_barrier(const XcdBarrier& b) {
    asm volatile("s_waitcnt vmcnt(0)" ::: "memory");
    __syncthreads();
    if (b.wave == 0 && lane_id() == 0) {
        unsigned* bar = b.bar;
        __builtin_amdgcn_s_waitcnt(0);
        unsigned nloc = b.st[0], nx = b.st[1];
        if (nloc == 0u) { xcd_barrier_complete(bar, b.x, nloc, nx); b.st[0] = nloc; b.st[1] = nx; }
        const unsigned old = xb_add(&bar[XB_XSUB(b.x)], 1u);
        const unsigned gen = old / nloc;
        if (old + 1u == (gen + 1u) * nloc) {
            __builtin_amdgcn_fence(__ATOMIC_RELEASE, "agent");
            asm volatile("s_waitcnt vmcnt(0)" ::: "memory");
            const unsigned og = xb_add(&bar[XB_TOP], 1u);
            const unsigned tg = og / nx;
            if (og + 1u == (tg + 1u) * nx) xb_add(&bar[XB_TOPGEN], 1u);
            else XB_SPIN(xb_ld(&bar[XB_TOPGEN]) == tg, bar);
            __builtin_amdgcn_fence(__ATOMIC_ACQUIRE, "agent");
            xb_add(&bar[XB_XGEN(b.x)], 1u);
            asm volatile("s_waitcnt vmcnt(0)" ::: "memory");
        } else {
            XB_SPIN(xb_ld(&bar[XB_XGEN(b.x)]) == gen, bar);
            __builtin_amdgcn_fence(__ATOMIC_ACQUIRE, "agent");
            asm volatile("s_waitcnt vmcnt(0)" ::: "memory");
        }
    }
    __syncthreads();
}

namespace pg8 {
constexpr int BM = 256, BK = 64, HALF = 128, HTB = HALF * BK * 2, STAGE_BYTES = 8 * HTB, NXCD = 8, WGM = 8;
__host__ __device__ __forceinline__ int lds_byte(int r, int c) { const int st = (r >> 4) * 2 + (c >> 5), rr = r & 15, cc = c & 31, ob = rr * 64 + cc * 2; return st * 1024 + (ob ^ (((ob >> 9) & 1) << 5)); }
__host__ __device__ __forceinline__ void stage_rc(int b, int& R, int& C) { const int st = b / 1024, sb = b % 1024, swz = sb ^ (((sb >> 9) & 1) << 5); R = (st >> 1) * 16 + swz / 64; C = (st & 1) * 32 + (swz % 64) / 2; }
__host__ __device__ __forceinline__ int perm32(int rho) { const int n = rho >> 4, i = rho & 15; return 8 * (i >> 2) + 4 * n + (i & 3); }

struct Unit { const char* A; const char* B; int pm, pn, rows, e, slot0, mt; };

struct DenseSched {
    static constexpr bool PER_UNIT_VOFF = false;
    const char* A; const char* B; int K, nM, nN, nwg, G, c;
    __device__ void init(const void* A_, const void* B_, int M, int N, int K_, int G_, int c_) { A = (const char*)A_; B = (const char*)B_; K = K_; nM = M / BM; nN = N / BM; nwg = nM * nN; G = G_; c = c_; }
    __device__ __forceinline__ bool next(int i, Unit& u) const {
        const int L = i * G + c; if (L >= nwg) return false;
        int wgid = L; { const int q = nwg / NXCD, r = nwg % NXCD, xcd = wgid % NXCD, off = wgid / NXCD; wgid = (xcd < r ? xcd * (q + 1) : r * (q + 1) + (xcd - r) * q) + off; }
        const int nig = WGM * nN, gid = wgid / nig, fm = gid * WGM, gsz = (nM - fm) < WGM ? (nM - fm) : WGM;
        u.pm = fm + ((wgid % nig) % gsz); u.pn = (wgid % nig) / gsz; u.rows = 256; u.e = 0; u.slot0 = 0; u.mt = 0;
        u.A = A + (size_t)u.pm * BM * K * 2; u.B = B + (size_t)u.pn * BM * K * 2; return true;
    }
    __device__ __forceinline__ void voff(const Unit&, const int (&sR)[2], const int (&sC)[2], unsigned (&v)[2][2]) const {
#pragma unroll
        for (int h = 0; h < 2; ++h)
#pragma unroll
            for (int i = 0; i < 2; ++i) v[h][i] = (unsigned)((h * HALF + sR[i]) * K + sC[i]) * 2u;
    }
};

template <bool GATHER> struct ExpertSched {
    static constexpr bool PER_UNIT_VOFF = GATHER;
    static constexpr int K = GATHER ? 1024 : 256, NT = GATHER ? 2 : 4;
    static constexpr unsigned WSTRIDE = GATHER ? 512u * 1024u * 2u : 1024u * 256u * 2u;
    LAS unsigned char* lds;
    const int* lists; const char* A; const char* W; int U, G, c;
    __device__ __forceinline__ bool next(int i, Unit& u) const {
        int L = i * G + c; if (L >= U) return false;
        { const int q = U / NXCD, r = U % NXCD, xcd = L % NXCD, off = L / NXCD; L = (xcd < r ? xcd * (q + 1) : r * (q + 1) + (xcd - r) * q) + off; }
        const LAS int* pref = (const LAS int*)(lds + LDS_PREF);
        int lo = 0, hi = NEXP;
        while (hi - lo > 1) { const int mid = (lo + hi) >> 1; const int pv = __builtin_amdgcn_readfirstlane(pref[mid]); if (NT * pv <= L) lo = mid; else hi = mid; }
        const int e = lo, p0 = __builtin_amdgcn_readfirstlane(pref[e]), p1 = __builtin_amdgcn_readfirstlane(pref[e + 1]), tiles = p1 - p0, r = L - NT * p0;
        u.e = e; u.pn = r / tiles; u.mt = r % tiles; u.pm = 0;
        const int n = __builtin_amdgcn_readfirstlane(((const LAS int*)(lds + LDS_CNT))[e]); u.rows = (n - u.mt * 256) < 256 ? (n - u.mt * 256) : 256;
        u.slot0 = __builtin_amdgcn_readfirstlane(((const LAS int*)(lds + LDS_OFFS))[e]) + u.mt * 256;
        u.A = GATHER ? A : A + (size_t)u.slot0 * (K * 2); u.B = W + (size_t)e * WSTRIDE + (size_t)u.pn * (BM * K * 2); return true;
    }
    __device__ __forceinline__ void voff(const Unit& u, const int (&sR)[2], const int (&sC)[2], unsigned (&v)[2][2]) const {
#pragma unroll
        for (int h = 0; h < 2; ++h)
#pragma unroll
            for (int i = 0; i < 2; ++i) {
                const int r = h * HALF + sR[i];
                if (GATHER) { int tok = 0; if (r < u.rows) tok = lists[(size_t)u.e * LIST_CAP + u.mt * 256 + r] >> 3; v[h][i] = (unsigned)(tok * K + sC[i]) * 2u; }
                else v[h][i] = (unsigned)(r * K + sC[i]) * 2u;
            }
    }
};

template <class Epi, class Sched, bool ALIGN_EPI>
__device__ __forceinline__ void gemm_phase(LAS unsigned char* lds, const int K, const Sched& S, const Epi& E, const int wid) {
    const int lane = lane_id(), tid = wid * 64 + lane, wr = wid >> 2, wc = wid & 3, fr = lane & 15, fq = lane >> 4;
    const int nt = K / BK;
    int sR[2], sC[2]; unsigned voffB[2];
#pragma unroll
    for (int i = 0; i < 2; ++i) { stage_rc(tid * 16 + i * 8192, sR[i], sC[i]); const int Rb = Epi::PERM ? ((sR[i] & ~31) + perm32(sR[i] & 31)) : sR[i]; voffB[i] = (unsigned)(Rb * K + sC[i]) * 2u; }
    const size_t kstep = (size_t)(BK * 2);
    const size_t hstep = (size_t)HALF * K * 2;
    const unsigned ldsw = (unsigned)wid * 1024u;
    const int aoff = lds_byte(wr * 64 + fr, fq * 8), boff = lds_byte(wc * 32 + fr, fq * 8);
#define PG8_SA(b, h) (((b) * 2 + (h)) * HTB)
#define PG8_SB(b, h) ((4 + (b) * 2 + (h)) * HTB)
#define PG8_STAGE(bufoff, gbase, voff) do { _Pragma("unroll") for (int _i = 0; _i < 2; ++_i) \
        __builtin_amdgcn_global_load_lds((const unsigned*)((const char*)(gbase) + (voff)[_i]), (LAS unsigned*)(lds + (bufoff) + ldsw + _i * 8192), 16, 0, 0); } while (0)
#define PG8_STAGE_A(bufoff, gbase, h, vset) do { if constexpr (Sched::PER_UNIT_VOFF) { PG8_STAGE(bufoff, gbase, (vset)[h]); } else { PG8_STAGE(bufoff, (gbase) + (h) * hstep, vc[0]); } } while (0)
#define PG8_LDA(dst, b, h) do { _Pragma("unroll") for (int m = 0; m < 4; ++m) _Pragma("unroll") for (int k = 0; k < 2; ++k) dst[m][k] = *(const LAS bf16x8*)(lds + PG8_SA(b, h) + aoff + m * 2048 + k * 1024); } while (0)
#define PG8_LDB(dst, b, h) do { _Pragma("unroll") for (int n = 0; n < 2; ++n) _Pragma("unroll") for (int k = 0; k < 2; ++k) dst[n][k] = *(const LAS bf16x8*)(lds + PG8_SB(b, h) + boff + n * 2048 + k * 1024); } while (0)
#define PG8_MMA(ai, bj, At, Bt) do { __builtin_amdgcn_s_setprio(1); _Pragma("unroll") for (int m = 0; m < 4; ++m) _Pragma("unroll") for (int n = 0; n < 2; ++n) _Pragma("unroll") for (int k = 0; k < 2; ++k) \
        acc[ai][bj][m][n] = __builtin_amdgcn_mfma_f32_16x16x32_bf16(Bt[n][k], At[m][k], acc[ai][bj][m][n], 0, 0, 0); __builtin_amdgcn_s_setprio(0); } while (0)
#define PG8_WAIT_V(n) asm volatile("s_waitcnt vmcnt(" #n ")" ::: "memory")
#define PG8_WAIT_L(n) asm volatile("s_waitcnt lgkmcnt(" #n ")" ::: "memory")
#define PG8_BAR __builtin_amdgcn_s_barrier()
#define PG8_SCHED __builtin_amdgcn_sched_barrier(0)
    Unit cur, nxt; int ui = 0;
    if (!S.next(0, cur)) return;
    unsigned vc[2][2], vn[2][2];
    S.voff(cur, sR, sC, vc);
    f32x4 acc[2][2][4][2];
#pragma unroll
    for (int a = 0; a < 2; ++a)
#pragma unroll
        for (int b = 0; b < 2; ++b)
#pragma unroll
            for (int m = 0; m < 4; ++m)
#pragma unroll
                for (int n = 0; n < 2; ++n) acc[a][b][m][n] = (f32x4){0.f, 0.f, 0.f, 0.f};
    bf16x8 At[4][2], B0[2][2], B1[2][2];
    const char* cA = cur.A; const char* cB = cur.B;
    PG8_STAGE(PG8_SB(0, 0), cB, voffB); PG8_STAGE(PG8_SB(0, 1), cB + hstep, voffB); PG8_STAGE_A(PG8_SA(0, 0), cA, 0, vc); PG8_STAGE_A(PG8_SA(0, 1), cA, 1, vc);
    if (wr == 1) PG8_BAR;
    PG8_WAIT_V(2); PG8_BAR;
    PG8_STAGE(PG8_SB(1, 0), cB + kstep, voffB); PG8_STAGE_A(PG8_SA(1, 0), cA + kstep, 0, vc); PG8_STAGE(PG8_SB(1, 1), cB + hstep + kstep, voffB);
    PG8_WAIT_V(6); PG8_BAR;
    for (;;) {
        const bool has_next = S.next(ui + 1, nxt);
        if constexpr (Sched::PER_UNIT_VOFF) {
            if (has_next) S.voff(nxt, sR, sC, vn);
            else {
#pragma unroll
                for (int h = 0; h < 2; ++h)
#pragma unroll
                    for (int i = 0; i < 2; ++i) vn[h][i] = vc[h][i];
            }
        }
        const char* nA = has_next ? nxt.A : cA; const char* nB = has_next ? nxt.B : cB;
        for (int t = 0; t < nt; t += 2) {
            const bool last = (t == nt - 2);
            const char* a1 = cA + (size_t)(t + 1) * kstep;
            const char* a2 = last ? nA : cA + (size_t)(t + 2) * kstep; const char* b2 = last ? nB : cB + (size_t)(t + 2) * kstep;
            const char* a3 = a2 + kstep; const char* b3 = b2 + kstep;
            unsigned v2[2][2];
#pragma unroll
            for (int h = 0; h < 2; ++h)
#pragma unroll
                for (int i = 0; i < 2; ++i) v2[h][i] = (Sched::PER_UNIT_VOFF && last) ? vn[h][i] : vc[h][i];
            PG8_LDB(B0, 0, 0); PG8_LDB(B1, 0, 1); PG8_SCHED; PG8_LDA(At, 0, 0); PG8_STAGE_A(PG8_SA(1, 1), a1, 1, vc);
            PG8_WAIT_V(8); PG8_WAIT_L(0); PG8_BAR; PG8_MMA(0, 0, At, B0); PG8_MMA(0, 1, At, B1); PG8_BAR; PG8_SCHED;
            PG8_LDA(At, 0, 1); PG8_STAGE(PG8_SB(0, 0), b2, voffB); PG8_STAGE(PG8_SB(0, 1), b2 + hstep, voffB); PG8_STAGE_A(PG8_SA(0, 0), a2, 0, v2);
            PG8_WAIT_V(8); PG8_WAIT_L(0); PG8_BAR; PG8_MMA(1, 0, At, B0); PG8_MMA(1, 1, At, B1); PG8_BAR; PG8_SCHED;
            PG8_LDB(B0, 1, 0); PG8_LDB(B1, 1, 1); PG8_SCHED; PG8_LDA(At, 1, 0); PG8_STAGE_A(PG8_SA(0, 1), a2, 1, v2);
            PG8_WAIT_V(8); PG8_WAIT_L(0); PG8_BAR; PG8_MMA(0, 0, At, B0); PG8_MMA(0, 1, At, B1); PG8_BAR; PG8_SCHED;
            PG8_LDA(At, 1, 1); PG8_STAGE(PG8_SB(1, 0), b3, voffB); PG8_STAGE(PG8_SB(1, 1), b3 + hstep, voffB); PG8_STAGE_A(PG8_SA(1, 0), a3, 0, v2);
            PG8_WAIT_V(8); PG8_WAIT_L(0); PG8_BAR; PG8_MMA(1, 0, At, B0); PG8_MMA(1, 1, At, B1); PG8_BAR; PG8_SCHED;
        }
        if constexpr (ALIGN_EPI) { if (wr == 0) PG8_BAR; }
        E(acc, cur, wr, wc, fr, fq);
        if (!has_next) break;
#pragma unroll
        for (int a = 0; a < 2; ++a)
#pragma unroll
            for (int b = 0; b < 2; ++b)
#pragma unroll
                for (int m = 0; m < 4; ++m)
#pragma unroll
                    for (int n = 0; n < 2; ++n) acc[a][b][m][n] = (f32x4){0.f, 0.f, 0.f, 0.f};
        cur = nxt; cA = nA; cB = nB; ++ui;
        if constexpr (Sched::PER_UNIT_VOFF) {
#pragma unroll
            for (int h = 0; h < 2; ++h)
#pragma unroll
                for (int i = 0; i < 2; ++i) vc[h][i] = vn[h][i];
        }
        if constexpr (ALIGN_EPI) { if (wr == 1) PG8_BAR; }
    }
    PG8_WAIT_V(0);
    if constexpr (!ALIGN_EPI) { if (wr == 0) PG8_BAR; }
    PG8_BAR;
#undef PG8_SA
#undef PG8_SB
#undef PG8_STAGE
#undef PG8_LDA
#undef PG8_STAGE_A
#undef PG8_LDB
#undef PG8_MMA
#undef PG8_WAIT_V
#undef PG8_WAIT_L
#undef PG8_BAR
#undef PG8_SCHED
}

struct EpiP {
    static constexpr bool PERM = true;
    bf16_t* O; int ldc;
    __device__ __forceinline__ void operator()(const f32x4 (&acc)[2][2][4][2], const Unit& u, int wr, int wc, int fr, int fq) const {
        const int row0 = u.pm * BM + wr * 64 + fr, col0 = u.pn * BM + wc * 32 + 8 * fq;
#pragma unroll
        for (int ai = 0; ai < 2; ++ai)
#pragma unroll
            for (int m = 0; m < 4; ++m) { bf16_t* rowp = O + (size_t)(row0 + ai * HALF + m * 16) * ldc + col0;
#pragma unroll
                for (int bj = 0; bj < 2; ++bj) { const f32x4 v0 = acc[ai][bj][m][0], v1 = acc[ai][bj][m][1];
                    u32x4 w; w.x = cvt_pk_bf16(v0[0], v0[1]); w.y = cvt_pk_bf16(v0[2], v0[3]); w.z = cvt_pk_bf16(v1[0], v1[1]); w.w = cvt_pk_bf16(v1[2], v1[3]);
                    *(u32x4*)(rowp + bj * HALF) = w; } }
    }
};
struct EpiU {
    static constexpr bool PERM = false;
    float* U; const float* X;
    __device__ __forceinline__ void operator()(const f32x4 (&acc)[2][2][4][2], const Unit& u, int wr, int wc, int fr, int fq) const {
        const int row0 = u.pm * BM + wr * 64 + fr, col0 = u.pn * BM + wc * 32 + 4 * fq;
#pragma unroll
        for (int ai = 0; ai < 2; ++ai)
#pragma unroll
            for (int m = 0; m < 4; ++m) { const size_t ro = (size_t)(row0 + ai * HALF + m * 16) * DM + col0;
#pragma unroll
                for (int bj = 0; bj < 2; ++bj)
#pragma unroll
                    for (int n = 0; n < 2; ++n) { const f32x4 xv = *(const f32x4*)(X + ro + bj * HALF + n * 16);
                        *(f32x4*)(U + ro + bj * HALF + n * 16) = xv * ALPHA_F + acc[ai][bj][m][n]; } }
    }
};
struct Epi3 {
    static constexpr bool PERM = true;
    float* LG; bf16_t* HS;
    __device__ __forceinline__ void operator()(const f32x4 (&acc)[2][2][4][2], const Unit& u, int wr, int wc, int fr, int fq) const {
        const int row0 = u.pm * BM + wr * 64 + fr;
        if (u.pn == 0) {
#pragma unroll
            for (int ai = 0; ai < 2; ++ai)
#pragma unroll
                for (int m = 0; m < 4; ++m) { float* rowp = LG + (size_t)(row0 + ai * HALF + m * 16) * 256 + wc * 32 + 8 * fq;
#pragma unroll
                    for (int bj = 0; bj < 2; ++bj)
#pragma unroll
                        for (int n = 0; n < 2; ++n) *(f32x4*)(rowp + bj * HALF + 4 * n) = acc[ai][bj][m][n]; }
        } else {
            const int hc0 = (u.pn - 1) * 128 + wc * 32 + 8 * fq;
#pragma unroll
            for (int ai = 0; ai < 2; ++ai)
#pragma unroll
                for (int m = 0; m < 4; ++m) { bf16_t* rowp = HS + (size_t)(row0 + ai * HALF + m * 16) * 256 + hc0;
                    float h[8];
#pragma unroll
                    for (int n = 0; n < 2; ++n)
#pragma unroll
                        for (int j = 0; j < 4; ++j) h[n * 4 + j] = siluf(acc[ai][0][m][n][j]) * acc[ai][1][m][n][j];
                    u32x4 w; w.x = cvt_pk_bf16(h[0], h[1]); w.y = cvt_pk_bf16(h[2], h[3]); w.z = cvt_pk_bf16(h[4], h[5]); w.w = cvt_pk_bf16(h[6], h[7]);
                    *(u32x4*)rowp = w; }
        }
    }
};
struct EpiH {
    static constexpr bool PERM = true;
    bf16_t* H;
    __device__ __forceinline__ void operator()(const f32x4 (&acc)[2][2][4][2], const Unit& u, int wr, int wc, int fr, int fq) const {
        const int hc0 = u.pn * 128 + wc * 32 + 8 * fq;
#pragma unroll
        for (int ai = 0; ai < 2; ++ai)
#pragma unroll
            for (int m = 0; m < 4; ++m) { const int r = ai * HALF + wr * 64 + m * 16 + fr;
                if (r < u.rows) { bf16_t* rowp = H + (size_t)(u.slot0 + r) * 256 + hc0;
                    float h[8];
#pragma unroll
                    for (int n = 0; n < 2; ++n)
#pragma unroll
                        for (int j = 0; j < 4; ++j) h[n * 4 + j] = siluf(acc[ai][0][m][n][j]) * acc[ai][1][m][n][j];
                    u32x4 w; w.x = cvt_pk_bf16(h[0], h[1]); w.y = cvt_pk_bf16(h[2], h[3]); w.z = cvt_pk_bf16(h[4], h[5]); w.w = cvt_pk_bf16(h[6], h[7]);
                    *(u32x4*)rowp = w; } }
    }
};
struct EpiYb {
    static constexpr bool PERM = true;
    bf16_t* YB; const int* lists; const float* tok_gate;
    __device__ __forceinline__ void operator()(const f32x4 (&acc)[2][2][4][2], const Unit& u, int wr, int wc, int fr, int fq) const {
        const int col0 = u.pn * BM + wc * 32 + 8 * fq;
#pragma unroll
        for (int ai = 0; ai < 2; ++ai)
#pragma unroll
            for (int m = 0; m < 4; ++m) { const int r = ai * HALF + wr * 64 + m * 16 + fr;
                if (r < u.rows) { const float g = tok_gate[lists[(size_t)u.e * LIST_CAP + u.mt * 256 + r]];
                    bf16_t* rowp = YB + (size_t)(u.slot0 + r) * 1024 + col0;
#pragma unroll
                    for (int bj = 0; bj < 2; ++bj) { const f32x4 v0 = acc[ai][bj][m][0] * g, v1 = acc[ai][bj][m][1] * g;
                        u32x4 w; w.x = cvt_pk_bf16(v0[0], v0[1]); w.y = cvt_pk_bf16(v0[2], v0[3]); w.z = cvt_pk_bf16(v1[0], v1[1]); w.w = cvt_pk_bf16(v1[2], v1[3]);
                        *(u32x4*)(rowp + bj * HALF) = w; } } }
    }
};
}

template <int OFF> __device__ __forceinline__ unsigned long long karg_u64() { unsigned long long v;
    asm volatile("s_load_dwordx2 %0, %1, %2\n\ts_waitcnt lgkmcnt(0)" : "=s"(v) : "s"(__builtin_amdgcn_kernarg_segment_ptr()), "i"(OFF)); return v; }
#define KARG_IN(k) ((const float*)karg_u64<8 * (k)>())
#define KARG_OUT() ((float*)karg_u64<184>())
struct Args { const float* in[23]; float* out; unsigned char* ws; int ph_lo, ph_hi, mode, li; };
struct Frame { LAS unsigned char* lds; int wave, G, vcu; unsigned char* ws; unsigned* ctl; };
#define F_LANE lane_id()
#define F_TID (F.wave * 64 + lane_id())
constexpr int NPH = 12;

__device__ __forceinline__ void transpose_item(const float* W, int ldw, int c0, int k0, bf16_t* WT, int K, int row0, LAS float* scr, int lane) {
#pragma unroll 8
    for (int i = 0; i < 32; ++i) { const int kk = 2 * i + (lane >> 5); scr[kk * 33 + (lane & 31)] = W[(size_t)(k0 + kk) * ldw + c0 + (lane & 31)]; }
    asm volatile("s_waitcnt lgkmcnt(0)" ::: "memory");
    const int c = lane & 7;
#pragma unroll
    for (int j = 0; j < 4; ++j) { const int n = (lane >> 3) + 8 * j; const LAS float* s = scr + (8 * c) * 33 + n;
        u32x4 o; o.x = cvt_pk_bf16(s[0 * 33], s[1 * 33]); o.y = cvt_pk_bf16(s[2 * 33], s[3 * 33]); o.z = cvt_pk_bf16(s[4 * 33], s[5 * 33]); o.w = cvt_pk_bf16(s[6 * 33], s[7 * 33]);
        *(u32x4*)(WT + (size_t)(row0 + n) * K + k0 + 8 * c) = o; }
    asm volatile("s_waitcnt lgkmcnt(0)" ::: "memory");
}

__device__ __forceinline__ void gu_item(const float* Wg, const float* Wu, bf16_t* WT, int item, LAS float* scr, int lane) {
    const int kb = item >> 4, nb = item & 15, row0 = nb * 32, pn = row0 >> 8, half = (row0 >> 7) & 1, r0 = row0 & 127;
    transpose_item(half ? Wu : Wg, 256, pn * 128 + r0, kb * 64, WT, 1024, row0, scr, lane);
}

__device__ __forceinline__ void phase_prep(const Frame& F, const Args& a) {
    float wdt[16][8];
    { const float* w_in0 = KARG_IN(1); const int tid = F_TID;
      __syncthreads();
#pragma unroll
      for (int i = 0; i < 2; ++i) { const int k = tid + 512 * i; const float* src = w_in0 + (size_t)k * NIN + 1536;
          *(LAS f32x4*)(F.lds + k * 32) = *(const f32x4*)src; *(LAS f32x4*)(F.lds + k * 32 + 16) = *(const f32x4*)(src + 4); }
      __syncthreads();
#pragma unroll
      for (int j = 0; j < 16; ++j) { const int k = (j < 8 ? 8 * F_LANE + j : 512 + 8 * F_LANE + (j - 8));
          const f32x4 lo = *(const LAS f32x4*)(F.lds + k * 32), hi = *(const LAS f32x4*)(F.lds + k * 32 + 16);
          wdt[j][0] = lo[0]; wdt[j][1] = lo[1]; wdt[j][2] = lo[2]; wdt[j][3] = lo[3]; wdt[j][4] = hi[0]; wdt[j][5] = hi[1]; wdt[j][6] = hi[2]; wdt[j][7] = hi[3]; }
      __syncthreads(); }
    LAS float* scr = (LAS float*)(F.lds + F.wave * 16384);
    const int gw = F.vcu * 8 + F.wave, NGW = F.G * 8;
    unsigned char* ws = F.ws;
    bf16_t* Win_t = (bf16_t*)(ws + WS_WIN_T); bf16_t* Wout_t = (bf16_t*)(ws + WS_WOUT_T); bf16_t* W3_t = (bf16_t*)(ws + WS_W3_T); bf16_t* Wds_t = (bf16_t*)(ws + WS_WDS_T);
    bf16_t* Wgu_t = (bf16_t*)(ws + WS_WGU_T); bf16_t* Wd_t = (bf16_t*)(ws + WS_WD_T);
    const float* w_in = KARG_IN(1); const float* w_out = KARG_IN(10); const float* w_router = KARG_IN(13);
    const float* wge = KARG_IN(15); const float* wue = KARG_IN(16); const float* wde = KARG_IN(17);
    const float* wgs = KARG_IN(18); const float* wus = KARG_IN(19); const float* wds = KARG_IN(20);
    constexpr int I_IN = 16 * (PW / 32), I_OUT = 16 * 32, I_R = 16 * 8, I_S = 16 * 16, I_DS = 4 * 32, I_EGU = 16 * 16, I_ED = 4 * 32;
#if defined(MK_OLD_EXPERTS)
    constexpr int NITEMS = I_IN + I_OUT + I_R + I_S + I_DS + NEXP * (I_EGU + I_ED);
#else
    constexpr int NITEMS = I_IN + I_OUT + I_R + I_S + I_DS;
#endif
    for (int it = gw; it < NITEMS; it += NGW) {
        int r = it;
        if (r < I_IN) { const int kb = r / (PW / 32), nb = r % (PW / 32), row0 = nb * 32; const int c0 = row0 < 1536 ? row0 : row0 + 8;
            transpose_item(w_in, NIN, c0, kb * 64, Win_t, 1024, row0, scr, F_LANE); continue; } r -= I_IN;
        if (r < I_OUT) { transpose_item(w_out, 1024, (r & 31) * 32, (r >> 5) * 64, Wout_t, 1024, (r & 31) * 32, scr, F_LANE); continue; } r -= I_OUT;
        if (r < I_R) { transpose_item(w_router, 256, (r & 7) * 32, (r >> 3) * 64, W3_t, 1024, (r & 7) * 32, scr, F_LANE); continue; } r -= I_R;
        if (r < I_S) { gu_item(wgs, wus, W3_t + (size_t)256 * 1024, r, scr, F_LANE); continue; } r -= I_S;
        if (r < I_DS) { transpose_item(wds, 1024, (r & 31) * 32, (r >> 5) * 64, Wds_t, 256, (r & 31) * 32, scr, F_LANE); continue; } r -= I_DS;
        const int e = r / (I_EGU + I_ED), q = r % (I_EGU + I_ED);
        if (q < I_EGU) gu_item(wge + (size_t)e * 1024 * 256, wue + (size_t)e * 1024 * 256, Wgu_t + (size_t)e * 512 * 1024, q, scr, F_LANE);
        else { const int qq = q - I_EGU; transpose_item(wde + (size_t)e * 256 * 1024, 1024, (qq & 31) * 32, (qq >> 5) * 64, Wd_t + (size_t)e * 1024 * 256, 256, (qq & 31) * 32, scr, F_LANE); }
    }
    const float* x = KARG_IN(0); bf16_t* xb = (bf16_t*)(ws + WS_XB); float* dtraw = (float*)(ws + WS_DTRAW);
    f32x4 n0, n1, n2, n3;
    { const float* xr = x + (size_t)(gw < T_TOK ? gw : 0) * DM; n0 = *(const f32x4*)(xr + 8 * F_LANE); n1 = *(const f32x4*)(xr + 8 * F_LANE + 4); n2 = *(const f32x4*)(xr + 512 + 8 * F_LANE); n3 = *(const f32x4*)(xr + 512 + 8 * F_LANE + 4); }
    for (int t = gw; t < T_TOK; t += NGW) {
        const f32x4 a0 = n0, a1 = n1, b0 = n2, b1 = n3;
        { const int tn = t + NGW < T_TOK ? t + NGW : t; const float* xr = x + (size_t)tn * DM;
          n0 = *(const f32x4*)(xr + 8 * F_LANE); n1 = *(const f32x4*)(xr + 8 * F_LANE + 4); n2 = *(const f32x4*)(xr + 512 + 8 * F_LANE); n3 = *(const f32x4*)(xr + 512 + 8 * F_LANE + 4); }
        u32x4 w0; w0.x = cvt_pk_bf16(a0[0], a0[1]); w0.y = cvt_pk_bf16(a0[2], a0[3]); w0.z = cvt_pk_bf16(a1[0], a1[1]); w0.w = cvt_pk_bf16(a1[2], a1[3]);
        u32x4 w1; w1.x = cvt_pk_bf16(b0[0], b0[1]); w1.y = cvt_pk_bf16(b0[2], b0[3]); w1.z = cvt_pk_bf16(b1[0], b1[1]); w1.w = cvt_pk_bf16(b1[2], b1[3]);
        *(u32x4*)(xb + (size_t)t * DM + 8 * F_LANE) = w0; *(u32x4*)(xb + (size_t)t * DM + 512 + 8 * F_LANE) = w1;
        const float xv[16] = {a0[0], a0[1], a0[2], a0[3], a1[0], a1[1], a1[2], a1[3], b0[0], b0[1], b0[2], b0[3], b1[0], b1[1], b1[2], b1[3]};
        float d[8];
#pragma unroll
        for (int h = 0; h < 8; ++h) { float sm = 0.f;
#pragma unroll
            for (int j = 0; j < 16; ++j) sm = fmaf(xv[j], wdt[j][h], sm);
            d[h] = wave_sum(sm); }
        if (F_LANE == 0) { *(f32x4*)(dtraw + t * 8) = (f32x4){d[0], d[1], d[2], d[3]}; *(f32x4*)(dtraw + t * 8 + 4) = (f32x4){d[4], d[5], d[6], d[7]}; }
    }
}

__device__ __forceinline__ void phase_ln1(const Frame& F, const Args& a) {
    const int gw = F.vcu * 8 + F.wave, NGW = F.G * 8;
    float* h1 = (float*)(F.ws + WS_H1); bf16_t* h1b = (bf16_t*)(F.ws + WS_H1B);
    const float* g = KARG_IN(11); const float* b = KARG_IN(12);
    const int c0 = 8 * F_LANE;
    f32x4 gv[4], bv[4];
    gv[0] = *(const f32x4*)(g + c0); gv[1] = *(const f32x4*)(g + c0 + 4); gv[2] = *(const f32x4*)(g + 512 + c0); gv[3] = *(const f32x4*)(g + 512 + c0 + 4);
    bv[0] = *(const f32x4*)(b + c0); bv[1] = *(const f32x4*)(b + c0 + 4); bv[2] = *(const f32x4*)(b + 512 + c0); bv[3] = *(const f32x4*)(b + 512 + c0 + 4);
    for (int t = gw; t < T_TOK; t += NGW) {
        float* r = h1 + (size_t)t * DM;
        f32x4 v[4]; v[0] = *(const f32x4*)(r + c0); v[1] = *(const f32x4*)(r + c0 + 4); v[2] = *(const f32x4*)(r + 512 + c0); v[3] = *(const f32x4*)(r + 512 + c0 + 4);
        float s = 0.f;
#pragma unroll
        for (int j = 0; j < 4; ++j) s += (v[j][0] + v[j][1]) + (v[j][2] + v[j][3]);
        const float mu = wave_sum(s) * (1.0f / 1024.0f);
        float q = 0.f;
#pragma unroll
        for (int j = 0; j < 4; ++j) { v[j] = v[j] - mu; q += (v[j][0] * v[j][0] + v[j][1] * v[j][1]) + (v[j][2] * v[j][2] + v[j][3] * v[j][3]); }
        const float rs = rsqrtf(wave_sum(q) * (1.0f / 1024.0f) + LN_EPS_F);
#pragma unroll
        for (int j = 0; j < 4; ++j) v[j] = v[j] * rs * gv[j] + bv[j];
        u32x4 w0; w0.x = cvt_pk_bf16(v[0][0], v[0][1]); w0.y = cvt_pk_bf16(v[0][2], v[0][3]); w0.z = cvt_pk_bf16(v[1][0], v[1][1]); w0.w = cvt_pk_bf16(v[1][2], v[1][3]);
        u32x4 w1; w1.x = cvt_pk_bf16(v[2][0], v[2][1]); w1.y = cvt_pk_bf16(v[2][2], v[2][3]); w1.z = cvt_pk_bf16(v[3][0], v[3][1]); w1.w = cvt_pk_bf16(v[3][2], v[3][3]);
        *(u32x4*)(h1b + (size_t)t * DM + c0) = w0; *(u32x4*)(h1b + (size_t)t * DM + 512 + c0) = w1;
    }
}

__device__ __forceinline__ void phase_route(const Frame& F, const Args& a) {
    const int gw = F.vcu * 8 + F.wave, NGW = F.G * 8, lane = F_LANE;
    const float* logits = (const float*)(F.ws + WS_LOGITS); const float* rbias = KARG_IN(14);
    int* counts = (int*)(F.ctl + CW_COUNTS); int* tok_e = (int*)(F.ws + WS_TOKE); int* tok_pos = (int*)(F.ws + WS_TOKPOS); float* tok_gate = (float*)(F.ws + WS_TOKGATE);
    int* lists = (int*)(F.ws + WS_LISTS);
    const f32x4 rb = *(const f32x4*)(rbias + lane * 4);
    f32x4 lgn = *(const f32x4*)(logits + (size_t)(gw < T_TOK ? gw : 0) * 256 + lane * 4);
    int p_t = -1, p_e = 0, p_pos = 0;
    for (int t = gw; t < T_TOK; t += NGW) {
        const f32x4 lg = lgn;
        { const int tn = t + NGW < T_TOK ? t + NGW : t; lgn = *(const f32x4*)(logits + (size_t)tn * 256 + lane * 4); }
        float sc[4] = {sigmf(lg[0]), sigmf(lg[1]), sigmf(lg[2]), sigmf(lg[3])};
        float bs[4] = {sc[0] + rb[0], sc[1] + rb[1], sc[2] + rb[2], sc[3] + rb[3]};
        float m1 = fmaxf(bs[0], bs[1]), m2 = fminf(bs[0], bs[1]);
        { const float n1 = fmaxf(bs[2], bs[3]), n2 = fminf(bs[2], bs[3]);
          const float a1 = fmaxf(m1, n1), a2 = fmaxf(fminf(m1, n1), fmaxf(m2, n2)); m1 = a1; m2 = a2; }
        { const float n1 = dpp_f<0xB1>(m1), n2 = dpp_f<0xB1>(m2); const float a1 = fmaxf(m1, n1), a2 = fmaxf(fminf(m1, n1), fmaxf(m2, n2)); m1 = a1; m2 = a2; }
        { const float n1 = dpp_f<0x4E>(m1), n2 = dpp_f<0x4E>(m2); const float a1 = fmaxf(m1, n1), a2 = fmaxf(fminf(m1, n1), fmaxf(m2, n2)); m1 = a1; m2 = a2; }
        { const float n1 = dpp_f<0x141>(m1), n2 = dpp_f<0x141>(m2); const float a1 = fmaxf(m1, n1), a2 = fmaxf(fminf(m1, n1), fmaxf(m2, n2)); m1 = a1; m2 = a2; }
        const float gs = m1 + m2; const int mygrp = lane >> 3; int rank = 0;
#pragma unroll
        for (int gI = 0; gI < 8; ++gI) { const float og = rdlane_f(gs, gI * 8); rank += (og > gs || (og == gs && gI < mygrp)) ? 1 : 0; }
        const bool sel = rank < 4;
        float cand[4];
#pragma unroll
        for (int j = 0; j < 4; ++j) cand[j] = sel ? bs[j] : -INFINITY;
        int my_e = -1; float my_s = 0.f; float gsum = 0.f;
#pragma unroll
        for (int k = 0; k < 8; ++k) {
            const float mx = wave_max(fmaxf(fmaxf(cand[0], cand[1]), fmaxf(cand[2], cand[3])));
            int be = 1 << 20;
#pragma unroll
            for (int j = 0; j < 4; ++j) { const unsigned long long bm = __ballot(cand[j] == mx); const int ej = bm ? (__ffsll((long long)bm) - 1) * 4 + j : (1 << 20); be = ej < be ? ej : be; }
            be = __builtin_amdgcn_readfirstlane(be);
            const int wj = be & 3, bl = be >> 2;
            const float mysc = wj == 0 ? sc[0] : wj == 1 ? sc[1] : wj == 2 ? sc[2] : sc[3];
            const float wsc = rdlane_f(mysc, bl);
#pragma unroll
            for (int j = 0; j < 4; ++j) cand[j] = (lane == bl && j == wj) ? -INFINITY : cand[j];
            gsum += wsc;
            if (lane == k) { my_e = be; my_s = wsc; }
        }
        if (lane < 8) {
            if (p_t >= 0) { tok_pos[p_t * 8 + lane] = p_pos; lists[(size_t)p_e * LIST_CAP + p_pos] = p_t * 8 + lane; }
            const float gate = my_s / gsum * 2.5f;
            p_pos = atomicAdd(&counts[my_e * CNT_STRIDE], 1); p_e = my_e; p_t = t;
            tok_e[t * 8 + lane] = my_e; tok_gate[t * 8 + lane] = gate;
        }
    }
    if (lane < 8 && p_t >= 0) { tok_pos[p_t * 8 + lane] = p_pos; lists[(size_t)p_e * LIST_CAP + p_pos] = p_t * 8 + lane; }
}

__device__ __forceinline__ void build_tables(const Frame& F) {
    const int* counts = (const int*)(F.ctl + CW_COUNTS);
    LAS int* pref = (LAS int*)(F.lds + LDS_PREF); LAS int* offs = (LAS int*)(F.lds + LDS_OFFS); LAS int* cnt = (LAS int*)(F.lds + LDS_CNT);
    LAS int* wt = (LAS int*)(F.lds);
    const int tid = F_TID, lane = tid & 63;
    __syncthreads();
    int n = 0, nt = 0, in_ = 0, it_ = 0;
    if (F.wave < 4) {
        n = __hip_atomic_load(&counts[tid * CNT_STRIDE], __ATOMIC_RELAXED, __HIP_MEMORY_SCOPE_AGENT); nt = (n + 255) >> 8; in_ = n; it_ = nt;
#pragma unroll
        for (int o = 1; o < 64; o <<= 1) { const int a = __shfl_up(in_, o), b = __shfl_up(it_, o); if (lane >= o) { in_ += a; it_ += b; } }
        if (lane == 63) { wt[F.wave] = in_; wt[4 + F.wave] = it_; }
    }
    __syncthreads();
    if (F.wave < 4) {
        for (int w = 0; w < F.wave; ++w) { in_ += wt[w]; it_ += wt[4 + w]; }
        cnt[tid] = n; offs[tid] = in_ - n; pref[tid] = it_ - nt;
        if (tid == NEXP - 1) { offs[NEXP] = in_; pref[NEXP] = it_; }
    }
    __syncthreads();
}

__device__ __forceinline__ void phase_final(const Frame& F, const Args& a) {
    const int gw = F.vcu * 8 + F.wave, NGW = F.G * 8;
    const float* h1 = (const float*)(F.ws + WS_H1); const bf16_t* ys = (const bf16_t*)(F.ws + WS_YS); const bf16_t* yb = (const bf16_t*)(F.ws + WS_YB);
    const int* tok_e = (const int*)(F.ws + WS_TOKE); const int* tok_pos = (const int*)(F.ws + WS_TOKPOS);
    const LAS int* offs = (const LAS int*)(F.lds + LDS_OFFS);
    const float* g = KARG_IN(21); const float* b = KARG_IN(22); float* out = KARG_OUT();
    const int c0 = 8 * F_LANE;
    f32x4 gv[4], bv[4];
    gv[0] = *(const f32x4*)(g + c0); gv[1] = *(const f32x4*)(g + c0 + 4); gv[2] = *(const f32x4*)(g + 512 + c0); gv[3] = *(const f32x4*)(g + 512 + c0 + 4);
    bv[0] = *(const f32x4*)(b + c0); bv[1] = *(const f32x4*)(b + c0 + 4); bv[2] = *(const f32x4*)(b + 512 + c0); bv[3] = *(const f32x4*)(b + 512 + c0 + 4);
    const int lane8 = F_LANE;
    const bf16_t* h1b = (const bf16_t*)(F.ws + WS_H1B); const unsigned char* yb8 = (const unsigned char*)(F.ws + WS_YB);
    int ekn = 0, pkn = 0;
    if (gw < T_TOK && lane8 < 8) { ekn = tok_e[gw * 8 + lane8]; pkn = tok_pos[gw * 8 + lane8]; }
    for (int t = gw; t < T_TOK; t += NGW) {
        const int myrow = lane8 < 8 ? offs[ekn] + pkn : 0;
        const u32x4 r0 = *(const u32x4*)(h1b + (size_t)t * DM + c0), r1 = *(const u32x4*)(h1b + (size_t)t * DM + 512 + c0);
        const u32x4 s0 = *(const u32x4*)(ys + (size_t)t * DM + c0), s1 = *(const u32x4*)(ys + (size_t)t * DM + 512 + c0);
        u32x2 W[8][2];
#pragma unroll
        for (int k = 0; k < 8; ++k) { const unsigned char* src = yb8 + (size_t)__shfl(myrow, k) * 1024; W[k][0] = *(const u32x2*)(src + c0); W[k][1] = *(const u32x2*)(src + 512 + c0); }
        { const int tn = t + NGW; if (tn < T_TOK && lane8 < 8) { ekn = tok_e[tn * 8 + lane8]; pkn = tok_pos[tn * 8 + lane8]; } }
        f32x4 v[4], y[4];
        v[0] = (f32x4){bflo(r0.x), bfhi(r0.x), bflo(r0.y), bfhi(r0.y)}; v[1] = (f32x4){bflo(r0.z), bfhi(r0.z), bflo(r0.w), bfhi(r0.w)};
        v[2] = (f32x4){bflo(r1.x), bfhi(r1.x), bflo(r1.y), bfhi(r1.y)}; v[3] = (f32x4){bflo(r1.z), bfhi(r1.z), bflo(r1.w), bfhi(r1.w)};
#pragma unroll
        for (int j = 0; j < 4; ++j) { v[j] = v[j] * ALPHA_F; y[j] = (f32x4){0.f, 0.f, 0.f, 0.f}; }
        v[0] = v[0] + (f32x4){bflo(s0.x), bfhi(s0.x), bflo(s0.y), bfhi(s0.y)}; v[1] = v[1] + (f32x4){bflo(s0.z), bfhi(s0.z), bflo(s0.w), bfhi(s0.w)};
        v[2] = v[2] + (f32x4){bflo(s1.x), bfhi(s1.x), bflo(s1.y), bfhi(s1.y)}; v[3] = v[3] + (f32x4){bflo(s1.z), bfhi(s1.z), bflo(s1.w), bfhi(s1.w)};
#pragma unroll
        for (int k = 0; k < 8; ++k) { y[0] = y[0] + un4_fp8(W[k][0].x); y[1] = y[1] + un4_fp8(W[k][0].y); y[2] = y[2] + un4_fp8(W[k][1].x); y[3] = y[3] + un4_fp8(W[k][1].y); }
#pragma unroll
        for (int j = 0; j < 4; ++j) v[j] = v[j] + y[j] * (1.0f / YB_SCALE);
        float s = 0.f;
#pragma unroll
        for (int j = 0; j < 4; ++j) s += (v[j][0] + v[j][1]) + (v[j][2] + v[j][3]);
        const float mu = wave_sum(s) * (1.0f / 1024.0f);
        float q = 0.f;
#pragma unroll
        for (int j = 0; j < 4; ++j) { v[j] = v[j] - mu; q += (v[j][0] * v[j][0] + v[j][1] * v[j][1]) + (v[j][2] * v[j][2] + v[j][3] * v[j][3]); }
        const float rs = rsqrtf(wave_sum(q) * (1.0f / 1024.0f) + LN_EPS_F);
        float* o = out + (size_t)t * DM;
#pragma unroll
        for (int j = 0; j < 4; ++j) v[j] = v[j] * rs * gv[j] + bv[j];
        *(f32x4*)(o + c0) = v[0]; *(f32x4*)(o + c0 + 4) = v[1]; *(f32x4*)(o + 512 + c0) = v[2]; *(f32x4*)(o + 512 + c0 + 4) = v[3];
    }
}


namespace xk {
constexpr int B_IMG = 16384, A_SLOT = 16384, L_B0 = 0, L_A0 = 4 * B_IMG, L_GATE = 8 * 16384;
typedef __amdgpu_buffer_rsrc_t rsrc_t;
__device__ __forceinline__ rsrc_t make_rsrc(const void* p) { return __builtin_amdgcn_make_buffer_rsrc((void*)p, 0, 0x7fffffff, 0x00020000); }
__device__ __forceinline__ u32x4 make_srd(const void* p) { const unsigned long long v = (unsigned long long)p; u32x4 d;
    d.x = (unsigned)__builtin_amdgcn_readfirstlane((int)(unsigned)v); d.y = (unsigned)__builtin_amdgcn_readfirstlane((int)(unsigned)(v >> 32)) & 0xffffu; d.z = 0x7fffffffu; d.w = 0x00020000u; return d; }
__device__ __forceinline__ void dma16(const u32x4 srd, unsigned voff, int soff, unsigned lds_addr) {
    asm volatile("s_mov_b32 m0, %0\n\ts_nop 0\n\tbuffer_load_dwordx4 %1, %2, %3 offen lds" :: "s"(lds_addr), "v"(voff), "s"(srd), "s"(soff) : "m0", "memory");
}
__device__ __forceinline__ void a_piece_rc(int b, int& R, int& C) { const int st = b >> 10, sb = b & 1023, ob = sb ^ (((sb >> 9) & 1) << 5); R = st * 16 + (ob >> 6); C = (ob & 63) >> 1; }
struct PassDesc { u32x4 ra; unsigned aoff[2]; rsrc_t rb0, rb1; int bcol, ncol; unsigned boff; int nh; bool preloaded, chain; };
typedef f32x4 Acc[2][4][2][2];

template <bool GU> __device__ __forceinline__ void kloop(LAS unsigned char* lds, const PassDesc& P, const int wid, const int lane, const int bir, Acc& acc, f32x4 (&Br)[4][4]) {
    const int wr = wid >> 2, wc = wid & 3, fr = lane & 15, fq = lane >> 4, hl = lane >> 5;
    const int KB = GU ? 32 * 256 * 4 : 32 * 1024 * 4;
#define XK_DMAA(hh, slot) do { _Pragma("unroll") for (int _i = 0; _i < 2; ++_i) dma16(P.ra, P.aoff[_i], (hh) * 64, (unsigned)(size_t)(lds + L_A0 + (slot) * A_SLOT + _i * 8192 + wid * 1024)); } while (0)
#define XK_LOADB(col, hh, st) do { _Pragma("unroll") for (int _i = 0; _i < 4; ++_i) { \
            const u32x4 _v = GU ? __builtin_amdgcn_raw_buffer_load_b128((_i >> 1) ? P.rb1 : P.rb0, P.boff, (col) + (hh) * KB + (_i & 1) * (2 * 256 * 4), 0) \
                                : __builtin_amdgcn_raw_buffer_load_b128(P.rb0, P.boff, (col) + (hh) * KB + _i * (1024 * 4), 0); \
            Br[st][_i] = __builtin_bit_cast(f32x4, _v); } } while (0)
    const unsigned swg = (unsigned)(((wid >> 1) & 1) << 4);
    unsigned bw0 = (unsigned)(size_t)(lds + L_B0) + (GU ? (4 * wid + hl) * 512 + (bir ^ (hl << 7) ^ swg) : 4 * wid * 512 + (bir ^ swg));
    const int q = (lane & 15) >> 2, p = lane & 3;
    unsigned br0 = (unsigned)(size_t)(lds + L_B0) + (8 * fq + q) * 512 + ((128 * wc + 32 * p) ^ ((q & 1) << 7) ^ (((q >> 1) & 1) << 3) ^ ((fq & 1) << 4));
    const LAS unsigned char* arp = lds + L_A0 + (wr * 4) * 1024 + ((fr * 64 + 16 * fq) ^ ((fr >> 3) << 5));
#define XK_WRITEB(st, img) do { _Pragma("unroll") for (int _i = 0; _i < 4; ++_i) { u32x2 _w; _w.x = cvt_pk_bf16(Br[st][_i][0], Br[st][_i][1]); _w.y = cvt_pk_bf16(Br[st][_i][2], Br[st][_i][3]); \
        if (GU) *(LAS u32x2*)(size_t)((bw0 ^ (unsigned)(((_i >> 1) << 4) | ((_i & 1) << 3))) + (img) * B_IMG + 2 * (_i & 1) * 512) = _w; \
        else *(LAS u32x2*)(size_t)((bw0 ^ (unsigned)(((_i & 1) << 7) | (((_i >> 1) & 1) << 3))) + (img) * B_IMG + _i * 512) = _w; } } while (0)
#define XK_FRAGS(slot, img) do { \
        _Pragma("unroll") for (int gI = 0; gI < 2; ++gI) _Pragma("unroll") for (int nn = 0; nn < 2; ++nn) { \
            const LAS unsigned char* _a = (const LAS unsigned char*)(size_t)((br0 ^ (unsigned)(16 * gI + 8 * nn)) + (img) * B_IMG); \
            const s16x4 _lo = __builtin_amdgcn_ds_read_tr16_b64_v4i16((LAS s16x4*)_a), _hi = __builtin_amdgcn_ds_read_tr16_b64_v4i16((LAS s16x4*)(_a + 2048)); \
            wf[gI][nn] = (bf16x8){_lo[0], _lo[1], _lo[2], _lo[3], _hi[0], _hi[1], _hi[2], _hi[3]}; } \
        _Pragma("unroll") for (int ai = 0; ai < 2; ++ai) _Pragma("unroll") for (int m = 0; m < 4; ++m) xf[ai][m] = *(const LAS bf16x8*)(arp + (slot) * A_SLOT + (8 * ai + m) * 1024); } while (0)
#define XK_MMA() do { __builtin_amdgcn_s_setprio(1); \
        _Pragma("unroll") for (int ai = 0; ai < 2; ++ai) _Pragma("unroll") for (int m = 0; m < 4; ++m) _Pragma("unroll") for (int gI = 0; gI < 2; ++gI) _Pragma("unroll") for (int nn = 0; nn < 2; ++nn) \
            acc[ai][m][gI][nn] = __builtin_amdgcn_mfma_f32_16x16x32_bf16(wf[gI][nn], xf[ai][m], acc[ai][m][gI][nn], 0, 0, 0); \
        __builtin_amdgcn_s_setprio(0); } while (0)
    bf16x8 wf[2][2], xf[2][4];
    const int nh = P.nh;
    if (!P.preloaded) {
        XK_LOADB(P.bcol, 0, 0); XK_LOADB(P.bcol, 1, 1); XK_LOADB(P.bcol, 2, 2); XK_DMAA(0, 0); XK_DMAA(1, 1);
        XK_WRITEB(0, 0);
        asm volatile("s_waitcnt vmcnt(0)" ::: "memory");
        __syncthreads();
    }
    const int tcol = P.chain ? P.ncol : P.bcol;
    if (wid >= 4) __builtin_amdgcn_s_barrier();
#define XK_ITER(j) do { const int _h = hb + (j); asm volatile("" : "+v"(bw0), "+v"(br0));     \
        { const bool _in2 = _h + 2 < nh; XK_DMAA(_in2 ? _h + 2 : _h + 2 - nh, ((j) + 2) & 3); \
          const bool _in3 = _h + 3 < nh; XK_LOADB(_in3 ? P.bcol : tcol, _in3 ? _h + 3 : _h + 3 - nh, ((j) + 3) & 3); } \
        XK_WRITEB(((j) + 1) & 3, ((j) + 1) & 3); \
        XK_FRAGS((j), (j));        \
        asm volatile("s_waitcnt vmcnt(10)" ::: "memory");     \
        asm volatile("s_waitcnt lgkmcnt(0)" ::: "memory"); __builtin_amdgcn_sched_barrier(0); __builtin_amdgcn_s_barrier(); __builtin_amdgcn_sched_barrier(0); \
        XK_MMA(); \
        __builtin_amdgcn_sched_barrier(0); __builtin_amdgcn_s_barrier(); __builtin_amdgcn_sched_barrier(0); } while (0)
    for (int hb = 0; hb < nh; hb += 4) { XK_ITER(0); XK_ITER(1); XK_ITER(2); XK_ITER(3); }
    if (wid < 4) __builtin_amdgcn_s_barrier();
#undef XK_ITER
#undef XK_DMAA
#undef XK_LOADB
#undef XK_WRITEB
#undef XK_FRAGS
#undef XK_MMA
}
}

__device__ __forceinline__ void phase_experts(const Frame& F, const Args& a, const int mode) {
    build_tables(F);
    const int wid = F.wave, wr = wid >> 2, wc = wid & 3;
    const LAS int* pref = (const LAS int*)(F.lds + LDS_PREF);
    const int U = __builtin_amdgcn_readfirstlane(pref[NEXP]);
    const int* lists = (const int*)(F.ws + WS_LISTS); const float* tok_gate = (const float*)(F.ws + WS_TOKGATE);
    const char* h1b = (const char*)(F.ws + WS_H1B); bf16_t* H = (bf16_t*)(F.ws + WS_H); bf16_t* YB = (bf16_t*)(F.ws + WS_YB);
    f32x4 Br[4][4];
    for (int ui = 0;; ++ui) {
        int L = ui * F.G + blockIdx.x; if (L >= U) break;
        { const int qq = U / 8, rr = U % 8, xcd = L % 8, off = L / 8; L = (xcd < rr ? xcd * (qq + 1) : rr * (qq + 1) + (xcd - rr) * qq) + off; }
        int lo = 0, hi = NEXP;
        while (hi - lo > 1) { const int mid = (lo + hi) >> 1; const int pv = __builtin_amdgcn_readfirstlane(pref[mid]); if (pv <= L) lo = mid; else hi = mid; }
        const int e = lo, mt = L - __builtin_amdgcn_readfirstlane(pref[e]);
        const int n = __builtin_amdgcn_readfirstlane(((const LAS int*)(F.lds + LDS_CNT))[e]);
        const int rows = (n - mt * 256) < 256 ? (n - mt * 256) : 256;
        const int slot0 = __builtin_amdgcn_readfirstlane(((const LAS int*)(F.lds + LDS_OFFS))[e]) + mt * 256;
        const int* lst = lists + (size_t)e * LIST_CAP + mt * 256;
        const int ew = (mode & 1) ? 0 : e;
        const float* Wg = KARG_IN(15) + (size_t)ew * 1024 * 256; const float* Wu = KARG_IN(16) + (size_t)ew * 1024 * 256; const float* Wd = KARG_IN(17) + (size_t)ew * 256 * 1024;
        {
            xk::PassDesc P; P.ra = xk::make_srd(h1b);
            { const int lane = lane_id(), tid = wid * 64 + lane;
#pragma unroll
              for (int i = 0; i < 2; ++i) { int R, C; xk::a_piece_rc(tid * 16 + i * 8192, R, C); int tok = 0; if (R < rows) tok = lst[R] >> 3; if (mode & 2) tok = (slot0 + R) & 16383; P.aoff[i] = (unsigned)(tok * 1024 + C) * 2u; }
              P.boff = (unsigned)((4 * wid + (lane >> 5)) * 256 + 4 * (lane & 31)) * 4u; }
            P.nh = 32; P.rb0 = xk::make_rsrc(Wg); P.rb1 = xk::make_rsrc(Wu);
#pragma unroll 1
            for (int pn = 0; pn < 2; ++pn) {
                P.bcol = pn * 128 * 4; P.ncol = 128 * 4;
                P.preloaded = pn == 1; P.chain = pn == 0;
                xk::Acc acc;
#pragma unroll
                for (int ai = 0; ai < 2; ++ai)
#pragma unroll
                    for (int m = 0; m < 4; ++m)
#pragma unroll
                        for (int gI = 0; gI < 2; ++gI)
#pragma unroll
                            for (int nn = 0; nn < 2; ++nn) acc[ai][m][gI][nn] = (f32x4){0.f, 0.f, 0.f, 0.f};
                { const int lane = lane_id(); xk::kloop<true>(F.lds, P, wid, lane, 128 * ((lane & 31) >> 3) + 32 * (((lane & 31) >> 1) & 3) + 8 * (lane & 1), acc, Br); }
                const int lane = lane_id(), fr = lane & 15, fq = lane >> 4;
                const xk::rsrc_t rH = xk::make_rsrc(H + (size_t)slot0 * 256);
#pragma unroll
                for (int ai = 0; ai < 2; ++ai)
#pragma unroll
                    for (int m = 0; m < 4; ++m) { const int r = ai * 128 + wr * 64 + m * 16 + fr;
                        if (r < rows && !(mode & 4) && !(mode & 16)) { float h[8];
#pragma unroll
                            for (int nn = 0; nn < 2; ++nn)
#pragma unroll
                                for (int j = 0; j < 4; ++j) h[nn * 4 + j] = siluf(acc[ai][m][0][nn][j]) * acc[ai][m][1][nn][j];
                            u32x4 w; w.x = cvt_pk_bf16(h[0], h[1]); w.y = cvt_pk_bf16(h[2], h[3]); w.z = cvt_pk_bf16(h[4], h[5]); w.w = cvt_pk_bf16(h[6], h[7]);
                            __builtin_amdgcn_raw_buffer_store_b128(w, rH, (unsigned)(r * 256 + pn * 128 + wc * 32 + 8 * fq) * 2u, 0, 0); } }
            }
        }
        { const int t = wid * 64 + lane_id();
          if (t < 256) ((LAS float*)(F.lds + xk::L_GATE))[t] = t < rows ? tok_gate[lst[t]] : 0.f; }
        asm volatile("s_waitcnt vmcnt(0)" ::: "memory");
        __syncthreads();
        {
            xk::PassDesc P; P.ra = xk::make_srd(H + (size_t)slot0 * 256);
            { const int lane = lane_id(), tid = wid * 64 + lane;
#pragma unroll
              for (int i = 0; i < 2; ++i) { int R, C; xk::a_piece_rc(tid * 16 + i * 8192, R, C); P.aoff[i] = (unsigned)(R * 256 + C) * 2u; }
              P.boff = (unsigned)(4 * wid * 1024 + 4 * lane) * 4u; }
            P.nh = 8; P.rb0 = xk::make_rsrc(Wd); P.rb1 = P.rb0;
#pragma unroll 1
            for (int pn = 0; pn < 4; ++pn) {
                P.bcol = pn * 256 * 4; P.ncol = (pn + 1) * 256 * 4;
                P.preloaded = pn > 0; P.chain = pn < 3;
                xk::Acc acc;
#pragma unroll
                for (int ai = 0; ai < 2; ++ai)
#pragma unroll
                    for (int m = 0; m < 4; ++m)
#pragma unroll
                        for (int gI = 0; gI < 2; ++gI)
#pragma unroll
                            for (int nn = 0; nn < 2; ++nn) acc[ai][m][gI][nn] = (f32x4){0.f, 0.f, 0.f, 0.f};
                { const int lane = lane_id(); xk::kloop<false>(F.lds, P, wid, lane, 8 * lane, acc, Br); }
                const int lane = lane_id(), fr = lane & 15, fq = lane >> 4;
                const xk::rsrc_t rY = xk::make_rsrc((const unsigned char*)YB + (size_t)slot0 * 1024);
#pragma unroll
                for (int ai = 0; ai < 2; ++ai)
#pragma unroll
                    for (int m = 0; m < 4; ++m) { const int r = ai * 128 + wr * 64 + m * 16 + fr;
                        if (r < rows && !(mode & 4) && !(mode & 8)) { const float g = ((const LAS float*)(F.lds + xk::L_GATE))[r] * YB_SCALE;
                            u32x4 w; w.x = pk4_fp8(acc[ai][m][0][0] * g); w.y = pk4_fp8(acc[ai][m][0][1] * g); w.z = pk4_fp8(acc[ai][m][1][0] * g); w.w = pk4_fp8(acc[ai][m][1][1] * g);
                            __builtin_amdgcn_raw_buffer_store_b128(w, rY, (unsigned)(r * 1024 + pn * 256 + 64 * wc + 16 * fq), 0, 0); } }
            }
        }
        __syncthreads();
    }
}

__device__ __forceinline__ float ldp(const bf16_t* p, size_t t, int c) { return bf2f(p[t * PW + c]); }
__device__ __forceinline__ void phase_m1(const Frame& F, const Args& a) {
  const bf16_t* p = (const bf16_t*)(F.ws + WS_P); const float* dtraw = (const float*)(F.ws + WS_DTRAW);
  const float* conv_w = KARG_IN(2); const float* conv_b = KARG_IN(3); const float* dt_bias = KARG_IN(4); const float* lb_logits = KARG_IN(8);
  float* xbc = (float*)(F.ws + WS_NXBC); float* fgk = (float*)(F.ws + WS_NFGK); float* qs = (float*)(F.ws + WS_NQS); float* dtb = (float*)(F.ws + WS_NDTB);
  const int tid = F_TID;
  for (int t = blockIdx.x; t < T_TOK; t += F.G) {
    for (int c = tid; c < 1024; c += 512) {
      float acc = conv_b[c];
#pragma unroll
      for (int j = 0; j < 4; ++j) { const int tt = t - 3 + j; if (tt >= 0) acc = fmaf(conv_w[j * 1024 + c], ldp(p, tt, PC_XBC + c), acc); }
      xbc[(size_t)t * 1024 + c] = siluf(acc);
    }
    { const int c = tid;
      const float l0 = lb_logits[c], l1 = lb_logits[512 + c];
      const float mx = fmaxf(l0, l1);
      const float e0 = expf(l0 - mx), e1 = expf(l1 - mx);
      const float lb = e0 / (e0 + e1);
      const float f = ldp(p, t, PC_F + c);
      fgk[(size_t)t * 512 + c] = lb + (1.0f - lb) * (1.0f / (1.0f + expf(-f)));
      const float q = ldp(p, t, PC_Q + c);
      qs[(size_t)t * 512 + c] = q / (1.0f + expf(-q)); }
    if (tid < 8) { const float v = dtraw[t * 8 + tid] + dt_bias[tid]; dtb[t * 8 + tid] = v > 20.f ? v : log1pf(expf(v)); }
  }
}
__device__ __forceinline__ void phase_m2(const Frame& F, const Args& a) {
  const int item = F.wave * F.G + blockIdx.x, lane = F_LANE;
  const float* xbc = (const float*)(F.ws + WS_NXBC); const float* dtb = (const float*)(F.ws + WS_NDTB);
  const float* fgk = (const float*)(F.ws + WS_NFGK); const float* qs = (const float*)(F.ws + WS_NQS); const bf16_t* p = (const bf16_t*)(F.ws + WS_P);
  float* y_ssd = (float*)(F.ws + WS_NYSSD); float* o_h = (float*)(F.ws + WS_NOH);
  if (item < 512) {
    const int h = item >> 6, pp = item & 63, g = h >> 2;
    const float aa = -expf(KARG_IN(5)[h]), D = KARG_IN(6)[h];
    float h0 = 0.f, h1 = 0.f;
    const float* xp = xbc + h * 64 + pp; const float* Bp = xbc + 512 + g * 128 + lane; const float* Cp = xbc + 768 + g * 128 + lane;
    for (int t0 = 0; t0 < T_TOK; t0 += 8) {
      float Bv0[8], Bv1[8], Cv0[8], Cv1[8], xv[8], dv[8];
#pragma unroll
      for (int i = 0; i < 8; ++i) { const size_t o = (size_t)(t0 + i) * 1024;
        Bv0[i] = Bp[o]; Bv1[i] = Bp[o + 64]; Cv0[i] = Cp[o]; Cv1[i] = Cp[o + 64]; xv[i] = xp[o]; dv[i] = dtb[(t0 + i) * 8 + h]; }
#pragma unroll
      for (int i = 0; i < 8; ++i) {
        const float dA = expf(dv[i] * aa), dx = dv[i] * xv[i];
        h0 = fmaf(dA, h0, dx * Bv0[i]); h1 = fmaf(dA, h1, dx * Bv1[i]);
        float part = wave_sum(Cv0[i] * h0 + Cv1[i] * h1);
        if (lane == 0) y_ssd[(size_t)(t0 + i) * 512 + h * 64 + pp] = part + D * xv[i];
      }
    }
  } else if (item < 1024) {
    const int it = item - 512, h = it >> 7, e = it & 127;
    float S0 = 0.f, S1 = 0.f;
    const float* fp = fgk + h * 128 + lane; const float* qp = qs + h * 128 + lane;
    for (int t0 = 0; t0 < T_TOK; t0 += 8) {
      float f0[8], f1[8], q0[8], q1[8], iv[8];
#pragma unroll
      for (int i = 0; i < 8; ++i) { const size_t o = (size_t)(t0 + i) * 512;
        f0[i] = fp[o]; f1[i] = fp[o + 64]; q0[i] = qp[o]; q1[i] = qp[o + 64]; iv[i] = ldp(p, t0 + i, PC_I + h * 128 + e); }
#pragma unroll
      for (int i = 0; i < 8; ++i) {
        S0 = fmaf(f0[i], S0, (1.0f - f0[i]) * iv[i]); S1 = fmaf(f1[i], S1, (1.0f - f1[i]) * iv[i]);
        float part = wave_sum(q0[i] * S0 + q1[i] * S1);
        if (lane == 0) o_h[(size_t)(t0 + i) * 512 + h * 128 + e] = part;
      }
    }
  }
}
__device__ __forceinline__ void phase_m3(const Frame& F, const Args& a) {
  const int gw = F.vcu * 8 + F.wave, NGW = F.G * 8, lane = F_LANE;
  const float* y_ssd = (const float*)(F.ws + WS_NYSSD); const float* o_h = (const float*)(F.ws + WS_NOH); const bf16_t* p = (const bf16_t*)(F.ws + WS_P);
  const float* snw = KARG_IN(7); const float* hnw = KARG_IN(9); bf16_t* mix = (bf16_t*)(F.ws + WS_MIX);
  for (int idx = gw; idx < T_TOK * 2; idx += NGW) {
    const int t = idx >> 1, g = idx & 1;
    float v[4]; float ss = 0.f;
#pragma unroll
    for (int j = 0; j < 4; ++j) { const int c = g * 256 + lane + 64 * j; v[j] = y_ssd[(size_t)t * 512 + c] * siluf(ldp(p, t, PC_Z + c)); ss += v[j] * v[j]; }
    ss = wave_sum(ss);
    const float r = rsqrtf(ss * (1.0f / 256.0f) + RMS_EPS_F);
#pragma unroll
    for (int j = 0; j < 4; ++j) { const int c = g * 256 + lane + 64 * j; mix[(size_t)t * 1024 + c] = (bf16_t)(cvt_pk_bf16(v[j] * r * snw[c], 0.f) & 0xffffu); }
  }
  for (int idx = gw; idx < T_TOK * 4; idx += NGW) {
    const int t = idx >> 2, h = idx & 3;
    float v[2]; float ss = 0.f;
#pragma unroll
    for (int j = 0; j < 2; ++j) { const int c = h * 128 + lane + 64 * j; v[j] = o_h[(size_t)t * 512 + c]; ss += v[j] * v[j]; }
    ss = wave_sum(ss);
    const float r = rsqrtf(ss * (1.0f / 128.0f) + RMS_EPS_F);
#pragma unroll
    for (int j = 0; j < 2; ++j) { const int c = h * 128 + lane + 64 * j;
      mix[(size_t)t * 1024 + 512 + c] = (bf16_t)(cvt_pk_bf16(v[j] * r * hnw[c] * siluf(ldp(p, t, PC_G + c)), 0.f) & 0xffffu); }
  }
}


#define MFMA32(a, b, c) __builtin_amdgcn_mfma_f32_32x32x16_bf16((a), (b), (c), 0, 0, 0)
__device__ __forceinline__ int drow(int r, int lane) { return (r & 3) + 8 * (r >> 2) + 4 * (lane >> 5); }
__device__ __forceinline__ bf16x8 frag_row(const LAS unsigned char* base, int pitch, int row0, int k0, int lane) {
    return *(const LAS bf16x8*)(base + (row0 + (lane & 31)) * pitch + (k0 + 8 * (lane >> 5)) * 2);
}
template <bool PERM> __device__ __forceinline__ bf16x8 frag_tr(const LAS unsigned char* base, int pitch, int k0, int col0, int lane) {
    const int h = lane >> 5, blk = (lane >> 4) & 1, q = (lane & 15) >> 2, p = lane & 3;
    const LAS unsigned char* a0 = base + (k0 + (PERM ? 4 : 8) * h + q) * pitch + (col0 + 16 * blk + 4 * p) * 2;
    const s16x4 lo = __builtin_amdgcn_ds_read_tr16_b64_v4i16((LAS s16x4*)a0);
    const s16x4 hi = __builtin_amdgcn_ds_read_tr16_b64_v4i16((LAS s16x4*)(a0 + (PERM ? 8 : 4) * pitch));
    return (bf16x8){lo[0], lo[1], lo[2], lo[3], hi[0], hi[1], hi[2], hi[3]};
}
__device__ __forceinline__ bf16x8 acc_frag(const f32x16& x, int s) {
    u32x4 w; w.x = cvt_pk_bf16(x[8 * s + 0], x[8 * s + 1]); w.y = cvt_pk_bf16(x[8 * s + 2], x[8 * s + 3]); w.z = cvt_pk_bf16(x[8 * s + 4], x[8 * s + 5]); w.w = cvt_pk_bf16(x[8 * s + 6], x[8 * s + 7]);
    return __builtin_bit_cast(bf16x8, w);
}
__device__ __forceinline__ float softplusf(float v) { return v > 20.f ? v : log1pf(__expf(v)); }
__device__ __forceinline__ unsigned short f2bf1(float v) { return (unsigned short)(cvt_pk_bf16(v, 0.f) & 0xffffu); }
__device__ __forceinline__ float half_sum(float v) {
#pragma unroll
    for (int o = 1; o < 32; o <<= 1) v += __shfl_xor(v, o);
    return v;
}

constexpr int SX_PITCH = 576, SB_TR_PITCH = 320, SB_ROW_PITCH = 272;
constexpr int SL_X = 0, SL_B = 128 * SX_PITCH  , SL_C = SL_B + 128 * SB_TR_PITCH  ;
constexpr int SL_DT = 151552, SL_ACUM = SL_DT + 2048, SL_SSQ = SL_ACUM + 2048;
static_assert(SL_C + 128 * SB_ROW_PITCH <= SL_DT && SL_SSQ + 1024 <= LDS_PHASE_BYTES, "SSD LDS map");
constexpr int HL_QD = 0, HL_QP = 64 * 272, HL_KP = 2 * 64 * 272, HL_V = 3 * 64 * 272  , HL_KD = HL_V + 64 * 320  , HL_SEG = HL_KD + 64 * 320  , HL_SSQ = HL_SEG + 4096;
static_assert(HL_SSQ + 1024 <= LDS_PHASE_BYTES, "HGRN LDS map");

__device__ __forceinline__ void ssd_dt_acum(const Frame& F, const Args& a, int c, int g) {
    if (F.wave < 4) {
        const int hh = g * 4 + F.wave, lane = F_LANE; const float* dtraw = (const float*)(F.ws + WS_DTRAW);
        const float bias = KARG_IN(4)[hh], aa = -__expf(KARG_IN(5)[hh]);
        const int t = c * 128 + 2 * lane;
        const float d0 = softplusf(dtraw[(size_t)t * 8 + hh] + bias), d1 = softplusf(dtraw[(size_t)(t + 1) * 8 + hh] + bias);
        const float a0 = d0 * aa, a1 = d1 * aa;
        float incl = a0 + a1;
#pragma unroll
        for (int o = 1; o < 64; o <<= 1) { const float v = __shfl_up(incl, o); if (lane >= o) incl += v; }
        LAS float* dts = (LAS float*)(F.lds + SL_DT) + F.wave * 128; LAS float* acs = (LAS float*)(F.lds + SL_ACUM) + F.wave * 128;
        dts[2 * lane] = d0; dts[2 * lane + 1] = d1; acs[2 * lane] = incl - a1; acs[2 * lane + 1] = incl;
    }
}
__device__ __forceinline__ void ssd_conv_item(const Frame& F, const Args& a, int c, int src_ch, int seg, int hl, int mode, LAS unsigned char* dst, int pitch, int dst_col) {
    const bf16_t* p = (const bf16_t*)(F.ws + WS_P) + PC_XBC + src_ch;
    const float* cw = KARG_IN(2) + src_ch; const float* cb = KARG_IN(3) + src_ch;
    float w[4][8], bias[8];
#pragma unroll
    for (int j = 0; j < 4; ++j) { const f32x4 x0 = *(const f32x4*)(cw + j * 1024), x1 = *(const f32x4*)(cw + j * 1024 + 4);
        w[j][0] = x0[0]; w[j][1] = x0[1]; w[j][2] = x0[2]; w[j][3] = x0[3]; w[j][4] = x1[0]; w[j][5] = x1[1]; w[j][6] = x1[2]; w[j][7] = x1[3]; }
    { const f32x4 x0 = *(const f32x4*)cb, x1 = *(const f32x4*)(cb + 4); bias[0] = x0[0]; bias[1] = x0[1]; bias[2] = x0[2]; bias[3] = x0[3]; bias[4] = x1[0]; bias[5] = x1[1]; bias[6] = x1[2]; bias[7] = x1[3]; }
    const int l0 = seg * 16, t0 = c * 128 + l0;
    u32x4 rw[19];
#pragma unroll
    for (int j = 0; j < 19; ++j) { const int tt = t0 - 3 + j; rw[j] = tt >= 0 ? *(const u32x4*)(p + (size_t)tt * PW) : (u32x4){0u, 0u, 0u, 0u}; }
    const LAS float* dts = (const LAS float*)(F.lds + SL_DT) + hl * 128; const LAS float* acs = (const LAS float*)(F.lds + SL_ACUM) + hl * 128;
    const float alast = acs[127];
#pragma unroll
    for (int i = 0; i < 16; ++i) {
        float v[8];
#pragma unroll
        for (int k = 0; k < 4; ++k) {
            const unsigned r0 = rw[i][k], r1 = rw[i + 1][k], r2 = rw[i + 2][k], r3 = rw[i + 3][k];
            v[2 * k] = siluf(fmaf(w[3][2 * k], bflo(r3), fmaf(w[2][2 * k], bflo(r2), fmaf(w[1][2 * k], bflo(r1), fmaf(w[0][2 * k], bflo(r0), bias[2 * k])))));
            v[2 * k + 1] = siluf(fmaf(w[3][2 * k + 1], bfhi(r3), fmaf(w[2][2 * k + 1], bfhi(r2), fmaf(w[1][2 * k + 1], bfhi(r1), fmaf(w[0][2 * k + 1], bfhi(r0), bias[2 * k + 1])))));
        }
        float sc = 1.f;
        if (mode >= 1) sc = dts[l0 + i];
        if (mode == 2) sc *= __expf(alast - acs[l0 + i]);
        u32x4 o; o.x = cvt_pk_bf16(v[0] * sc, v[1] * sc); o.y = cvt_pk_bf16(v[2] * sc, v[3] * sc); o.z = cvt_pk_bf16(v[4] * sc, v[5] * sc); o.w = cvt_pk_bf16(v[6] * sc, v[7] * sc);
        *(LAS u32x4*)(dst + (l0 + i) * pitch + dst_col * 2) = o;
    }
}

__device__ __forceinline__ void ssd_states_unit(const Frame& F, const Args& a, int c, int g) {
    const int tid = F_TID, lane = F_LANE;
    __syncthreads();
    ssd_dt_acum(F, a, c, g);
    __syncthreads();
    { const int cg = tid & 63, seg = tid >> 6; const bool isx = cg < 32;
      if (cg < 48) ssd_conv_item(F, a, c, isx ? g * 256 + cg * 8 : 512 + g * 128 + (cg - 32) * 8, seg, isx ? (cg >> 3) : 0, isx ? 2 : 0,
                                 F.lds + (isx ? SL_X : SL_B), isx ? SX_PITCH : SB_TR_PITCH, isx ? cg * 8 : (cg - 32) * 8); }
    __syncthreads();
    const int hl = F.wave >> 1, pt = F.wave & 1, hh = g * 4 + hl;
    f32x16 S[4];
#pragma unroll
    for (int nt = 0; nt < 4; ++nt)
#pragma unroll
        for (int r = 0; r < 16; ++r) S[nt][r] = 0.f;
#pragma unroll 2
    for (int ks = 0; ks < 8; ++ks) {
        const bf16x8 A = frag_tr<false>(F.lds + SL_X, SX_PITCH, 16 * ks, hl * 64 + 32 * pt, lane);
#pragma unroll
        for (int nt = 0; nt < 4; ++nt) { const bf16x8 B = frag_tr<false>(F.lds + SL_B, SB_TR_PITCH, 16 * ks, 32 * nt, lane); S[nt] = MFMA32(A, B, S[nt]); }
    }
    float* st = (float*)(F.ws + WS_SSTATE) + ((size_t)(c * 8 + hh) * 64 + 32 * pt) * 128;
#pragma unroll
    for (int nt = 0; nt < 4; ++nt)
#pragma unroll
        for (int r = 0; r < 16; ++r) st[(size_t)drow(r, lane) * 128 + 32 * nt + (lane & 31)] = S[nt][r];
    if (tid < 4) ((float*)(F.ws + WS_CDECAY))[c * 8 + g * 4 + tid] = __expf(((const LAS float*)(F.lds + SL_ACUM))[tid * 128 + 127]);
}

__device__ __forceinline__ void ssd_out_unit(const Frame& F, const Args& a, int c, int g, const int xm = 0) {
    const int lane = F_LANE;
    __syncthreads();
    ssd_dt_acum(F, a, c, g);
    __syncthreads();
    if (!(xm & 4)) { const int tid = F_TID, cg = tid & 63, seg = tid >> 6; const bool isx = cg < 32, isb = cg < 48;
      ssd_conv_item(F, a, c, isx ? g * 256 + cg * 8 : (isb ? 512 + g * 128 + (cg - 32) * 8 : 768 + g * 128 + (cg - 48) * 8), seg, isx ? (cg >> 3) : 0, isx ? 1 : 0,
                    F.lds + (isx ? SL_X : (isb ? SL_B : SL_C)), isx ? SX_PITCH : SB_ROW_PITCH, isx ? cg * 8 : (isb ? (cg - 32) * 8 : (cg - 48) * 8)); }
    __syncthreads();
    const int lt = F.wave >> 1, hp = F.wave & 1;
    const int lcol = 32 * lt + (lane & 31);
    f32x16 acc[2][2];
#pragma unroll
    for (int hi = 0; hi < 2; ++hi)
#pragma unroll
        for (int pt = 0; pt < 2; ++pt)
#pragma unroll
            for (int r = 0; r < 16; ++r) acc[hi][pt][r] = 0.f;
    if (!(xm & 8))
#pragma unroll
    for (int hi = 0; hi < 2; ++hi) {
        const int hl = hp * 2 + hi, hh = g * 4 + hl;
        const bf16_t* sp = (const bf16_t*)(F.ws + WS_SPREV) + (size_t)(c * 8 + hh) * 64 * 128 + (size_t)(lane & 31) * 128 + 8 * (lane >> 5);
        bf16x8 Bsv[2][8];
#pragma unroll
        for (int pt = 0; pt < 2; ++pt)
#pragma unroll
            for (int ks = 0; ks < 8; ++ks) Bsv[pt][ks] = *(const bf16x8*)(sp + (size_t)(32 * pt) * 128 + 16 * ks);
#pragma unroll
        for (int ks = 0; ks < 8; ++ks) {
            const bf16x8 A = frag_row(F.lds + SL_C, SB_ROW_PITCH, 32 * lt, 16 * ks, lane);
#pragma unroll
            for (int pt = 0; pt < 2; ++pt) acc[hi][pt] = MFMA32(A, Bsv[pt][ks], acc[hi][pt]);
        }
        const LAS float* acs = (const LAS float*)(F.lds + SL_ACUM) + hl * 128;
#pragma unroll
        for (int r = 0; r < 16; ++r) { const float e = __expf(acs[32 * lt + drow(r, lane)]); acc[hi][0][r] *= e; acc[hi][1][r] *= e; }
    }
    float dskip[2]; { const float* dsp = KARG_IN(6); dskip[0] = dsp[g * 4 + hp * 2]; dskip[1] = dsp[g * 4 + hp * 2 + 1]; }
#pragma unroll 1
    for (int st = (xm & 16) ? lt + 1 : 0; st <= lt; ++st) {
        f32x16 GT;
#pragma unroll
        for (int r = 0; r < 16; ++r) GT[r] = 0.f;
#pragma unroll 2
        for (int ks = 0; ks < 8; ++ks) {
            const bf16x8 A = frag_row(F.lds + SL_B, SB_ROW_PITCH, 32 * st, 16 * ks, lane), B = frag_row(F.lds + SL_C, SB_ROW_PITCH, 32 * lt, 16 * ks, lane);
            GT = MFMA32(A, B, GT);
        }
#pragma unroll
        for (int hi = 0; hi < 2; ++hi) {
            const int hl = hp * 2 + hi, hh = g * 4 + hl;
            const LAS float* dts = (const LAS float*)(F.lds + SL_DT) + hl * 128; const LAS float* acs = (const LAS float*)(F.lds + SL_ACUM) + hl * 128;
            const float al = acs[lcol], dsk = dskip[hi] * __builtin_amdgcn_rcpf(dts[lcol]);
            f32x16 M;
#pragma unroll
            for (int r = 0; r < 16; ++r) { const int srow = 32 * st + drow(r, lane);
                float v = srow <= lcol ? GT[r] * __expf(al - acs[srow]) : 0.f;
                if (srow == lcol) v += dsk;
                M[r] = v; }
#pragma unroll
            for (int s2 = 0; s2 < 2; ++s2) { const bf16x8 A = acc_frag(M, s2);
#pragma unroll
                for (int pt = 0; pt < 2; ++pt) { const bf16x8 B = frag_tr<true>(F.lds + SL_X, SX_PITCH, 32 * st + 16 * s2, hl * 64 + 32 * pt, lane); acc[hi][pt] = MFMA32(A, B, acc[hi][pt]); } }
        }
    }
    float ssq[16];
#pragma unroll
    for (int r = 0; r < 16; ++r) ssq[r] = 0.f;
    if (!(xm & 32)) {
        const bf16_t* pz = (const bf16_t*)(F.ws + WS_P) + (size_t)(c * 128 + 32 * lt) * PW + PC_Z + g * 256 + hp * 128 + (lane & 31);
#pragma unroll
        for (int hi = 0; hi < 2; ++hi)
#pragma unroll
            for (int pt = 0; pt < 2; ++pt)
#pragma unroll
                for (int r = 0; r < 16; ++r) { const float z = bf2f(pz[(size_t)drow(r, lane) * PW + hi * 64 + 32 * pt]);
                    const float y = acc[hi][pt][r] * siluf(z); acc[hi][pt][r] = y; ssq[r] += y * y; }
    }
    LAS float* ssqs = (LAS float*)(F.lds + SL_SSQ);
#pragma unroll
    for (int r = 0; r < 16; ++r) { const float sm = half_sum(ssq[r]); if ((lane & 31) == 0) ssqs[F.wave * 32 + drow(r, lane)] = sm; }
    __syncthreads();
    const float* nw = KARG_IN(7) + g * 256 + hp * 128 + (lane & 31);
#pragma unroll
    for (int r = 0; r < 16; ++r) { const int row = drow(r, lane);
        const float rs = rsqrtf((ssqs[F.wave * 32 + row] + ssqs[(F.wave ^ 1) * 32 + row]) * (1.0f / 256.0f) + RMS_EPS_F);
#pragma unroll
        for (int hi = 0; hi < 2; ++hi)
#pragma unroll
            for (int pt = 0; pt < 2; ++pt) *(LAS unsigned short*)(F.lds + SL_X + (32 * lt + row) * 528 + (hp * 128 + hi * 64 + 32 * pt + (lane & 31)) * 2) = f2bf1(acc[hi][pt][r] * rs * nw[hi * 64 + 32 * pt]); }
    __syncthreads();
    { const int tid = F_TID; bf16_t* mo = (bf16_t*)(F.ws + WS_MIX) + (size_t)(c * 128) * DM + g * 256;
#pragma unroll
      for (int i = 0; i < 8; ++i) { const int pc = tid + 512 * i, row = pc >> 5, ch = (pc & 31) * 8;
          *(u32x4*)(mo + (size_t)row * DM + ch) = *(const LAS u32x4*)(F.lds + SL_X + row * 528 + ch * 2); } }
}

struct HgrnLocal { float fg[8][2], cum[8][2], qv[8][2], iv[8][2], tot[2], mid[2]; };
struct HgrnRaw { unsigned fw[8], iw[8], qw[8]; };
template <bool NEEDQ> __device__ __forceinline__ void hgrn_fetch(const Frame& F, int c, int h, HgrnRaw& R) {
    const int tid = F_TID, cp = tid & 63, seg = tid >> 6, d0 = 2 * cp;
    const bf16_t* p = (const bf16_t*)(F.ws + WS_P) + (size_t)(c * 64 + seg * 8) * PW + h * 128 + d0;
#pragma unroll
    for (int i = 0; i < 8; ++i) { R.fw[i] = *(const unsigned*)(p + (size_t)i * PW + PC_F); R.iw[i] = *(const unsigned*)(p + (size_t)i * PW + PC_I);
        if (NEEDQ) R.qw[i] = *(const unsigned*)(p + (size_t)i * PW + PC_Q); }
}
__device__ __forceinline__ void hgrn_lb(const Frame& F, int h, float (&lb)[2]) {
    const int d0 = 2 * (F_TID & 63); const float* lg = KARG_IN(8);
#pragma unroll
    for (int j = 0; j < 2; ++j) { const float l0 = lg[h * 128 + d0 + j], l1 = lg[512 + h * 128 + d0 + j]; const float mx = fmaxf(l0, l1), e0 = __expf(l0 - mx), e1 = __expf(l1 - mx); lb[j] = e0 / (e0 + e1); }
}
template <bool NEEDQ> __device__ __forceinline__ void hgrn_load(const Frame& F, const Args& a, int h, const HgrnRaw& R, HgrnLocal& L, const float (&lb)[2]) {
    const int tid = F_TID, cp = tid & 63, seg = tid >> 6, d0 = 2 * cp;
    float run[2] = {0.f, 0.f};
#pragma unroll
    for (int i = 0; i < 8; ++i) {
        const unsigned fw = R.fw[i], iw = R.iw[i];
        const float fr[2] = {bflo(fw), bfhi(fw)};
        L.iv[i][0] = bflo(iw); L.iv[i][1] = bfhi(iw);
        if (NEEDQ) { const unsigned qw = R.qw[i]; L.qv[i][0] = siluf(bflo(qw)); L.qv[i][1] = siluf(bfhi(qw)); }
#pragma unroll
        for (int j = 0; j < 2; ++j) { const float fg = lb[j] + (1.0f - lb[j]) * sigmf(fr[j]); L.fg[i][j] = fg; run[j] += __logf(fg); L.cum[i][j] = run[j]; }
    }
    LAS float* segs = (LAS float*)(F.lds + HL_SEG);
    segs[seg * 128 + d0] = run[0]; segs[seg * 128 + d0 + 1] = run[1];
    __syncthreads();
    float pre[2] = {0.f, 0.f}, tot[2] = {0.f, 0.f}, mid[2] = {0.f, 0.f};
#pragma unroll
    for (int s2 = 0; s2 < 8; ++s2) {
#pragma unroll
        for (int j = 0; j < 2; ++j) { const float v = segs[s2 * 128 + d0 + j]; tot[j] += v; if (s2 < seg) pre[j] += v; if (s2 < 4) mid[j] += v; }
    }
#pragma unroll
    for (int i = 0; i < 8; ++i)
#pragma unroll
        for (int j = 0; j < 2; ++j) L.cum[i][j] += pre[j];
    L.tot[0] = tot[0]; L.tot[1] = tot[1]; L.mid[0] = mid[0]; L.mid[1] = mid[1];
}

__device__ __forceinline__ void hgrn_states_unit(const Frame& F, const Args& a, int c, int h, const HgrnRaw& R, const float (&lb)[2]) {
    const int tid = F_TID, lane = F_LANE, cp = tid & 63, seg = tid >> 6, d0 = 2 * cp;
    __syncthreads();
    HgrnLocal L; hgrn_load<false>(F, a, h, R, L, lb);
#pragma unroll
    for (int i = 0; i < 8; ++i) { const int t = seg * 8 + i;
        *(LAS unsigned*)(F.lds + HL_KD + t * 320 + d0 * 2) = cvt_pk_bf16((1.0f - L.fg[i][0]) * __expf(L.tot[0] - L.cum[i][0]), (1.0f - L.fg[i][1]) * __expf(L.tot[1] - L.cum[i][1]));
        *(LAS unsigned*)(F.lds + HL_V + t * 320 + d0 * 2) = cvt_pk_bf16(L.iv[i][0], L.iv[i][1]); }
    if (seg == 0) { float* hd = (float*)(F.ws + WS_HDECAY) + (size_t)(c * 4 + h) * 128 + d0; hd[0] = __expf(L.tot[0]); hd[1] = __expf(L.tot[1]); }
    __syncthreads();
    const int et = F.wave >> 1, dh = F.wave & 1;
    f32x16 acc[2];
#pragma unroll
    for (int dj = 0; dj < 2; ++dj)
#pragma unroll
        for (int r = 0; r < 16; ++r) acc[dj][r] = 0.f;
#pragma unroll
    for (int ks = 0; ks < 4; ++ks) {
        const bf16x8 A = frag_tr<false>(F.lds + HL_V, 320, 16 * ks, 32 * et, lane);
#pragma unroll
        for (int dj = 0; dj < 2; ++dj) { const bf16x8 B = frag_tr<false>(F.lds + HL_KD, 320, 16 * ks, 32 * (2 * dh + dj), lane); acc[dj] = MFMA32(A, B, acc[dj]); }
    }
    float* kv = (float*)(F.ws + WS_HKV) + ((size_t)(c * 4 + h) * 128 + 32 * et) * 128;
#pragma unroll
    for (int dj = 0; dj < 2; ++dj)
#pragma unroll
        for (int r = 0; r < 16; ++r) kv[(size_t)drow(r, lane) * 128 + 32 * (2 * dh + dj) + (lane & 31)] = acc[dj][r];
}

__device__ __forceinline__ void hgrn_out_unit(const Frame& F, const Args& a, int c, int h, const HgrnRaw& R, const float (&lb)[2]) {
    const int tid = F_TID, lane = F_LANE, cp = tid & 63, seg = tid >> 6, d0 = 2 * cp;
    const int tt = F.wave >> 2, et = F.wave & 3;
    bf16x8 Bs[8];
    { const bf16_t* sp = (const bf16_t*)(F.ws + WS_HSPREV) + ((size_t)(c * 4 + h) * 128 + 32 * et) * 128 + (size_t)(lane & 31) * 128 + 8 * (lane >> 5);
#pragma unroll
      for (int ks = 0; ks < 8; ++ks) Bs[ks] = *(const bf16x8*)(sp + 16 * ks); }
    const int e = 32 * et + (lane & 31);
    unsigned short gv[16];
    { const bf16_t* pg = (const bf16_t*)(F.ws + WS_P) + (size_t)(c * 64 + 32 * tt) * PW + PC_G + h * 128 + e;
#pragma unroll
      for (int r = 0; r < 16; ++r) gv[r] = pg[(size_t)drow(r, lane) * PW]; }
    const float nw = KARG_IN(9)[h * 128 + e];
    __syncthreads();
    HgrnLocal L; hgrn_load<true>(F, a, h, R, L, lb);
#pragma unroll
    for (int i = 0; i < 8; ++i) { const int t = seg * 8 + i;
        float qd[2], qp[2], kp[2];
#pragma unroll
        for (int j = 0; j < 2; ++j) { qd[j] = L.qv[i][j] * __expf(L.cum[i][j]); qp[j] = L.qv[i][j] * __expf(L.cum[i][j] - L.mid[j]); kp[j] = (1.0f - L.fg[i][j]) * __expf(L.mid[j] - L.cum[i][j]); }
        *(LAS unsigned*)(F.lds + HL_QD + t * 272 + d0 * 2) = cvt_pk_bf16(qd[0], qd[1]);
        *(LAS unsigned*)(F.lds + HL_QP + t * 272 + d0 * 2) = cvt_pk_bf16(qp[0], qp[1]);
        *(LAS unsigned*)(F.lds + HL_KP + t * 272 + d0 * 2) = cvt_pk_bf16(kp[0], kp[1]);
        *(LAS unsigned*)(F.lds + HL_V + t * 320 + d0 * 2) = cvt_pk_bf16(L.iv[i][0], L.iv[i][1]); }
    __syncthreads();
    f32x16 acc;
#pragma unroll
    for (int r = 0; r < 16; ++r) acc[r] = 0.f;
#pragma unroll
    for (int ks = 0; ks < 8; ++ks) { const bf16x8 A = frag_row(F.lds + HL_QD, 272, 32 * tt, 16 * ks, lane); acc = MFMA32(A, Bs[ks], acc); }
    const int tcol = 32 * tt + (lane & 31);
#pragma unroll
    for (int st = 0; st < 2; ++st) {
        if (st <= tt) {
            f32x16 X;
#pragma unroll
            for (int r = 0; r < 16; ++r) X[r] = 0.f;
#pragma unroll 2
            for (int ks = 0; ks < 8; ++ks) { const bf16x8 A = frag_row(F.lds + HL_KP, 272, 32 * st, 16 * ks, lane), B = frag_row(F.lds + HL_QP, 272, 32 * tt, 16 * ks, lane); X = MFMA32(A, B, X); }
#pragma unroll
            for (int r = 0; r < 16; ++r) X[r] = (32 * st + drow(r, lane) <= tcol) ? X[r] : 0.f;
#pragma unroll
            for (int s2 = 0; s2 < 2; ++s2) { const bf16x8 A = acc_frag(X, s2), B = frag_tr<true>(F.lds + HL_V, 320, 32 * st + 16 * s2, 32 * et, lane); acc = MFMA32(A, B, acc); }
        }
    }
    LAS float* ssqs = (LAS float*)(F.lds + HL_SSQ);
#pragma unroll
    for (int r = 0; r < 16; ++r) { const float sm = half_sum(acc[r] * acc[r]); if ((lane & 31) == 0) ssqs[F.wave * 32 + drow(r, lane)] = sm; }
    __syncthreads();
#pragma unroll
    for (int r = 0; r < 16; ++r) { const int row = drow(r, lane);
        const float ss = ssqs[(tt * 4 + 0) * 32 + row] + ssqs[(tt * 4 + 1) * 32 + row] + ssqs[(tt * 4 + 2) * 32 + row] + ssqs[(tt * 4 + 3) * 32 + row];
        const float rs = rsqrtf(ss * (1.0f / 128.0f) + RMS_EPS_F);
        *(LAS unsigned short*)(F.lds + HL_QD + (32 * tt + row) * 272 + e * 2) = f2bf1(acc[r] * rs * nw * siluf(bf2f(gv[r]))); }
    __syncthreads();
    { bf16_t* mo = (bf16_t*)(F.ws + WS_MIX) + (size_t)(c * 64) * DM + 512 + h * 128;
#pragma unroll
      for (int i = 0; i < 2; ++i) { const int pc = tid + 512 * i, row = pc >> 4, ch = (pc & 15) * 8;
          *(u32x4*)(mo + (size_t)row * DM + ch) = *(const LAS u32x4*)(F.lds + HL_QD + row * 272 + ch * 2); } }
}

__device__ __forceinline__ void phase_mix_states(const Frame& F, const Args& a, const int mode) {
    if (!(mode & 1)) for (int u = blockIdx.x; u < 256; u += F.G) ssd_states_unit(F, a, u >> 1, u & 1);
    if (!(mode & 2)) {
        HgrnRaw Ra, Rb; int u = blockIdx.x; float lb[2]; int hcur = -1;
        if (u < 1024) hgrn_fetch<false>(F, u >> 2, u & 3, Ra);
        while (u < 1024) {
            int un = u + F.G; if (un < 1024) hgrn_fetch<false>(F, un >> 2, un & 3, Rb);
            if ((u & 3) != hcur) { hcur = u & 3; hgrn_lb(F, hcur, lb); }
            hgrn_states_unit(F, a, u >> 2, u & 3, Ra, lb); u = un; if (u >= 1024) break;
            un = u + F.G; if (un < 1024) hgrn_fetch<false>(F, un >> 2, un & 3, Ra);
            if ((u & 3) != hcur) { hcur = u & 3; hgrn_lb(F, hcur, lb); }
            hgrn_states_unit(F, a, u >> 2, u & 3, Rb, lb); u = un;
        }
    }
}
__device__ __forceinline__ void phase_mix_out(const Frame& F, const Args& a, const int mode) {
    if (!(mode & 1)) for (int u = blockIdx.x; u < 256; u += F.G) ssd_out_unit(F, a, u >> 1, u & 1, mode);
    if (!(mode & 2)) {
        HgrnRaw Ra, Rb; int u = blockIdx.x; float lb[2]; int hcur = -1;
        if (u < 1024) hgrn_fetch<true>(F, u >> 2, u & 3, Ra);
        while (u < 1024) {
            int un = u + F.G; if (un < 1024) hgrn_fetch<true>(F, un >> 2, un & 3, Rb);
            if ((u & 3) != hcur) { hcur = u & 3; hgrn_lb(F, hcur, lb); }
            hgrn_out_unit(F, a, u >> 2, u & 3, Ra, lb); u = un; if (u >= 1024) break;
            un = u + F.G; if (un < 1024) hgrn_fetch<true>(F, un >> 2, un & 3, Ra);
            if ((u & 3) != hcur) { hcur = u & 3; hgrn_lb(F, hcur, lb); }
            hgrn_out_unit(F, a, u >> 2, u & 3, Rb, lb); u = un;
        }
    }
}
__device__ __forceinline__ void phase_mix_scan(const Frame& F, const Args& a) {
    const int gt = blockIdx.x * 512 + F_TID;
    if (blockIdx.x < 128 || F.G < 256) {
        for (int idx = gt; idx < 65536; idx += (F.G < 256 ? F.G : 128) * 512) {
            const int hh = idx >> 13; const float* st = (const float*)(F.ws + WS_SSTATE) + idx; const float* cd = (const float*)(F.ws + WS_CDECAY) + hh;
            bf16_t* sp = (bf16_t*)(F.ws + WS_SPREV) + idx; float S = 0.f;
            for (int c0 = 0; c0 < 128; c0 += 16) { float v[16], d[16];
#pragma unroll
                for (int i = 0; i < 16; ++i) { v[i] = st[(size_t)(c0 + i) * 65536]; d[i] = cd[(c0 + i) * 8]; }
#pragma unroll
                for (int i = 0; i < 16; ++i) { sp[(size_t)(c0 + i) * 65536] = f2bf1(S); S = fmaf(S, d[i], v[i]); } }
        }
    }
    if (blockIdx.x >= 128 || F.G < 256) {
        const int gt2 = F.G < 256 ? gt : gt - 128 * 512;
        for (int idx = gt2; idx < 65536; idx += (F.G < 256 ? F.G : 128) * 512) {
            const int h = idx >> 14, d = idx & 127; const float* kv = (const float*)(F.ws + WS_HKV) + idx; const float* hd = (const float*)(F.ws + WS_HDECAY) + h * 128 + d;
            bf16_t* sp = (bf16_t*)(F.ws + WS_HSPREV) + idx; float S = 0.f;
            for (int c0 = 0; c0 < 256; c0 += 16) { float v[16], dd[16];
#pragma unroll
                for (int i = 0; i < 16; ++i) { v[i] = kv[(size_t)(c0 + i) * 65536]; dd[i] = hd[(size_t)(c0 + i) * 512]; }
#pragma unroll
                for (int i = 0; i < 16; ++i) { sp[(size_t)(c0 + i) * 65536] = f2bf1(S); S = fmaf(S, dd[i], v[i]); } }
        }
    }
}

__global__ void __launch_bounds__(512, 2) mk_fwd(Args args) {
    extern __shared__ __attribute__((aligned(16))) unsigned char lds_raw[];
    Frame F;
    F.lds = (LAS unsigned char*)lds_raw;
    F.wave = __builtin_amdgcn_readfirstlane(threadIdx.x >> 6);
    F.G = gridDim.x; { const int bx = blockIdx.x; F.vcu = (F.G % 8 == 0) ? (bx % 8) * (F.G / 8) + bx / 8 : bx; }
    F.ws = args.ws; F.ctl = (unsigned*)(args.ws + WS_CTL);
    volatile LAS unsigned* MISC = (volatile LAS unsigned*)(F.lds + LDS_MISC);
    if (F_TID < 64) MISC[F_TID] = 0u;
    __syncthreads();
    const bool use_bar = (args.ph_hi - args.ph_lo) > 1;
    XcdBarrier bar; bar.bar = F.ctl + CW_BAR + args.li * XCD_BAR_WORDS; bar.x = 0; bar.st = MISC + 8; bar.wave = F.wave;
    if (use_bar) bar = xcd_barrier_post(F.ctl + CW_BAR + args.li * XCD_BAR_WORDS, MISC + 8, F.wave);
#define PH(k) (args.ph_lo <= (k) && (k) < args.ph_hi)
#define SEAM(k) do { if (use_bar && (k) + 1 < args.ph_hi && (k) >= args.ph_lo) xcd_barrier(bar); } while (0)
    unsigned char* ws = F.ws;
    if (PH(0)) phase_prep(F, args);
    SEAM(0);
    if (PH(1)) {
        pg8::DenseSched S; S.init(ws + WS_XB, ws + WS_WIN_T, T_TOK, 3072, 1024, F.G, blockIdx.x);
        pg8::EpiP E; E.O = (bf16_t*)(ws + WS_P); E.ldc = PW;
        pg8::gemm_phase<pg8::EpiP, pg8::DenseSched, true>(F.lds, 1024, S, E, F.wave);
    }
    SEAM(1);
#if defined(MK_NAIVE_MIX)
    if (PH(2)) phase_m1(F, args);
    SEAM(2);
    if (PH(3)) phase_m2(F, args);
    SEAM(3);
    if (PH(4)) phase_m3(F, args);
#else
    if (PH(2)) phase_mix_states(F, args, args.mode);
    SEAM(2);
    if (PH(3)) {
        phase_mix_scan(F, args);
        if (blockIdx.x < 128 && F.G >= 256) {
            __syncthreads();
            pg8::DenseSched S; S.init(ws + WS_XB, ws + WS_WIN_T + (size_t)3072 * 1024 * 2, T_TOK, 512, 1024, 128, blockIdx.x);
            pg8::EpiP E; E.O = (bf16_t*)(ws + WS_P) + 3072; E.ldc = PW;
            pg8::gemm_phase<pg8::EpiP, pg8::DenseSched, true>(F.lds, 1024, S, E, F.wave);
        } else if (F.G < 256) {
            __syncthreads();
            pg8::DenseSched S; S.init(ws + WS_XB, ws + WS_WIN_T + (size_t)3072 * 1024 * 2, T_TOK, 512, 1024, F.G, blockIdx.x);
            pg8::EpiP E; E.O = (bf16_t*)(ws + WS_P) + 3072; E.ldc = PW;
            pg8::gemm_phase<pg8::EpiP, pg8::DenseSched, true>(F.lds, 1024, S, E, F.wave);
        }
    }
    SEAM(3);
    if (PH(4)) phase_mix_out(F, args, args.mode);
#endif
    SEAM(4);
    if (PH(5)) {
        pg8::DenseSched S; S.init(ws + WS_MIX, ws + WS_WOUT_T, T_TOK, 1024, 1024, F.G, blockIdx.x);
        pg8::EpiU E; E.U = (float*)(ws + WS_H1); E.X = KARG_IN(0);
        pg8::gemm_phase<pg8::EpiU, pg8::DenseSched, false>(F.lds, 1024, S, E, F.wave);
    }
    SEAM(5);
    if (PH(6)) phase_ln1(F, args);
    SEAM(6);
    if (PH(7)) {
        pg8::DenseSched S; S.init(ws + WS_H1B, ws + WS_W3_T, T_TOK, 768, 1024, F.G, blockIdx.x);
        pg8::Epi3 E; E.LG = (float*)(ws + WS_LOGITS); E.HS = (bf16_t*)(ws + WS_HS);
        pg8::gemm_phase<pg8::Epi3, pg8::DenseSched, false>(F.lds, 1024, S, E, F.wave);
    }
    SEAM(7);
    if (PH(8)) {
        if (!(args.mode & 32)) phase_route(F, args);
        if (!(args.mode & 64)) {
        pg8::DenseSched S; S.init(ws + WS_HS, ws + WS_WDS_T, T_TOK, 1024, 256, F.G, blockIdx.x);
        pg8::EpiP E; E.O = (bf16_t*)(ws + WS_YS); E.ldc = 1024;
        pg8::gemm_phase<pg8::EpiP, pg8::DenseSched, false>(F.lds, 256, S, E, F.wave); }
    }
    SEAM(8);
#if defined(MK_OLD_EXPERTS)
    if (PH(9)) {
        build_tables(F);
        pg8::ExpertSched<true> S; S.lds = F.lds;
        S.lists = (const int*)(ws + WS_LISTS); S.A = (const char*)(ws + WS_H1B); S.W = (const char*)(ws + WS_WGU_T);
        S.U = 2 * __builtin_amdgcn_readfirstlane(((const LAS int*)(F.lds + LDS_PREF))[NEXP]); S.G = F.G; S.c = blockIdx.x;
        pg8::EpiH E; E.H = (bf16_t*)(ws + WS_H);
        pg8::gemm_phase<pg8::EpiH, pg8::ExpertSched<true>, true>(F.lds, 1024, S, E, F.wave);
    }
    SEAM(9);
    if (PH(10)) {
        build_tables(F);
        pg8::ExpertSched<false> S; S.lds = F.lds;
        S.lists = (const int*)(ws + WS_LISTS); S.A = (const char*)(ws + WS_H); S.W = (const char*)(ws + WS_WD_T);
        S.U = 4 * __builtin_amdgcn_readfirstlane(((const LAS int*)(F.lds + LDS_PREF))[NEXP]); S.G = F.G; S.c = blockIdx.x;
        pg8::EpiYb E; E.YB = (bf16_t*)(ws + WS_YB); E.lists = (const int*)(ws + WS_LISTS); E.tok_gate = (const float*)(ws + WS_TOKGATE);
        pg8::gemm_phase<pg8::EpiYb, pg8::ExpertSched<false>, true>(F.lds, 256, S, E, F.wave);
    }
    SEAM(10);
#else
    if (PH(9)) phase_experts(F, args, args.mode);
    SEAM(9);
#endif
    if (PH(11)) { build_tables(F); phase_final(F, args); }
}

extern "C" void kernel_launch(void* const* d_in, const int* in_sizes, int n_in, void* d_out, int out_size, void* d_ws, size_t ws_size, hipStream_t stream) {
    static int grid = 0;
    if (grid == 0) {
        int dev = 0, cus = 0;
        if (hipGetDevice(&dev) != hipSuccess || hipDeviceGetAttribute(&cus, hipDeviceAttributeMultiprocessorCount, dev) != hipSuccess) { fprintf(stderr, "device query failed\n"); grid = -1; return; }
        if (hipFuncSetAttribute((const void*)mk_fwd, hipFuncAttributeMaxDynamicSharedMemorySize, LDS_BYTES) != hipSuccess) { fprintf(stderr, "hipFuncSetAttribute failed\n"); grid = -1; return; }
        if (ws_size < WS_END) { fprintf(stderr, "workspace too small: %zu < %zu\n", ws_size, (size_t)WS_END); grid = -1; return; }
        (void)hipGetLastError();
        grid = cus;
    }
    if (grid < 0) return;
    unsigned char* ws = (unsigned char*)d_ws;
    (void)hipMemsetAsync(ws + WS_CTL, 0, CTL_ZERO_BYTES, stream);
    Args a{};
    for (int i = 0; i < 23; ++i) a.in[i] = (const float*)d_in[i];
    a.out = (float*)d_out; a.ws = ws;
    auto launch = [&](int lo, int hi) { a.ph_lo = lo; a.ph_hi = hi; hipLaunchKernelGGL(mk_fwd, dim3(grid), dim3(512), LDS_BYTES, stream, a); };
#if defined(MK_PER_PHASE)
    for (int ph = 0; ph < NPH; ++ph) launch(ph, ph + 1);
#else
    launch(0, NPH);
#endif
}
```

```cpp
#include <hip/hip_runtime.h>
#include <stdint.h>
#include <cstdio>

#define GAS __attribute__((address_space(1)))
#define LAS __attribute__((address_space(3)))
typedef unsigned short bf16_t;
typedef short bf16x8 __attribute__((ext_vector_type(8)));
typedef float f32x4 __attribute__((ext_vector_type(4)));
typedef unsigned u32x4 __attribute__((ext_vector_type(4)));
typedef unsigned u32x2 __attribute__((ext_vector_type(2)));
typedef float f32x16 __attribute__((ext_vector_type(16)));
typedef short s16x4 __attribute__((ext_vector_type(4)));

constexpr int T_TOK = 16384, DM = 1024, NIN = 3592, PW = 3584;
constexpr int NEXP = 256, LIST_CAP = 16384;
constexpr int PC_Z = 0, PC_XBC = 512, PC_Q = 1536, PC_F = 2048, PC_I = 2560, PC_G = 3072;
#define ALPHA_F 1.189207115002721f
#define LN_EPS_F 1e-5f
#define RMS_EPS_F 1e-6f

constexpr size_t MiB = 1u << 20;
constexpr size_t WS_CTL = 0, CTL_ZERO_BYTES = 1 * MiB;
constexpr size_t WS_WIN_T = 2 * MiB, WS_WOUT_T = 9 * MiB, WS_W3_T = 11 * MiB, WS_WDS_T = 13 * MiB, WS_DTRAW = 14 * MiB;
constexpr size_t WS_TOKE = 15 * MiB, WS_TOKPOS = 15 * MiB + 512 * 1024, WS_TOKGATE = 16 * MiB;
constexpr size_t WS_LISTS = 17 * MiB, WS_LOGITS = 33 * MiB, WS_HS = 49 * MiB, WS_YS = 57 * MiB, WS_H1 = 89 * MiB, WS_H1B = 153 * MiB;
constexpr size_t WS_WGU_T = 185 * MiB, WS_WD_T = 441 * MiB;
constexpr size_t WS_X0 = 569 * MiB;
constexpr size_t WS_XB = WS_X0, WS_P = WS_X0 + 32 * MiB, WS_MIX = WS_X0 + 144 * MiB;
constexpr size_t WS_NXBC = WS_X0 + 176 * MiB, WS_NFGK = WS_X0 + 240 * MiB, WS_NQS = WS_X0 + 272 * MiB, WS_NYSSD = WS_X0 + 304 * MiB, WS_NOH = WS_X0 + 336 * MiB, WS_NDTB = WS_X0 + 368 * MiB;
constexpr size_t WS_SSTATE = WS_X0 + 176 * MiB, WS_SPREV = WS_X0 + 208 * MiB, WS_HKV = WS_X0 + 224 * MiB, WS_HSPREV = WS_X0 + 288 * MiB;
constexpr size_t WS_CDECAY = WS_X0 + 320 * MiB, WS_HDECAY = WS_X0 + 320 * MiB + 64 * 1024;
constexpr size_t WS_H = WS_X0, WS_YB = WS_X0 + 65 * MiB;
constexpr size_t WS_END = WS_X0 + 369 * MiB;
constexpr int CW_BAR = 4096;
constexpr int CW_COUNTS = 16384, CNT_STRIDE = 64;

constexpr int RING_BYTES = 131072;
constexpr int LDS_BYTES = 163840;
constexpr int LDS_MISC = LDS_BYTES - 4096;
constexpr int LDS_PREF = LDS_MISC + 256;
constexpr int LDS_OFFS = LDS_PREF + 1040;
constexpr int LDS_CNT = LDS_OFFS + 1040;
constexpr int LDS_PHASE_BYTES = LDS_MISC;

__device__ __forceinline__ int lane_id() { int l; asm volatile("v_mbcnt_lo_u32_b32 %0, -1, 0\n\tv_mbcnt_hi_u32_b32 %0, -1, %0" : "=v"(l)); return l; }
__device__ __forceinline__ float siluf(float x) { return x * __builtin_amdgcn_rcpf(1.0f + __expf(-x)); }
__device__ __forceinline__ float sigmf(float x) { return __builtin_amdgcn_rcpf(1.0f + __expf(-x)); }
template <int CTRL> __device__ __forceinline__ float dpp_f(float v) { return __builtin_bit_cast(float, __builtin_amdgcn_update_dpp(0, __builtin_bit_cast(int, v), CTRL, 0xf, 0xf, true)); }
__device__ __forceinline__ float rdlane_f(float v, int l) { return __builtin_bit_cast(float, __builtin_amdgcn_readlane(__builtin_bit_cast(int, v), l)); }
__device__ __forceinline__ float wave_sum(float v) {
  v += dpp_f<0xB1>(v); v += dpp_f<0x4E>(v); v += dpp_f<0x141>(v); v += dpp_f<0x140>(v);
  return (rdlane_f(v, 0) + rdlane_f(v, 16)) + (rdlane_f(v, 32) + rdlane_f(v, 48));
}
__device__ __forceinline__ float wave_max(float v) {
  v = fmaxf(v, dpp_f<0xB1>(v)); v = fmaxf(v, dpp_f<0x4E>(v)); v = fmaxf(v, dpp_f<0x141>(v)); v = fmaxf(v, dpp_f<0x140>(v));
  return fmaxf(fmaxf(rdlane_f(v, 0), rdlane_f(v, 16)), fmaxf(rdlane_f(v, 32), rdlane_f(v, 48)));
}
__device__ __forceinline__ unsigned cvt_pk_bf16(float lo, float hi) { unsigned r; asm volatile("v_cvt_pk_bf16_f32 %0, %1, %2" : "=v"(r) : "v"(lo), "v"(hi)); return r; }
#define YB_SCALE 64.0f
__device__ __forceinline__ unsigned pk4_fp8(const f32x4 v) {
    const float a = fminf(fmaxf(v[0], -440.f), 440.f), b = fminf(fmaxf(v[1], -440.f), 440.f), c = fminf(fmaxf(v[2], -440.f), 440.f), d = fminf(fmaxf(v[3], -440.f), 440.f);
    int w = 0; w = __builtin_amdgcn_cvt_pk_fp8_f32(a, b, w, false); w = __builtin_amdgcn_cvt_pk_fp8_f32(c, d, w, true); return (unsigned)w; }
__device__ __forceinline__ f32x4 un4_fp8(const unsigned w) { return (f32x4){__builtin_amdgcn_cvt_f32_fp8((int)w, 0), __builtin_amdgcn_cvt_f32_fp8((int)w, 1), __builtin_amdgcn_cvt_f32_fp8((int)w, 2), __builtin_amdgcn_cvt_f32_fp8((int)w, 3)}; }
__device__ __forceinline__ float bf2f(unsigned b) { return __uint_as_float(b << 16); }
__device__ __forceinline__ float bflo(unsigned w) { return __uint_as_float(w << 16); }
__device__ __forceinline__ float bfhi(unsigned w) { return __uint_as_float(w & 0xffff0000u); }

#define XB_TMO      128
#define XB_XCNT(j)  (256  + 64 * (j))
#define XB_XSUB(j)  (1280 + 64 * (j))
#define XB_XGEN(j)  (2304 + 64 * (j))
#define XB_TOP      3328
#define XB_TOPGEN   3392
#define XCD_BAR_WORDS 3456
#define XB_SPIN_CAP (1u << 18)
__device__ __forceinline__ unsigned xb_ld(unsigned* p)              { return __hip_atomic_load(p, __ATOMIC_RELAXED, __HIP_MEMORY_SCOPE_AGENT); }
__device__ __forceinline__ unsigned xb_add(unsigned* p, unsigned v) { return __hip_atomic_fetch_add(p, v, __ATOMIC_RELAXED, __HIP_MEMORY_SCOPE_AGENT); }
__device__ __forceinline__ unsigned xb_xcc_id() { return (unsigned)__builtin_amdgcn_s_getreg((3 << 11) | 20) & 0xFu; }
#define XB_SPIN(cond, bar) do { unsigned _sp = 0; while (cond) { __builtin_amdgcn_s_sleep(1); \
    if ((++_sp & 255u) == 0u) { if (xb_ld(&(bar)[XB_TMO])) break; if (_sp > XB_SPIN_CAP) { atomicAdd(&(bar)[XB_TMO], 1u); break; } } } } while (0)
struct XcdBarrier { unsigned* bar; unsigned x; volatile LAS unsigned* st; int wave; };
__device__ __forceinline__ XcdBarrier xcd_barrier_post(unsigned* bar, volatile LAS unsigned* st, int wave) {
    XcdBarrier b; b.bar = bar; b.x = xb_xcc_id(); b.st = st; b.wave = wave;
    if (wave == 0 && lane_id() == 0) (void)xb_add(&bar[XB_XCNT(b.x)], 1u);
    return b;
}
__device__ __forceinline__ void xcd_barrier_complete(unsigned* bar, unsigned x, unsigned& nloc, unsigned& nx) {
    const unsigned G = gridDim.x * gridDim.y * gridDim.z;
    unsigned sum, cnt, mine, sp = 0u;
    for (;;) {
        sum = 0u; cnt = 0u; mine = 0u;
#pragma unroll
        for (unsigned j = 0; j < 16; ++j) { const unsigned c = xb_ld(&bar[XB_XCNT(j)]); sum += c; cnt += (c > 0u) ? 1u : 0u; mine = (j == x) ? c : mine; }
        if (sum == G) break;
        __builtin_amdgcn_s_sleep(1);
        if ((++sp & 255u) == 0u) { if (xb_ld(&bar[XB_TMO])) break; if (sp > XB_SPIN_CAP) { atomicAdd(&bar[XB_TMO], 1u); break; } }
    }
    nloc = mine > 0u ? mine : 1u; nx = cnt > 0u ? cnt : 1u;
}
__device__ __forceinline__ void xcd_barrier(const XcdBarrier& b) {
    asm volatile("s_waitcnt vmcnt(0)" ::: "memory");
    __syncthreads();
    if (b.wave == 0 && lane_id() == 0) {
        unsigned* bar = b.bar;
        __builtin_amdgcn_s_waitcnt(0);
        unsigned nloc = b.st[0], nx = b.st[1];
        if (nloc == 0u) { xcd_barrier_complete(bar, b.x, nloc, nx); b.st[0] = nloc; b.st[1] = nx; }
        const unsigned old = xb_add(&bar[XB_XSUB(b.x)], 1u);
        const unsigned gen = old / nloc;
        if (old + 1u == (gen + 1u) * nloc) {
            __builtin_amdgcn_fence(__ATOMIC_RELEASE, "agent");
            asm volatile("s_waitcnt vmcnt(0)" ::: "memory");
            const unsigned og = xb_add(&bar[XB_TOP], 1u);
            const unsigned tg = og / nx;
            if (og + 1u == (tg + 1u) * nx) xb_add(&bar[XB_TOPGEN], 1u);
            else XB_SPIN(xb_ld(&bar[XB_TOPGEN]) == tg, bar);
            __builtin_amdgcn_fence(__ATOMIC_ACQUIRE, "agent");
            xb_add(&bar[XB_XGEN(b.x)], 1u);
            asm volatile("s_waitcnt vmcnt(0)" ::: "memory");
        } else {
            XB_SPIN(xb_ld(&bar[XB_XGEN(b.x)]) == gen, bar);
            __builtin_amdgcn_fence(__ATOMIC_ACQUIRE, "agent");
            asm volatile("s_waitcnt vmcnt(0)" ::: "memory");
        }
    }
    __syncthreads();
}

namespace pg8 {
constexpr int BM = 256, BK = 64, HALF = 128, HTB = HALF * BK * 2, STAGE_BYTES = 8 * HTB, NXCD = 8, WGM = 8;
__host__ __device__ __forceinline__ int lds_byte(int r, int c) { const int st = (r >> 4) * 2 + (c >> 5), rr = r & 15, cc = c & 31, ob = rr * 64 + cc * 2; return st * 1024 + (ob ^ (((ob >> 9) & 1) << 5)); }
__host__ __device__ __forceinline__ void stage_rc(int b, int& R, int& C) { const int st = b / 1024, sb = b % 1024, swz = sb ^ (((sb >> 9) & 1) << 5); R = (st >> 1) * 16 + swz / 64; C = (st & 1) * 32 + (swz % 64) / 2; }
__host__ __device__ __forceinline__ int perm32(int rho) { const int n = rho >> 4, i = rho & 15; return 8 * (i >> 2) + 4 * n + (i & 3); }

struct Unit { const char* A; const char* B; int pm, pn, rows, e, slot0, mt; };

struct DenseSched {
    static constexpr bool PER_UNIT_VOFF = false;
    const char* A; const char* B; int K, nM, nN, nwg, G, c;
    __device__ void init(const void* A_, const void* B_, int M, int N, int K_, int G_, int c_) { A = (const char*)A_; B = (const char*)B_; K = K_; nM = M / BM; nN = N / BM; nwg = nM * nN; G = G_; c = c_; }
    __device__ __forceinline__ bool next(int i, Unit& u) const {
        const int L = i * G + c; if (L >= nwg) return false;
        int wgid = L; { const int q = nwg / NXCD, r = nwg % NXCD, xcd = wgid % NXCD, off = wgid / NXCD; wgid = (xcd < r ? xcd * (q + 1) : r * (q + 1) + (xcd - r) * q) + off; }
        const int nig = WGM * nN, gid = wgid / nig, fm = gid * WGM, gsz = (nM - fm) < WGM ? (nM - fm) : WGM;
        u.pm = fm + ((wgid % nig) % gsz); u.pn = (wgid % nig) / gsz; u.rows = 256; u.e = 0; u.slot0 = 0; u.mt = 0;
        u.A = A + (size_t)u.pm * BM * K * 2; u.B = B + (size_t)u.pn * BM * K * 2; return true;
    }
    __device__ __forceinline__ void voff(const Unit&, const int (&sR)[2], const int (&sC)[2], unsigned (&v)[2][2]) const {
#pragma unroll
        for (int h = 0; h < 2; ++h)
#pragma unroll
            for (int i = 0; i < 2; ++i) v[h][i] = (unsigned)((h * HALF + sR[i]) * K + sC[i]) * 2u;
    }
};

template <bool GATHER> struct ExpertSched {
    static constexpr bool PER_UNIT_VOFF = GATHER;
    static constexpr int K = GATHER ? 1024 : 256, NT = GATHER ? 2 : 4;
    static constexpr unsigned WSTRIDE = GATHER ? 512u * 1024u * 2u : 1024u * 256u * 2u;
    LAS unsigned char* lds;
    const int* lists; const char* A; const char* W; int U, G, c;
    __device__ __forceinline__ bool next(int i, Unit& u) const {
        int L = i * G + c; if (L >= U) return false;
        { const int q = U / NXCD, r = U % NXCD, xcd = L % NXCD, off = L / NXCD; L = (xcd < r ? xcd * (q + 1) : r * (q + 1) + (xcd - r) * q) + off; }
        const LAS int* pref = (const LAS int*)(lds + LDS_PREF);
        int lo = 0, hi = NEXP;
        while (hi - lo > 1) { const int mid = (lo + hi) >> 1; const int pv = __builtin_amdgcn_readfirstlane(pref[mid]); if (NT * pv <= L) lo = mid; else hi = mid; }
        const int e = lo, p0 = __builtin_amdgcn_readfirstlane(pref[e]), p1 = __builtin_amdgcn_readfirstlane(pref[e + 1]), tiles = p1 - p0, r = L - NT * p0;
        u.e = e; u.pn = r / tiles; u.mt = r % tiles; u.pm = 0;
        const int n = __builtin_amdgcn_readfirstlane(((const LAS int*)(lds + LDS_CNT))[e]); u.rows = (n - u.mt * 256) < 256 ? (n - u.mt * 256) : 256;
        u.slot0 = __builtin_amdgcn_readfirstlane(((const LAS int*)(lds + LDS_OFFS))[e]) + u.mt * 256;
        u.A = GATHER ? A : A + (size_t)u.slot0 * (K * 2); u.B = W + (size_t)e * WSTRIDE + (size_t)u.pn * (BM * K * 2); return true;
    }
    __device__ __forceinline__ void voff(const Unit& u, const int (&sR)[2], const int (&sC)[2], unsigned (&v)[2][2]) const {
#pragma unroll
        for (int h = 0; h < 2; ++h)
#pragma unroll
            for (int i = 0; i < 2; ++i) {
                const int r = h * HALF + sR[i];
                if (GATHER) { int tok = 0; if (r < u.rows) tok = lists[(size_t)u.e * LIST_CAP + u.mt * 256 + r] >> 3; v[h][i] = (unsigned)(tok * K + sC[i]) * 2u; }
                else v[h][i] = (unsigned)(r * K + sC[i]) * 2u;
            }
    }
};

template <class Epi, class Sched, bool ALIGN_EPI>
__device__ __forceinline__ void gemm_phase(LAS unsigned char* lds, const int K, const Sched& S, const Epi& E, const int wid) {
    const int lane = lane_id(), tid = wid * 64 + lane, wr = wid >> 2, wc = wid & 3, fr = lane & 15, fq = lane >> 4;
    const int nt = K / BK;
    int sR[2], sC[2]; unsigned voffB[2];
#pragma unroll
    for (int i = 0; i < 2; ++i) { stage_rc(tid * 16 + i * 8192, sR[i], sC[i]); const int Rb = Epi::PERM ? ((sR[i] & ~31) + perm32(sR[i] & 31)) : sR[i]; voffB[i] = (unsigned)(Rb * K + sC[i]) * 2u; }
    const size_t kstep = (size_t)(BK * 2);
    const size_t hstep = (size_t)HALF * K * 2;
    const unsigned ldsw = (unsigned)wid * 1024u;
    const int aoff = lds_byte(wr * 64 + fr, fq * 8), boff = lds_byte(wc * 32 + fr, fq * 8);
#define PG8_SA(b, h) (((b) * 2 + (h)) * HTB)
#define PG8_SB(b, h) ((4 + (b) * 2 + (h)) * HTB)
#define PG8_STAGE(bufoff, gbase, voff) do { _Pragma("unroll") for (int _i = 0; _i < 2; ++_i) \
        __builtin_amdgcn_global_load_lds((const unsigned*)((const char*)(gbase) + (voff)[_i]), (LAS unsigned*)(lds + (bufoff) + ldsw + _i * 8192), 16, 0, 0); } while (0)
#define PG8_STAGE_A(bufoff, gbase, h, vset) do { if constexpr (Sched::PER_UNIT_VOFF) { PG8_STAGE(bufoff, gbase, (vset)[h]); } else { PG8_STAGE(bufoff, (gbase) + (h) * hstep, vc[0]); } } while (0)
#define PG8_LDA(dst, b, h) do { _Pragma("unroll") for (int m = 0; m < 4; ++m) _Pragma("unroll") for (int k = 0; k < 2; ++k) dst[m][k] = *(const LAS bf16x8*)(lds + PG8_SA(b, h) + aoff + m * 2048 + k * 1024); } while (0)
#define PG8_LDB(dst, b, h) do { _Pragma("unroll") for (int n = 0; n < 2; ++n) _Pragma("unroll") for (int k = 0; k < 2; ++k) dst[n][k] = *(const LAS bf16x8*)(lds + PG8_SB(b, h) + boff + n * 2048 + k * 1024); } while (0)
#define PG8_MMA(ai, bj, At, Bt) do { __builtin_amdgcn_s_setprio(1); _Pragma("unroll") for (int m = 0; m < 4; ++m) _Pragma("unroll") for (int n = 0; n < 2; ++n) _Pragma("unroll") for (int k = 0; k < 2; ++k) \
        acc[ai][bj][m][n] = __builtin_amdgcn_mfma_f32_16x16x32_bf16(Bt[n][k], At[m][k], acc[ai][bj][m][n], 0, 0, 0); __builtin_amdgcn_s_setprio(0); } while (0)
#define PG8_WAIT_V(n) asm volatile("s_waitcnt vmcnt(" #n ")" ::: "memory")
#define PG8_WAIT_L(n) asm volatile("s_waitcnt lgkmcnt(" #n ")" ::: "memory")
#define PG8_BAR __builtin_amdgcn_s_barrier()
#define PG8_SCHED __builtin_amdgcn_sched_barrier(0)
    Unit cur, nxt; int ui = 0;
    if (!S.next(0, cur)) return;
    unsigned vc[2][2], vn[2][2];
    S.voff(cur, sR, sC, vc);
    f32x4 acc[2][2][4][2];
#pragma unroll
    for (int a = 0; a < 2; ++a)
#pragma unroll
        for (int b = 0; b < 2; ++b)
#pragma unroll
            for (int m = 0; m < 4; ++m)
#pragma unroll
                for (int n = 0; n < 2; ++n) acc[a][b][m][n] = (f32x4){0.f, 0.f, 0.f, 0.f};
    bf16x8 At[4][2], B0[2][2], B1[2][2];
    const char* cA = cur.A; const char* cB = cur.B;
    PG8_STAGE(PG8_SB(0, 0), cB, voffB); PG8_STAGE(PG8_SB(0, 1), cB + hstep, voffB); PG8_STAGE_A(PG8_SA(0, 0), cA, 0, vc); PG8_STAGE_A(PG8_SA(0, 1), cA, 1, vc);
    if (wr == 1) PG8_BAR;
    PG8_WAIT_V(2); PG8_BAR;
    PG8_STAGE(PG8_SB(1, 0), cB + kstep, voffB); PG8_STAGE_A(PG8_SA(1, 0), cA + kstep, 0, vc); PG8_STAGE(PG8_SB(1, 1), cB + hstep + kstep, voffB);
    PG8_WAIT_V(6); PG8_BAR;
    for (;;) {
        const bool has_next = S.next(ui + 1, nxt);
        if constexpr (Sched::PER_UNIT_VOFF) {
            if (has_next) S.voff(nxt, sR, sC, vn);
            else {
#pragma unroll
                for (int h = 0; h < 2; ++h)
#pragma unroll
                    for (int i = 0; i < 2; ++i) vn[h][i] = vc[h][i];
            }
        }
        const char* nA = has_next ? nxt.A : cA; const char* nB = has_next ? nxt.B : cB;
        for (int t = 0; t < nt; t += 2) {
            const bool last = (t == nt - 2);
            const char* a1 = cA + (size_t)(t + 1) * kstep;
            const char* a2 = last ? nA : cA + (size_t)(t + 2) * kstep; const char* b2 = last ? nB : cB + (size_t)(t + 2) * kstep;
            const char* a3 = a2 + kstep; const char* b3 = b2 + kstep;
            unsigned v2[2][2];
#pragma unroll
            for (int h = 0; h < 2; ++h)
#pragma unroll
                for (int i = 0; i < 2; ++i) v2[h][i] = (Sched::PER_UNIT_VOFF && last) ? vn[h][i] : vc[h][i];
            PG8_LDB(B0, 0, 0); PG8_LDB(B1, 0, 1); PG8_SCHED; PG8_LDA(At, 0, 0); PG8_STAGE_A(PG8_SA(1, 1), a1, 1, vc);
            PG8_WAIT_V(8); PG8_WAIT_L(0); PG8_BAR; PG8_MMA(0, 0, At, B0); PG8_MMA(0, 1, At, B1); PG8_BAR; PG8_SCHED;
            PG8_LDA(At, 0, 1); PG8_STAGE(PG8_SB(0, 0), b2, voffB); PG8_STAGE(PG8_SB(0, 1), b2 + hstep, voffB); PG8_STAGE_A(PG8_SA(0, 0), a2, 0, v2);
            PG8_WAIT_V(8); PG8_WAIT_L(0); PG8_BAR; PG8_MMA(1, 0, At, B0); PG8_MMA(1, 1, At, B1); PG8_BAR; PG8_SCHED;
            PG8_LDB(B0, 1, 0); PG8_LDB(B1, 1, 1); PG8_SCHED; PG8_LDA(At, 1, 0); PG8_STAGE_A(PG8_SA(0, 1), a2, 1, v2);
            PG8_WAIT_V(8); PG8_WAIT_L(0); PG8_BAR; PG8_MMA(0, 0, At, B0); PG8_MMA(0, 1, At, B1); PG8_BAR; PG8_SCHED;
            PG8_LDA(At, 1, 1); PG8_STAGE(PG8_SB(1, 0), b3, voffB); PG8_STAGE(PG8_SB(1, 1), b3 + hstep, voffB); PG8_STAGE_A(PG8_SA(1, 0), a3, 0, v2);
            PG8_WAIT_V(8); PG8_WAIT_L(0); PG8_BAR; PG8_MMA(1, 0, At, B0); PG8_MMA(1, 1, At, B1); PG8_BAR; PG8_SCHED;
        }
        if constexpr (ALIGN_EPI) { if (wr == 0) PG8_BAR; }
        E(acc, cur, wr, wc, fr, fq);
        if (!has_next) break;
#pragma unroll
        for (int a = 0; a < 2; ++a)
#pragma unroll
            for (int b = 0; b < 2; ++b)
#pragma unroll
                for (int m = 0; m < 4; ++m)
#pragma unroll
                    for (int n = 0; n < 2; ++n) acc[a][b][m][n] = (f32x4){0.f, 0.f, 0.f, 0.f};
        cur = nxt; cA = nA; cB = nB; ++ui;
        if constexpr (Sched::PER_UNIT_VOFF) {
#pragma unroll
            for (int h = 0; h < 2; ++h)
#pragma unroll
                for (int i = 0; i < 2; ++i) vc[h][i] = vn[h][i];
        }
        if constexpr (ALIGN_EPI) { if (wr == 1) PG8_BAR; }
    }
    PG8_WAIT_V(0);
    if constexpr (!ALIGN_EPI) { if (wr == 0) PG8_BAR; }
    PG8_BAR;
#undef PG8_SA
#undef PG8_SB
#undef PG8_STAGE
#undef PG8_LDA
#undef PG8_STAGE_A
#undef PG8_LDB
#undef PG8_MMA
#undef PG8_WAIT_V
#undef PG8_WAIT_L
#undef PG8_BAR
#undef PG8_SCHED
}

struct EpiP {
    static constexpr bool PERM = true;
    bf16_t* O; int ldc;
    __device__ __forceinline__ void operator()(const f32x4 (&acc)[2][2][4][2], const Unit& u, int wr, int wc, int fr, int fq) const {
        const int row0 = u.pm * BM + wr * 64 + fr, col0 = u.pn * BM + wc * 32 + 8 * fq;
#pragma unroll
        for (int ai = 0; ai < 2; ++ai)
#pragma unroll
            for (int m = 0; m < 4; ++m) { bf16_t* rowp = O + (size_t)(row0 + ai * HALF + m * 16) * ldc + col0;
#pragma unroll
                for (int bj = 0; bj < 2; ++bj) { const f32x4 v0 = acc[ai][bj][m][0], v1 = acc[ai][bj][m][1];
                    u32x4 w; w.x = cvt_pk_bf16(v0[0], v0[1]); w.y = cvt_pk_bf16(v0[2], v0[3]); w.z = cvt_pk_bf16(v1[0], v1[1]); w.w = cvt_pk_bf16(v1[2], v1[3]);
                    *(u32x4*)(rowp + bj * HALF) = w; } }
    }
};
struct EpiU {
    static constexpr bool PERM = false;
    float* U; const float* X;
    __device__ __forceinline__ void operator()(const f32x4 (&acc)[2][2][4][2], const Unit& u, int wr, int wc, int fr, int fq) const {
        const int row0 = u.pm * BM + wr * 64 + fr, col0 = u.pn * BM + wc * 32 + 4 * fq;
#pragma unroll
        for (int ai = 0; ai < 2; ++ai)
#pragma unroll
            for (int m = 0; m < 4; ++m) { const size_t ro = (size_t)(row0 + ai * HALF + m * 16) * DM + col0;
#pragma unroll
                for (int bj = 0; bj < 2; ++bj)
#pragma unroll
                    for (int n = 0; n < 2; ++n) { const f32x4 xv = *(const f32x4*)(X + ro + bj * HALF + n * 16);
                        *(f32x4*)(U + ro + bj * HALF + n * 16) = xv * ALPHA_F + acc[ai][bj][m][n]; } }
    }
};
struct Epi3 {
    static constexpr bool PERM = true;
    float* LG; bf16_t* HS;
    __device__ __forceinline__ void operator()(const f32x4 (&acc)[2][2][4][2], const Unit& u, int wr, int wc, int fr, int fq) const {
        const int row0 = u.pm * BM + wr * 64 + fr;
        if (u.pn == 0) {
#pragma unroll
            for (int ai = 0; ai < 2; ++ai)
#pragma unroll
                for (int m = 0; m < 4; ++m) { float* rowp = LG + (size_t)(row0 + ai * HALF + m * 16) * 256 + wc * 32 + 8 * fq;
#pragma unroll
                    for (int bj = 0; bj < 2; ++bj)
#pragma unroll
                        for (int n = 0; n < 2; ++n) *(f32x4*)(rowp + bj * HALF + 4 * n) = acc[ai][bj][m][n]; }
        } else {
            const int hc0 = (u.pn - 1) * 128 + wc * 32 + 8 * fq;
#pragma unroll
            for (int ai = 0; ai < 2; ++ai)
#pragma unroll
                for (int m = 0; m < 4; ++m) { bf16_t* rowp = HS + (size_t)(row0 + ai * HALF + m * 16) * 256 + hc0;
                    float h[8];
#pragma unroll
                    for (int n = 0; n < 2; ++n)
#pragma unroll
                        for (int j = 0; j < 4; ++j) h[n * 4 + j] = siluf(acc[ai][0][m][n][j]) * acc[ai][1][m][n][j];
                    u32x4 w; w.x = cvt_pk_bf16(h[0], h[1]); w.y = cvt_pk_bf16(h[2], h[3]); w.z = cvt_pk_bf16(h[4], h[5]); w.w = cvt_pk_bf16(h[6], h[7]);
                    *(u32x4*)rowp = w; }
        }
    }
};
struct EpiH {
    static constexpr bool PERM = true;
    bf16_t* H;
    __device__ __forceinline__ void operator()(const f32x4 (&acc)[2][2][4][2], const Unit& u, int wr, int wc, int fr, int fq) const {
        const int hc0 = u.pn * 128 + wc * 32 + 8 * fq;
#pragma unroll
        for (int ai = 0; ai < 2; ++ai)
#pragma unroll
            for (int m = 0; m < 4; ++m) { const int r = ai * HALF + wr * 64 + m * 16 + fr;
                if (r < u.rows) { bf16_t* rowp = H + (size_t)(u.slot0 + r) * 256 + hc0;
                    float h[8];
#pragma unroll
                    for (int n = 0; n < 2; ++n)
#pragma unroll
                        for (int j = 0; j < 4; ++j) h[n * 4 + j] = siluf(acc[ai][0][m][n][j]) * acc[ai][1][m][n][j];
                    u32x4 w; w.x = cvt_pk_bf16(h[0], h[1]); w.y = cvt_pk_bf16(h[2], h[3]); w.z = cvt_pk_bf16(h[4], h[5]); w.w = cvt_pk_bf16(h[6], h[7]);
                    *(u32x4*)rowp = w; } }
    }
};
struct EpiYb {
    static constexpr bool PERM = true;
    bf16_t* YB; const int* lists; const float* tok_gate;
    __device__ __forceinline__ void operator()(const f32x4 (&acc)[2][2][4][2], const Unit& u, int wr, int wc, int fr, int fq) const {
        const int col0 = u.pn * BM + wc * 32 + 8 * fq;
#pragma unroll
        for (int ai = 0; ai < 2; ++ai)
#pragma unroll
            for (int m = 0; m < 4; ++m) { const int r = ai * HALF + wr * 64 + m * 16 + fr;
                if (r < u.rows) { const float g = tok_gate[lists[(size_t)u.e * LIST_CAP + u.mt * 256 + r]];
                    bf16_t* rowp = YB + (size_t)(u.slot0 + r) * 1024 + col0;
#pragma unroll
                    for (int bj = 0; bj < 2; ++bj) { const f32x4 v0 = acc[ai][bj][m][0] * g, v1 = acc[ai][bj][m][1] * g;
                        u32x4 w; w.x = cvt_pk_bf16(v0[0], v0[1]); w.y = cvt_pk_bf16(v0[2], v0[3]); w.z = cvt_pk_bf16(v1[0], v1[1]); w.w = cvt_pk_bf16(v1[2], v1[3]);
                        *(u32x4*)(rowp + bj * HALF) = w; } } }
    }
};
}

template <int OFF> __device__ __forceinline__ unsigned long long karg_u64() { unsigned long long v;
    asm volatile("s_load_dwordx2 %0, %1, %2\n\ts_waitcnt lgkmcnt(0)" : "=s"(v) : "s"(__builtin_amdgcn_kernarg_segment_ptr()), "i"(OFF)); return v; }
#define KARG_IN(k) ((const float*)karg_u64<8 * (k)>())
#define KARG_OUT() ((float*)karg_u64<184>())
struct Args { const float* in[23]; float* out; unsigned char* ws; int ph_lo, ph_hi, mode, li; };
struct Frame { LAS unsigned char* lds; int wave, G, vcu; unsigned char* ws; unsigned* ctl; };
#define F_LANE lane_id()
#define F_TID (F.wave * 64 + lane_id())
constexpr int NPH = 12;

__device__ __forceinline__ void transpose_item(const float* W, int ldw, int c0, int k0, bf16_t* WT, int K, int row0, LAS float* scr, int lane) {
#pragma unroll 8
    for (int i = 0; i < 32; ++i) { const int kk = 2 * i + (lane >> 5); scr[kk * 33 + (lane & 31)] = W[(size_t)(k0 + kk) * ldw + c0 + (lane & 31)]; }
    asm volatile("s_waitcnt lgkmcnt(0)" ::: "memory");
    const int c = lane & 7;
#pragma unroll
    for (int j = 0; j < 4; ++j) { const int n = (lane >> 3) + 8 * j; const LAS float* s = scr + (8 * c) * 33 + n;
        u32x4 o; o.x = cvt_pk_bf16(s[0 * 33], s[1 * 33]); o.y = cvt_pk_bf16(s[2 * 33], s[3 * 33]); o.z = cvt_pk_bf16(s[4 * 33], s[5 * 33]); o.w = cvt_pk_bf16(s[6 * 33], s[7 * 33]);
        *(u32x4*)(WT + (size_t)(row0 + n) * K + k0 + 8 * c) = o; }
    asm volatile("s_waitcnt lgkmcnt(0)" ::: "memory");
}

__device__ __forceinline__ void gu_item(const float* Wg, const float* Wu, bf16_t* WT, int item, LAS float* scr, int lane) {
    const int kb = item >> 4, nb = item & 15, row0 = nb * 32, pn = row0 >> 8, half = (row0 >> 7) & 1, r0 = row0 & 127;
    transpose_item(half ? Wu : Wg, 256, pn * 128 + r0, kb * 64, WT, 1024, row0, scr, lane);
}

__device__ __forceinline__ void phase_prep(const Frame& F, const Args& a) {
    float wdt[16][8];
    { const float* w_in0 = KARG_IN(1); const int tid = F_TID;
      __syncthreads();
#pragma unroll
      for (int i = 0; i < 2; ++i) { const int k = tid + 512 * i; const float* src = w_in0 + (size_t)k * NIN + 1536;
          *(LAS f32x4*)(F.lds + k * 32) = *(const f32x4*)src; *(LAS f32x4*)(F.lds + k * 32 + 16) = *(const f32x4*)(src + 4); }
      __syncthreads();
#pragma unroll
      for (int j = 0; j < 16; ++j) { const int k = (j < 8 ? 8 * F_LANE + j : 512 + 8 * F_LANE + (j - 8));
          const f32x4 lo = *(const LAS f32x4*)(F.lds + k * 32), hi = *(const LAS f32x4*)(F.lds + k * 32 + 16);
          wdt[j][0] = lo[0]; wdt[j][1] = lo[1]; wdt[j][2] = lo[2]; wdt[j][3] = lo[3]; wdt[j][4] = hi[0]; wdt[j][5] = hi[1]; wdt[j][6] = hi[2]; wdt[j][7] = hi[3]; }
      __syncthreads(); }
    LAS float* scr = (LAS float*)(F.lds + F.wave * 16384);
    const int gw = F.vcu * 8 + F.wave, NGW = F.G * 8;
    unsigned char* ws = F.ws;
    bf16_t* Win_t = (bf16_t*)(ws + WS_WIN_T); bf16_t* Wout_t = (bf16_t*)(ws + WS_WOUT_T); bf16_t* W3_t = (bf16_t*)(ws + WS_W3_T); bf16_t* Wds_t = (bf16_t*)(ws + WS_WDS_T);
    bf16_t* Wgu_t = (bf16_t*)(ws + WS_WGU_T); bf16_t* Wd_t = (bf16_t*)(ws + WS_WD_T);
    const float* w_in = KARG_IN(1); const float* w_out = KARG_IN(10); const float* w_router = KARG_IN(13);
    const float* wge = KARG_IN(15); const float* wue = KARG_IN(16); const float* wde = KARG_IN(17);
    const float* wgs = KARG_IN(18); const float* wus = KARG_IN(19); const float* wds = KARG_IN(20);
    constexpr int I_IN = 16 * (PW / 32), I_OUT = 16 * 32, I_R = 16 * 8, I_S = 16 * 16, I_DS = 4 * 32, I_EGU = 16 * 16, I_ED = 4 * 32;
#if defined(MK_OLD_EXPERTS)
    constexpr int NITEMS = I_IN + I_OUT + I_R + I_S + I_DS + NEXP * (I_EGU + I_ED);
#else
    constexpr int NITEMS = I_IN + I_OUT + I_R + I_S + I_DS;
#endif
    for (int it = gw; it < NITEMS; it += NGW) {
        int r = it;
        if (r < I_IN) { const int kb = r / (PW / 32), nb = r % (PW / 32), row0 = nb * 32; const int c0 = row0 < 1536 ? row0 : row0 + 8;
            transpose_item(w_in, NIN, c0, kb * 64, Win_t, 1024, row0, scr, F_LANE); continue; } r -= I_IN;
        if (r < I_OUT) { transpose_item(w_out, 1024, (r & 31) * 32, (r >> 5) * 64, Wout_t, 1024, (r & 31) * 32, scr, F_LANE); continue; } r -= I_OUT;
        if (r < I_R) { transpose_item(w_router, 256, (r & 7) * 32, (r >> 3) * 64, W3_t, 1024, (r & 7) * 32, scr, F_LANE); continue; } r -= I_R;
        if (r < I_S) { gu_item(wgs, wus, W3_t + (size_t)256 * 1024, r, scr, F_LANE); continue; } r -= I_S;
        if (r < I_DS) { transpose_item(wds, 1024, (r & 31) * 32, (r >> 5) * 64, Wds_t, 256, (r & 31) * 32, scr, F_LANE); continue; } r -= I_DS;
        const int e = r / (I_EGU + I_ED), q = r % (I_EGU + I_ED);
        if (q < I_EGU) gu_item(wge + (size_t)e * 1024 * 256, wue + (size_t)e * 1024 * 256, Wgu_t + (size_t)e * 512 * 1024, q, scr, F_LANE);
        else { const int qq = q - I_EGU; transpose_item(wde + (size_t)e * 256 * 1024, 1024, (qq & 31) * 32, (qq >> 5) * 64, Wd_t + (size_t)e * 1024 * 256, 256, (qq & 31) * 32, scr, F_LANE); }
    }
    const float* x = KARG_IN(0); bf16_t* xb = (bf16_t*)(ws + WS_XB); float* dtraw = (float*)(ws + WS_DTRAW);
    f32x4 n0, n1, n2, n3;
    { const float* xr = x + (size_t)(gw < T_TOK ? gw : 0) * DM; n0 = *(const f32x4*)(xr + 8 * F_LANE); n1 = *(const f32x4*)(xr + 8 * F_LANE + 4); n2 = *(const f32x4*)(xr + 512 + 8 * F_LANE); n3 = *(const f32x4*)(xr + 512 + 8 * F_LANE + 4); }
    for (int t = gw; t < T_TOK; t += NGW) {
        const f32x4 a0 = n0, a1 = n1, b0 = n2, b1 = n3;
        { const int tn = t + NGW < T_TOK ? t + NGW : t; const float* xr = x + (size_t)tn * DM;
          n0 = *(const f32x4*)(xr + 8 * F_LANE); n1 = *(const f32x4*)(xr + 8 * F_LANE + 4); n2 = *(const f32x4*)(xr + 512 + 8 * F_LANE); n3 = *(const f32x4*)(xr + 512 + 8 * F_LANE + 4); }
        u32x4 w0; w0.x = cvt_pk_bf16(a0[0], a0[1]); w0.y = cvt_pk_bf16(a0[2], a0[3]); w0.z = cvt_pk_bf16(a1[0], a1[1]); w0.w = cvt_pk_bf16(a1[2], a1[3]);
        u32x4 w1; w1.x = cvt_pk_bf16(b0[0], b0[1]); w1.y = cvt_pk_bf16(b0[2], b0[3]); w1.z = cvt_pk_bf16(b1[0], b1[1]); w1.w = cvt_pk_bf16(b1[2], b1[3]);
        *(u32x4*)(xb + (size_t)t * DM + 8 * F_LANE) = w0; *(u32x4*)(xb + (size_t)t * DM + 512 + 8 * F_LANE) = w1;
        const float xv[16] = {a0[0], a0[1], a0[2], a0[3], a1[0], a1[1], a1[2], a1[3], b0[0], b0[1], b0[2], b0[3], b1[0], b1[1], b1[2], b1[3]};
        float d[8];
#pragma unroll
        for (int h = 0; h < 8; ++h) { float sm = 0.f;
#pragma unroll
            for (int j = 0; j < 16; ++j) sm = fmaf(xv[j], wdt[j][h], sm);
            d[h] = wave_sum(sm); }
        if (F_LANE == 0) { *(f32x4*)(dtraw + t * 8) = (f32x4){d[0], d[1], d[2], d[3]}; *(f32x4*)(dtraw + t * 8 + 4) = (f32x4){d[4], d[5], d[6], d[7]}; }
    }
}

__device__ __forceinline__ void phase_ln1(const Frame& F, const Args& a) {
    const int gw = F.vcu * 8 + F.wave, NGW = F.G * 8;
    float* h1 = (float*)(F.ws + WS_H1); bf16_t* h1b = (bf16_t*)(F.ws + WS_H1B);
    const float* g = KARG_IN(11); const float* b = KARG_IN(12);
    const int c0 = 8 * F_LANE;
    f32x4 gv[4], bv[4];
    gv[0] = *(const f32x4*)(g + c0); gv[1] = *(const f32x4*)(g + c0 + 4); gv[2] = *(const f32x4*)(g + 512 + c0); gv[3] = *(const f32x4*)(g + 512 + c0 + 4);
    bv[0] = *(const f32x4*)(b + c0); bv[1] = *(const f32x4*)(b + c0 + 4); bv[2] = *(const f32x4*)(b + 512 + c0); bv[3] = *(const f32x4*)(b + 512 + c0 + 4);
    for (int t = gw; t < T_TOK; t += NGW) {
        float* r = h1 + (size_t)t * DM;
        f32x4 v[4]; v[0] = *(const f32x4*)(r + c0); v[1] = *(const f32x4*)(r + c0 + 4); v[2] = *(const f32x4*)(r + 512 + c0); v[3] = *(const f32x4*)(r + 512 + c0 + 4);
        float s = 0.f;
#pragma unroll
        for (int j = 0; j < 4; ++j) s += (v[j][0] + v[j][1]) + (v[j][2] + v[j][3]);
        const float mu = wave_sum(s) * (1.0f / 1024.0f);
        float q = 0.f;
#pragma unroll
        for (int j = 0; j < 4; ++j) { v[j] = v[j] - mu; q += (v[j][0] * v[j][0] + v[j][1] * v[j][1]) + (v[j][2] * v[j][2] + v[j][3] * v[j][3]); }
        const float rs = rsqrtf(wave_sum(q) * (1.0f / 1024.0f) + LN_EPS_F);
#pragma unroll
        for (int j = 0; j < 4; ++j) v[j] = v[j] * rs * gv[j] + bv[j];
        u32x4 w0; w0.x = cvt_pk_bf16(v[0][0], v[0][1]); w0.y = cvt_pk_bf16(v[0][2], v[0][3]); w0.z = cvt_pk_bf16(v[1][0], v[1][1]); w0.w = cvt_pk_bf16(v[1][2], v[1][3]);
        u32x4 w1; w1.x = cvt_pk_bf16(v[2][0], v[2][1]); w1.y = cvt_pk_bf16(v[2][2], v[2][3]); w1.z = cvt_pk_bf16(v[3][0], v[3][1]); w1.w = cvt_pk_bf16(v[3][2], v[3][3]);
        *(u32x4*)(h1b + (size_t)t * DM + c0) = w0; *(u32x4*)(h1b + (size_t)t * DM + 512 + c0) = w1;
    }
}

__device__ __forceinline__ void phase_route(const Frame& F, const Args& a) {
    const int gw = F.vcu * 8 + F.wave, NGW = F.G * 8, lane = F_LANE;
    const float* logits = (const float*)(F.ws + WS_LOGITS); const float* rbias = KARG_IN(14);
    int* counts = (int*)(F.ctl + CW_COUNTS); int* tok_e = (int*)(F.ws + WS_TOKE); int* tok_pos = (int*)(F.ws + WS_TOKPOS); float* tok_gate = (float*)(F.ws + WS_TOKGATE);
    int* lists = (int*)(F.ws + WS_LISTS);
    const f32x4 rb = *(const f32x4*)(rbias + lane * 4);
    f32x4 lgn = *(const f32x4*)(logits + (size_t)(gw < T_TOK ? gw : 0) * 256 + lane * 4);
    int p_t = -1, p_e = 0, p_pos = 0;
    for (int t = gw; t < T_TOK; t += NGW) {
        const f32x4 lg = lgn;
        { const int tn = t + NGW < T_TOK ? t + NGW : t; lgn = *(const f32x4*)(logits + (size_t)tn * 256 + lane * 4); }
        float sc[4] = {sigmf(lg[0]), sigmf(lg[1]), sigmf(lg[2]), sigmf(lg[3])};
        float bs[4] = {sc[0] + rb[0], sc[1] + rb[1], sc[2] + rb[2], sc[3] + rb[3]};
        float m1 = fmaxf(bs[0], bs[1]), m2 = fminf(bs[0], bs[1]);
        { const float n1 = fmaxf(bs[2], bs[3]), n2 = fminf(bs[2], bs[3]);
          const float a1 = fmaxf(m1, n1), a2 = fmaxf(fminf(m1, n1), fmaxf(m2, n2)); m1 = a1; m2 = a2; }
        { const float n1 = dpp_f<0xB1>(m1), n2 = dpp_f<0xB1>(m2); const float a1 = fmaxf(m1, n1), a2 = fmaxf(fminf(m1, n1), fmaxf(m2, n2)); m1 = a1; m2 = a2; }
        { const float n1 = dpp_f<0x4E>(m1), n2 = dpp_f<0x4E>(m2); const float a1 = fmaxf(m1, n1), a2 = fmaxf(fminf(m1, n1), fmaxf(m2, n2)); m1 = a1; m2 = a2; }
        { const float n1 = dpp_f<0x141>(m1), n2 = dpp_f<0x141>(m2); const float a1 = fmaxf(m1, n1), a2 = fmaxf(fminf(m1, n1), fmaxf(m2, n2)); m1 = a1; m2 = a2; }
        const float gs = m1 + m2; const int mygrp = lane >> 3; int rank = 0;
#pragma unroll
        for (int gI = 0; gI < 8; ++gI) { const float og = rdlane_f(gs, gI * 8); rank += (og > gs || (og == gs && gI < mygrp)) ? 1 : 0; }
        const bool sel = rank < 4;
        float cand[4];
#pragma unroll
        for (int j = 0; j < 4; ++j) cand[j] = sel ? bs[j] : -INFINITY;
        int my_e = -1; float my_s = 0.f; float gsum = 0.f;
#pragma unroll
        for (int k = 0; k < 8; ++k) {
            const float mx = wave_max(fmaxf(fmaxf(cand[0], cand[1]), fmaxf(cand[2], cand[3])));
            int be = 1 << 20;
#pragma unroll
            for (int j = 0; j < 4; ++j) { const unsigned long long bm = __ballot(cand[j] == mx); const int ej = bm ? (__ffsll((long long)bm) - 1) * 4 + j : (1 << 20); be = ej < be ? ej : be; }
            be = __builtin_amdgcn_readfirstlane(be);
            const int wj = be & 3, bl = be >> 2;
            const float mysc = wj == 0 ? sc[0] : wj == 1 ? sc[1] : wj == 2 ? sc[2] : sc[3];
            const float wsc = rdlane_f(mysc, bl);
#pragma unroll
            for (int j = 0; j < 4; ++j) cand[j] = (lane == bl && j == wj) ? -INFINITY : cand[j];
            gsum += wsc;
            if (lane == k) { my_e = be; my_s = wsc; }
        }
        if (lane < 8) {
            if (p_t >= 0) { tok_pos[p_t * 8 + lane] = p_pos; lists[(size_t)p_e * LIST_CAP + p_pos] = p_t * 8 + lane; }
            const float gate = my_s / gsum * 2.5f;
            p_pos = atomicAdd(&counts[my_e * CNT_STRIDE], 1); p_e = my_e; p_t = t;
            tok_e[t * 8 + lane] = my_e; tok_gate[t * 8 + lane] = gate;
        }
    }
    if (lane < 8 && p_t >= 0) { tok_pos[p_t * 8 + lane] = p_pos; lists[(size_t)p_e * LIST_CAP + p_pos] = p_t * 8 + lane; }
}

__device__ __forceinline__ void build_tables(const Frame& F) {
    const int* counts = (const int*)(F.ctl + CW_COUNTS);
    LAS int* pref = (LAS int*)(F.lds + LDS_PREF); LAS int* offs = (LAS int*)(F.lds + LDS_OFFS); LAS int* cnt = (LAS int*)(F.lds + LDS_CNT);
    LAS int* wt = (LAS int*)(F.lds);
    const int tid = F_TID, lane = tid & 63;
    __syncthreads();
    int n = 0, nt = 0, in_ = 0, it_ = 0;
    if (F.wave < 4) {
        n = __hip_atomic_load(&counts[tid * CNT_STRIDE], __ATOMIC_RELAXED, __HIP_MEMORY_SCOPE_AGENT); nt = (n + 255) >> 8; in_ = n; it_ = nt;
#pragma unroll
        for (int o = 1; o < 64; o <<= 1) { const int a = __shfl_up(in_, o), b = __shfl_up(it_, o); if (lane >= o) { in_ += a; it_ += b; } }
        if (lane == 63) { wt[F.wave] = in_; wt[4 + F.wave] = it_; }
    }
    __syncthreads();
    if (F.wave < 4) {
        for (int w = 0; w < F.wave; ++w) { in_ += wt[w]; it_ += wt[4 + w]; }
        cnt[tid] = n; offs[tid] = in_ - n; pref[tid] = it_ - nt;
        if (tid == NEXP - 1) { offs[NEXP] = in_; pref[NEXP] = it_; }
    }
    __syncthreads();
}

__device__ __forceinline__ void phase_final(const Frame& F, const Args& a) {
    const int gw = F.vcu * 8 + F.wave, NGW = F.G * 8;
    const float* h1 = (const float*)(F.ws + WS_H1); const bf16_t* ys = (const bf16_t*)(F.ws + WS_YS); const bf16_t* yb = (const bf16_t*)(F.ws + WS_YB);
    const int* tok_e = (const int*)(F.ws + WS_TOKE); const int* tok_pos = (const int*)(F.ws + WS_TOKPOS);
    const LAS int* offs = (const LAS int*)(F.lds + LDS_OFFS);
    const float* g = KARG_IN(21); const float* b = KARG_IN(22); float* out = KARG_OUT();
    const int c0 = 8 * F_LANE;
    f32x4 gv[4], bv[4];
    gv[0] = *(const f32x4*)(g + c0); gv[1] = *(const f32x4*)(g + c0 + 4); gv[2] = *(const f32x4*)(g + 512 + c0); gv[3] = *(const f32x4*)(g + 512 + c0 + 4);
    bv[0] = *(const f32x4*)(b + c0); bv[1] = *(const f32x4*)(b + c0 + 4); bv[2] = *(const f32x4*)(b + 512 + c0); bv[3] = *(const f32x4*)(b + 512 + c0 + 4);
    const int lane8 = F_LANE;
    const bf16_t* h1b = (const bf16_t*)(F.ws + WS_H1B); const unsigned char* yb8 = (const unsigned char*)(F.ws + WS_YB);
    int ekn = 0, pkn = 0;
    if (gw < T_TOK && lane8 < 8) { ekn = tok_e[gw * 8 + lane8]; pkn = tok_pos[gw * 8 + lane8]; }
    for (int t = gw; t < T_TOK; t += NGW) {
        const int myrow = lane8 < 8 ? offs[ekn] + pkn : 0;
        const u32x4 r0 = *(const u32x4*)(h1b + (size_t)t * DM + c0), r1 = *(const u32x4*)(h1b + (size_t)t * DM + 512 + c0);
        const u32x4 s0 = *(const u32x4*)(ys + (size_t)t * DM + c0), s1 = *(const u32x4*)(ys + (size_t)t * DM + 512 + c0);
        u32x2 W[8][2];
#pragma unroll
        for (int k = 0; k < 8; ++k) { const unsigned char* src = yb8 + (size_t)__shfl(myrow, k) * 1024; W[k][0] = *(const u32x2*)(src + c0); W[k][1] = *(const u32x2*)(src + 512 + c0); }
        { const int tn = t + NGW; if (tn < T_TOK && lane8 < 8) { ekn = tok_e[tn * 8 + lane8]; pkn = tok_pos[tn * 8 + lane8]; } }
        f32x4 v[4], y[4];
        v[0] = (f32x4){bflo(r0.x), bfhi(r0.x), bflo(r0.y), bfhi(r0.y)}; v[1] = (f32x4){bflo(r0.z), bfhi(r0.z), bflo(r0.w), bfhi(r0.w)};
        v[2] = (f32x4){bflo(r1.x), bfhi(r1.x), bflo(r1.y), bfhi(r1.y)}; v[3] = (f32x4){bflo(r1.z), bfhi(r1.z), bflo(r1.w), bfhi(r1.w)};
#pragma unroll
        for (int j = 0; j < 4; ++j) { v[j] = v[j] * ALPHA_F; y[j] = (f32x4){0.f, 0.f, 0.f, 0.f}; }
        v[0] = v[0] + (f32x4){bflo(s0.x), bfhi(s0.x), bflo(s0.y), bfhi(s0.y)}; v[1] = v[1] + (f32x4){bflo(s0.z), bfhi(s0.z), bflo(s0.w), bfhi(s0.w)};
        v[2] = v[2] + (f32x4){bflo(s1.x), bfhi(s1.x), bflo(s1.y), bfhi(s1.y)}; v[3] = v[3] + (f32x4){bflo(s1.z), bfhi(s1.z), bflo(s1.w), bfhi(s1.w)};
#pragma unroll
        for (int k = 0; k < 8; ++k) { y[0] = y[0] + un4_fp8(W[k][0].x); y[1] = y[1] + un4_fp8(W[k][0].y); y[2] = y[2] + un4_fp8(W[k][1].x); y[3] = y[3] + un4_fp8(W[k][1].y); }
#pragma unroll
        for (int j = 0; j < 4; ++j) v[j] = v[j] + y[j] * (1.0f / YB_SCALE);
        float s = 0.f;
#pragma unroll
        for (int j = 0; j < 4; ++j) s += (v[j][0] + v[j][1]) + (v[j][2] + v[j][3]);
        const float mu = wave_sum(s) * (1.0f / 1024.0f);
        float q = 0.f;
#pragma unroll
        for (int j = 0; j < 4; ++j) { v[j] = v[j] - mu; q += (v[j][0] * v[j][0] + v[j][1] * v[j][1]) + (v[j][2] * v[j][2] + v[j][3] * v[j][3]); }
        const float rs = rsqrtf(wave_sum(q) * (1.0f / 1024.0f) + LN_EPS_F);
        float* o = out + (size_t)t * DM;
#pragma unroll
        for (int j = 0; j < 4; ++j) v[j] = v[j] * rs * gv[j] + bv[j];
        *(f32x4*)(o + c0) = v[0]; *(f32x4*)(o + c0 + 4) = v[1]; *(f32x4*)(o + 512 + c0) = v[2]; *(f32x4*)(o + 512 + c0 + 4) = v[3];
    }
}


namespace xk {
constexpr int B_IMG = 16384, A_SLOT = 16384, L_B0 = 0, L_A0 = 4 * B_IMG, L_GATE = 8 * 16384;
typedef __amdgpu_buffer_rsrc_t rsrc_t;
__device__ __forceinline__ rsrc_t make_rsrc(const void* p) { return __builtin_amdgcn_make_buffer_rsrc((void*)p, 0, 0x7fffffff, 0x00020000); }
__device__ __forceinline__ u32x4 make_srd(const void* p) { const unsigned long long v = (unsigned long long)p; u32x4 d;
    d.x = (unsigned)__builtin_amdgcn_readfirstlane((int)(unsigned)v); d.y = (unsigned)__builtin_amdgcn_readfirstlane((int)(unsigned)(v >> 32)) & 0xffffu; d.z = 0x7fffffffu; d.w = 0x00020000u; return d; }
__device__ __forceinline__ void dma16(const u32x4 srd, unsigned voff, int soff, unsigned lds_addr) {
    asm volatile("s_mov_b32 m0, %0\n\ts_nop 0\n\tbuffer_load_dwordx4 %1, %2, %3 offen lds" :: "s"(lds_addr), "v"(voff), "s"(srd), "s"(soff) : "m0", "memory");
}
__device__ __forceinline__ void a_piece_rc(int b, int& R, int& C) { const int st = b >> 10, sb = b & 1023, ob = sb ^ (((sb >> 9) & 1) << 5); R = st * 16 + (ob >> 6); C = (ob & 63) >> 1; }
struct PassDesc { u32x4 ra; unsigned aoff[2]; rsrc_t rb0, rb1; int bcol, ncol; unsigned boff; int nh; bool preloaded, chain; };
typedef f32x4 Acc[2][4][2][2];

template <bool GU> __device__ __forceinline__ void kloop(LAS unsigned char* lds, const PassDesc& P, const int wid, const int lane, const int bir, Acc& acc, f32x4 (&Br)[4][4]) {
    const int wr = wid >> 2, wc = wid & 3, fr = lane & 15, fq = lane >> 4, hl = lane >> 5;
    const int KB = GU ? 32 * 256 * 4 : 32 * 1024 * 4;
#define XK_DMAA(hh, slot) do { _Pragma("unroll") for (int _i = 0; _i < 2; ++_i) dma16(P.ra, P.aoff[_i], (hh) * 64, (unsigned)(size_t)(lds + L_A0 + (slot) * A_SLOT + _i * 8192 + wid * 1024)); } while (0)
#define XK_LOADB(col, hh, st) do { _Pragma("unroll") for (int _i = 0; _i < 4; ++_i) { \
            const u32x4 _v = GU ? __builtin_amdgcn_raw_buffer_load_b128((_i >> 1) ? P.rb1 : P.rb0, P.boff, (col) + (hh) * KB + (_i & 1) * (2 * 256 * 4), 0) \
                                : __builtin_amdgcn_raw_buffer_load_b128(P.rb0, P.boff, (col) + (hh) * KB + _i * (1024 * 4), 0); \
            Br[st][_i] = __builtin_bit_cast(f32x4, _v); } } while (0)
    const unsigned swg = (unsigned)(((wid >> 1) & 1) << 4);
    unsigned bw0 = (unsigned)(size_t)(lds + L_B0) + (GU ? (4 * wid + hl) * 512 + (bir ^ (hl << 7) ^ swg) : 4 * wid * 512 + (bir ^ swg));
    const int q = (lane & 15) >> 2, p = lane & 3;
    unsigned br0 = (unsigned)(size_t)(lds + L_B0) + (8 * fq + q) * 512 + ((128 * wc + 32 * p) ^ ((q & 1) << 7) ^ (((q >> 1) & 1) << 3) ^ ((fq & 1) << 4));
    const LAS unsigned char* arp = lds + L_A0 + (wr * 4) * 1024 + ((fr * 64 + 16 * fq) ^ ((fr >> 3) << 5));
#define XK_WRITEB(st, img) do { _Pragma("unroll") for (int _i = 0; _i < 4; ++_i) { u32x2 _w; _w.x = cvt_pk_bf16(Br[st][_i][0], Br[st][_i][1]); _w.y = cvt_pk_bf16(Br[st][_i][2], Br[st][_i][3]); \
        if (GU) *(LAS u32x2*)(size_t)((bw0 ^ (unsigned)(((_i >> 1) << 4) | ((_i & 1) << 3))) + (img) * B_IMG + 2 * (_i & 1) * 512) = _w; \
        else *(LAS u32x2*)(size_t)((bw0 ^ (unsigned)(((_i & 1) << 7) | (((_i >> 1) & 1) << 3))) + (img) * B_IMG + _i * 512) = _w; } } while (0)
#define XK_FRAGS(slot, img) do { \
        _Pragma("unroll") for (int gI = 0; gI < 2; ++gI) _Pragma("unroll") for (int nn = 0; nn < 2; ++nn) { \
            const LAS unsigned char* _a = (const LAS unsigned char*)(size_t)((br0 ^ (unsigned)(16 * gI + 8 * nn)) + (img) * B_IMG); \
            const s16x4 _lo = __builtin_amdgcn_ds_read_tr16_b64_v4i16((LAS s16x4*)_a), _hi = __builtin_amdgcn_ds_read_tr16_b64_v4i16((LAS s16x4*)(_a + 2048)); \
            wf[gI][nn] = (bf16x8){_lo[0], _lo[1], _lo[2], _lo[3], _hi[0], _hi[1], _hi[2], _hi[3]}; } \
        _Pragma("unroll") for (int ai = 0; ai < 2; ++ai) _Pragma("unroll") for (int m = 0; m < 4; ++m) xf[ai][m] = *(const LAS bf16x8*)(arp + (slot) * A_SLOT + (8 * ai + m) * 1024); } while (0)
#define XK_MMA() do { __builtin_amdgcn_s_setprio(1); \
        _Pragma("unroll") for (int ai = 0; ai < 2; ++ai) _Pragma("unroll") for (int m = 0; m < 4; ++m) _Pragma("unroll") for (int gI = 0; gI < 2; ++gI) _Pragma("unroll") for (int nn = 0; nn < 2; ++nn) \
            acc[ai][m][gI][nn] = __builtin_amdgcn_mfma_f32_16x16x32_bf16(wf[gI][nn], xf[ai][m], acc[ai][m][gI][nn], 0, 0, 0); \
        __builtin_amdgcn_s_setprio(0); } while (0)
    bf16x8 wf[2][2], xf[2][4];
    const int nh = P.nh;
    if (!P.preloaded) {
        XK_LOADB(P.bcol, 0, 0); XK_LOADB(P.bcol, 1, 1); XK_LOADB(P.bcol, 2, 2); XK_DMAA(0, 0); XK_DMAA(1, 1);
        XK_WRITEB(0, 0);
        asm volatile("s_waitcnt vmcnt(0)" ::: "memory");
        __syncthreads();
    }
    const int tcol = P.chain ? P.ncol : P.bcol;
    if (wid >= 4) __builtin_amdgcn_s_barrier();
#define XK_ITER(j) do { const int _h = hb + (j); asm volatile("" : "+v"(bw0), "+v"(br0));     \
        { const bool _in2 = _h + 2 < nh; XK_DMAA(_in2 ? _h + 2 : _h + 2 - nh, ((j) + 2) & 3); \
          const bool _in3 = _h + 3 < nh; XK_LOADB(_in3 ? P.bcol : tcol, _in3 ? _h + 3 : _h + 3 - nh, ((j) + 3) & 3); } \
        XK_WRITEB(((j) + 1) & 3, ((j) + 1) & 3); \
        XK_FRAGS((j), (j));        \
        asm volatile("s_waitcnt vmcnt(10)" ::: "memory");     \
        asm volatile("s_waitcnt lgkmcnt(0)" ::: "memory"); __builtin_amdgcn_sched_barrier(0); __builtin_amdgcn_s_barrier(); __builtin_amdgcn_sched_barrier(0); \
        XK_MMA(); \
        __builtin_amdgcn_sched_barrier(0); __builtin_amdgcn_s_barrier(); __builtin_amdgcn_sched_barrier(0); } while (0)
    for (int hb = 0; hb < nh; hb += 4) { XK_ITER(0); XK_ITER(1); XK_ITER(2); XK_ITER(3); }
    if (wid < 4) __builtin_amdgcn_s_barrier();
#undef XK_ITER
#undef XK_DMAA
#undef XK_LOADB
#undef XK_WRITEB
#undef XK_FRAGS
#undef XK_MMA
}
}

__device__ __forceinline__ void phase_experts(const Frame& F, const Args& a, const int mode) {
    build_tables(F);
    const int wid = F.wave, wr = wid >> 2, wc = wid & 3;
    const LAS int* pref = (const LAS int*)(F.lds + LDS_PREF);
    const int U = __builtin_amdgcn_readfirstlane(pref[NEXP]);
    const int* lists = (const int*)(F.ws + WS_LISTS); const float* tok_gate = (const float*)(F.ws + WS_TOKGATE);
    const char* h1b = (const char*)(F.ws + WS_H1B); bf16_t* H = (bf16_t*)(F.ws + WS_H); bf16_t* YB = (bf16_t*)(F.ws + WS_YB);
    f32x4 Br[4][4];
    for (int ui = 0;; ++ui) {
        int L = ui * F.G + blockIdx.x; if (L >= U) break;
        { const int qq = U / 8, rr = U % 8, xcd = L % 8, off = L / 8; L = (xcd < rr ? xcd * (qq + 1) : rr * (qq + 1) + (xcd - rr) * qq) + off; }
        int lo = 0, hi = NEXP;
        while (hi - lo > 1) { const int mid = (lo + hi) >> 1; const int pv = __builtin_amdgcn_readfirstlane(pref[mid]); if (pv <= L) lo = mid; else hi = mid; }
        const int e = lo, mt = L - __builtin_amdgcn_readfirstlane(pref[e]);
        const int n = __builtin_amdgcn_readfirstlane(((const LAS int*)(F.lds + LDS_CNT))[e]);
        const int rows = (n - mt * 256) < 256 ? (n - mt * 256) : 256;
        const int slot0 = __builtin_amdgcn_readfirstlane(((const LAS int*)(F.lds + LDS_OFFS))[e]) + mt * 256;
        const int* lst = lists + (size_t)e * LIST_CAP + mt * 256;
        const int ew = (mode & 1) ? 0 : e;
        const float* Wg = KARG_IN(15) + (size_t)ew * 1024 * 256; const float* Wu = KARG_IN(16) + (size_t)ew * 1024 * 256; const float* Wd = KARG_IN(17) + (size_t)ew * 256 * 1024;
        {
            xk::PassDesc P; P.ra = xk::make_srd(h1b);
            { const int lane = lane_id(), tid = wid * 64 + lane;
#pragma unroll
              for (int i = 0; i < 2; ++i) { int R, C; xk::a_piece_rc(tid * 16 + i * 8192, R, C); int tok = 0; if (R < rows) tok = lst[R] >> 3; if (mode & 2) tok = (slot0 + R) & 16383; P.aoff[i] = (unsigned)(tok * 1024 + C) * 2u; }
              P.boff = (unsigned)((4 * wid + (lane >> 5)) * 256 + 4 * (lane & 31)) * 4u; }
            P.nh = 32; P.rb0 = xk::make_rsrc(Wg); P.rb1 = xk::make_rsrc(Wu);
#pragma unroll 1
            for (int pn = 0; pn < 2; ++pn) {
                P.bcol = pn * 128 * 4; P.ncol = 128 * 4;
                P.preloaded = pn == 1; P.chain = pn == 0;
                xk::Acc acc;
#pragma unroll
                for (int ai = 0; ai < 2; ++ai)
#pragma unroll
                    for (int m = 0; m < 4; ++m)
#pragma unroll
                        for (int gI = 0; gI < 2; ++gI)
#pragma unroll
                            for (int nn = 0; nn < 2; ++nn) acc[ai][m][gI][nn] = (f32x4){0.f, 0.f, 0.f, 0.f};
                { const int lane = lane_id(); xk::kloop<true>(F.lds, P, wid, lane, 128 * ((lane & 31) >> 3) + 32 * (((lane & 31) >> 1) & 3) + 8 * (lane & 1), acc, Br); }
                const int lane = lane_id(), fr = lane & 15, fq = lane >> 4;
                const xk::rsrc_t rH = xk::make_rsrc(H + (size_t)slot0 * 256);
#pragma unroll
                for (int ai = 0; ai < 2; ++ai)
#pragma unroll
                    for (int m = 0; m < 4; ++m) { const int r = ai * 128 + wr * 64 + m * 16 + fr;
                        if (r < rows && !(mode & 4) && !(mode & 16)) { float h[8];
#pragma unroll
                            for (int nn = 0; nn < 2; ++nn)
#pragma unroll
                                for (int j = 0; j < 4; ++j) h[nn * 4 + j] = siluf(acc[ai][m][0][nn][j]) * acc[ai][m][1][nn][j];
                            u32x4 w; w.x = cvt_pk_bf16(h[0], h[1]); w.y = cvt_pk_bf16(h[2], h[3]); w.z = cvt_pk_bf16(h[4], h[5]); w.w = cvt_pk_bf16(h[6], h[7]);
                            __builtin_amdgcn_raw_buffer_store_b128(w, rH, (unsigned)(r * 256 + pn * 128 + wc * 32 + 8 * fq) * 2u, 0, 0); } }
            }
        }
        { const int t = wid * 64 + lane_id();
          if (t < 256) ((LAS float*)(F.lds + xk::L_GATE))[t] = t < rows ? tok_gate[lst[t]] : 0.f; }
        asm volatile("s_waitcnt vmcnt(0)" ::: "memory");
        __syncthreads();
        {
            xk::PassDesc P; P.ra = xk::make_srd(H + (size_t)slot0 * 256);
            { const int lane = lane_id(), tid = wid * 64 + lane;
#pragma unroll
              for (int i = 0; i < 2; ++i) { int R, C; xk::a_piece_rc(tid * 16 + i * 8192, R, C); P.aoff[i] = (unsigned)(R * 256 + C) * 2u; }
              P.boff = (unsigned)(4 * wid * 1024 + 4 * lane) * 4u; }
            P.nh = 8; P.rb0 = xk::make_rsrc(Wd); P.rb1 = P.rb0;
#pragma unroll 1
            for (int pn = 0; pn < 4; ++pn) {
                P.bcol = pn * 256 * 4; P.ncol = (pn + 1) * 256 * 4;
                P.preloaded = pn > 0; P.chain = pn < 3;
                xk::Acc acc;
#pragma unroll
                for (int ai = 0; ai < 2; ++ai)
#pragma unroll
                    for (int m = 0; m < 4; ++m)
#pragma unroll
                        for (int gI = 0; gI < 2; ++gI)
#pragma unroll
                            for (int nn = 0; nn < 2; ++nn) acc[ai][m][gI][nn] = (f32x4){0.f, 0.f, 0.f, 0.f};
                { const int lane = lane_id(); xk::kloop<false>(F.lds, P, wid, lane, 8 * lane, acc, Br); }
                const int lane = lane_id(), fr = lane & 15, fq = lane >> 4;
                const xk::rsrc_t rY = xk::make_rsrc((const unsigned char*)YB + (size_t)slot0 * 1024);
#pragma unroll
                for (int ai = 0; ai < 2; ++ai)
#pragma unroll
                    for (int m = 0; m < 4; ++m) { const int r = ai * 128 + wr * 64 + m * 16 + fr;
                        if (r < rows && !(mode & 4) && !(mode & 8)) { const float g = ((const LAS float*)(F.lds + xk::L_GATE))[r] * YB_SCALE;
                            u32x4 w; w.x = pk4_fp8(acc[ai][m][0][0] * g); w.y = pk4_fp8(acc[ai][m][0][1] * g); w.z = pk4_fp8(acc[ai][m][1][0] * g); w.w = pk4_fp8(acc[ai][m][1][1] * g);
                            __builtin_amdgcn_raw_buffer_store_b128(w, rY, (unsigned)(r * 1024 + pn * 256 + 64 * wc + 16 * fq), 0, 0); } }
            }
        }
        __syncthreads();
    }
}

__device__ __forceinline__ float ldp(const bf16_t* p, size_t t, int c) { return bf2f(p[t * PW + c]); }
__device__ __forceinline__ void phase_m1(const Frame& F, const Args& a) {
  const bf16_t* p = (const bf16_t*)(F.ws + WS_P); const float* dtraw = (const float*)(F.ws + WS_DTRAW);
  const float* conv_w = KARG_IN(2); const float* conv_b = KARG_IN(3); const float* dt_bias = KARG_IN(4); const float* lb_logits = KARG_IN(8);
  float* xbc = (float*)(F.ws + WS_NXBC); float* fgk = (float*)(F.ws + WS_NFGK); float* qs = (float*)(F.ws + WS_NQS); float* dtb = (float*)(F.ws + WS_NDTB);
  const int tid = F_TID;
  for (int t = blockIdx.x; t < T_TOK; t += F.G) {
    for (int c = tid; c < 1024; c += 512) {
      float acc = conv_b[c];
#pragma unroll
      for (int j = 0; j < 4; ++j) { const int tt = t - 3 + j; if (tt >= 0) acc = fmaf(conv_w[j * 1024 + c], ldp(p, tt, PC_XBC + c), acc); }
      xbc[(size_t)t * 1024 + c] = siluf(acc);
    }
    { const int c = tid;
      const float l0 = lb_logits[c], l1 = lb_logits[512 + c];
      const float mx = fmaxf(l0, l1);
      const float e0 = expf(l0 - mx), e1 = expf(l1 - mx);
      const float lb = e0 / (e0 + e1);
      const float f = ldp(p, t, PC_F + c);
      fgk[(size_t)t * 512 + c] = lb + (1.0f - lb) * (1.0f / (1.0f + expf(-f)));
      const float q = ldp(p, t, PC_Q + c);
      qs[(size_t)t * 512 + c] = q / (1.0f + expf(-q)); }
    if (tid < 8) { const float v = dtraw[t * 8 + tid] + dt_bias[tid]; dtb[t * 8 + tid] = v > 20.f ? v : log1pf(expf(v)); }
  }
}
__device__ __forceinline__ void phase_m2(const Frame& F, const Args& a) {
  const int item = F.wave * F.G + blockIdx.x, lane = F_LANE;
  const float* xbc = (const float*)(F.ws + WS_NXBC); const float* dtb = (const float*)(F.ws + WS_NDTB);
  const float* fgk = (const float*)(F.ws + WS_NFGK); const float* qs = (const float*)(F.ws + WS_NQS); const bf16_t* p = (const bf16_t*)(F.ws + WS_P);
  float* y_ssd = (float*)(F.ws + WS_NYSSD); float* o_h = (float*)(F.ws + WS_NOH);
  if (item < 512) {
    const int h = item >> 6, pp = item & 63, g = h >> 2;
    const float aa = -expf(KARG_IN(5)[h]), D = KARG_IN(6)[h];
    float h0 = 0.f, h1 = 0.f;
    const float* xp = xbc + h * 64 + pp; const float* Bp = xbc + 512 + g * 128 + lane; const float* Cp = xbc + 768 + g * 128 + lane;
    for (int t0 = 0; t0 < T_TOK; t0 += 8) {
      float Bv0[8], Bv1[8], Cv0[8], Cv1[8], xv[8], dv[8];
#pragma unroll
      for (int i = 0; i < 8; ++i) { const size_t o = (size_t)(t0 + i) * 1024;
        Bv0[i] = Bp[o]; Bv1[i] = Bp[o + 64]; Cv0[i] = Cp[o]; Cv1[i] = Cp[o + 64]; xv[i] = xp[o]; dv[i] = dtb[(t0 + i) * 8 + h]; }
#pragma unroll
      for (int i = 0; i < 8; ++i) {
        const float dA = expf(dv[i] * aa), dx = dv[i] * xv[i];
        h0 = fmaf(dA, h0, dx * Bv0[i]); h1 = fmaf(dA, h1, dx * Bv1[i]);
        float part = wave_sum(Cv0[i] * h0 + Cv1[i] * h1);
        if (lane == 0) y_ssd[(size_t)(t0 + i) * 512 + h * 64 + pp] = part + D * xv[i];
      }
    }
  } else if (item < 1024) {
    const int it = item - 512, h = it >> 7, e = it & 127;
    float S0 = 0.f, S1 = 0.f;
    const float* fp = fgk + h * 128 + lane; const float* qp = qs + h * 128 + lane;
    for (int t0 = 0; t0 < T_TOK; t0 += 8) {
      float f0[8], f1[8], q0[8], q1[8], iv[8];
#pragma unroll
      for (int i = 0; i < 8; ++i) { const size_t o = (size_t)(t0 + i) * 512;
        f0[i] = fp[o]; f1[i] = fp[o + 64]; q0[i] = qp[o]; q1[i] = qp[o + 64]; iv[i] = ldp(p, t0 + i, PC_I + h * 128 + e); }
#pragma unroll
      for (int i = 0; i < 8; ++i) {
        S0 = fmaf(f0[i], S0, (1.0f - f0[i]) * iv[i]); S1 = fmaf(f1[i], S1, (1.0f - f1[i]) * iv[i]);
        float part = wave_sum(q0[i] * S0 + q1[i] * S1);
        if (lane == 0) o_h[(size_t)(t0 + i) * 512 + h * 128 + e] = part;
      }
    }
  }
}
__device__ __forceinline__ void phase_m3(const Frame& F, const Args& a) {
  const int gw = F.vcu * 8 + F.wave, NGW = F.G * 8, lane = F_LANE;
  const float* y_ssd = (const float*)(F.ws + WS_NYSSD); const float* o_h = (const float*)(F.ws + WS_NOH); const bf16_t* p = (const bf16_t*)(F.ws + WS_P);
  const float* snw = KARG_IN(7); const float* hnw = KARG_IN(9); bf16_t* mix = (bf16_t*)(F.ws + WS_MIX);
  for (int idx = gw; idx < T_TOK * 2; idx += NGW) {
    const int t = idx >> 1, g = idx & 1;
    float v[4]; float ss = 0.f;
#pragma unroll
    for (int j = 0; j < 4; ++j) { const int c = g * 256 + lane + 64 * j; v[j] = y_ssd[(size_t)t * 512 + c] * siluf(ldp(p, t, PC_Z + c)); ss += v[j] * v[j]; }
    ss = wave_sum(ss);
    const float r = rsqrtf(ss * (1.0f / 256.0f) + RMS_EPS_F);
#pragma unroll
    for (int j = 0; j < 4; ++j) { const int c = g * 256 + lane + 64 * j; mix[(size_t)t * 1024 + c] = (bf16_t)(cvt_pk_bf16(v[j] * r * snw[c], 0.f) & 0xffffu); }
  }
  for (int idx = gw; idx < T_TOK * 4; idx += NGW) {
    const int t = idx >> 2, h = idx & 3;
    float v[2]; float ss = 0.f;
#pragma unroll
    for (int j = 0; j < 2; ++j) { const int c = h * 128 + lane + 64 * j; v[j] = o_h[(size_t)t * 512 + c]; ss += v[j] * v[j]; }
    ss = wave_sum(ss);
    const float r = rsqrtf(ss * (1.0f / 128.0f) + RMS_EPS_F);
#pragma unroll
    for (int j = 0; j < 2; ++j) { const int c = h * 128 + lane + 64 * j;
      mix[(size_t)t * 1024 + 512 + c] = (bf16_t)(cvt_pk_bf16(v[j] * r * hnw[c] * siluf(ldp(p, t, PC_G + c)), 0.f) & 0xffffu); }
  }
}


#define MFMA32(a, b, c) __builtin_amdgcn_mfma_f32_32x32x16_bf16((a), (b), (c), 0, 0, 0)
__device__ __forceinline__ int drow(int r, int lane) { return (r & 3) + 8 * (r >> 2) + 4 * (lane >> 5); }
__device__ __forceinline__ bf16x8 frag_row(const LAS unsigned char* base, int pitch, int row0, int k0, int lane) {
    return *(const LAS bf16x8*)(base + (row0 + (lane & 31)) * pitch + (k0 + 8 * (lane >> 5)) * 2);
}
template <bool PERM> __device__ __forceinline__ bf16x8 frag_tr(const LAS unsigned char* base, int pitch, int k0, int col0, int lane) {
    const int h = lane >> 5, blk = (lane >> 4) & 1, q = (lane & 15) >> 2, p = lane & 3;
    const LAS unsigned char* a0 = base + (k0 + (PERM ? 4 : 8) * h + q) * pitch + (col0 + 16 * blk + 4 * p) * 2;
    const s16x4 lo = __builtin_amdgcn_ds_read_tr16_b64_v4i16((LAS s16x4*)a0);
    const s16x4 hi = __builtin_amdgcn_ds_read_tr16_b64_v4i16((LAS s16x4*)(a0 + (PERM ? 8 : 4) * pitch));
    return (bf16x8){lo[0], lo[1], lo[2], lo[3], hi[0], hi[1], hi[2], hi[3]};
}
__device__ __forceinline__ bf16x8 acc_frag(const f32x16& x, int s) {
    u32x4 w; w.x = cvt_pk_bf16(x[8 * s + 0], x[8 * s + 1]); w.y = cvt_pk_bf16(x[8 * s + 2], x[8 * s + 3]); w.z = cvt_pk_bf16(x[8 * s + 4], x[8 * s + 5]); w.w = cvt_pk_bf16(x[8 * s + 6], x[8 * s + 7]);
    return __builtin_bit_cast(bf16x8, w);
}
__device__ __forceinline__ float softplusf(float v) { return v > 20.f ? v : log1pf(__expf(v)); }
__device__ __forceinline__ unsigned short f2bf1(float v) { return (unsigned short)(cvt_pk_bf16(v, 0.f) & 0xffffu); }
__device__ __forceinline__ float half_sum(float v) {
    v += dpp_f<0xB1>(v); v += dpp_f<0x4E>(v); v += dpp_f<0x141>(v); v += dpp_f<0x140>(v);
    float a = v, b = v;
    asm volatile("s_nop 1\n\tv_permlane16_swap_b32 %0, %1" : "+v"(a), "+v"(b));
    return a + b;
}

constexpr int SX_PITCH = 576, SB_TR_PITCH = 320, SB_ROW_PITCH = 272;
constexpr int SL_X = 0, SL_B = 128 * SX_PITCH  , SL_C = SL_B + 128 * SB_TR_PITCH  ;
constexpr int SL_DT = 151552, SL_ACUM = SL_DT + 2048, SL_SSQ = SL_ACUM + 2048;
static_assert(SL_C + 128 * SB_ROW_PITCH <= SL_DT && SL_SSQ + 1024 <= LDS_PHASE_BYTES, "SSD LDS map");
constexpr int HL_QD = 0, HL_QP = 64 * 272, HL_KP = 2 * 64 * 272, HL_V = 3 * 64 * 272  , HL_KD = HL_V + 64 * 320  , HL_SEG = HL_KD + 64 * 320  , HL_SSQ = HL_SEG + 4096;
static_assert(HL_SSQ + 1024 <= LDS_PHASE_BYTES, "HGRN LDS map");

__device__ __forceinline__ void ssd_dt_acum(const Frame& F, const Args& a, int c, int g) {
    if (F.wave < 4) {
        const int hh = g * 4 + F.wave, lane = F_LANE; const float* dtraw = (const float*)(F.ws + WS_DTRAW);
        const float bias = KARG_IN(4)[hh], aa = -__expf(KARG_IN(5)[hh]);
        const int t = c * 128 + 2 * lane;
        const float d0 = softplusf(dtraw[(size_t)t * 8 + hh] + bias), d1 = softplusf(dtraw[(size_t)(t + 1) * 8 + hh] + bias);
        const float a0 = d0 * aa, a1 = d1 * aa;
        float incl = a0 + a1;
#pragma unroll
        for (int o = 1; o < 64; o <<= 1) { const float v = __shfl_up(incl, o); if (lane >= o) incl += v; }
        LAS float* dts = (LAS float*)(F.lds + SL_DT) + F.wave * 128; LAS float* acs = (LAS float*)(F.lds + SL_ACUM) + F.wave * 128;
        dts[2 * lane] = d0; dts[2 * lane + 1] = d1; acs[2 * lane] = incl - a1; acs[2 * lane + 1] = incl;
    }
}
__device__ __forceinline__ void ssd_conv_item(const Frame& F, const Args& a, int c, int src_ch, int seg, int hl, int mode, LAS unsigned char* dst, int pitch, int dst_col) {
    const bf16_t* p = (const bf16_t*)(F.ws + WS_P) + PC_XBC + src_ch;
    const float* cw = KARG_IN(2) + src_ch; const float* cb = KARG_IN(3) + src_ch;
    float w[4][8], bias[8];
#pragma unroll
    for (int j = 0; j < 4; ++j) { const f32x4 x0 = *(const f32x4*)(cw + j * 1024), x1 = *(const f32x4*)(cw + j * 1024 + 4);
        w[j][0] = x0[0]; w[j][1] = x0[1]; w[j][2] = x0[2]; w[j][3] = x0[3]; w[j][4] = x1[0]; w[j][5] = x1[1]; w[j][6] = x1[2]; w[j][7] = x1[3]; }
    { const f32x4 x0 = *(const f32x4*)cb, x1 = *(const f32x4*)(cb + 4); bias[0] = x0[0]; bias[1] = x0[1]; bias[2] = x0[2]; bias[3] = x0[3]; bias[4] = x1[0]; bias[5] = x1[1]; bias[6] = x1[2]; bias[7] = x1[3]; }
    const int l0 = seg * 16, t0 = c * 128 + l0;
    u32x4 rw[19];
#pragma unroll
    for (int j = 0; j < 19; ++j) { const int tt = t0 - 3 + j; rw[j] = tt >= 0 ? *(const u32x4*)(p + (size_t)tt * PW) : (u32x4){0u, 0u, 0u, 0u}; }
    const LAS float* dts = (const LAS float*)(F.lds + SL_DT) + hl * 128; const LAS float* acs = (const LAS float*)(F.lds + SL_ACUM) + hl * 128;
    const float alast = acs[127];
#pragma unroll
    for (int i = 0; i < 16; ++i) {
        float v[8];
#pragma unroll
        for (int k = 0; k < 4; ++k) {
            const unsigned r0 = rw[i][k], r1 = rw[i + 1][k], r2 = rw[i + 2][k], r3 = rw[i + 3][k];
            v[2 * k] = siluf(fmaf(w[3][2 * k], bflo(r3), fmaf(w[2][2 * k], bflo(r2), fmaf(w[1][2 * k], bflo(r1), fmaf(w[0][2 * k], bflo(r0), bias[2 * k])))));
            v[2 * k + 1] = siluf(fmaf(w[3][2 * k + 1], bfhi(r3), fmaf(w[2][2 * k + 1], bfhi(r2), fmaf(w[1][2 * k + 1], bfhi(r1), fmaf(w[0][2 * k + 1], bfhi(r0), bias[2 * k + 1])))));
        }
        float sc = 1.f;
        if (mode >= 1) sc = dts[l0 + i];
        if (mode == 2) sc *= __expf(alast - acs[l0 + i]);
        u32x4 o; o.x = cvt_pk_bf16(v[0] * sc, v[1] * sc); o.y = cvt_pk_bf16(v[2] * sc, v[3] * sc); o.z = cvt_pk_bf16(v[4] * sc, v[5] * sc); o.w = cvt_pk_bf16(v[6] * sc, v[7] * sc);
        *(LAS u32x4*)(dst + (l0 + i) * pitch + dst_col * 2) = o;
    }
}

__device__ __forceinline__ void ssd_states_unit(const Frame& F, const Args& a, int c, int g) {
    const int tid = F_TID, lane = F_LANE;
    __syncthreads();
    ssd_dt_acum(F, a, c, g);
    __syncthreads();
    { const int cg = tid & 63, seg = tid >> 6; const bool isx = cg < 32;
      if (cg < 48) ssd_conv_item(F, a, c, isx ? g * 256 + cg * 8 : 512 + g * 128 + (cg - 32) * 8, seg, isx ? (cg >> 3) : 0, isx ? 2 : 0,
                                 F.lds + (isx ? SL_X : SL_B), isx ? SX_PITCH : SB_TR_PITCH, isx ? cg * 8 : (cg - 32) * 8); }
    __syncthreads();
    const int hl = F.wave >> 1, pt = F.wave & 1, hh = g * 4 + hl;
    f32x16 S[4];
#pragma unroll
    for (int nt = 0; nt < 4; ++nt)
#pragma unroll
        for (int r = 0; r < 16; ++r) S[nt][r] = 0.f;
#pragma unroll 2
    for (int ks = 0; ks < 8; ++ks) {
        const bf16x8 A = frag_tr<false>(F.lds + SL_X, SX_PITCH, 16 * ks, hl * 64 + 32 * pt, lane);
#pragma unroll
        for (int nt = 0; nt < 4; ++nt) { const bf16x8 B = frag_tr<false>(F.lds + SL_B, SB_TR_PITCH, 16 * ks, 32 * nt, lane); S[nt] = MFMA32(A, B, S[nt]); }
    }
    float* st = (float*)(F.ws + WS_SSTATE) + ((size_t)(c * 8 + hh) * 64 + 32 * pt) * 128;
#pragma unroll
    for (int nt = 0; nt < 4; ++nt)
#pragma unroll
        for (int r = 0; r < 16; ++r) st[(size_t)drow(r, lane) * 128 + 32 * nt + (lane & 31)] = S[nt][r];
    if (tid < 4) ((float*)(F.ws + WS_CDECAY))[c * 8 + g * 4 + tid] = __expf(((const LAS float*)(F.lds + SL_ACUM))[tid * 128 + 127]);
}

__device__ __forceinline__ void ssd_out_unit(const Frame& F, const Args& a, int c, int g, const int xm = 0) {
    const int lane = F_LANE;
    __syncthreads();
    ssd_dt_acum(F, a, c, g);
    __syncthreads();
    if (!(xm & 4)) { const int tid = F_TID, cg = tid & 63, seg = tid >> 6; const bool isx = cg < 32, isb = cg < 48;
      ssd_conv_item(F, a, c, isx ? g * 256 + cg * 8 : (isb ? 512 + g * 128 + (cg - 32) * 8 : 768 + g * 128 + (cg - 48) * 8), seg, isx ? (cg >> 3) : 0, isx ? 1 : 0,
                    F.lds + (isx ? SL_X : (isb ? SL_B : SL_C)), isx ? SX_PITCH : SB_ROW_PITCH, isx ? cg * 8 : (isb ? (cg - 32) * 8 : (cg - 48) * 8)); }
    const int lt = F.wave >> 1, hp = F.wave & 1;
    const int lcol = 32 * lt + (lane & 31);
    bf16x8 Bsv[2][2][8];
#pragma unroll
    for (int hi = 0; hi < 2; ++hi) {
        const bf16_t* sp = (const bf16_t*)(F.ws + WS_SPREV) + (size_t)(c * 8 + g * 4 + hp * 2 + hi) * 64 * 128 + (size_t)(lane & 31) * 128 + 8 * (lane >> 5);
#pragma unroll
        for (int pt = 0; pt < 2; ++pt)
#pragma unroll
            for (int ks = 0; ks < 8; ++ks) Bsv[hi][pt][ks] = *(const bf16x8*)(sp + (size_t)(32 * pt) * 128 + 16 * ks);
    }
    __syncthreads();
    f32x16 acc[2][2];
#pragma unroll
    for (int hi = 0; hi < 2; ++hi)
#pragma unroll
        for (int pt = 0; pt < 2; ++pt)
#pragma unroll
            for (int r = 0; r < 16; ++r) acc[hi][pt][r] = 0.f;
    if (!(xm & 8))
#pragma unroll
    for (int hi = 0; hi < 2; ++hi) {
        const int hl = hp * 2 + hi;
#pragma unroll
        for (int ks = 0; ks < 8; ++ks) {
            const bf16x8 A = frag_row(F.lds + SL_C, SB_ROW_PITCH, 32 * lt, 16 * ks, lane);
#pragma unroll
            for (int pt = 0; pt < 2; ++pt) acc[hi][pt] = MFMA32(A, Bsv[hi][pt][ks], acc[hi][pt]);
        }
        const LAS float* acs = (const LAS float*)(F.lds + SL_ACUM) + hl * 128;
#pragma unroll
        for (int r = 0; r < 16; ++r) { const float e = __expf(acs[32 * lt + drow(r, lane)]); acc[hi][0][r] *= e; acc[hi][1][r] *= e; }
    }
    unsigned short zv[2][2][16];
    { const bf16_t* pz = (const bf16_t*)(F.ws + WS_P) + (size_t)(c * 128 + 32 * lt) * PW + PC_Z + g * 256 + hp * 128 + (lane & 31);
#pragma unroll
      for (int hi = 0; hi < 2; ++hi)
#pragma unroll
        for (int pt = 0; pt < 2; ++pt)
#pragma unroll
            for (int r = 0; r < 16; ++r) zv[hi][pt][r] = pz[(size_t)drow(r, lane) * PW + hi * 64 + 32 * pt]; }
    float dskip[2]; { const float* dsp = KARG_IN(6); dskip[0] = dsp[g * 4 + hp * 2]; dskip[1] = dsp[g * 4 + hp * 2 + 1]; }
#pragma unroll 1
    for (int st = (xm & 16) ? lt + 1 : 0; st <= lt; ++st) {
        f32x16 GT;
#pragma unroll
        for (int r = 0; r < 16; ++r) GT[r] = 0.f;
#pragma unroll 2
        for (int ks = 0; ks < 8; ++ks) {
            const bf16x8 A = frag_row(F.lds + SL_B, SB_ROW_PITCH, 32 * st, 16 * ks, lane), B = frag_row(F.lds + SL_C, SB_ROW_PITCH, 32 * lt, 16 * ks, lane);
            GT = MFMA32(A, B, GT);
        }
#pragma unroll
        for (int hi = 0; hi < 2; ++hi) {
            const int hl = hp * 2 + hi, hh = g * 4 + hl;
            const LAS float* dts = (const LAS float*)(F.lds + SL_DT) + hl * 128; const LAS float* acs = (const LAS float*)(F.lds + SL_ACUM) + hl * 128;
            const float al = acs[lcol], dsk = dskip[hi] * __builtin_amdgcn_rcpf(dts[lcol]);
            f32x16 M; float av[16];
#pragma unroll
            for (int r = 0; r < 16; ++r) av[r] = acs[32 * st + drow(r, lane)];
#pragma unroll
            for (int r = 0; r < 16; ++r) { const int srow = 32 * st + drow(r, lane);
                const float e = __expf(fminf(al - av[r], 0.f));
                M[r] = GT[r] * e * (srow <= lcol ? 1.f : 0.f) + (srow == lcol ? dsk : 0.f); }
#pragma unroll
            for (int s2 = 0; s2 < 2; ++s2) { const bf16x8 A = acc_frag(M, s2);
#pragma unroll
                for (int pt = 0; pt < 2; ++pt) { const bf16x8 B = frag_tr<true>(F.lds + SL_X, SX_PITCH, 32 * st + 16 * s2, hl * 64 + 32 * pt, lane); acc[hi][pt] = MFMA32(A, B, acc[hi][pt]); } }
        }
    }
    float ssq[16];
#pragma unroll
    for (int r = 0; r < 16; ++r) ssq[r] = 0.f;
    if (!(xm & 32)) {
#pragma unroll
        for (int hi = 0; hi < 2; ++hi)
#pragma unroll
            for (int pt = 0; pt < 2; ++pt)
#pragma unroll
                for (int r = 0; r < 16; ++r) { const float z = bf2f(zv[hi][pt][r]);
                    const float y = acc[hi][pt][r] * siluf(z); acc[hi][pt][r] = y; ssq[r] += y * y; }
    }
    LAS float* ssqs = (LAS float*)(F.lds + SL_SSQ);
#pragma unroll
    for (int r = 0; r < 16; ++r) ssq[r] = half_sum(ssq[r]);
    if ((lane & 31) == 0) {
#pragma unroll
        for (int r = 0; r < 16; ++r) ssqs[F.wave * 32 + drow(r, lane)] = ssq[r]; }
    __syncthreads();
    const float* nw = KARG_IN(7) + g * 256 + hp * 128 + (lane & 31);
#pragma unroll
    for (int r = 0; r < 16; ++r) { const int row = drow(r, lane);
        const float rs = rsqrtf((ssqs[F.wave * 32 + row] + ssqs[(F.wave ^ 1) * 32 + row]) * (1.0f / 256.0f) + RMS_EPS_F);
#pragma unroll
        for (int hi = 0; hi < 2; ++hi)
#pragma unroll
            for (int pt = 0; pt < 2; ++pt) *(LAS unsigned short*)(F.lds + SL_X + (32 * lt + row) * 528 + (hp * 128 + hi * 64 + 32 * pt + (lane & 31)) * 2) = f2bf1(acc[hi][pt][r] * rs * nw[hi * 64 + 32 * pt]); }
    __syncthreads();
    { const int tid = F_TID; bf16_t* mo = (bf16_t*)(F.ws + WS_MIX) + (size_t)(c * 128) * DM + g * 256;
#pragma unroll
      for (int i = 0; i < 8; ++i) { const int pc = tid + 512 * i, row = pc >> 5, ch = (pc & 31) * 8;
          *(u32x4*)(mo + (size_t)row * DM + ch) = *(const LAS u32x4*)(F.lds + SL_X + row * 528 + ch * 2); } }
}

struct HgrnLocal { float fg[8][2], cum[8][2], qv[8][2], iv[8][2], tot[2], mid[2]; };
struct HgrnRaw { unsigned fw[8], iw[8], qw[8]; };
template <bool NEEDQ> __device__ __forceinline__ void hgrn_fetch(const Frame& F, int c, int h, HgrnRaw& R) {
    const int tid = F_TID, cp = tid & 63, seg = tid >> 6, d0 = 2 * cp;
    const bf16_t* p = (const bf16_t*)(F.ws + WS_P) + (size_t)(c * 64 + seg * 8) * PW + h * 128 + d0;
#pragma unroll
    for (int i = 0; i < 8; ++i) { R.fw[i] = *(const unsigned*)(p + (size_t)i * PW + PC_F); R.iw[i] = *(const unsigned*)(p + (size_t)i * PW + PC_I);
        if (NEEDQ) R.qw[i] = *(const unsigned*)(p + (size_t)i * PW + PC_Q); }
}
__device__ __forceinline__ void hgrn_lb(const Frame& F, int h, float (&lb)[2]) {
    const int d0 = 2 * (F_TID & 63); const float* lg = KARG_IN(8);
#pragma unroll
    for (int j = 0; j < 2; ++j) { const float l0 = lg[h * 128 + d0 + j], l1 = lg[512 + h * 128 + d0 + j]; const float mx = fmaxf(l0, l1), e0 = __expf(l0 - mx), e1 = __expf(l1 - mx); lb[j] = e0 / (e0 + e1); }
}
template <bool NEEDQ> __device__ __forceinline__ void hgrn_load(const Frame& F, const Args& a, int h, const HgrnRaw& R, HgrnLocal& L, const float (&lb)[2]) {
    const int tid = F_TID, cp = tid & 63, seg = tid >> 6, d0 = 2 * cp;
    float run[2] = {0.f, 0.f};
#pragma unroll
    for (int i = 0; i < 8; ++i) {
        const unsigned fw = R.fw[i], iw = R.iw[i];
        const float fr[2] = {bflo(fw), bfhi(fw)};
        L.iv[i][0] = bflo(iw); L.iv[i][1] = bfhi(iw);
        if (NEEDQ) { const unsigned qw = R.qw[i]; L.qv[i][0] = siluf(bflo(qw)); L.qv[i][1] = siluf(bfhi(qw)); }
#pragma unroll
        for (int j = 0; j < 2; ++j) { const float fg = lb[j] + (1.0f - lb[j]) * sigmf(fr[j]); L.fg[i][j] = fg; run[j] += __logf(fg); L.cum[i][j] = run[j]; }
    }
    LAS float* segs = (LAS float*)(F.lds + HL_SEG);
    segs[seg * 128 + d0] = run[0]; segs[seg * 128 + d0 + 1] = run[1];
    __syncthreads();
    float pre[2] = {0.f, 0.f}, tot[2] = {0.f, 0.f}, mid[2] = {0.f, 0.f};
#pragma unroll
    for (int s2 = 0; s2 < 8; ++s2) {
#pragma unroll
        for (int j = 0; j < 2; ++j) { const float v = segs[s2 * 128 + d0 + j]; tot[j] += v; if (s2 < seg) pre[j] += v; if (s2 < 4) mid[j] += v; }
    }
#pragma unroll
    for (int i = 0; i < 8; ++i)
#pragma unroll
        for (int j = 0; j < 2; ++j) L.cum[i][j] += pre[j];
    L.tot[0] = tot[0]; L.tot[1] = tot[1]; L.mid[0] = mid[0]; L.mid[1] = mid[1];
}

__device__ __forceinline__ void hgrn_states_unit(const Frame& F, const Args& a, int c, int h, const HgrnRaw& R, const float (&lb)[2]) {
    const int tid = F_TID, lane = F_LANE, cp = tid & 63, seg = tid >> 6, d0 = 2 * cp;
    __syncthreads();
    HgrnLocal L; hgrn_load<false>(F, a, h, R, L, lb);
#pragma unroll
    for (int i = 0; i < 8; ++i) { const int t = seg * 8 + i;
        *(LAS unsigned*)(F.lds + HL_KD + t * 320 + d0 * 2) = cvt_pk_bf16((1.0f - L.fg[i][0]) * __expf(L.tot[0] - L.cum[i][0]), (1.0f - L.fg[i][1]) * __expf(L.tot[1] - L.cum[i][1]));
        *(LAS unsigned*)(F.lds + HL_V + t * 320 + d0 * 2) = cvt_pk_bf16(L.iv[i][0], L.iv[i][1]); }
    if (seg == 0) { float* hd = (float*)(F.ws + WS_HDECAY) + (size_t)(c * 4 + h) * 128 + d0; hd[0] = __expf(L.tot[0]); hd[1] = __expf(L.tot[1]); }
    __syncthreads();
    const int et = F.wave >> 1, dh = F.wave & 1;
    f32x16 acc[2];
#pragma unroll
    for (int dj = 0; dj < 2; ++dj)
#pragma unroll
        for (int r = 0; r < 16; ++r) acc[dj][r] = 0.f;
#pragma unroll
    for (int ks = 0; ks < 4; ++ks) {
        const bf16x8 A = frag_tr<false>(F.lds + HL_V, 320, 16 * ks, 32 * et, lane);
#pragma unroll
        for (int dj = 0; dj < 2; ++dj) { const bf16x8 B = frag_tr<false>(F.lds + HL_KD, 320, 16 * ks, 32 * (2 * dh + dj), lane); acc[dj] = MFMA32(A, B, acc[dj]); }
    }
    float* kv = (float*)(F.ws + WS_HKV) + ((size_t)(c * 4 + h) * 128 + 32 * et) * 128;
#pragma unroll
    for (int dj = 0; dj < 2; ++dj)
#pragma unroll
        for (int r = 0; r < 16; ++r) kv[(size_t)drow(r, lane) * 128 + 32 * (2 * dh + dj) + (lane & 31)] = acc[dj][r];
}

__device__ __forceinline__ void hgrn_out_unit(const Frame& F, const Args& a, int c, int h, const HgrnRaw& R, const float (&lb)[2]) {
    const int tid = F_TID, lane = F_LANE, cp = tid & 63, seg = tid >> 6, d0 = 2 * cp;
    const int tt = F.wave >> 2, et = F.wave & 3;
    bf16x8 Bs[8];
    { const bf16_t* sp = (const bf16_t*)(F.ws + WS_HSPREV) + ((size_t)(c * 4 + h) * 128 + 32 * et) * 128 + (size_t)(lane & 31) * 128 + 8 * (lane >> 5);
#pragma unroll
      for (int ks = 0; ks < 8; ++ks) Bs[ks] = *(const bf16x8*)(sp + 16 * ks); }
    const int e = 32 * et + (lane & 31);
    unsigned short gv[16];
    { const bf16_t* pg = (const bf16_t*)(F.ws + WS_P) + (size_t)(c * 64 + 32 * tt) * PW + PC_G + h * 128 + e;
#pragma unroll
      for (int r = 0; r < 16; ++r) gv[r] = pg[(size_t)drow(r, lane) * PW]; }
    const float nw = KARG_IN(9)[h * 128 + e];
    __syncthreads();
    HgrnLocal L; hgrn_load<true>(F, a, h, R, L, lb);
#pragma unroll
    for (int i = 0; i < 8; ++i) { const int t = seg * 8 + i;
        float qd[2], qp[2], kp[2];
#pragma unroll
        for (int j = 0; j < 2; ++j) { qd[j] = L.qv[i][j] * __expf(L.cum[i][j]); qp[j] = L.qv[i][j] * __expf(L.cum[i][j] - L.mid[j]); kp[j] = (1.0f - L.fg[i][j]) * __expf(L.mid[j] - L.cum[i][j]); }
        *(LAS unsigned*)(F.lds + HL_QD + t * 272 + d0 * 2) = cvt_pk_bf16(qd[0], qd[1]);
        *(LAS unsigned*)(F.lds + HL_QP + t * 272 + d0 * 2) = cvt_pk_bf16(qp[0], qp[1]);
        *(LAS unsigned*)(F.lds + HL_KP + t * 272 + d0 * 2) = cvt_pk_bf16(kp[0], kp[1]);
        *(LAS unsigned*)(F.lds + HL_V + t * 320 + d0 * 2) = cvt_pk_bf16(L.iv[i][0], L.iv[i][1]); }
    __syncthreads();
    f32x16 acc;
#pragma unroll
    for (int r = 0; r < 16; ++r) acc[r] = 0.f;
#pragma unroll
    for (int ks = 0; ks < 8; ++ks) { const bf16x8 A = frag_row(F.lds + HL_QD, 272, 32 * tt, 16 * ks, lane); acc = MFMA32(A, Bs[ks], acc); }
    const int tcol = 32 * tt + (lane & 31);
#pragma unroll
    for (int st = 0; st < 2; ++st) {
        if (st <= tt) {
            f32x16 X;
#pragma unroll
            for (int r = 0; r < 16; ++r) X[r] = 0.f;
#pragma unroll 2
            for (int ks = 0; ks < 8; ++ks) { const bf16x8 A = frag_row(F.lds + HL_KP, 272, 32 * st, 16 * ks, lane), B = frag_row(F.lds + HL_QP, 272, 32 * tt, 16 * ks, lane); X = MFMA32(A, B, X); }
#pragma unroll
            for (int r = 0; r < 16; ++r) X[r] = (32 * st + drow(r, lane) <= tcol) ? X[r] : 0.f;
#pragma unroll
            for (int s2 = 0; s2 < 2; ++s2) { const bf16x8 A = acc_frag(X, s2), B = frag_tr<true>(F.lds + HL_V, 320, 32 * st + 16 * s2, 32 * et, lane); acc = MFMA32(A, B, acc); }
        }
    }
    LAS float* ssqs = (LAS float*)(F.lds + HL_SSQ);
    { float sm[16];
#pragma unroll
      for (int r = 0; r < 16; ++r) sm[r] = half_sum(acc[r] * acc[r]);
      if ((lane & 31) == 0) {
#pragma unroll
          for (int r = 0; r < 16; ++r) ssqs[F.wave * 32 + drow(r, lane)] = sm[r]; } }
    __syncthreads();
#pragma unroll
    for (int r = 0; r < 16; ++r) { const int row = drow(r, lane);
        const float ss = ssqs[(tt * 4 + 0) * 32 + row] + ssqs[(tt * 4 + 1) * 32 + row] + ssqs[(tt * 4 + 2) * 32 + row] + ssqs[(tt * 4 + 3) * 32 + row];
        const float rs = rsqrtf(ss * (1.0f / 128.0f) + RMS_EPS_F);
        *(LAS unsigned short*)(F.lds + HL_QD + (32 * tt + row) * 272 + e * 2) = f2bf1(acc[r] * rs * nw * siluf(bf2f(gv[r]))); }
    __syncthreads();
    { bf16_t* mo = (bf16_t*)(F.ws + WS_MIX) + (size_t)(c * 64) * DM + 512 + h * 128;
#pragma unroll
      for (int i = 0; i < 2; ++i) { const int pc = tid + 512 * i, row = pc >> 4, ch = (pc & 15) * 8;
          *(u32x4*)(mo + (size_t)row * DM + ch) = *(const LAS u32x4*)(F.lds + HL_QD + row * 272 + ch * 2); } }
}

__device__ __forceinline__ void phase_mix_states(const Frame& F, const Args& a, const int mode) {
    HgrnRaw Ra, Rb; int u = blockIdx.x; float lb[2]; int hcur = -1;
    if (!(mode & 2) && u < 1024) hgrn_fetch<false>(F, u >> 2, u & 3, Ra);
    if (!(mode & 1)) for (int us = blockIdx.x; us < 256; us += F.G) ssd_states_unit(F, a, us >> 1, us & 1);
    if (!(mode & 2)) {
        while (u < 1024) {
            int un = u + F.G; if (un < 1024) hgrn_fetch<false>(F, un >> 2, un & 3, Rb);
            if ((u & 3) != hcur) { hcur = u & 3; hgrn_lb(F, hcur, lb); }
            hgrn_states_unit(F, a, u >> 2, u & 3, Ra, lb); u = un; if (u >= 1024) break;
            un = u + F.G; if (un < 1024) hgrn_fetch<false>(F, un >> 2, un & 3, Ra);
            if ((u & 3) != hcur) { hcur = u & 3; hgrn_lb(F, hcur, lb); }
            hgrn_states_unit(F, a, u >> 2, u & 3, Rb, lb); u = un;
        }
    }
}
__device__ __forceinline__ void phase_mix_out(const Frame& F, const Args& a, const int mode) {
    HgrnRaw Ra, Rb; int u = blockIdx.x; float lb[2]; int hcur = -1;
    if (!(mode & 2) && u < 1024) hgrn_fetch<true>(F, u >> 2, u & 3, Ra);
    if (!(mode & 1)) for (int rep = 0; rep < ((mode & 64) ? 2 : 1); ++rep) for (int us = blockIdx.x; us < 256; us += F.G) ssd_out_unit(F, a, us >> 1, us & 1, mode);
    if (!(mode & 2)) {
        while (u < 1024) {
            int un = u + F.G; if (un < 1024) hgrn_fetch<true>(F, un >> 2, un & 3, Rb);
            if ((u & 3) != hcur) { hcur = u & 3; hgrn_lb(F, hcur, lb); }
            hgrn_out_unit(F, a, u >> 2, u & 3, Ra, lb); u = un; if (u >= 1024) break;
            un = u + F.G; if (un < 1024) hgrn_fetch<true>(F, un >> 2, un & 3, Ra);
            if ((u & 3) != hcur) { hcur = u & 3; hgrn_lb(F, hcur, lb); }
            hgrn_out_unit(F, a, u >> 2, u & 3, Rb, lb); u = un;
        }
    }
}
__device__ __forceinline__ void phase_mix_scan(const Frame& F, const Args& a) {
    const int gt = blockIdx.x * 512 + F_TID;
    if (blockIdx.x < 128 || F.G < 256) {
        for (int idx = gt; idx < 65536; idx += (F.G < 256 ? F.G : 128) * 512) {
            const int hh = idx >> 13; const float* st = (const float*)(F.ws + WS_SSTATE) + idx; const float* cd = (const float*)(F.ws + WS_CDECAY) + hh;
            bf16_t* sp = (bf16_t*)(F.ws + WS_SPREV) + idx; float S = 0.f;
            for (int c0 = 0; c0 < 128; c0 += 16) { float v[16], d[16];
#pragma unroll
                for (int i = 0; i < 16; ++i) { v[i] = st[(size_t)(c0 + i) * 65536]; d[i] = cd[(c0 + i) * 8]; }
#pragma unroll
                for (int i = 0; i < 16; ++i) { sp[(size_t)(c0 + i) * 65536] = f2bf1(S); S = fmaf(S, d[i], v[i]); } }
        }
    }
    if (blockIdx.x >= 128 || F.G < 256) {
        const int gt2 = F.G < 256 ? gt : gt - 128 * 512;
        for (int idx = gt2; idx < 65536; idx += (F.G < 256 ? F.G : 128) * 512) {
            const int h = idx >> 14, d = idx & 127; const float* kv = (const float*)(F.ws + WS_HKV) + idx; const float* hd = (const float*)(F.ws + WS_HDECAY) + h * 128 + d;
            bf16_t* sp = (bf16_t*)(F.ws + WS_HSPREV) + idx; float S = 0.f;
            for (int c0 = 0; c0 < 256; c0 += 16) { float v[16], dd[16];
#pragma unroll
                for (int i = 0; i < 16; ++i) { v[i] = kv[(size_t)(c0 + i) * 65536]; dd[i] = hd[(size_t)(c0 + i) * 512]; }
#pragma unroll
                for (int i = 0; i < 16; ++i) { sp[(size_t)(c0 + i) * 65536] = f2bf1(S); S = fmaf(S, dd[i], v[i]); } }
        }
    }
}

__global__ void __launch_bounds__(512, 2) mk_fwd(Args args) {
    extern __shared__ __attribute__((aligned(16))) unsigned char lds_raw[];
    Frame F;
    F.lds = (LAS unsigned char*)lds_raw;
    F.wave = __builtin_amdgcn_readfirstlane(threadIdx.x >> 6);
    F.G = gridDim.x; { const int bx = blockIdx.x; F.vcu = (F.G % 8 == 0) ? (bx % 8) * (F.G / 8) + bx / 8 : bx; }
    F.ws = args.ws; F.ctl = (unsigned*)(args.ws + WS_CTL);
    volatile LAS unsigned* MISC = (volatile LAS unsigned*)(F.lds + LDS_MISC);
    if (F_TID < 64) MISC[F_TID] = 0u;
    __syncthreads();
    const bool use_bar = (args.ph_hi - args.ph_lo) > 1;
    XcdBarrier bar; bar.bar = F.ctl + CW_BAR + args.li * XCD_BAR_WORDS; bar.x = 0; bar.st = MISC + 8; bar.wave = F.wave;
    if (use_bar) bar = xcd_barrier_post(F.ctl + CW_BAR + args.li * XCD_BAR_WORDS, MISC + 8, F.wave);
#define PH(k) (args.ph_lo <= (k) && (k) < args.ph_hi)
#define SEAM(k) do { if (use_bar && (k) + 1 < args.ph_hi && (k) >= args.ph_lo) xcd_barrier(bar); } while (0)
    unsigned char* ws = F.ws;
    if (PH(0)) phase_prep(F, args);
    SEAM(0);
    if (PH(1)) {
        pg8::DenseSched S; S.init(ws + WS_XB, ws + WS_WIN_T, T_TOK, 3072, 1024, F.G, blockIdx.x);
        pg8::EpiP E; E.O = (bf16_t*)(ws + WS_P); E.ldc = PW;
        pg8::gemm_phase<pg8::EpiP, pg8::DenseSched, true>(F.lds, 1024, S, E, F.wave);
    }
    SEAM(1);
#if defined(MK_NAIVE_MIX)
    if (PH(2)) phase_m1(F, args);
    SEAM(2);
    if (PH(3)) phase_m2(F, args);
    SEAM(3);
    if (PH(4)) phase_m3(F, args);
#else
    if (PH(2)) phase_mix_states(F, args, args.mode);
    SEAM(2);
    if (PH(3)) {
        phase_mix_scan(F, args);
        if (blockIdx.x < 128 && F.G >= 256) {
            __syncthreads();
            pg8::DenseSched S; S.init(ws + WS_XB, ws + WS_WIN_T + (size_t)3072 * 1024 * 2, T_TOK, 512, 1024, 128, blockIdx.x);
            pg8::EpiP E; E.O = (bf16_t*)(ws + WS_P) + 3072; E.ldc = PW;
            pg8::gemm_phase<pg8::EpiP, pg8::DenseSched, true>(F.lds, 1024, S, E, F.wave);
        } else if (F.G < 256) {
            __syncthreads();
            pg8::DenseSched S; S.init(ws + WS_XB, ws + WS_WIN_T + (size_t)3072 * 1024 * 2, T_TOK, 512, 1024, F.G, blockIdx.x);
            pg8::EpiP E; E.O = (bf16_t*)(ws + WS_P) + 3072; E.ldc = PW;
            pg8::gemm_phase<pg8::EpiP, pg8::DenseSched, true>(F.lds, 1024, S, E, F.wave);
        }
    }
    SEAM(3);
    if (PH(4)) phase_mix_out(F, args, args.mode);
#endif
    SEAM(4);
    if (PH(5)) {
        pg8::DenseSched S; S.init(ws + WS_MIX, ws + WS_WOUT_T, T_TOK, 1024, 1024, F.G, blockIdx.x);
        pg8::EpiU E; E.U = (float*)(ws + WS_H1); E.X = KARG_IN(0);
        pg8::gemm_phase<pg8::EpiU, pg8::DenseSched, false>(F.lds, 1024, S, E, F.wave);
    }
    SEAM(5);
    if (PH(6)) phase_ln1(F, args);
    SEAM(6);
    if (PH(7)) {
        pg8::DenseSched S; S.init(ws + WS_H1B, ws + WS_W3_T, T_TOK, 768, 1024, F.G, blockIdx.x);
        pg8::Epi3 E; E.LG = (float*)(ws + WS_LOGITS); E.HS = (bf16_t*)(ws + WS_HS);
        pg8::gemm_phase<pg8::Epi3, pg8::DenseSched, false>(F.lds, 1024, S, E, F.wave);
    }
    SEAM(7);
    if (PH(8)) {
        if (!(args.mode & 32)) phase_route(F, args);
        if (!(args.mode & 64)) {
        pg8::DenseSched S; S.init(ws + WS_HS, ws + WS_WDS_T, T_TOK, 1024, 256, F.G, blockIdx.x);
        pg8::EpiP E; E.O = (bf16_t*)(ws + WS_YS); E.ldc = 1024;
        pg8::gemm_phase<pg8::EpiP, pg8::DenseSched, false>(F.lds, 256, S, E, F.wave); }
    }
    SEAM(8);
#if defined(MK_OLD_EXPERTS)
    if (PH(9)) {
        build_tables(F);
        pg8::ExpertSched<true> S; S.lds = F.lds;
        S.lists = (const int*)(ws + WS_LISTS); S.A = (const char*)(ws + WS_H1B); S.W = (const char*)(ws + WS_WGU_T);
        S.U = 2 * __builtin_amdgcn_readfirstlane(((const LAS int*)(F.lds + LDS_PREF))[NEXP]); S.G = F.G; S.c = blockIdx.x;
        pg8::EpiH E; E.H = (bf16_t*)(ws + WS_H);
        pg8::gemm_phase<pg8::EpiH, pg8::ExpertSched<true>, true>(F.lds, 1024, S, E, F.wave);
    }
    SEAM(9);
    if (PH(10)) {
        build_tables(F);
        pg8::ExpertSched<false> S; S.lds = F.lds;
        S.lists = (const int*)(ws + WS_LISTS); S.A = (const char*)(ws + WS_H); S.W = (const char*)(ws + WS_WD_T);
        S.U = 4 * __builtin_amdgcn_readfirstlane(((const LAS int*)(F.lds + LDS_PREF))[NEXP]); S.G = F.G; S.c = blockIdx.x;
        pg8::EpiYb E; E.YB = (bf16_t*)(ws + WS_YB); E.lists = (const int*)(ws + WS_LISTS); E.tok_gate = (const float*)(ws + WS_TOKGATE);
        pg8::gemm_phase<pg8::EpiYb, pg8::ExpertSched<false>, true>(F.lds, 256, S, E, F.wave);
    }
    SEAM(10);
#else
    if (PH(9)) phase_experts(F, args, args.mode);
    SEAM(9);
#endif
    if (PH(11)) { build_tables(F); phase_final(F, args); }
}

extern "C" void kernel_launch(void* const* d_in, const int* in_sizes, int n_in, void* d_out, int out_size, void* d_ws, size_t ws_size, hipStream_t stream) {
    static int grid = 0;
    if (grid == 0) {
        int dev = 0, cus = 0;
        if (hipGetDevice(&dev) != hipSuccess || hipDeviceGetAttribute(&cus, hipDeviceAttributeMultiprocessorCount, dev) != hipSuccess) { fprintf(stderr, "device query failed\n"); grid = -1; return; }
        if (hipFuncSetAttribute((const void*)mk_fwd, hipFuncAttributeMaxDynamicSharedMemorySize, LDS_BYTES) != hipSuccess) { fprintf(stderr, "hipFuncSetAttribute failed\n"); grid = -1; return; }
        if (ws_size < WS_END) { fprintf(stderr, "workspace too small: %zu < %zu\n", ws_size, (size_t)WS_END); grid = -1; return; }
        (void)hipGetLastError();
        grid = cus;
    }
    if (grid < 0) return;
    unsigned char* ws = (unsigned char*)d_ws;
    (void)hipMemsetAsync(ws + WS_CTL, 0, CTL_ZERO_BYTES, stream);
    Args a{};
    for (int i = 0; i < 23; ++i) a.in[i] = (const float*)d_in[i];
    a.out = (float*)d_out; a.ws = ws;
    auto launch = [&](int lo, int hi) { a.ph_lo = lo; a.ph_hi = hi; hipLaunchKernelGGL(mk_fwd, dim3(grid), dim3(512), LDS_BYTES, stream, a); };
#if defined(MK_PER_PHASE)
    for (int ph = 0; ph < NPH; ++ph) launch(ph, ph + 1);
#else
    launch(0, NPH);
#endif
}
```

```cpp
#include <hip/hip_runtime.h>
#include <stdint.h>
#include <cstdio>

#define GAS __attribute__((address_space(1)))
#define LAS __attribute__((address_space(3)))
typedef unsigned short bf16_t;
typedef short bf16x8 __attribute__((ext_vector_type(8)));
typedef float f32x4 __attribute__((ext_vector_type(4)));
typedef unsigned u32x4 __attribute__((ext_vector_type(4)));
typedef unsigned u32x2 __attribute__((ext_vector_type(2)));
typedef float f32x16 __attribute__((ext_vector_type(16)));
typedef short s16x4 __attribute__((ext_vector_type(4)));

constexpr int T_TOK = 16384, DM = 1024, NIN = 3592, PW = 3584;
constexpr int NEXP = 256, LIST_CAP = 16384;
constexpr int PC_Z = 0, PC_XBC = 512, PC_Q = 1536, PC_F = 2048, PC_I = 2560, PC_G = 3072;
#define ALPHA_F 1.189207115002721f
#define LN_EPS_F 1e-5f
#define RMS_EPS_F 1e-6f

constexpr size_t MiB = 1u << 20;
constexpr size_t WS_CTL = 0, CTL_ZERO_BYTES = 1 * MiB;
constexpr size_t WS_WIN_T = 2 * MiB, WS_WOUT_T = 9 * MiB, WS_W3_T = 11 * MiB, WS_WDS_T = 13 * MiB, WS_DTRAW = 14 * MiB;
constexpr size_t WS_TOKE = 15 * MiB, WS_TOKPOS = 15 * MiB + 512 * 1024, WS_TOKGATE = 16 * MiB;
constexpr size_t WS_LISTS = 17 * MiB, WS_LOGITS = 33 * MiB, WS_HS = 49 * MiB, WS_YS = 57 * MiB, WS_H1 = 89 * MiB, WS_H1B = 153 * MiB;
constexpr size_t WS_WGU_T = 185 * MiB, WS_WD_T = 441 * MiB;
constexpr size_t WS_X0 = 569 * MiB;
constexpr size_t WS_XB = WS_X0, WS_P = WS_X0 + 32 * MiB, WS_MIX = WS_X0 + 144 * MiB;
constexpr size_t WS_NXBC = WS_X0 + 176 * MiB, WS_NFGK = WS_X0 + 240 * MiB, WS_NQS = WS_X0 + 272 * MiB, WS_NYSSD = WS_X0 + 304 * MiB, WS_NOH = WS_X0 + 336 * MiB, WS_NDTB = WS_X0 + 368 * MiB;
constexpr size_t WS_SSTATE = WS_X0 + 176 * MiB, WS_SPREV = WS_X0 + 208 * MiB, WS_HKV = WS_X0 + 224 * MiB, WS_HSPREV = WS_X0 + 288 * MiB;
constexpr size_t WS_CDECAY = WS_X0 + 320 * MiB, WS_HDECAY = WS_X0 + 320 * MiB + 64 * 1024;
constexpr size_t WS_H = WS_X0, WS_YB = WS_X0 + 65 * MiB;
constexpr size_t WS_END = WS_X0 + 369 * MiB;
constexpr int CW_BAR = 4096;
constexpr int CW_COUNTS = 16384, CNT_STRIDE = 64;

constexpr int RING_BYTES = 131072;
constexpr int LDS_BYTES = 163840;
constexpr int LDS_MISC = LDS_BYTES - 4096;
constexpr int LDS_PREF = LDS_MISC + 256;
constexpr int LDS_OFFS = LDS_PREF + 1040;
constexpr int LDS_CNT = LDS_OFFS + 1040;
constexpr int LDS_PHASE_BYTES = LDS_MISC;

__device__ __forceinline__ int lane_id() { int l; asm volatile("v_mbcnt_lo_u32_b32 %0, -1, 0\n\tv_mbcnt_hi_u32_b32 %0, -1, %0" : "=v"(l)); return l; }
__device__ __forceinline__ float siluf(float x) { return x * __builtin_amdgcn_rcpf(1.0f + __expf(-x)); }
__device__ __forceinline__ float sigmf(float x) { return __builtin_amdgcn_rcpf(1.0f + __expf(-x)); }
template <int CTRL> __device__ __forceinline__ float dpp_f(float v) { return __builtin_bit_cast(float, __builtin_amdgcn_update_dpp(0, __builtin_bit_cast(int, v), CTRL, 0xf, 0xf, true)); }
__device__ __forceinline__ float rdlane_f(float v, int l) { return __builtin_bit_cast(float, __builtin_amdgcn_readlane(__builtin_bit_cast(int, v), l)); }
__device__ __forceinline__ float wave_sum(float v) {
  v += dpp_f<0xB1>(v); v += dpp_f<0x4E>(v); v += dpp_f<0x141>(v); v += dpp_f<0x140>(v);
  return (rdlane_f(v, 0) + rdlane_f(v, 16)) + (rdlane_f(v, 32) + rdlane_f(v, 48));
}
__device__ __forceinline__ float wave_max(float v) {
  v = fmaxf(v, dpp_f<0xB1>(v)); v = fmaxf(v, dpp_f<0x4E>(v)); v = fmaxf(v, dpp_f<0x141>(v)); v = fmaxf(v, dpp_f<0x140>(v));
  return fmaxf(fmaxf(rdlane_f(v, 0), rdlane_f(v, 16)), fmaxf(rdlane_f(v, 32), rdlane_f(v, 48)));
}
__device__ __forceinline__ unsigned cvt_pk_bf16(float lo, float hi) { unsigned r; asm volatile("v_cvt_pk_bf16_f32 %0, %1, %2" : "=v"(r) : "v"(lo), "v"(hi)); return r; }
#define YB_SCALE 64.0f
__device__ __forceinline__ unsigned pk4_fp8(const f32x4 v) {
    const float a = fminf(fmaxf(v[0], -440.f), 440.f), b = fminf(fmaxf(v[1], -440.f), 440.f), c = fminf(fmaxf(v[2], -440.f), 440.f), d = fminf(fmaxf(v[3], -440.f), 440.f);
    int w = 0; w = __builtin_amdgcn_cvt_pk_fp8_f32(a, b, w, false); w = __builtin_amdgcn_cvt_pk_fp8_f32(c, d, w, true); return (unsigned)w; }
__device__ __forceinline__ f32x4 un4_fp8(const unsigned w) { return (f32x4){__builtin_amdgcn_cvt_f32_fp8((int)w, 0), __builtin_amdgcn_cvt_f32_fp8((int)w, 1), __builtin_amdgcn_cvt_f32_fp8((int)w, 2), __builtin_amdgcn_cvt_f32_fp8((int)w, 3)}; }
__device__ __forceinline__ float bf2f(unsigned b) { return __uint_as_float(b << 16); }
__device__ __forceinline__ float bflo(unsigned w) { return __uint_as_float(w << 16); }
__device__ __forceinline__ float bfhi(unsigned w) { return __uint_as_float(w & 0xffff0000u); }

#define XB_TMO      128
#define XB_XCNT(j)  (256  + 64 * (j))
#define XB_XSUB(j)  (1280 + 64 * (j))
#define XB_XGEN(j)  (2304 + 64 * (j))
#define XB_TOP      3328
#define XB_TOPGEN   3392
#define XCD_BAR_WORDS 3456
#define XB_SPIN_CAP (1u << 18)
__device__ __forceinline__ unsigned xb_ld(unsigned* p)              { return __hip_atomic_load(p, __ATOMIC_RELAXED, __HIP_MEMORY_SCOPE_AGENT); }
__device__ __forceinline__ unsigned xb_add(unsigned* p, unsigned v) { return __hip_atomic_fetch_add(p, v, __ATOMIC_RELAXED, __HIP_MEMORY_SCOPE_AGENT); }
__device__ __forceinline__ unsigned xb_xcc_id() { return (unsigned)__builtin_amdgcn_s_getreg((3 << 11) | 20) & 0xFu; }
#define XB_SPIN(cond, bar) do { unsigned _sp = 0; while (cond) { __builtin_amdgcn_s_sleep(1); \
    if ((++_sp & 255u) == 0u) { if (xb_ld(&(bar)[XB_TMO])) break; if (_sp > XB_SPIN_CAP) { atomicAdd(&(bar)[XB_TMO], 1u); break; } } } } while (0)
struct XcdBarrier { unsigned* bar; unsigned x; volatile LAS unsigned* st; int wave; };
__device__ __forceinline__ XcdBarrier xcd_barrier_post(unsigned* bar, volatile LAS unsigned* st, int wave) {
    XcdBarrier b; b.bar = bar; b.x = xb_xcc_id(); b.st = st; b.wave = wave;
    if (wave == 0 && lane_id() == 0) (void)xb_add(&bar[XB_XCNT(b.x)], 1u);
    return b;
}
__device__ __forceinline__ void xcd_barrier_complete(unsigned* bar, unsigned x, unsigned& nloc, unsigned& nx) {
    const unsigned G = gridDim.x * gridDim.y * gridDim.z;
    unsigned sum, cnt, mine, sp = 0u;
    for (;;) {
        sum = 0u; cnt = 0u; mine = 0u;
#pragma unroll
        for (unsigned j = 0; j < 16; ++j) { const unsigned c = xb_ld(&bar[XB_XCNT(j)]); sum += c; cnt += (c > 0u) ? 1u : 0u; mine = (j == x) ? c : mine; }
        if (sum == G) break;
        __builtin_amdgcn_s_sleep(1);
        if ((++sp & 255u) == 0u) { if (xb_ld(&bar[XB_TMO])) break; if (sp > XB_SPIN_CAP) { atomicAdd(&bar[XB_TMO], 1u); break; } }
    }
    nloc = mine > 0u ? mine : 1u; nx = cnt > 0u ? cnt : 1u;
}
__device__ __forceinline__ void xcd_barrier(const XcdBarrier& b) {
    asm volatile("s_waitcnt vmcnt(0)" ::: "memory");
    __syncthreads();
    if (b.wave == 0 && lane_id() == 0) {
        unsigned* bar = b.bar;
        __builtin_amdgcn_s_waitcnt(0);
        unsigned nloc = b.st[0], nx = b.st[1];
        if (nloc == 0u) { xcd_barrier_complete(bar, b.x, nloc, nx); b.st[0] = nloc; b.st[1] = nx; }
        const unsigned old = xb_add(&bar[XB_XSUB(b.x)], 1u);
        const unsigned gen = old / nloc;
        if (old + 1u == (gen + 1u) * nloc) {
            __builtin_amdgcn_fence(__ATOMIC_RELEASE, "agent");
            asm volatile("s_waitcnt vmcnt(0)" ::: "memory");
            const unsigned og = xb_add(&bar[XB_TOP], 1u);
            const unsigned tg = og / nx;
            if (og + 1u == (tg + 1u) * nx) xb_add(&bar[XB_TOPGEN], 1u);
            else XB_SPIN(xb_ld(&bar[XB_TOPGEN]) == tg, bar);
            __builtin_amdgcn_fence(__ATOMIC_ACQUIRE, "agent");
            xb_add(&bar[XB_XGEN(b.x)], 1u);
            asm volatile("s_waitcnt vmcnt(0)" ::: "memory");
        } else {
            XB_SPIN(xb_ld(&bar[XB_XGEN(b.x)]) == gen, bar);
            __builtin_amdgcn_fence(__ATOMIC_ACQUIRE, "agent");
            asm volatile("s_waitcnt vmcnt(0)" ::: "memory");
        }
    }
    __syncthreads();
}

namespace pg8 {
constexpr int BM = 256, BK = 64, HALF = 128, HTB = HALF * BK * 2, STAGE_BYTES = 8 * HTB, NXCD = 8, WGM = 8;
__host__ __device__ __forceinline__ int lds_byte(int r, int c) { const int st = (r >> 4) * 2 + (c >> 5), rr = r & 15, cc = c & 31, ob = rr * 64 + cc * 2; return st * 1024 + (ob ^ (((ob >> 9) & 1) << 5)); }
__host__ __device__ __forceinline__ void stage_rc(int b, int& R, int& C) { const int st = b / 1024, sb = b % 1024, swz = sb ^ (((sb >> 9) & 1) << 5); R = (st >> 1) * 16 + swz / 64; C = (st & 1) * 32 + (swz % 64) / 2; }
__host__ __device__ __forceinline__ int perm32(int rho) { const int n = rho >> 4, i = rho & 15; return 8 * (i >> 2) + 4 * n + (i & 3); }

struct Unit { const char* A; const char* B; int pm, pn, rows, e, slot0, mt; };

struct DenseSched {
    static constexpr bool PER_UNIT_VOFF = false;
    const char* A; const char* B; int K, nM, nN, nwg, G, c;
    __device__ void init(const void* A_, const void* B_, int M, int N, int K_, int G_, int c_) { A = (const char*)A_; B = (const char*)B_; K = K_; nM = M / BM; nN = N / BM; nwg = nM * nN; G = G_; c = c_; }
    __device__ __forceinline__ bool next(int i, Unit& u) const {
        const int L = i * G + c; if (L >= nwg) return false;
        int wgid = L; { const int q = nwg / NXCD, r = nwg % NXCD, xcd = wgid % NXCD, off = wgid / NXCD; wgid = (xcd < r ? xcd * (q + 1) : r * (q + 1) + (xcd - r) * q) + off; }
        const int nig = WGM * nN, gid = wgid / nig, fm = gid * WGM, gsz = (nM - fm) < WGM ? (nM - fm) : WGM;
        u.pm = fm + ((wgid % nig) % gsz); u.pn = (wgid % nig) / gsz; u.rows = 256; u.e = 0; u.slot0 = 0; u.mt = 0;
        u.A = A + (size_t)u.pm * BM * K * 2; u.B = B + (size_t)u.pn * BM * K * 2; return true;
    }
    __device__ __forceinline__ void voff(const Unit&, const int (&sR)[2], const int (&sC)[2], unsigned (&v)[2][2]) const {
#pragma unroll
        for (int h = 0; h < 2; ++h)
#pragma unroll
            for (int i = 0; i < 2; ++i) v[h][i] = (unsigned)((h * HALF + sR[i]) * K + sC[i]) * 2u;
    }
};

template <bool GATHER> struct ExpertSched {
    static constexpr bool PER_UNIT_VOFF = GATHER;
    static constexpr int K = GATHER ? 1024 : 256, NT = GATHER ? 2 : 4;
    static constexpr unsigned WSTRIDE = GATHER ? 512u * 1024u * 2u : 1024u * 256u * 2u;
    LAS unsigned char* lds;
    const int* lists; const char* A; const char* W; int U, G, c;
    __device__ __forceinline__ bool next(int i, Unit& u) const {
        int L = i * G + c; if (L >= U) return false;
        { const int q = U / NXCD, r = U % NXCD, xcd = L % NXCD, off = L / NXCD; L = (xcd < r ? xcd * (q + 1) : r * (q + 1) + (xcd - r) * q) + off; }
        const LAS int* pref = (const LAS int*)(lds + LDS_PREF);
        int lo = 0, hi = NEXP;
        while (hi - lo > 1) { const int mid = (lo + hi) >> 1; const int pv = __builtin_amdgcn_readfirstlane(pref[mid]); if (NT * pv <= L) lo = mid; else hi = mid; }
        const int e = lo, p0 = __builtin_amdgcn_readfirstlane(pref[e]), p1 = __builtin_amdgcn_readfirstlane(pref[e + 1]), tiles = p1 - p0, r = L - NT * p0;
        u.e = e; u.pn = r / tiles; u.mt = r % tiles; u.pm = 0;
        const int n = __builtin_amdgcn_readfirstlane(((const LAS int*)(lds + LDS_CNT))[e]); u.rows = (n - u.mt * 256) < 256 ? (n - u.mt * 256) : 256;
        u.slot0 = __builtin_amdgcn_readfirstlane(((const LAS int*)(lds + LDS_OFFS))[e]) + u.mt * 256;
        u.A = GATHER ? A : A + (size_t)u.slot0 * (K * 2); u.B = W + (size_t)e * WSTRIDE + (size_t)u.pn * (BM * K * 2); return true;
    }
    __device__ __forceinline__ void voff(const Unit& u, const int (&sR)[2], const int (&sC)[2], unsigned (&v)[2][2]) const {
#pragma unroll
        for (int h = 0; h < 2; ++h)
#pragma unroll
            for (int i = 0; i < 2; ++i) {
                const int r = h * HALF + sR[i];
                if (GATHER) { int tok = 0; if (r < u.rows) tok = lists[(size_t)u.e * LIST_CAP + u.mt * 256 + r] >> 3; v[h][i] = (unsigned)(tok * K + sC[i]) * 2u; }
                else v[h][i] = (unsigned)(r * K + sC[i]) * 2u;
            }
    }
};

template <class Epi, class Sched, bool ALIGN_EPI>
__device__ __forceinline__ void gemm_phase(LAS unsigned char* lds, const int K, const Sched& S, const Epi& E, const int wid) {
    const int lane = lane_id(), tid = wid * 64 + lane, wr = wid >> 2, wc = wid & 3, fr = lane & 15, fq = lane >> 4;
    const int nt = K / BK;
    int sR[2], sC[2]; unsigned voffB[2];
#pragma unroll
    for (int i = 0; i < 2; ++i) { stage_rc(tid * 16 + i * 8192, sR[i], sC[i]); const int Rb = Epi::PERM ? ((sR[i] & ~31) + perm32(sR[i] & 31)) : sR[i]; voffB[i] = (unsigned)(Rb * K + sC[i]) * 2u; }
    const size_t kstep = (size_t)(BK * 2);
    const size_t hstep = (size_t)HALF * K * 2;
    const unsigned ldsw = (unsigned)wid * 1024u;
    const int aoff = lds_byte(wr * 64 + fr, fq * 8), boff = lds_byte(wc * 32 + fr, fq * 8);
#define PG8_SA(b, h) (((b) * 2 + (h)) * HTB)
#define PG8_SB(b, h) ((4 + (b) * 2 + (h)) * HTB)
#define PG8_STAGE(bufoff, gbase, voff) do { _Pragma("unroll") for (int _i = 0; _i < 2; ++_i) \
        __builtin_amdgcn_global_load_lds((const unsigned*)((const char*)(gbase) + (voff)[_i]), (LAS unsigned*)(lds + (bufoff) + ldsw + _i * 8192), 16, 0, 0); } while (0)
#define PG8_STAGE_A(bufoff, gbase, h, vset) do { if constexpr (Sched::PER_UNIT_VOFF) { PG8_STAGE(bufoff, gbase, (vset)[h]); } else { PG8_STAGE(bufoff, (gbase) + (h) * hstep, vc[0]); } } while (0)
#define PG8_LDA(dst, b, h) do { _Pragma("unroll") for (int m = 0; m < 4; ++m) _Pragma("unroll") for (int k = 0; k < 2; ++k) dst[m][k] = *(const LAS bf16x8*)(lds + PG8_SA(b, h) + aoff + m * 2048 + k * 1024); } while (0)
#define PG8_LDB(dst, b, h) do { _Pragma("unroll") for (int n = 0; n < 2; ++n) _Pragma("unroll") for (int k = 0; k < 2; ++k) dst[n][k] = *(const LAS bf16x8*)(lds + PG8_SB(b, h) + boff + n * 2048 + k * 1024); } while (0)
#define PG8_MMA(ai, bj, At, Bt) do { __builtin_amdgcn_s_setprio(1); _Pragma("unroll") for (int m = 0; m < 4; ++m) _Pragma("unroll") for (int n = 0; n < 2; ++n) _Pragma("unroll") for (int k = 0; k < 2; ++k) \
        acc[ai][bj][m][n] = __builtin_amdgcn_mfma_f32_16x16x32_bf16(Bt[n][k], At[m][k], acc[ai][bj][m][n], 0, 0, 0); __builtin_amdgcn_s_setprio(0); } while (0)
#define PG8_WAIT_V(n) asm volatile("s_waitcnt vmcnt(" #n ")" ::: "memory")
#define PG8_WAIT_L(n) asm volatile("s_waitcnt lgkmcnt(" #n ")" ::: "memory")
#define PG8_BAR __builtin_amdgcn_s_barrier()
#define PG8_SCHED __builtin_amdgcn_sched_barrier(0)
    Unit cur, nxt; int ui = 0;
    if (!S.next(0, cur)) return;
    unsigned vc[2][2], vn[2][2];
    S.voff(cur, sR, sC, vc);
    f32x4 acc[2][2][4][2];
#pragma unroll
    for (int a = 0; a < 2; ++a)
#pragma unroll
        for (int b = 0; b < 2; ++b)
#pragma unroll
            for (int m = 0; m < 4; ++m)
#pragma unroll
                for (int n = 0; n < 2; ++n) acc[a][b][m][n] = (f32x4){0.f, 0.f, 0.f, 0.f};
    bf16x8 At[4][2], B0[2][2], B1[2][2];
    const char* cA = cur.A; const char* cB = cur.B;
    PG8_STAGE(PG8_SB(0, 0), cB, voffB); PG8_STAGE(PG8_SB(0, 1), cB + hstep, voffB); PG8_STAGE_A(PG8_SA(0, 0), cA, 0, vc); PG8_STAGE_A(PG8_SA(0, 1), cA, 1, vc);
    if (wr == 1) PG8_BAR;
    PG8_WAIT_V(2); PG8_BAR;
    PG8_STAGE(PG8_SB(1, 0), cB + kstep, voffB); PG8_STAGE_A(PG8_SA(1, 0), cA + kstep, 0, vc); PG8_STAGE(PG8_SB(1, 1), cB + hstep + kstep, voffB);
    PG8_WAIT_V(6); PG8_BAR;
    for (;;) {
        const bool has_next = S.next(ui + 1, nxt);
        if constexpr (Sched::PER_UNIT_VOFF) {
            if (has_next) S.voff(nxt, sR, sC, vn);
            else {
#pragma unroll
                for (int h = 0; h < 2; ++h)
#pragma unroll
                    for (int i = 0; i < 2; ++i) vn[h][i] = vc[h][i];
            }
        }
        const char* nA = has_next ? nxt.A : cA; const char* nB = has_next ? nxt.B : cB;
        for (int t = 0; t < nt; t += 2) {
            const bool last = (t == nt - 2);
            const char* a1 = cA + (size_t)(t + 1) * kstep;
            const char* a2 = last ? nA : cA + (size_t)(t + 2) * kstep; const char* b2 = last ? nB : cB + (size_t)(t + 2) * kstep;
            const char* a3 = a2 + kstep; const char* b3 = b2 + kstep;
            unsigned v2[2][2];
#pragma unroll
            for (int h = 0; h < 2; ++h)
#pragma unroll
                for (int i = 0; i < 2; ++i) v2[h][i] = (Sched::PER_UNIT_VOFF && last) ? vn[h][i] : vc[h][i];
            PG8_LDB(B0, 0, 0); PG8_LDB(B1, 0, 1); PG8_SCHED; PG8_LDA(At, 0, 0); PG8_STAGE_A(PG8_SA(1, 1), a1, 1, vc);
            PG8_WAIT_V(8); PG8_WAIT_L(0); PG8_BAR; PG8_MMA(0, 0, At, B0); PG8_MMA(0, 1, At, B1); PG8_BAR; PG8_SCHED;
            PG8_LDA(At, 0, 1); PG8_STAGE(PG8_SB(0, 0), b2, voffB); PG8_STAGE(PG8_SB(0, 1), b2 + hstep, voffB); PG8_STAGE_A(PG8_SA(0, 0), a2, 0, v2);
            PG8_WAIT_V(8); PG8_WAIT_L(0); PG8_BAR; PG8_MMA(1, 0, At, B0); PG8_MMA(1, 1, At, B1); PG8_BAR; PG8_SCHED;
            PG8_LDB(B0, 1, 0); PG8_LDB(B1, 1, 1); PG8_SCHED; PG8_LDA(At, 1, 0); PG8_STAGE_A(PG8_SA(0, 1), a2, 1, v2);
            PG8_WAIT_V(8); PG8_WAIT_L(0); PG8_BAR; PG8_MMA(0, 0, At, B0); PG8_MMA(0, 1, At, B1); PG8_BAR; PG8_SCHED;
            PG8_LDA(At, 1, 1); PG8_STAGE(PG8_SB(1, 0), b3, voffB); PG8_STAGE(PG8_SB(1, 1), b3 + hstep, voffB); PG8_STAGE_A(PG8_SA(1, 0), a3, 0, v2);
            PG8_WAIT_V(8); PG8_WAIT_L(0); PG8_BAR; PG8_MMA(1, 0, At, B0); PG8_MMA(1, 1, At, B1); PG8_BAR; PG8_SCHED;
        }
        if constexpr (ALIGN_EPI) { if (wr == 0) PG8_BAR; }
        E(acc, cur, wr, wc, fr, fq);
        if (!has_next) break;
#pragma unroll
        for (int a = 0; a < 2; ++a)
#pragma unroll
            for (int b = 0; b < 2; ++b)
#pragma unroll
                for (int m = 0; m < 4; ++m)
#pragma unroll
                    for (int n = 0; n < 2; ++n) acc[a][b][m][n] = (f32x4){0.f, 0.f, 0.f, 0.f};
        cur = nxt; cA = nA; cB = nB; ++ui;
        if constexpr (Sched::PER_UNIT_VOFF) {
#pragma unroll
            for (int h = 0; h < 2; ++h)
#pragma unroll
                for (int i = 0; i < 2; ++i) vc[h][i] = vn[h][i];
        }
        if constexpr (ALIGN_EPI) { if (wr == 1) PG8_BAR; }
    }
    PG8_WAIT_V(0);
    if constexpr (!ALIGN_EPI) { if (wr == 0) PG8_BAR; }
    PG8_BAR;
#undef PG8_SA
#undef PG8_SB
#undef PG8_STAGE
#undef PG8_LDA
#undef PG8_STAGE_A
#undef PG8_LDB
#undef PG8_MMA
#undef PG8_WAIT_V
#undef PG8_WAIT_L
#undef PG8_BAR
#undef PG8_SCHED
}

struct EpiP {
    static constexpr bool PERM = true;
    bf16_t* O; int ldc;
    __device__ __forceinline__ void operator()(const f32x4 (&acc)[2][2][4][2], const Unit& u, int wr, int wc, int fr, int fq) const {
        const int row0 = u.pm * BM + wr * 64 + fr, col0 = u.pn * BM + wc * 32 + 8 * fq;
#pragma unroll
        for (int ai = 0; ai < 2; ++ai)
#pragma unroll
            for (int m = 0; m < 4; ++m) { bf16_t* rowp = O + (size_t)(row0 + ai * HALF + m * 16) * ldc + col0;
#pragma unroll
                for (int bj = 0; bj < 2; ++bj) { const f32x4 v0 = acc[ai][bj][m][0], v1 = acc[ai][bj][m][1];
                    u32x4 w; w.x = cvt_pk_bf16(v0[0], v0[1]); w.y = cvt_pk_bf16(v0[2], v0[3]); w.z = cvt_pk_bf16(v1[0], v1[1]); w.w = cvt_pk_bf16(v1[2], v1[3]);
                    *(u32x4*)(rowp + bj * HALF) = w; } }
    }
};
struct EpiU {
    static constexpr bool PERM = false;
    float* U; const float* X;
    __device__ __forceinline__ void operator()(const f32x4 (&acc)[2][2][4][2], const Unit& u, int wr, int wc, int fr, int fq) const {
        const int row0 = u.pm * BM + wr * 64 + fr, col0 = u.pn * BM + wc * 32 + 4 * fq;
#pragma unroll
        for (int ai = 0; ai < 2; ++ai)
#pragma unroll
            for (int m = 0; m < 4; ++m) { const size_t ro = (size_t)(row0 + ai * HALF + m * 16) * DM + col0;
#pragma unroll
                for (int bj = 0; bj < 2; ++bj)
#pragma unroll
                    for (int n = 0; n < 2; ++n) { const f32x4 xv = *(const f32x4*)(X + ro + bj * HALF + n * 16);
                        *(f32x4*)(U + ro + bj * HALF + n * 16) = xv * ALPHA_F + acc[ai][bj][m][n]; } }
    }
};
struct Epi3 {
    static constexpr bool PERM = true;
    float* LG; bf16_t* HS;
    __device__ __forceinline__ void operator()(const f32x4 (&acc)[2][2][4][2], const Unit& u, int wr, int wc, int fr, int fq) const {
        const int row0 = u.pm * BM + wr * 64 + fr;
        if (u.pn == 0) {
#pragma unroll
            for (int ai = 0; ai < 2; ++ai)
#pragma unroll
                for (int m = 0; m < 4; ++m) { float* rowp = LG + (size_t)(row0 + ai * HALF + m * 16) * 256 + wc * 32 + 8 * fq;
#pragma unroll
                    for (int bj = 0; bj < 2; ++bj)
#pragma unroll
                        for (int n = 0; n < 2; ++n) *(f32x4*)(rowp + bj * HALF + 4 * n) = acc[ai][bj][m][n]; }
        } else {
            const int hc0 = (u.pn - 1) * 128 + wc * 32 + 8 * fq;
#pragma unroll
            for (int ai = 0; ai < 2; ++ai)
#pragma unroll
                for (int m = 0; m < 4; ++m) { bf16_t* rowp = HS + (size_t)(row0 + ai * HALF + m * 16) * 256 + hc0;
                    float h[8];
#pragma unroll
                    for (int n = 0; n < 2; ++n)
#pragma unroll
                        for (int j = 0; j < 4; ++j) h[n * 4 + j] = siluf(acc[ai][0][m][n][j]) * acc[ai][1][m][n][j];
                    u32x4 w; w.x = cvt_pk_bf16(h[0], h[1]); w.y = cvt_pk_bf16(h[2], h[3]); w.z = cvt_pk_bf16(h[4], h[5]); w.w = cvt_pk_bf16(h[6], h[7]);
                    *(u32x4*)rowp = w; }
        }
    }
};
struct EpiH {
    static constexpr bool PERM = true;
    bf16_t* H;
    __device__ __forceinline__ void operator()(const f32x4 (&acc)[2][2][4][2], const Unit& u, int wr, int wc, int fr, int fq) const {
        const int hc0 = u.pn * 128 + wc * 32 + 8 * fq;
#pragma unroll
        for (int ai = 0; ai < 2; ++ai)
#pragma unroll
            for (int m = 0; m < 4; ++m) { const int r = ai * HALF + wr * 64 + m * 16 + fr;
                if (r < u.rows) { bf16_t* rowp = H + (size_t)(u.slot0 + r) * 256 + hc0;
                    float h[8];
#pragma unroll
                    for (int n = 0; n < 2; ++n)
#pragma unroll
                        for (int j = 0; j < 4; ++j) h[n * 4 + j] = siluf(acc[ai][0][m][n][j]) * acc[ai][1][m][n][j];
                    u32x4 w; w.x = cvt_pk_bf16(h[0], h[1]); w.y = cvt_pk_bf16(h[2], h[3]); w.z = cvt_pk_bf16(h[4], h[5]); w.w = cvt_pk_bf16(h[6], h[7]);
                    *(u32x4*)rowp = w; } }
    }
};
struct EpiYb {
    static constexpr bool PERM = true;
    bf16_t* YB; const int* lists; const float* tok_gate;
    __device__ __forceinline__ void operator()(const f32x4 (&acc)[2][2][4][2], const Unit& u, int wr, int wc, int fr, int fq) const {
        const int col0 = u.pn * BM + wc * 32 + 8 * fq;
#pragma unroll
        for (int ai = 0; ai < 2; ++ai)
#pragma unroll
            for (int m = 0; m < 4; ++m) { const int r = ai * HALF + wr * 64 + m * 16 + fr;
                if (r < u.rows) { const float g = tok_gate[lists[(size_t)u.e * LIST_CAP + u.mt * 256 + r]];
                    bf16_t* rowp = YB + (size_t)(u.slot0 + r) * 1024 + col0;
#pragma unroll
                    for (int bj = 0; bj < 2; ++bj) { const f32x4 v0 = acc[ai][bj][m][0] * g, v1 = acc[ai][bj][m][1] * g;
                        u32x4 w; w.x = cvt_pk_bf16(v0[0], v0[1]); w.y = cvt_pk_bf16(v0[2], v0[3]); w.z = cvt_pk_bf16(v1[0], v1[1]); w.w = cvt_pk_bf16(v1[2], v1[3]);
                        *(u32x4*)(rowp + bj * HALF) = w; } } }
    }
};
}

template <int OFF> __device__ __forceinline__ unsigned long long karg_u64() { unsigned long long v;
    asm volatile("s_load_dwordx2 %0, %1, %2\n\ts_waitcnt lgkmcnt(0)" : "=s"(v) : "s"(__builtin_amdgcn_kernarg_segment_ptr()), "i"(OFF)); return v; }
#define KARG_IN(k) ((const float*)karg_u64<8 * (k)>())
#define KARG_OUT() ((float*)karg_u64<184>())
struct Args { const float* in[23]; float* out; unsigned char* ws; int ph_lo, ph_hi, mode, li; };
struct Frame { LAS unsigned char* lds; int wave, G, vcu; unsigned char* ws; unsigned* ctl; };
#define F_LANE lane_id()
#define F_TID (F.wave * 64 + lane_id())
constexpr int NPH = 12;

__device__ __forceinline__ void transpose_item(const float* W, int ldw, int c0, int k0, bf16_t* WT, int K, int row0, LAS float* scr, int lane) {
    { float v[32];
#pragma unroll
      for (int i = 0; i < 32; ++i) { const int kk = 2 * i + (lane >> 5); v[i] = W[(size_t)(k0 + kk) * ldw + c0 + (lane & 31)]; }
#pragma unroll
      for (int i = 0; i < 32; ++i) { const int kk = 2 * i + (lane >> 5); scr[kk * 33 + (lane & 31)] = v[i]; } }
    asm volatile("s_waitcnt lgkmcnt(0)" ::: "memory");
    const int c = lane & 7;
#pragma unroll
    for (int j = 0; j < 4; ++j) { const int n = (lane >> 3) + 8 * j; const LAS float* s = scr + (8 * c) * 33 + n;
        u32x4 o; o.x = cvt_pk_bf16(s[0 * 33], s[1 * 33]); o.y = cvt_pk_bf16(s[2 * 33], s[3 * 33]); o.z = cvt_pk_bf16(s[4 * 33], s[5 * 33]); o.w = cvt_pk_bf16(s[6 * 33], s[7 * 33]);
        *(u32x4*)(WT + (size_t)(row0 + n) * K + k0 + 8 * c) = o; }
    asm volatile("s_waitcnt lgkmcnt(0)" ::: "memory");
}

__device__ __forceinline__ void gu_item(const float* Wg, const float* Wu, bf16_t* WT, int item, LAS float* scr, int lane) {
    const int kb = item >> 4, nb = item & 15, row0 = nb * 32, pn = row0 >> 8, half = (row0 >> 7) & 1, r0 = row0 & 127;
    transpose_item(half ? Wu : Wg, 256, pn * 128 + r0, kb * 64, WT, 1024, row0, scr, lane);
}

__device__ __forceinline__ void phase_prep(const Frame& F, const Args& a) {
    LAS float* scr = (LAS float*)(F.lds + F.wave * 16384);
    const int gw = F.vcu * 8 + F.wave, NGW = F.G * 8;
    unsigned char* ws = F.ws;
    bf16_t* Win_t = (bf16_t*)(ws + WS_WIN_T); bf16_t* Wout_t = (bf16_t*)(ws + WS_WOUT_T); bf16_t* W3_t = (bf16_t*)(ws + WS_W3_T); bf16_t* Wds_t = (bf16_t*)(ws + WS_WDS_T);
    bf16_t* Wgu_t = (bf16_t*)(ws + WS_WGU_T); bf16_t* Wd_t = (bf16_t*)(ws + WS_WD_T);
    const float* w_in = KARG_IN(1); const float* w_out = KARG_IN(10); const float* w_router = KARG_IN(13);
    const float* wge = KARG_IN(15); const float* wue = KARG_IN(16); const float* wde = KARG_IN(17);
    const float* wgs = KARG_IN(18); const float* wus = KARG_IN(19); const float* wds = KARG_IN(20);
    constexpr int I_IN = 16 * (PW / 32), I_OUT = 16 * 32, I_R = 16 * 8, I_S = 16 * 16, I_DS = 4 * 32, I_EGU = 16 * 16, I_ED = 4 * 32;
    constexpr int NITEMS = I_IN + I_OUT + I_R + I_S + I_DS;
    for (int it = gw; it < NITEMS; it += NGW) {
        int r = it; const float* W; int ldw, c0, k0, K, row0; bf16_t* WT;
        if (r < I_IN) { const int kb = r / (PW / 32), nb = r % (PW / 32); row0 = nb * 32; c0 = row0 < 1536 ? row0 : row0 + 8; W = w_in; ldw = NIN; k0 = kb * 64; WT = Win_t; K = 1024; }
        else if ((r -= I_IN) < I_OUT) { W = w_out; ldw = 1024; c0 = (r & 31) * 32; k0 = (r >> 5) * 64; WT = Wout_t; K = 1024; row0 = c0; }
        else if ((r -= I_OUT) < I_R) { W = w_router; ldw = 256; c0 = (r & 7) * 32; k0 = (r >> 3) * 64; WT = W3_t; K = 1024; row0 = c0; }
        else if ((r -= I_R) < I_S) { const int kb = r >> 4, nb = r & 15; row0 = nb * 32; const int pn = row0 >> 8, half = (row0 >> 7) & 1, r0 = row0 & 127;
            W = half ? wus : wgs; ldw = 256; c0 = pn * 128 + r0; k0 = kb * 64; WT = W3_t + (size_t)256 * 1024; K = 1024; }
        else { r -= I_S; W = wds; ldw = 1024; c0 = (r & 31) * 32; k0 = (r >> 5) * 64; WT = Wds_t; K = 256; row0 = c0; }
        transpose_item(W, ldw, c0, k0, WT, K, row0, scr, F_LANE);
    }
    float wdt[16][8];
    { const float* w_in0 = KARG_IN(1); const int tid = F_TID;
      __syncthreads();
#pragma unroll
      for (int i = 0; i < 2; ++i) { const int k = tid + 512 * i; const float* src = w_in0 + (size_t)k * NIN + 1536;
          *(LAS f32x4*)(F.lds + k * 32) = *(const f32x4*)src; *(LAS f32x4*)(F.lds + k * 32 + 16) = *(const f32x4*)(src + 4); }
      __syncthreads();
#pragma unroll
      for (int j = 0; j < 16; ++j) { const int k = (j < 8 ? 8 * F_LANE + j : 512 + 8 * F_LANE + (j - 8));
          const f32x4 lo = *(const LAS f32x4*)(F.lds + k * 32), hi = *(const LAS f32x4*)(F.lds + k * 32 + 16);
          wdt[j][0] = lo[0]; wdt[j][1] = lo[1]; wdt[j][2] = lo[2]; wdt[j][3] = lo[3]; wdt[j][4] = hi[0]; wdt[j][5] = hi[1]; wdt[j][6] = hi[2]; wdt[j][7] = hi[3]; }
      __syncthreads(); }
    const float* x = KARG_IN(0); bf16_t* xb = (bf16_t*)(ws + WS_XB); float* dtraw = (float*)(ws + WS_DTRAW);
    f32x4 n0, n1, n2, n3;
    { const float* xr = x + (size_t)(gw < T_TOK ? gw : 0) * DM; n0 = *(const f32x4*)(xr + 8 * F_LANE); n1 = *(const f32x4*)(xr + 8 * F_LANE + 4); n2 = *(const f32x4*)(xr + 512 + 8 * F_LANE); n3 = *(const f32x4*)(xr + 512 + 8 * F_LANE + 4); }
    for (int t = gw; t < T_TOK; t += NGW) {
        const f32x4 a0 = n0, a1 = n1, b0 = n2, b1 = n3;
        { const int tn = t + NGW < T_TOK ? t + NGW : t; const float* xr = x + (size_t)tn * DM;
          n0 = *(const f32x4*)(xr + 8 * F_LANE); n1 = *(const f32x4*)(xr + 8 * F_LANE + 4); n2 = *(const f32x4*)(xr + 512 + 8 * F_LANE); n3 = *(const f32x4*)(xr + 512 + 8 * F_LANE + 4); }
        u32x4 w0; w0.x = cvt_pk_bf16(a0[0], a0[1]); w0.y = cvt_pk_bf16(a0[2], a0[3]); w0.z = cvt_pk_bf16(a1[0], a1[1]); w0.w = cvt_pk_bf16(a1[2], a1[3]);
        u32x4 w1; w1.x = cvt_pk_bf16(b0[0], b0[1]); w1.y = cvt_pk_bf16(b0[2], b0[3]); w1.z = cvt_pk_bf16(b1[0], b1[1]); w1.w = cvt_pk_bf16(b1[2], b1[3]);
        *(u32x4*)(xb + (size_t)t * DM + 8 * F_LANE) = w0; *(u32x4*)(xb + (size_t)t * DM + 512 + 8 * F_LANE) = w1;
        const float xv[16] = {a0[0], a0[1], a0[2], a0[3], a1[0], a1[1], a1[2], a1[3], b0[0], b0[1], b0[2], b0[3], b1[0], b1[1], b1[2], b1[3]};
        float d[8];
#pragma unroll
        for (int h = 0; h < 8; ++h) { float sm = 0.f;
#pragma unroll
            for (int j = 0; j < 16; ++j) sm = fmaf(xv[j], wdt[j][h], sm);
            d[h] = wave_sum(sm); }
        if (F_LANE == 0) { *(f32x4*)(dtraw + t * 8) = (f32x4){d[0], d[1], d[2], d[3]}; *(f32x4*)(dtraw + t * 8 + 4) = (f32x4){d[4], d[5], d[6], d[7]}; }
    }
}

__device__ __forceinline__ void phase_ln1(const Frame& F, const Args& a) {
    const int gw = F.vcu * 8 + F.wave, NGW = F.G * 8;
    float* h1 = (float*)(F.ws + WS_H1); bf16_t* h1b = (bf16_t*)(F.ws + WS_H1B);
    const float* g = KARG_IN(11); const float* b = KARG_IN(12);
    const int c0 = 8 * F_LANE;
    f32x4 gv[4], bv[4];
    gv[0] = *(const f32x4*)(g + c0); gv[1] = *(const f32x4*)(g + c0 + 4); gv[2] = *(const f32x4*)(g + 512 + c0); gv[3] = *(const f32x4*)(g + 512 + c0 + 4);
    bv[0] = *(const f32x4*)(b + c0); bv[1] = *(const f32x4*)(b + c0 + 4); bv[2] = *(const f32x4*)(b + 512 + c0); bv[3] = *(const f32x4*)(b + 512 + c0 + 4);
    for (int t = gw; t < T_TOK; t += NGW) {
        float* r = h1 + (size_t)t * DM;
        f32x4 v[4]; v[0] = *(const f32x4*)(r + c0); v[1] = *(const f32x4*)(r + c0 + 4); v[2] = *(const f32x4*)(r + 512 + c0); v[3] = *(const f32x4*)(r + 512 + c0 + 4);
        float s = 0.f;
#pragma unroll
        for (int j = 0; j < 4; ++j) s += (v[j][0] + v[j][1]) + (v[j][2] + v[j][3]);
        const float mu = wave_sum(s) * (1.0f / 1024.0f);
        float q = 0.f;
#pragma unroll
        for (int j = 0; j < 4; ++j) { v[j] = v[j] - mu; q += (v[j][0] * v[j][0] + v[j][1] * v[j][1]) + (v[j][2] * v[j][2] + v[j][3] * v[j][3]); }
        const float rs = rsqrtf(wave_sum(q) * (1.0f / 1024.0f) + LN_EPS_F);
#pragma unroll
        for (int j = 0; j < 4; ++j) v[j] = v[j] * rs * gv[j] + bv[j];
        u32x4 w0; w0.x = cvt_pk_bf16(v[0][0], v[0][1]); w0.y = cvt_pk_bf16(v[0][2], v[0][3]); w0.z = cvt_pk_bf16(v[1][0], v[1][1]); w0.w = cvt_pk_bf16(v[1][2], v[1][3]);
        u32x4 w1; w1.x = cvt_pk_bf16(v[2][0], v[2][1]); w1.y = cvt_pk_bf16(v[2][2], v[2][3]); w1.z = cvt_pk_bf16(v[3][0], v[3][1]); w1.w = cvt_pk_bf16(v[3][2], v[3][3]);
        *(u32x4*)(h1b + (size_t)t * DM + c0) = w0; *(u32x4*)(h1b + (size_t)t * DM + 512 + c0) = w1;
    }
}

__device__ __forceinline__ void phase_route(const Frame& F, const Args& a) {
    const int gw = F.vcu * 8 + F.wave, NGW = F.G * 8, lane = F_LANE;
    const float* logits = (const float*)(F.ws + WS_LOGITS); const float* rbias = KARG_IN(14);
    int* counts = (int*)(F.ctl + CW_COUNTS); int* tok_e = (int*)(F.ws + WS_TOKE); int* tok_pos = (int*)(F.ws + WS_TOKPOS); float* tok_gate = (float*)(F.ws + WS_TOKGATE);
    int* lists = (int*)(F.ws + WS_LISTS);
    const f32x4 rb = *(const f32x4*)(rbias + lane * 4);
    f32x4 lgn = *(const f32x4*)(logits + (size_t)(gw < T_TOK ? gw : 0) * 256 + lane * 4);
    int p_t = -1, p_e = 0, p_pos = 0;
    for (int t = gw; t < T_TOK; t += NGW) {
        const f32x4 lg = lgn;
        { const int tn = t + NGW < T_TOK ? t + NGW : t; lgn = *(const f32x4*)(logits + (size_t)tn * 256 + lane * 4); }
        float sc[4] = {sigmf(lg[0]), sigmf(lg[1]), sigmf(lg[2]), sigmf(lg[3])};
        float bs[4] = {sc[0] + rb[0], sc[1] + rb[1], sc[2] + rb[2], sc[3] + rb[3]};
        float m1 = fmaxf(bs[0], bs[1]), m2 = fminf(bs[0], bs[1]);
        { const float n1 = fmaxf(bs[2], bs[3]), n2 = fminf(bs[2], bs[3]);
          const float a1 = fmaxf(m1, n1), a2 = fmaxf(fminf(m1, n1), fmaxf(m2, n2)); m1 = a1; m2 = a2; }
        { const float n1 = dpp_f<0xB1>(m1), n2 = dpp_f<0xB1>(m2); const float a1 = fmaxf(m1, n1), a2 = fmaxf(fminf(m1, n1), fmaxf(m2, n2)); m1 = a1; m2 = a2; }
        { const float n1 = dpp_f<0x4E>(m1), n2 = dpp_f<0x4E>(m2); const float a1 = fmaxf(m1, n1), a2 = fmaxf(fminf(m1, n1), fmaxf(m2, n2)); m1 = a1; m2 = a2; }
        { const float n1 = dpp_f<0x141>(m1), n2 = dpp_f<0x141>(m2); const float a1 = fmaxf(m1, n1), a2 = fmaxf(fminf(m1, n1), fmaxf(m2, n2)); m1 = a1; m2 = a2; }
        const float gs = m1 + m2; const int mygrp = lane >> 3; int rank = 0;
#pragma unroll
        for (int gI = 0; gI < 8; ++gI) { const float og = rdlane_f(gs, gI * 8); rank += (og > gs || (og == gs && gI < mygrp)) ? 1 : 0; }
        const bool sel = rank < 4;
        float cand[4];
#pragma unroll
        for (int j = 0; j < 4; ++j) cand[j] = sel ? bs[j] : -INFINITY;
        int my_e = -1; float my_s = 0.f; float gsum = 0.f;
#pragma unroll
        for (int k = 0; k < 8; ++k) {
            const float mx = wave_max(fmaxf(fmaxf(cand[0], cand[1]), fmaxf(cand[2], cand[3])));
            int be = 1 << 20;
#pragma unroll
            for (int j = 0; j < 4; ++j) { const unsigned long long bm = __ballot(cand[j] == mx); const int ej = bm ? (__ffsll((long long)bm) - 1) * 4 + j : (1 << 20); be = ej < be ? ej : be; }
            be = __builtin_amdgcn_readfirstlane(be);
            const int wj = be & 3, bl = be >> 2;
            const float mysc = wj == 0 ? sc[0] : wj == 1 ? sc[1] : wj == 2 ? sc[2] : sc[3];
            const float wsc = rdlane_f(mysc, bl);
#pragma unroll
            for (int j = 0; j < 4; ++j) cand[j] = (lane == bl && j == wj) ? -INFINITY : cand[j];
            gsum += wsc;
            if (lane == k) { my_e = be; my_s = wsc; }
        }
        if (lane < 8) {
            if (p_t >= 0) { tok_pos[p_t * 8 + lane] = p_pos; lists[(size_t)p_e * LIST_CAP + p_pos] = p_t * 8 + lane; }
            const float gate = my_s / gsum * 2.5f;
            p_pos = atomicAdd(&counts[my_e * CNT_STRIDE], 1); p_e = my_e; p_t = t;
            tok_e[t * 8 + lane] = my_e; tok_gate[t * 8 + lane] = gate;
        }
    }
    if (lane < 8 && p_t >= 0) { tok_pos[p_t * 8 + lane] = p_pos; lists[(size_t)p_e * LIST_CAP + p_pos] = p_t * 8 + lane; }
}

__device__ __forceinline__ void build_tables(const Frame& F) {
    const int* counts = (const int*)(F.ctl + CW_COUNTS);
    LAS int* pref = (LAS int*)(F.lds + LDS_PREF); LAS int* offs = (LAS int*)(F.lds + LDS_OFFS); LAS int* cnt = (LAS int*)(F.lds + LDS_CNT);
    LAS int* wt = (LAS int*)(F.lds);
    const int tid = F_TID, lane = tid & 63;
    __syncthreads();
    int n = 0, nt = 0, in_ = 0, it_ = 0;
    if (F.wave < 4) {
        n = __hip_atomic_load(&counts[tid * CNT_STRIDE], __ATOMIC_RELAXED, __HIP_MEMORY_SCOPE_AGENT); nt = (n + 255) >> 8; in_ = n; it_ = nt;
#pragma unroll
        for (int o = 1; o < 64; o <<= 1) { const int a = __shfl_up(in_, o), b = __shfl_up(it_, o); if (lane >= o) { in_ += a; it_ += b; } }
        if (lane == 63) { wt[F.wave] = in_; wt[4 + F.wave] = it_; }
    }
    __syncthreads();
    if (F.wave < 4) {
        for (int w = 0; w < F.wave; ++w) { in_ += wt[w]; it_ += wt[4 + w]; }
        cnt[tid] = n; offs[tid] = in_ - n; pref[tid] = it_ - nt;
        if (tid == NEXP - 1) { offs[NEXP] = in_; pref[NEXP] = it_; }
    }
    __syncthreads();
}

__device__ __forceinline__ void phase_final(const Frame& F, const Args& a) {
    const int gw = F.vcu * 8 + F.wave, NGW = F.G * 8;
    const float* h1 = (const float*)(F.ws + WS_H1); const bf16_t* ys = (const bf16_t*)(F.ws + WS_YS); const bf16_t* yb = (const bf16_t*)(F.ws + WS_YB);
    const int* tok_e = (const int*)(F.ws + WS_TOKE); const int* tok_pos = (const int*)(F.ws + WS_TOKPOS);
    const LAS int* offs = (const LAS int*)(F.lds + LDS_OFFS);
    const float* g = KARG_IN(21); const float* b = KARG_IN(22); float* out = KARG_OUT();
    const int c0 = 8 * F_LANE;
    f32x4 gv[4], bv[4];
    gv[0] = *(const f32x4*)(g + c0); gv[1] = *(const f32x4*)(g + c0 + 4); gv[2] = *(const f32x4*)(g + 512 + c0); gv[3] = *(const f32x4*)(g + 512 + c0 + 4);
    bv[0] = *(const f32x4*)(b + c0); bv[1] = *(const f32x4*)(b + c0 + 4); bv[2] = *(const f32x4*)(b + 512 + c0); bv[3] = *(const f32x4*)(b + 512 + c0 + 4);
    const int lane8 = F_LANE;
    const bf16_t* h1b = (const bf16_t*)(F.ws + WS_H1B); const unsigned char* yb8 = (const unsigned char*)(F.ws + WS_YB);
    int ekn = 0, pkn = 0;
    if (gw < T_TOK && lane8 < 8) { ekn = tok_e[gw * 8 + lane8]; pkn = tok_pos[gw * 8 + lane8]; }
    for (int t = gw; t < T_TOK; t += NGW) {
        const int myrow = lane8 < 8 ? offs[ekn] + pkn : 0;
        const u32x4 r0 = *(const u32x4*)(h1b + (size_t)t * DM + c0), r1 = *(const u32x4*)(h1b + (size_t)t * DM + 512 + c0);
        const u32x4 s0 = *(const u32x4*)(ys + (size_t)t * DM + c0), s1 = *(const u32x4*)(ys + (size_t)t * DM + 512 + c0);
        u32x2 W[8][2];
#pragma unroll
        for (int k = 0; k < 8; ++k) { const unsigned char* src = yb8 + (size_t)__shfl(myrow, k) * 1024; W[k][0] = *(const u32x2*)(src + c0); W[k][1] = *(const u32x2*)(src + 512 + c0); }
        { const int tn = t + NGW; if (tn < T_TOK && lane8 < 8) { ekn = tok_e[tn * 8 + lane8]; pkn = tok_pos[tn * 8 + lane8]; } }
        f32x4 v[4], y[4];
        v[0] = (f32x4){bflo(r0.x), bfhi(r0.x), bflo(r0.y), bfhi(r0.y)}; v[1] = (f32x4){bflo(r0.z), bfhi(r0.z), bflo(r0.w), bfhi(r0.w)};
        v[2] = (f32x4){bflo(r1.x), bfhi(r1.x), bflo(r1.y), bfhi(r1.y)}; v[3] = (f32x4){bflo(r1.z), bfhi(r1.z), bflo(r1.w), bfhi(r1.w)};
#pragma unroll
        for (int j = 0; j < 4; ++j) { v[j] = v[j] * ALPHA_F; y[j] = (f32x4){0.f, 0.f, 0.f, 0.f}; }
        v[0] = v[0] + (f32x4){bflo(s0.x), bfhi(s0.x), bflo(s0.y), bfhi(s0.y)}; v[1] = v[1] + (f32x4){bflo(s0.z), bfhi(s0.z), bflo(s0.w), bfhi(s0.w)};
        v[2] = v[2] + (f32x4){bflo(s1.x), bfhi(s1.x), bflo(s1.y), bfhi(s1.y)}; v[3] = v[3] + (f32x4){bflo(s1.z), bfhi(s1.z), bflo(s1.w), bfhi(s1.w)};
#pragma unroll
        for (int k = 0; k < 8; ++k) { y[0] = y[0] + un4_fp8(W[k][0].x); y[1] = y[1] + un4_fp8(W[k][0].y); y[2] = y[2] + un4_fp8(W[k][1].x); y[3] = y[3] + un4_fp8(W[k][1].y); }
#pragma unroll
        for (int j = 0; j < 4; ++j) v[j] = v[j] + y[j] * (1.0f / YB_SCALE);
        float s = 0.f;
#pragma unroll
        for (int j = 0; j < 4; ++j) s += (v[j][0] + v[j][1]) + (v[j][2] + v[j][3]);
        const float mu = wave_sum(s) * (1.0f / 1024.0f);
        float q = 0.f;
#pragma unroll
        for (int j = 0; j < 4; ++j) { v[j] = v[j] - mu; q += (v[j][0] * v[j][0] + v[j][1] * v[j][1]) + (v[j][2] * v[j][2] + v[j][3] * v[j][3]); }
        const float rs = rsqrtf(wave_sum(q) * (1.0f / 1024.0f) + LN_EPS_F);
        float* o = out + (size_t)t * DM;
#pragma unroll
        for (int j = 0; j < 4; ++j) v[j] = v[j] * rs * gv[j] + bv[j];
        *(f32x4*)(o + c0) = v[0]; *(f32x4*)(o + c0 + 4) = v[1]; *(f32x4*)(o + 512 + c0) = v[2]; *(f32x4*)(o + 512 + c0 + 4) = v[3];
    }
}


namespace xk {
constexpr int B_IMG = 16384, A_SLOT = 16384, L_B0 = 0, L_A0 = 4 * B_IMG, L_GATE = 8 * 16384;
typedef __amdgpu_buffer_rsrc_t rsrc_t;
__device__ __forceinline__ rsrc_t make_rsrc(const void* p) { return __builtin_amdgcn_make_buffer_rsrc((void*)p, 0, 0x7fffffff, 0x00020000); }
__device__ __forceinline__ u32x4 make_srd(const void* p) { const unsigned long long v = (unsigned long long)p; u32x4 d;
    d.x = (unsigned)__builtin_amdgcn_readfirstlane((int)(unsigned)v); d.y = (unsigned)__builtin_amdgcn_readfirstlane((int)(unsigned)(v >> 32)) & 0xffffu; d.z = 0x7fffffffu; d.w = 0x00020000u; return d; }
__device__ __forceinline__ void dma16(const u32x4 srd, unsigned voff, int soff, unsigned lds_addr) {
    asm volatile("s_mov_b32 m0, %0\n\ts_nop 0\n\tbuffer_load_dwordx4 %1, %2, %3 offen lds" :: "s"(lds_addr), "v"(voff), "s"(srd), "s"(soff) : "m0", "memory");
}
__device__ __forceinline__ void a_piece_rc(int b, int& R, int& C) { const int st = b >> 10, sb = b & 1023, ob = sb ^ (((sb >> 9) & 1) << 5); R = st * 16 + (ob >> 6); C = (ob & 63) >> 1; }
struct PassDesc { u32x4 ra; unsigned aoff[2]; rsrc_t rb0, rb1; int bcol, ncol; unsigned boff; int nh; bool preloaded, chain; };
typedef f32x4 Acc[2][4][2][2];

template <bool GU> __device__ __forceinline__ void kloop(LAS unsigned char* lds, const PassDesc& P, const int wid, const int lane, const int bir, Acc& acc, f32x4 (&Br)[4][4]) {
    const int wr = wid >> 2, wc = wid & 3, fr = lane & 15, fq = lane >> 4, hl = lane >> 5;
    const int KB = GU ? 32 * 256 * 4 : 32 * 1024 * 4;
#define XK_DMAA(hh, slot) do { _Pragma("unroll") for (int _i = 0; _i < 2; ++_i) dma16(P.ra, P.aoff[_i], (hh) * 64, (unsigned)(size_t)(lds + L_A0 + (slot) * A_SLOT + _i * 8192 + wid * 1024)); } while (0)
#define XK_LOADB(col, hh, st) do { _Pragma("unroll") for (int _i = 0; _i < 4; ++_i) { \
            const u32x4 _v = GU ? __builtin_amdgcn_raw_buffer_load_b128((_i >> 1) ? P.rb1 : P.rb0, P.boff, (col) + (hh) * KB + (_i & 1) * (2 * 256 * 4), 0) \
                                : __builtin_amdgcn_raw_buffer_load_b128(P.rb0, P.boff, (col) + (hh) * KB + _i * (1024 * 4), 0); \
            Br[st][_i] = __builtin_bit_cast(f32x4, _v); } } while (0)
    const unsigned swg = (unsigned)(((wid >> 1) & 1) << 4);
    unsigned bw0 = (unsigned)(size_t)(lds + L_B0) + (GU ? (4 * wid + hl) * 512 + (bir ^ (hl << 7) ^ swg) : 4 * wid * 512 + (bir ^ swg));
    const int q = (lane & 15) >> 2, p = lane & 3;
    unsigned br0 = (unsigned)(size_t)(lds + L_B0) + (8 * fq + q) * 512 + ((128 * wc + 32 * p) ^ ((q & 1) << 7) ^ (((q >> 1) & 1) << 3) ^ ((fq & 1) << 4));
    const LAS unsigned char* arp = lds + L_A0 + (wr * 4) * 1024 + ((fr * 64 + 16 * fq) ^ ((fr >> 3) << 5));
#define XK_WRITEB(st, img) do { _Pragma("unroll") for (int _i = 0; _i < 4; ++_i) { u32x2 _w; _w.x = cvt_pk_bf16(Br[st][_i][0], Br[st][_i][1]); _w.y = cvt_pk_bf16(Br[st][_i][2], Br[st][_i][3]); \
        if (GU) *(LAS u32x2*)(size_t)((bw0 ^ (unsigned)(((_i >> 1) << 4) | ((_i & 1) << 3))) + (img) * B_IMG + 2 * (_i & 1) * 512) = _w; \
        else *(LAS u32x2*)(size_t)((bw0 ^ (unsigned)(((_i & 1) << 7) | (((_i >> 1) & 1) << 3))) + (img) * B_IMG + _i * 512) = _w; } } while (0)
#define XK_FRAGS(slot, img) do { \
        _Pragma("unroll") for (int gI = 0; gI < 2; ++gI) _Pragma("unroll") for (int nn = 0; nn < 2; ++nn) { \
            const LAS unsigned char* _a = (const LAS unsigned char*)(size_t)((br0 ^ (unsigned)(16 * gI + 8 * nn)) + (img) * B_IMG); \
            const s16x4 _lo = __builtin_amdgcn_ds_read_tr16_b64_v4i16((LAS s16x4*)_a), _hi = __builtin_amdgcn_ds_read_tr16_b64_v4i16((LAS s16x4*)(_a + 2048)); \
            wf[gI][nn] = (bf16x8){_lo[0], _lo[1], _lo[2], _lo[3], _hi[0], _hi[1], _hi[2], _hi[3]}; } \
        _Pragma("unroll") for (int ai = 0; ai < 2; ++ai) _Pragma("unroll") for (int m = 0; m < 4; ++m) xf[ai][m] = *(const LAS bf16x8*)(arp + (slot) * A_SLOT + (8 * ai + m) * 1024); } while (0)
#define XK_MMA() do { __builtin_amdgcn_s_setprio(1); \
        _Pragma("unroll") for (int ai = 0; ai < 2; ++ai) _Pragma("unroll") for (int m = 0; m < 4; ++m) _Pragma("unroll") for (int gI = 0; gI < 2; ++gI) _Pragma("unroll") for (int nn = 0; nn < 2; ++nn) \
            acc[ai][m][gI][nn] = __builtin_amdgcn_mfma_f32_16x16x32_bf16(wf[gI][nn], xf[ai][m], acc[ai][m][gI][nn], 0, 0, 0); \
        __builtin_amdgcn_s_setprio(0); } while (0)
    bf16x8 wf[2][2], xf[2][4];
    const int nh = P.nh;
    if (!P.preloaded) {
        XK_LOADB(P.bcol, 0, 0); XK_LOADB(P.bcol, 1, 1); XK_LOADB(P.bcol, 2, 2); XK_DMAA(0, 0); XK_DMAA(1, 1);
        XK_WRITEB(0, 0);
        asm volatile("s_waitcnt vmcnt(0)" ::: "memory");
        __syncthreads();
    }
    const int tcol = P.chain ? P.ncol : P.bcol;
    if (wid >= 4) __builtin_amdgcn_s_barrier();
#define XK_ITER(j) do { const int _h = hb + (j); asm volatile("" : "+v"(bw0), "+v"(br0));     \
        { const bool _in2 = _h + 2 < nh; XK_DMAA(_in2 ? _h + 2 : _h + 2 - nh, ((j) + 2) & 3); \
          const bool _in3 = _h + 3 < nh; XK_LOADB(_in3 ? P.bcol : tcol, _in3 ? _h + 3 : _h + 3 - nh, ((j) + 3) & 3); } \
        XK_WRITEB(((j) + 1) & 3, ((j) + 1) & 3); \
        XK_FRAGS((j), (j));        \
        asm volatile("s_waitcnt vmcnt(10)" ::: "memory");     \
        asm volatile("s_waitcnt lgkmcnt(0)" ::: "memory"); __builtin_amdgcn_sched_barrier(0); __builtin_amdgcn_s_barrier(); __builtin_amdgcn_sched_barrier(0); \
        XK_MMA(); \
        __builtin_amdgcn_sched_barrier(0); __builtin_amdgcn_s_barrier(); __builtin_amdgcn_sched_barrier(0); } while (0)
    for (int hb = 0; hb < nh; hb += 4) { XK_ITER(0); XK_ITER(1); XK_ITER(2); XK_ITER(3); }
    if (wid < 4) __builtin_amdgcn_s_barrier();
#undef XK_ITER
#undef XK_DMAA
#undef XK_LOADB
#undef XK_WRITEB
#undef XK_FRAGS
#undef XK_MMA
}
}

__device__ __forceinline__ void phase_experts(const Frame& F, const Args& a, const int mode) {
    build_tables(F);
    const int wid = F.wave, wr = wid >> 2, wc = wid & 3;
    const LAS int* pref = (const LAS int*)(F.lds + LDS_PREF);
    const int U = __builtin_amdgcn_readfirstlane(pref[NEXP]);
    const int* lists = (const int*)(F.ws + WS_LISTS); const float* tok_gate = (const float*)(F.ws + WS_TOKGATE);
    const char* h1b = (const char*)(F.ws + WS_H1B); bf16_t* H = (bf16_t*)(F.ws + WS_H); bf16_t* YB = (bf16_t*)(F.ws + WS_YB);
    f32x4 Br[4][4];
    for (int ui = 0;; ++ui) {
        int L = ui * F.G + blockIdx.x; if (L >= U) break;
        { const int qq = U / 8, rr = U % 8, xcd = L % 8, off = L / 8; L = (xcd < rr ? xcd * (qq + 1) : rr * (qq + 1) + (xcd - rr) * qq) + off; }
        int lo = 0, hi = NEXP;
        while (hi - lo > 1) { const int mid = (lo + hi) >> 1; const int pv = __builtin_amdgcn_readfirstlane(pref[mid]); if (pv <= L) lo = mid; else hi = mid; }
        const int e = lo, mt = L - __builtin_amdgcn_readfirstlane(pref[e]);
        const int n = __builtin_amdgcn_readfirstlane(((const LAS int*)(F.lds + LDS_CNT))[e]);
        const int rows = (n - mt * 256) < 256 ? (n - mt * 256) : 256;
        const int slot0 = __builtin_amdgcn_readfirstlane(((const LAS int*)(F.lds + LDS_OFFS))[e]) + mt * 256;
        const int* lst = lists + (size_t)e * LIST_CAP + mt * 256;
        const int ew = (mode & 1) ? 0 : e;
        const float* Wg = KARG_IN(15) + (size_t)ew * 1024 * 256; const float* Wu = KARG_IN(16) + (size_t)ew * 1024 * 256; const float* Wd = KARG_IN(17) + (size_t)ew * 256 * 1024;
        {
            xk::PassDesc P; P.ra = xk::make_srd(h1b);
            { const int lane = lane_id(), tid = wid * 64 + lane;
#pragma unroll
              for (int i = 0; i < 2; ++i) { int R, C; xk::a_piece_rc(tid * 16 + i * 8192, R, C); int tok = 0; if (R < rows) tok = lst[R] >> 3; if (mode & 2) tok = (slot0 + R) & 16383; P.aoff[i] = (unsigned)(tok * 1024 + C) * 2u; }
              P.boff = (unsigned)((4 * wid + (lane >> 5)) * 256 + 4 * (lane & 31)) * 4u; }
            P.nh = 32; P.rb0 = xk::make_rsrc(Wg); P.rb1 = xk::make_rsrc(Wu);
#pragma unroll 1
            for (int pn = 0; pn < 2; ++pn) {
                P.bcol = pn * 128 * 4; P.ncol = 128 * 4;
                P.preloaded = pn == 1; P.chain = pn == 0;
                xk::Acc acc;
#pragma unroll
                for (int ai = 0; ai < 2; ++ai)
#pragma unroll
                    for (int m = 0; m < 4; ++m)
#pragma unroll
                        for (int gI = 0; gI < 2; ++gI)
#pragma unroll
                            for (int nn = 0; nn < 2; ++nn) acc[ai][m][gI][nn] = (f32x4){0.f, 0.f, 0.f, 0.f};
                { const int lane = lane_id(); xk::kloop<true>(F.lds, P, wid, lane, 128 * ((lane & 31) >> 3) + 32 * (((lane & 31) >> 1) & 3) + 8 * (lane & 1), acc, Br); }
                const int lane = lane_id(), fr = lane & 15, fq = lane >> 4;
                const xk::rsrc_t rH = xk::make_rsrc(H + (size_t)slot0 * 256);
#pragma unroll
                for (int ai = 0; ai < 2; ++ai)
#pragma unroll
                    for (int m = 0; m < 4; ++m) { const int r = ai * 128 + wr * 64 + m * 16 + fr;
                        if (r < rows && !(mode & 4) && !(mode & 16)) { float h[8];
#pragma unroll
                            for (int nn = 0; nn < 2; ++nn)
#pragma unroll
                                for (int j = 0; j < 4; ++j) h[nn * 4 + j] = siluf(acc[ai][m][0][nn][j]) * acc[ai][m][1][nn][j];
                            u32x4 w; w.x = cvt_pk_bf16(h[0], h[1]); w.y = cvt_pk_bf16(h[2], h[3]); w.z = cvt_pk_bf16(h[4], h[5]); w.w = cvt_pk_bf16(h[6], h[7]);
                            __builtin_amdgcn_raw_buffer_store_b128(w, rH, (unsigned)(r * 256 + pn * 128 + wc * 32 + 8 * fq) * 2u, 0, 0); } }
            }
        }
        { const int t = wid * 64 + lane_id();
          if (t < 256) ((LAS float*)(F.lds + xk::L_GATE))[t] = t < rows ? tok_gate[lst[t]] : 0.f; }
        asm volatile("s_waitcnt vmcnt(0)" ::: "memory");
        __syncthreads();
        {
            xk::PassDesc P; P.ra = xk::make_srd(H + (size_t)slot0 * 256);
            { const int lane = lane_id(), tid = wid * 64 + lane;
#pragma unroll
              for (int i = 0; i < 2; ++i) { int R, C; xk::a_piece_rc(tid * 16 + i * 8192, R, C); P.aoff[i] = (unsigned)(R * 256 + C) * 2u; }
              P.boff = (unsigned)(4 * wid * 1024 + 4 * lane) * 4u; }
            P.nh = 8; P.rb0 = xk::make_rsrc(Wd); P.rb1 = P.rb0;
#pragma unroll 1
            for (int pn = 0; pn < 4; ++pn) {
                P.bcol = pn * 256 * 4; P.ncol = (pn + 1) * 256 * 4;
                P.preloaded = pn > 0; P.chain = pn < 3;
                xk::Acc acc;
#pragma unroll
                for (int ai = 0; ai < 2; ++ai)
#pragma unroll
                    for (int m = 0; m < 4; ++m)
#pragma unroll
                        for (int gI = 0; gI < 2; ++gI)
#pragma unroll
                            for (int nn = 0; nn < 2; ++nn) acc[ai][m][gI][nn] = (f32x4){0.f, 0.f, 0.f, 0.f};
                { const int lane = lane_id(); xk::kloop<false>(F.lds, P, wid, lane, 8 * lane, acc, Br); }
                const int lane = lane_id(), fr = lane & 15, fq = lane >> 4;
                const xk::rsrc_t rY = xk::make_rsrc((const unsigned char*)YB + (size_t)slot0 * 1024);
#pragma unroll
                for (int ai = 0; ai < 2; ++ai)
#pragma unroll
                    for (int m = 0; m < 4; ++m) { const int r = ai * 128 + wr * 64 + m * 16 + fr;
                        if (r < rows && !(mode & 4) && !(mode & 8)) { const float g = ((const LAS float*)(F.lds + xk::L_GATE))[r] * YB_SCALE;
                            u32x4 w; w.x = pk4_fp8(acc[ai][m][0][0] * g); w.y = pk4_fp8(acc[ai][m][0][1] * g); w.z = pk4_fp8(acc[ai][m][1][0] * g); w.w = pk4_fp8(acc[ai][m][1][1] * g);
                            __builtin_amdgcn_raw_buffer_store_b128(w, rY, (unsigned)(r * 1024 + pn * 256 + 64 * wc + 16 * fq), 0, 0); } }
            }
        }
        __syncthreads();
    }
}

__device__ __forceinline__ float ldp(const bf16_t* p, size_t t, int c) { return bf2f(p[t * PW + c]); }
__device__ __forceinline__ void phase_m1(const Frame& F, const Args& a) {
  const bf16_t* p = (const bf16_t*)(F.ws + WS_P); const float* dtraw = (const float*)(F.ws + WS_DTRAW);
  const float* conv_w = KARG_IN(2); const float* conv_b = KARG_IN(3); const float* dt_bias = KARG_IN(4); const float* lb_logits = KARG_IN(8);
  float* xbc = (float*)(F.ws + WS_NXBC); float* fgk = (float*)(F.ws + WS_NFGK); float* qs = (float*)(F.ws + WS_NQS); float* dtb = (float*)(F.ws + WS_NDTB);
  const int tid = F_TID;
  for (int t = blockIdx.x; t < T_TOK; t += F.G) {
    for (int c = tid; c < 1024; c += 512) {
      float acc = conv_b[c];
#pragma unroll
      for (int j = 0; j < 4; ++j) { const int tt = t - 3 + j; if (tt >= 0) acc = fmaf(conv_w[j * 1024 + c], ldp(p, tt, PC_XBC + c), acc); }
      xbc[(size_t)t * 1024 + c] = siluf(acc);
    }
    { const int c = tid;
      const float l0 = lb_logits[c], l1 = lb_logits[512 + c];
      const float mx = fmaxf(l0, l1);
      const float e0 = expf(l0 - mx), e1 = expf(l1 - mx);
      const float lb = e0 / (e0 + e1);
      const float f = ldp(p, t, PC_F + c);
      fgk[(size_t)t * 512 + c] = lb + (1.0f - lb) * (1.0f / (1.0f + expf(-f)));
      const float q = ldp(p, t, PC_Q + c);
      qs[(size_t)t * 512 + c] = q / (1.0f + expf(-q)); }
    if (tid < 8) { const float v = dtraw[t * 8 + tid] + dt_bias[tid]; dtb[t * 8 + tid] = v > 20.f ? v : log1pf(expf(v)); }
  }
}
__device__ __forceinline__ void phase_m2(const Frame& F, const Args& a) {
  const int item = F.wave * F.G + blockIdx.x, lane = F_LANE;
  const float* xbc = (const float*)(F.ws + WS_NXBC); const float* dtb = (const float*)(F.ws + WS_NDTB);
  const float* fgk = (const float*)(F.ws + WS_NFGK); const float* qs = (const float*)(F.ws + WS_NQS); const bf16_t* p = (const bf16_t*)(F.ws + WS_P);
  float* y_ssd = (float*)(F.ws + WS_NYSSD); float* o_h = (float*)(F.ws + WS_NOH);
  if (item < 512) {
    const int h = item >> 6, pp = item & 63, g = h >> 2;
    const float aa = -expf(KARG_IN(5)[h]), D = KARG_IN(6)[h];
    float h0 = 0.f, h1 = 0.f;
    const float* xp = xbc + h * 64 + pp; const float* Bp = xbc + 512 + g * 128 + lane; const float* Cp = xbc + 768 + g * 128 + lane;
    for (int t0 = 0; t0 < T_TOK; t0 += 8) {
      float Bv0[8], Bv1[8], Cv0[8], Cv1[8], xv[8], dv[8];
#pragma unroll
      for (int i = 0; i < 8; ++i) { const size_t o = (size_t)(t0 + i) * 1024;
        Bv0[i] = Bp[o]; Bv1[i] = Bp[o + 64]; Cv0[i] = Cp[o]; Cv1[i] = Cp[o + 64]; xv[i] = xp[o]; dv[i] = dtb[(t0 + i) * 8 + h]; }
#pragma unroll
      for (int i = 0; i < 8; ++i) {
        const float dA = expf(dv[i] * aa), dx = dv[i] * xv[i];
        h0 = fmaf(dA, h0, dx * Bv0[i]); h1 = fmaf(dA, h1, dx * Bv1[i]);
        float part = wave_sum(Cv0[i] * h0 + Cv1[i] * h1);
        if (lane == 0) y_ssd[(size_t)(t0 + i) * 512 + h * 64 + pp] = part + D * xv[i];
      }
    }
  } else if (item < 1024) {
    const int it = item - 512, h = it >> 7, e = it & 127;
    float S0 = 0.f, S1 = 0.f;
    const float* fp = fgk + h * 128 + lane; const float* qp = qs + h * 128 + lane;
    for (int t0 = 0; t0 < T_TOK; t0 += 8) {
      float f0[8], f1[8], q0[8], q1[8], iv[8];
#pragma unroll
      for (int i = 0; i < 8; ++i) { const size_t o = (size_t)(t0 + i) * 512;
        f0[i] = fp[o]; f1[i] = fp[o + 64]; q0[i] = qp[o]; q1[i] = qp[o + 64]; iv[i] = ldp(p, t0 + i, PC_I + h * 128 + e); }
#pragma unroll
      for (int i = 0; i < 8; ++i) {
        S0 = fmaf(f0[i], S0, (1.0f - f0[i]) * iv[i]); S1 = fmaf(f1[i], S1, (1.0f - f1[i]) * iv[i]);
        float part = wave_sum(q0[i] * S0 + q1[i] * S1);
        if (lane == 0) o_h[(size_t)(t0 + i) * 512 + h * 128 + e] = part;
      }
    }
  }
}
__device__ __forceinline__ void phase_m3(const Frame& F, const Args& a) {
  const int gw = F.vcu * 8 + F.wave, NGW = F.G * 8, lane = F_LANE;
  const float* y_ssd = (const float*)(F.ws + WS_NYSSD); const float* o_h = (const float*)(F.ws + WS_NOH); const bf16_t* p = (const bf16_t*)(F.ws + WS_P);
  const float* snw = KARG_IN(7); const float* hnw = KARG_IN(9); bf16_t* mix = (bf16_t*)(F.ws + WS_MIX);
  for (int idx = gw; idx < T_TOK * 2; idx += NGW) {
    const int t = idx >> 1, g = idx & 1;
    float v[4]; float ss = 0.f;
#pragma unroll
    for (int j = 0; j < 4; ++j) { const int c = g * 256 + lane + 64 * j; v[j] = y_ssd[(size_t)t * 512 + c] * siluf(ldp(p, t, PC_Z + c)); ss += v[j] * v[j]; }
    ss = wave_sum(ss);
    const float r = rsqrtf(ss * (1.0f / 256.0f) + RMS_EPS_F);
#pragma unroll
    for (int j = 0; j < 4; ++j) { const int c = g * 256 + lane + 64 * j; mix[(size_t)t * 1024 + c] = (bf16_t)(cvt_pk_bf16(v[j] * r * snw[c], 0.f) & 0xffffu); }
  }
  for (int idx = gw; idx < T_TOK * 4; idx += NGW) {
    const int t = idx >> 2, h = idx & 3;
    float v[2]; float ss = 0.f;
#pragma unroll
    for (int j = 0; j < 2; ++j) { const int c = h * 128 + lane + 64 * j; v[j] = o_h[(size_t)t * 512 + c]; ss += v[j] * v[j]; }
    ss = wave_sum(ss);
    const float r = rsqrtf(ss * (1.0f / 128.0f) + RMS_EPS_F);
#pragma unroll
    for (int j = 0; j < 2; ++j) { const int c = h * 128 + lane + 64 * j;
      mix[(size_t)t * 1024 + 512 + c] = (bf16_t)(cvt_pk_bf16(v[j] * r * hnw[c] * siluf(ldp(p, t, PC_G + c)), 0.f) & 0xffffu); }
  }
}


#define MFMA32(a, b, c) __builtin_amdgcn_mfma_f32_32x32x16_bf16((a), (b), (c), 0, 0, 0)
__device__ __forceinline__ int drow(int r, int lane) { return (r & 3) + 8 * (r >> 2) + 4 * (lane >> 5); }
__device__ __forceinline__ bf16x8 frag_row(const LAS unsigned char* base, int pitch, int row0, int k0, int lane) {
    return *(const LAS bf16x8*)(base + (row0 + (lane & 31)) * pitch + (k0 + 8 * (lane >> 5)) * 2);
}
template <bool PERM> __device__ __forceinline__ bf16x8 frag_tr(const LAS unsigned char* base, int pitch, int k0, int col0, int lane) {
    const int h = lane >> 5, blk = (lane >> 4) & 1, q = (lane & 15) >> 2, p = lane & 3;
    const LAS unsigned char* a0 = base + (k0 + (PERM ? 4 : 8) * h + q) * pitch + (col0 + 16 * blk + 4 * p) * 2;
    const s16x4 lo = __builtin_amdgcn_ds_read_tr16_b64_v4i16((LAS s16x4*)a0);
    const s16x4 hi = __builtin_amdgcn_ds_read_tr16_b64_v4i16((LAS s16x4*)(a0 + (PERM ? 8 : 4) * pitch));
    return (bf16x8){lo[0], lo[1], lo[2], lo[3], hi[0], hi[1], hi[2], hi[3]};
}
__device__ __forceinline__ bf16x8 acc_frag(const f32x16& x, int s) {
    u32x4 w; w.x = cvt_pk_bf16(x[8 * s + 0], x[8 * s + 1]); w.y = cvt_pk_bf16(x[8 * s + 2], x[8 * s + 3]); w.z = cvt_pk_bf16(x[8 * s + 4], x[8 * s + 5]); w.w = cvt_pk_bf16(x[8 * s + 6], x[8 * s + 7]);
    return __builtin_bit_cast(bf16x8, w);
}
__device__ __forceinline__ float softplusf(float v) { return v > 20.f ? v : log1pf(__expf(v)); }
__device__ __forceinline__ unsigned short f2bf1(float v) { return (unsigned short)(cvt_pk_bf16(v, 0.f) & 0xffffu); }
__device__ __forceinline__ float half_sum(float v) {
    v += dpp_f<0xB1>(v); v += dpp_f<0x4E>(v); v += dpp_f<0x141>(v); v += dpp_f<0x140>(v);
    float a = v, b = v;
    asm volatile("s_nop 1\n\tv_permlane16_swap_b32 %0, %1" : "+v"(a), "+v"(b));
    return a + b;
}

constexpr int SX_PITCH = 576, SB_TR_PITCH = 320, SB_ROW_PITCH = 272;
constexpr int SL_X = 0, SL_B = 128 * SX_PITCH  , SL_C = SL_B + 128 * SB_TR_PITCH  ;
constexpr int SL_DT = 151552, SL_ACUM = SL_DT + 2048, SL_SSQ = SL_ACUM + 2048;
static_assert(SL_C + 128 * SB_ROW_PITCH <= SL_DT && SL_SSQ + 1024 <= LDS_PHASE_BYTES, "SSD LDS map");
constexpr int HL_QD = 0, HL_QP = 64 * 272, HL_KP = 2 * 64 * 272, HL_V = 3 * 64 * 272  , HL_KD = HL_V + 64 * 320  , HL_SEG = HL_KD + 64 * 320  , HL_SSQ = HL_SEG + 4096;
static_assert(HL_SSQ + 1024 <= LDS_PHASE_BYTES, "HGRN LDS map");

__device__ __forceinline__ void ssd_dt_acum(const Frame& F, const Args& a, int c, int g) {
    if (F.wave < 4) {
        const int hh = g * 4 + F.wave, lane = F_LANE; const float* dtraw = (const float*)(F.ws + WS_DTRAW);
        const float bias = KARG_IN(4)[hh], aa = -__expf(KARG_IN(5)[hh]);
        const int t = c * 128 + 2 * lane;
        const float d0 = softplusf(dtraw[(size_t)t * 8 + hh] + bias), d1 = softplusf(dtraw[(size_t)(t + 1) * 8 + hh] + bias);
        const float a0 = d0 * aa, a1 = d1 * aa;
        float incl = a0 + a1;
#pragma unroll
        for (int o = 1; o < 64; o <<= 1) { const float v = __shfl_up(incl, o); if (lane >= o) incl += v; }
        LAS float* dts = (LAS float*)(F.lds + SL_DT) + F.wave * 128; LAS float* acs = (LAS float*)(F.lds + SL_ACUM) + F.wave * 128;
        dts[2 * lane] = d0; dts[2 * lane + 1] = d1; acs[2 * lane] = incl - a1; acs[2 * lane + 1] = incl;
    }
}
__device__ __forceinline__ void ssd_conv_item(const Frame& F, const Args& a, int c, int src_ch, int seg, int hl, int mode, LAS unsigned char* dst, int pitch, int dst_col) {
    const bf16_t* p = (const bf16_t*)(F.ws + WS_P) + PC_XBC + src_ch;
    const float* cw = KARG_IN(2) + src_ch; const float* cb = KARG_IN(3) + src_ch;
    float w[4][8], bias[8];
#pragma unroll
    for (int j = 0; j < 4; ++j) { const f32x4 x0 = *(const f32x4*)(cw + j * 1024), x1 = *(const f32x4*)(cw + j * 1024 + 4);
        w[j][0] = x0[0]; w[j][1] = x0[1]; w[j][2] = x0[2]; w[j][3] = x0[3]; w[j][4] = x1[0]; w[j][5] = x1[1]; w[j][6] = x1[2]; w[j][7] = x1[3]; }
    { const f32x4 x0 = *(const f32x4*)cb, x1 = *(const f32x4*)(cb + 4); bias[0] = x0[0]; bias[1] = x0[1]; bias[2] = x0[2]; bias[3] = x0[3]; bias[4] = x1[0]; bias[5] = x1[1]; bias[6] = x1[2]; bias[7] = x1[3]; }
    const int l0 = seg * 16, t0 = c * 128 + l0;
    u32x4 rw[19];
#pragma unroll
    for (int j = 0; j < 19; ++j) { const int tt = t0 - 3 + j; rw[j] = tt >= 0 ? *(const u32x4*)(p + (size_t)tt * PW) : (u32x4){0u, 0u, 0u, 0u}; }
    const LAS float* dts = (const LAS float*)(F.lds + SL_DT) + hl * 128; const LAS float* acs = (const LAS float*)(F.lds + SL_ACUM) + hl * 128;
    const float alast = acs[127];
#pragma unroll
    for (int i = 0; i < 16; ++i) {
        float v[8];
#pragma unroll
        for (int k = 0; k < 4; ++k) {
            const unsigned r0 = rw[i][k], r1 = rw[i + 1][k], r2 = rw[i + 2][k], r3 = rw[i + 3][k];
            v[2 * k] = siluf(fmaf(w[3][2 * k], bflo(r3), fmaf(w[2][2 * k], bflo(r2), fmaf(w[1][2 * k], bflo(r1), fmaf(w[0][2 * k], bflo(r0), bias[2 * k])))));
            v[2 * k + 1] = siluf(fmaf(w[3][2 * k + 1], bfhi(r3), fmaf(w[2][2 * k + 1], bfhi(r2), fmaf(w[1][2 * k + 1], bfhi(r1), fmaf(w[0][2 * k + 1], bfhi(r0), bias[2 * k + 1])))));
        }
        float sc = 1.f;
        if (mode >= 1) sc = dts[l0 + i];
        if (mode == 2) sc *= __expf(alast - acs[l0 + i]);
        u32x4 o; o.x = cvt_pk_bf16(v[0] * sc, v[1] * sc); o.y = cvt_pk_bf16(v[2] * sc, v[3] * sc); o.z = cvt_pk_bf16(v[4] * sc, v[5] * sc); o.w = cvt_pk_bf16(v[6] * sc, v[7] * sc);
        *(LAS u32x4*)(dst + (l0 + i) * pitch + dst_col * 2) = o;
    }
}

__device__ __forceinline__ void ssd_states_unit(const Frame& F, const Args& a, int c, int g) {
    const int tid = F_TID, lane = F_LANE;
    __syncthreads();
    ssd_dt_acum(F, a, c, g);
    __syncthreads();
    { const int cg = tid & 63, seg = tid >> 6; const bool isx = cg < 32;
      if (cg < 48) ssd_conv_item(F, a, c, isx ? g * 256 + cg * 8 : 512 + g * 128 + (cg - 32) * 8, seg, isx ? (cg >> 3) : 0, isx ? 2 : 0,
                                 F.lds + (isx ? SL_X : SL_B), isx ? SX_PITCH : SB_TR_PITCH, isx ? cg * 8 : (cg - 32) * 8); }
    __syncthreads();
    const int hl = F.wave >> 1, pt = F.wave & 1, hh = g * 4 + hl;
    f32x16 S[4];
#pragma unroll
    for (int nt = 0; nt < 4; ++nt)
#pragma unroll
        for (int r = 0; r < 16; ++r) S[nt][r] = 0.f;
#pragma unroll 2
    for (int ks = 0; ks < 8; ++ks) {
        const bf16x8 A = frag_tr<false>(F.lds + SL_X, SX_PITCH, 16 * ks, hl * 64 + 32 * pt, lane);
#pragma unroll
        for (int nt = 0; nt < 4; ++nt) { const bf16x8 B = frag_tr<false>(F.lds + SL_B, SB_TR_PITCH, 16 * ks, 32 * nt, lane); S[nt] = MFMA32(A, B, S[nt]); }
    }
    float* st = (float*)(F.ws + WS_SSTATE) + ((size_t)(c * 8 + hh) * 64 + 32 * pt) * 128;
#pragma unroll
    for (int nt = 0; nt < 4; ++nt)
#pragma unroll
        for (int r = 0; r < 16; ++r) st[(size_t)drow(r, lane) * 128 + 32 * nt + (lane & 31)] = S[nt][r];
    if (tid < 4) ((float*)(F.ws + WS_CDECAY))[c * 8 + g * 4 + tid] = __expf(((const LAS float*)(F.lds + SL_ACUM))[tid * 128 + 127]);
}

__device__ __forceinline__ void ssd_out_unit(const Frame& F, const Args& a, int c, int g, const int xm = 0) {
    const int lane = F_LANE;
    __syncthreads();
    ssd_dt_acum(F, a, c, g);
    __syncthreads();
    if (!(xm & 4)) { const int tid = F_TID, cg = tid & 63, seg = tid >> 6; const bool isx = cg < 32, isb = cg < 48;
      ssd_conv_item(F, a, c, isx ? g * 256 + cg * 8 : (isb ? 512 + g * 128 + (cg - 32) * 8 : 768 + g * 128 + (cg - 48) * 8), seg, isx ? (cg >> 3) : 0, isx ? 1 : 0,
                    F.lds + (isx ? SL_X : (isb ? SL_B : SL_C)), isx ? SX_PITCH : SB_ROW_PITCH, isx ? cg * 8 : (isb ? (cg - 32) * 8 : (cg - 48) * 8)); }
    const int lt = F.wave >> 1, hp = F.wave & 1;
    const int lcol = 32 * lt + (lane & 31);
    bf16x8 Bsv[2][2][8];
#pragma unroll
    for (int hi = 0; hi < 2; ++hi) {
        const bf16_t* sp = (const bf16_t*)(F.ws + WS_SPREV) + (size_t)(c * 8 + g * 4 + hp * 2 + hi) * 64 * 128 + (size_t)(lane & 31) * 128 + 8 * (lane >> 5);
#pragma unroll
        for (int pt = 0; pt < 2; ++pt)
#pragma unroll
            for (int ks = 0; ks < 8; ++ks) Bsv[hi][pt][ks] = *(const bf16x8*)(sp + (size_t)(32 * pt) * 128 + 16 * ks);
    }
    __syncthreads();
    f32x16 acc[2][2];
#pragma unroll
    for (int hi = 0; hi < 2; ++hi)
#pragma unroll
        for (int pt = 0; pt < 2; ++pt)
#pragma unroll
            for (int r = 0; r < 16; ++r) acc[hi][pt][r] = 0.f;
    if (!(xm & 8))
#pragma unroll
    for (int hi = 0; hi < 2; ++hi) {
        const int hl = hp * 2 + hi;
#pragma unroll
        for (int ks = 0; ks < 8; ++ks) {
            const bf16x8 A = frag_row(F.lds + SL_C, SB_ROW_PITCH, 32 * lt, 16 * ks, lane);
#pragma unroll
            for (int pt = 0; pt < 2; ++pt) acc[hi][pt] = MFMA32(A, Bsv[hi][pt][ks], acc[hi][pt]);
        }
        const LAS float* acs = (const LAS float*)(F.lds + SL_ACUM) + hl * 128;
#pragma unroll
        for (int r = 0; r < 16; ++r) { const float e = __expf(acs[32 * lt + drow(r, lane)]); acc[hi][0][r] *= e; acc[hi][1][r] *= e; }
    }
    unsigned short zv[2][2][16];
    { const bf16_t* pz = (const bf16_t*)(F.ws + WS_P) + (size_t)(c * 128 + 32 * lt) * PW + PC_Z + g * 256 + hp * 128 + (lane & 31);
#pragma unroll
      for (int hi = 0; hi < 2; ++hi)
#pragma unroll
        for (int pt = 0; pt < 2; ++pt)
#pragma unroll
            for (int r = 0; r < 16; ++r) zv[hi][pt][r] = pz[(size_t)drow(r, lane) * PW + hi * 64 + 32 * pt]; }
    float dskip[2]; { const float* dsp = KARG_IN(6); dskip[0] = dsp[g * 4 + hp * 2]; dskip[1] = dsp[g * 4 + hp * 2 + 1]; }
#pragma unroll 1
    for (int st = (xm & 16) ? lt + 1 : 0; st <= lt; ++st) {
        f32x16 GT;
#pragma unroll
        for (int r = 0; r < 16; ++r) GT[r] = 0.f;
#pragma unroll 2
        for (int ks = 0; ks < 8; ++ks) {
            const bf16x8 A = frag_row(F.lds + SL_B, SB_ROW_PITCH, 32 * st, 16 * ks, lane), B = frag_row(F.lds + SL_C, SB_ROW_PITCH, 32 * lt, 16 * ks, lane);
            GT = MFMA32(A, B, GT);
        }
#pragma unroll
        for (int hi = 0; hi < 2; ++hi) {
            const int hl = hp * 2 + hi, hh = g * 4 + hl;
            const LAS float* dts = (const LAS float*)(F.lds + SL_DT) + hl * 128; const LAS float* acs = (const LAS float*)(F.lds + SL_ACUM) + hl * 128;
            const float al = acs[lcol], dsk = dskip[hi] * __builtin_amdgcn_rcpf(dts[lcol]);
            f32x16 M; float av[16];
#pragma unroll
            for (int r = 0; r < 16; ++r) av[r] = acs[32 * st + drow(r, lane)];
#pragma unroll
            for (int r = 0; r < 16; ++r) { const int srow = 32 * st + drow(r, lane);
                const float e = __expf(fminf(al - av[r], 0.f));
                M[r] = GT[r] * e * (srow <= lcol ? 1.f : 0.f) + (srow == lcol ? dsk : 0.f); }
#pragma unroll
            for (int s2 = 0; s2 < 2; ++s2) { const bf16x8 A = acc_frag(M, s2);
#pragma unroll
                for (int pt = 0; pt < 2; ++pt) { const bf16x8 B = frag_tr<true>(F.lds + SL_X, SX_PITCH, 32 * st + 16 * s2, hl * 64 + 32 * pt, lane); acc[hi][pt] = MFMA32(A, B, acc[hi][pt]); } }
        }
    }
    float ssq[16];
#pragma unroll
    for (int r = 0; r < 16; ++r) ssq[r] = 0.f;
    if (!(xm & 32)) {
#pragma unroll
        for (int hi = 0; hi < 2; ++hi)
#pragma unroll
            for (int pt = 0; pt < 2; ++pt)
#pragma unroll
                for (int r = 0; r < 16; ++r) { const float z = bf2f(zv[hi][pt][r]);
                    const float y = acc[hi][pt][r] * siluf(z); acc[hi][pt][r] = y; ssq[r] += y * y; }
    }
    LAS float* ssqs = (LAS float*)(F.lds + SL_SSQ);
#pragma unroll
    for (int r = 0; r < 16; ++r) ssq[r] = half_sum(ssq[r]);
    if ((lane & 31) == 0) {
#pragma unroll
        for (int r = 0; r < 16; ++r) ssqs[F.wave * 32 + drow(r, lane)] = ssq[r]; }
    __syncthreads();
    const float* nw = KARG_IN(7) + g * 256 + hp * 128 + (lane & 31);
#pragma unroll
    for (int r = 0; r < 16; ++r) { const int row = drow(r, lane);
        const float rs = rsqrtf((ssqs[F.wave * 32 + row] + ssqs[(F.wave ^ 1) * 32 + row]) * (1.0f / 256.0f) + RMS_EPS_F);
#pragma unroll
        for (int hi = 0; hi < 2; ++hi)
#pragma unroll
            for (int pt = 0; pt < 2; ++pt) *(LAS unsigned short*)(F.lds + SL_X + (32 * lt + row) * 528 + (hp * 128 + hi * 64 + 32 * pt + (lane & 31)) * 2) = f2bf1(acc[hi][pt][r] * rs * nw[hi * 64 + 32 * pt]); }
    __syncthreads();
    { const int tid = F_TID; bf16_t* mo = (bf16_t*)(F.ws + WS_MIX) + (size_t)(c * 128) * DM + g * 256;
#pragma unroll
      for (int i = 0; i < 8; ++i) { const int pc = tid + 512 * i, row = pc >> 5, ch = (pc & 31) * 8;
          *(u32x4*)(mo + (size_t)row * DM + ch) = *(const LAS u32x4*)(F.lds + SL_X + row * 528 + ch * 2); } }
}

struct HgrnLocal { float fg[8][2], cum[8][2], qv[8][2], iv[8][2], tot[2], mid[2]; };
struct HgrnRaw { unsigned fw[8], iw[8], qw[8]; };
template <bool NEEDQ> __device__ __forceinline__ void hgrn_fetch(const Frame& F, int c, int h, HgrnRaw& R) {
    const int tid = F_TID, cp = tid & 63, seg = tid >> 6, d0 = 2 * cp;
    const bf16_t* p = (const bf16_t*)(F.ws + WS_P) + (size_t)(c * 64 + seg * 8) * PW + h * 128 + d0;
#pragma unroll
    for (int i = 0; i < 8; ++i) { R.fw[i] = *(const unsigned*)(p + (size_t)i * PW + PC_F); R.iw[i] = *(const unsigned*)(p + (size_t)i * PW + PC_I);
        if (NEEDQ) R.qw[i] = *(const unsigned*)(p + (size_t)i * PW + PC_Q); }
}
__device__ __forceinline__ void hgrn_lb(const Frame& F, int h, float (&lb)[2]) {
    const int d0 = 2 * (F_TID & 63); const float* lg = KARG_IN(8);
#pragma unroll
    for (int j = 0; j < 2; ++j) { const float l0 = lg[h * 128 + d0 + j], l1 = lg[512 + h * 128 + d0 + j]; const float mx = fmaxf(l0, l1), e0 = __expf(l0 - mx), e1 = __expf(l1 - mx); lb[j] = e0 / (e0 + e1); }
}
template <bool NEEDQ> __device__ __forceinline__ void hgrn_load(const Frame& F, const Args& a, int h, const HgrnRaw& R, HgrnLocal& L, const float (&lb)[2]) {
    const int tid = F_TID, cp = tid & 63, seg = tid >> 6, d0 = 2 * cp;
    float run[2] = {0.f, 0.f};
#pragma unroll
    for (int i = 0; i < 8; ++i) {
        const unsigned fw = R.fw[i], iw = R.iw[i];
        const float fr[2] = {bflo(fw), bfhi(fw)};
        L.iv[i][0] = bflo(iw); L.iv[i][1] = bfhi(iw);
        if (NEEDQ) { const unsigned qw = R.qw[i]; L.qv[i][0] = siluf(bflo(qw)); L.qv[i][1] = siluf(bfhi(qw)); }
#pragma unroll
        for (int j = 0; j < 2; ++j) { const float fg = lb[j] + (1.0f - lb[j]) * sigmf(fr[j]); L.fg[i][j] = fg; run[j] += __logf(fg); L.cum[i][j] = run[j]; }
    }
    LAS float* segs = (LAS float*)(F.lds + HL_SEG);
    segs[seg * 128 + d0] = run[0]; segs[seg * 128 + d0 + 1] = run[1];
    __syncthreads();
    float pre[2] = {0.f, 0.f}, tot[2] = {0.f, 0.f}, mid[2] = {0.f, 0.f};
#pragma unroll
    for (int s2 = 0; s2 < 8; ++s2) {
#pragma unroll
        for (int j = 0; j < 2; ++j) { const float v = segs[s2 * 128 + d0 + j]; tot[j] += v; if (s2 < seg) pre[j] += v; if (s2 < 4) mid[j] += v; }
    }
#pragma unroll
    for (int i = 0; i < 8; ++i)
#pragma unroll
        for (int j = 0; j < 2; ++j) L.cum[i][j] += pre[j];
    L.tot[0] = tot[0]; L.tot[1] = tot[1]; L.mid[0] = mid[0]; L.mid[1] = mid[1];
}

__device__ __forceinline__ void hgrn_states_unit(const Frame& F, const Args& a, int c, int h, const HgrnRaw& R, const float (&lb)[2]) {
    const int tid = F_TID, lane = F_LANE, cp = tid & 63, seg = tid >> 6, d0 = 2 * cp;
    __syncthreads();
    HgrnLocal L; hgrn_load<false>(F, a, h, R, L, lb);
#pragma unroll
    for (int i = 0; i < 8; ++i) { const int t = seg * 8 + i;
        *(LAS unsigned*)(F.lds + HL_KD + t * 320 + d0 * 2) = cvt_pk_bf16((1.0f - L.fg[i][0]) * __expf(L.tot[0] - L.cum[i][0]), (1.0f - L.fg[i][1]) * __expf(L.tot[1] - L.cum[i][1]));
        *(LAS unsigned*)(F.lds + HL_V + t * 320 + d0 * 2) = cvt_pk_bf16(L.iv[i][0], L.iv[i][1]); }
    if (seg == 0) { float* hd = (float*)(F.ws + WS_HDECAY) + (size_t)(c * 4 + h) * 128 + d0; hd[0] = __expf(L.tot[0]); hd[1] = __expf(L.tot[1]); }
    __syncthreads();
    const int et = F.wave >> 1, dh = F.wave & 1;
    f32x16 acc[2];
#pragma unroll
    for (int dj = 0; dj < 2; ++dj)
#pragma unroll
        for (int r = 0; r < 16; ++r) acc[dj][r] = 0.f;
#pragma unroll
    for (int ks = 0; ks < 4; ++ks) {
        const bf16x8 A = frag_tr<false>(F.lds + HL_V, 320, 16 * ks, 32 * et, lane);
#pragma unroll
        for (int dj = 0; dj < 2; ++dj) { const bf16x8 B = frag_tr<false>(F.lds + HL_KD, 320, 16 * ks, 32 * (2 * dh + dj), lane); acc[dj] = MFMA32(A, B, acc[dj]); }
    }
    float* kv = (float*)(F.ws + WS_HKV) + ((size_t)(c * 4 + h) * 128 + 32 * et) * 128;
#pragma unroll
    for (int dj = 0; dj < 2; ++dj)
#pragma unroll
        for (int r = 0; r < 16; ++r) kv[(size_t)drow(r, lane) * 128 + 32 * (2 * dh + dj) + (lane & 31)] = acc[dj][r];
}

__device__ __forceinline__ void hgrn_out_unit(const Frame& F, const Args& a, int c, int h, const HgrnRaw& R, const float (&lb)[2]) {
    const int tid = F_TID, lane = F_LANE, cp = tid & 63, seg = tid >> 6, d0 = 2 * cp;
    const int tt = F.wave >> 2, et = F.wave & 3;
    bf16x8 Bs[8];
    { const bf16_t* sp = (const bf16_t*)(F.ws + WS_HSPREV) + ((size_t)(c * 4 + h) * 128 + 32 * et) * 128 + (size_t)(lane & 31) * 128 + 8 * (lane >> 5);
#pragma unroll
      for (int ks = 0; ks < 8; ++ks) Bs[ks] = *(const bf16x8*)(sp + 16 * ks); }
    const int e = 32 * et + (lane & 31);
    unsigned short gv[16];
    { const bf16_t* pg = (const bf16_t*)(F.ws + WS_P) + (size_t)(c * 64 + 32 * tt) * PW + PC_G + h * 128 + e;
#pragma unroll
      for (int r = 0; r < 16; ++r) gv[r] = pg[(size_t)drow(r, lane) * PW]; }
    const float nw = KARG_IN(9)[h * 128 + e];
    __syncthreads();
    HgrnLocal L; hgrn_load<true>(F, a, h, R, L, lb);
#pragma unroll
    for (int i = 0; i < 8; ++i) { const int t = seg * 8 + i;
        float qd[2], qp[2], kp[2];
#pragma unroll
        for (int j = 0; j < 2; ++j) { qd[j] = L.qv[i][j] * __expf(L.cum[i][j]); qp[j] = L.qv[i][j] * __expf(L.cum[i][j] - L.mid[j]); kp[j] = (1.0f - L.fg[i][j]) * __expf(L.mid[j] - L.cum[i][j]); }
        *(LAS unsigned*)(F.lds + HL_QD + t * 272 + d0 * 2) = cvt_pk_bf16(qd[0], qd[1]);
        *(LAS unsigned*)(F.lds + HL_QP + t * 272 + d0 * 2) = cvt_pk_bf16(qp[0], qp[1]);
        *(LAS unsigned*)(F.lds + HL_KP + t * 272 + d0 * 2) = cvt_pk_bf16(kp[0], kp[1]);
        *(LAS unsigned*)(F.lds + HL_V + t * 320 + d0 * 2) = cvt_pk_bf16(L.iv[i][0], L.iv[i][1]); }
    __syncthreads();
    f32x16 acc;
#pragma unroll
    for (int r = 0; r < 16; ++r) acc[r] = 0.f;
#pragma unroll
    for (int ks = 0; ks < 8; ++ks) { const bf16x8 A = frag_row(F.lds + HL_QD, 272, 32 * tt, 16 * ks, lane); acc = MFMA32(A, Bs[ks], acc); }
    const int tcol = 32 * tt + (lane & 31);
#pragma unroll
    for (int st = 0; st < 2; ++st) {
        if (st <= tt) {
            f32x16 X;
#pragma unroll
            for (int r = 0; r < 16; ++r) X[r] = 0.f;
#pragma unroll 2
            for (int ks = 0; ks < 8; ++ks) { const bf16x8 A = frag_row(F.lds + HL_KP, 272, 32 * st, 16 * ks, lane), B = frag_row(F.lds + HL_QP, 272, 32 * tt, 16 * ks, lane); X = MFMA32(A, B, X); }
#pragma unroll
            for (int r = 0; r < 16; ++r) X[r] = (32 * st + drow(r, lane) <= tcol) ? X[r] : 0.f;
#pragma unroll
            for (int s2 = 0; s2 < 2; ++s2) { const bf16x8 A = acc_frag(X, s2), B = frag_tr<true>(F.lds + HL_V, 320, 32 * st + 16 * s2, 32 * et, lane); acc = MFMA32(A, B, acc); }
        }
    }
    LAS float* ssqs = (LAS float*)(F.lds + HL_SSQ);
    { float sm[16];
#pragma unroll
      for (int r = 0; r < 16; ++r) sm[r] = half_sum(acc[r] * acc[r]);
      if ((lane & 31) == 0) {
#pragma unroll
          for (int r = 0; r < 16; ++r) ssqs[F.wave * 32 + drow(r, lane)] = sm[r]; } }
    __syncthreads();
#pragma unroll
    for (int r = 0; r < 16; ++r) { const int row = drow(r, lane);
        const float ss = ssqs[(tt * 4 + 0) * 32 + row] + ssqs[(tt * 4 + 1) * 32 + row] + ssqs[(tt * 4 + 2) * 32 + row] + ssqs[(tt * 4 + 3) * 32 + row];
        const float rs = rsqrtf(ss * (1.0f / 128.0f) + RMS_EPS_F);
        *(LAS unsigned short*)(F.lds + HL_QD + (32 * tt + row) * 272 + e * 2) = f2bf1(acc[r] * rs * nw * siluf(bf2f(gv[r]))); }
    __syncthreads();
    { bf16_t* mo = (bf16_t*)(F.ws + WS_MIX) + (size_t)(c * 64) * DM + 512 + h * 128;
#pragma unroll
      for (int i = 0; i < 2; ++i) { const int pc = tid + 512 * i, row = pc >> 4, ch = (pc & 15) * 8;
          *(u32x4*)(mo + (size_t)row * DM + ch) = *(const LAS u32x4*)(F.lds + HL_QD + row * 272 + ch * 2); } }
}

__device__ __forceinline__ void phase_mix_states(const Frame& F, const Args& a, const int mode) {
    HgrnRaw Ra, Rb; int u = blockIdx.x; float lb[2]; int hcur = -1;
    if (!(mode & 2) && u < 1024) hgrn_fetch<false>(F, u >> 2, u & 3, Ra);
    if (!(mode & 1)) for (int us = blockIdx.x; us < 256; us += F.G) ssd_states_unit(F, a, us >> 1, us & 1);
    if (!(mode & 2)) {
        while (u < 1024) {
            int un = u + F.G; if (un < 1024) hgrn_fetch<false>(F, un >> 2, un & 3, Rb);
            if ((u & 3) != hcur) { hcur = u & 3; hgrn_lb(F, hcur, lb); }
            hgrn_states_unit(F, a, u >> 2, u & 3, Ra, lb); u = un; if (u >= 1024) break;
            un = u + F.G; if (un < 1024) hgrn_fetch<false>(F, un >> 2, un & 3, Ra);
            if ((u & 3) != hcur) { hcur = u & 3; hgrn_lb(F, hcur, lb); }
            hgrn_states_unit(F, a, u >> 2, u & 3, Rb, lb); u = un;
        }
    }
}
__device__ __forceinline__ void phase_mix_out(const Frame& F, const Args& a, const int mode) {
    HgrnRaw Ra, Rb; int u = blockIdx.x; float lb[2]; int hcur = -1;
    if (!(mode & 2) && u < 1024) hgrn_fetch<true>(F, u >> 2, u & 3, Ra);
    if (!(mode & 1)) for (int rep = 0; rep < ((mode & 64) ? 2 : 1); ++rep) for (int us = blockIdx.x; us < 256; us += F.G) ssd_out_unit(F, a, us >> 1, us & 1, mode);
    if (!(mode & 2)) {
        while (u < 1024) {
            int un = u + F.G; if (un < 1024) hgrn_fetch<true>(F, un >> 2, un & 3, Rb);
            if ((u & 3) != hcur) { hcur = u & 3; hgrn_lb(F, hcur, lb); }
            hgrn_out_unit(F, a, u >> 2, u & 3, Ra, lb); u = un; if (u >= 1024) break;
            un = u + F.G; if (un < 1024) hgrn_fetch<true>(F, un >> 2, un & 3, Ra);
            if ((u & 3) != hcur) { hcur = u & 3; hgrn_lb(F, hcur, lb); }
            hgrn_out_unit(F, a, u >> 2, u & 3, Rb, lb); u = un;
        }
    }
}
__device__ __forceinline__ void phase_mix_scan(const Frame& F, const Args& a) {
    const int gt = blockIdx.x * 512 + F_TID;
    if (blockIdx.x < 128 || F.G < 256) {
        for (int idx = gt; idx < 65536; idx += (F.G < 256 ? F.G : 128) * 512) {
            const int hh = idx >> 13; const float* st = (const float*)(F.ws + WS_SSTATE) + idx; const float* cd = (const float*)(F.ws + WS_CDECAY) + hh;
            bf16_t* sp = (bf16_t*)(F.ws + WS_SPREV) + idx; float S = 0.f;
            for (int c0 = 0; c0 < 128; c0 += 16) { float v[16], d[16];
#pragma unroll
                for (int i = 0; i < 16; ++i) { v[i] = st[(size_t)(c0 + i) * 65536]; d[i] = cd[(c0 + i) * 8]; }
#pragma unroll
                for (int i = 0; i < 16; ++i) { sp[(size_t)(c0 + i) * 65536] = f2bf1(S); S = fmaf(S, d[i], v[i]); } }
        }
    }
    if (blockIdx.x >= 128 || F.G < 256) {
        const int gt2 = F.G < 256 ? gt : gt - 128 * 512;
        for (int idx = gt2; idx < 65536; idx += (F.G < 256 ? F.G : 128) * 512) {
            const int h = idx >> 14, d = idx & 127; const float* kv = (const float*)(F.ws + WS_HKV) + idx; const float* hd = (const float*)(F.ws + WS_HDECAY) + h * 128 + d;
            bf16_t* sp = (bf16_t*)(F.ws + WS_HSPREV) + idx; float S = 0.f;
            for (int c0 = 0; c0 < 256; c0 += 16) { float v[16], dd[16];
#pragma unroll
                for (int i = 0; i < 16; ++i) { v[i] = kv[(size_t)(c0 + i) * 65536]; dd[i] = hd[(size_t)(c0 + i) * 512]; }
#pragma unroll
                for (int i = 0; i < 16; ++i) { sp[(size_t)(c0 + i) * 65536] = f2bf1(S); S = fmaf(S, dd[i], v[i]); } }
        }
    }
}

__global__ void __launch_bounds__(512, 2) mk_fwd(Args args) {
    extern __shared__ __attribute__((aligned(16))) unsigned char lds_raw[];
    Frame F;
    F.lds = (LAS unsigned char*)lds_raw;
    F.wave = __builtin_amdgcn_readfirstlane(threadIdx.x >> 6);
    F.G = gridDim.x; { const int bx = blockIdx.x; F.vcu = (F.G % 8 == 0) ? (bx % 8) * (F.G / 8) + bx / 8 : bx; }
    F.ws = args.ws; F.ctl = (unsigned*)(args.ws + WS_CTL);
    volatile LAS unsigned* MISC = (volatile LAS unsigned*)(F.lds + LDS_MISC);
    if (F_TID < 64) MISC[F_TID] = 0u;
    __syncthreads();
    const bool use_bar = (args.ph_hi - args.ph_lo) > 1;
    XcdBarrier bar; bar.bar = F.ctl + CW_BAR + args.li * XCD_BAR_WORDS; bar.x = 0; bar.st = MISC + 8; bar.wave = F.wave;
    if (use_bar) bar = xcd_barrier_post(F.ctl + CW_BAR + args.li * XCD_BAR_WORDS, MISC + 8, F.wave);
#define PH(k) (args.ph_lo <= (k) && (k) < args.ph_hi)
#define SEAM(k) do { if (use_bar && (k) + 1 < args.ph_hi && (k) >= args.ph_lo) xcd_barrier(bar); } while (0)
    unsigned char* ws = F.ws;
    if (PH(0)) phase_prep(F, args);
    SEAM(0);
    if (PH(1)) {
        pg8::DenseSched S; S.init(ws + WS_XB, ws + WS_WIN_T, T_TOK, 3072, 1024, F.G, blockIdx.x);
        pg8::EpiP E; E.O = (bf16_t*)(ws + WS_P); E.ldc = PW;
        pg8::gemm_phase<pg8::EpiP, pg8::DenseSched, true>(F.lds, 1024, S, E, F.wave);
    }
    SEAM(1);
#if defined(MK_NAIVE_MIX)
    if (PH(2)) phase_m1(F, args);
    SEAM(2);
    if (PH(3)) phase_m2(F, args);
    SEAM(3);
    if (PH(4)) phase_m3(F, args);
#else
    if (PH(2)) phase_mix_states(F, args, args.mode);
    SEAM(2);
    if (PH(3)) {
        phase_mix_scan(F, args);
        if (blockIdx.x < 128 && F.G >= 256) {
            __syncthreads();
            pg8::DenseSched S; S.init(ws + WS_XB, ws + WS_WIN_T + (size_t)3072 * 1024 * 2, T_TOK, 512, 1024, 128, blockIdx.x);
            pg8::EpiP E; E.O = (bf16_t*)(ws + WS_P) + 3072; E.ldc = PW;
            pg8::gemm_phase<pg8::EpiP, pg8::DenseSched, true>(F.lds, 1024, S, E, F.wave);
        } else if (F.G < 256) {
            __syncthreads();
            pg8::DenseSched S; S.init(ws + WS_XB, ws + WS_WIN_T + (size_t)3072 * 1024 * 2, T_TOK, 512, 1024, F.G, blockIdx.x);
            pg8::EpiP E; E.O = (bf16_t*)(ws + WS_P) + 3072; E.ldc = PW;
            pg8::gemm_phase<pg8::EpiP, pg8::DenseSched, true>(F.lds, 1024, S, E, F.wave);
        }
    }
    SEAM(3);
    if (PH(4)) phase_mix_out(F, args, args.mode);
#endif
    SEAM(4);
    if (PH(5)) {
        pg8::DenseSched S; S.init(ws + WS_MIX, ws + WS_WOUT_T, T_TOK, 1024, 1024, F.G, blockIdx.x);
        pg8::EpiU E; E.U = (float*)(ws + WS_H1); E.X = KARG_IN(0);
        pg8::gemm_phase<pg8::EpiU, pg8::DenseSched, false>(F.lds, 1024, S, E, F.wave);
    }
    SEAM(5);
    if (PH(6)) phase_ln1(F, args);
    SEAM(6);
    if (PH(7)) {
        pg8::DenseSched S; S.init(ws + WS_H1B, ws + WS_W3_T, T_TOK, 768, 1024, F.G, blockIdx.x);
        pg8::Epi3 E; E.LG = (float*)(ws + WS_LOGITS); E.HS = (bf16_t*)(ws + WS_HS);
        pg8::gemm_phase<pg8::Epi3, pg8::DenseSched, false>(F.lds, 1024, S, E, F.wave);
    }
    SEAM(7);
    if (PH(8)) {
        if (!(args.mode & 32)) phase_route(F, args);
        if (!(args.mode & 64)) {
        pg8::DenseSched S; S.init(ws + WS_HS, ws + WS_WDS_T, T_TOK, 1024, 256, F.G, blockIdx.x);
        pg8::EpiP E; E.O = (bf16_t*)(ws + WS_YS); E.ldc = 1024;
        pg8::gemm_phase<pg8::EpiP, pg8::DenseSched, false>(F.lds, 256, S, E, F.wave); }
    }
    SEAM(8);
#if defined(MK_OLD_EXPERTS)
    if (PH(9)) {
        build_tables(F);
        pg8::ExpertSched<true> S; S.lds = F.lds;
        S.lists = (const int*)(ws + WS_LISTS); S.A = (const char*)(ws + WS_H1B); S.W = (const char*)(ws + WS_WGU_T);
        S.U = 2 * __builtin_amdgcn_readfirstlane(((const LAS int*)(F.lds + LDS_PREF))[NEXP]); S.G = F.G; S.c = blockIdx.x;
        pg8::EpiH E; E.H = (bf16_t*)(ws + WS_H);
        pg8::gemm_phase<pg8::EpiH, pg8::ExpertSched<true>, true>(F.lds, 1024, S, E, F.wave);
    }
    SEAM(9);
    if (PH(10)) {
        build_tables(F);
        pg8::ExpertSched<false> S; S.lds = F.lds;
        S.lists = (const int*)(ws + WS_LISTS); S.A = (const char*)(ws + WS_H); S.W = (const char*)(ws + WS_WD_T);
        S.U = 4 * __builtin_amdgcn_readfirstlane(((const LAS int*)(F.lds + LDS_PREF))[NEXP]); S.G = F.G; S.c = blockIdx.x;
        pg8::EpiYb E; E.YB = (bf16_t*)(ws + WS_YB); E.lists = (const int*)(ws + WS_LISTS); E.tok_gate = (const float*)(ws + WS_TOKGATE);
        pg8::gemm_phase<pg8::EpiYb, pg8::ExpertSched<false>, true>(F.lds, 256, S, E, F.wave);
    }
    SEAM(10);
#else
    if (PH(9)) phase_experts(F, args, args.mode);
    SEAM(9);
#endif
    if (PH(11)) { build_tables(F); phase_final(F, args); }
}

extern "C" void kernel_launch(void* const* d_in, const int* in_sizes, int n_in, void* d_out, int out_size, void* d_ws, size_t ws_size, hipStream_t stream) {
    static int grid = 0;
    if (grid == 0) {
        int dev = 0, cus = 0;
        if (hipGetDevice(&dev) != hipSuccess || hipDeviceGetAttribute(&cus, hipDeviceAttributeMultiprocessorCount, dev) != hipSuccess) { fprintf(stderr, "device query failed\n"); grid = -1; return; }
        if (hipFuncSetAttribute((const void*)mk_fwd, hipFuncAttributeMaxDynamicSharedMemorySize, LDS_BYTES) != hipSuccess) { fprintf(stderr, "hipFuncSetAttribute failed\n"); grid = -1; return; }
        if (ws_size < WS_END) { fprintf(stderr, "workspace too small: %zu < %zu\n", ws_size, (size_t)WS_END); grid = -1; return; }
        (void)hipGetLastError();
        grid = cus;
    }
    if (grid < 0) return;
    unsigned char* ws = (unsigned char*)d_ws;
    (void)hipMemsetAsync(ws + WS_CTL, 0, CTL_ZERO_BYTES, stream);
    Args a{};
    for (int i = 0; i < 23; ++i) a.in[i] = (const float*)d_in[i];
    a.out = (float*)d_out; a.ws = ws;
    auto launch = [&](int lo, int hi) { a.ph_lo = lo; a.ph_hi = hi; hipLaunchKernelGGL(mk_fwd, dim3(grid), dim3(512), LDS_BYTES, stream, a); };
#if defined(MK_PER_PHASE)
    for (int ph = 0; ph < NPH; ++ph) launch(ph, ph + 1);
#else
    launch(0, NPH);
#endif
}
```

```cpp
#include <hip/hip_runtime.h>
#include <stdint.h>
#include <cstdio>

#define GAS __attribute__((address_space(1)))
#define LAS __attribute__((address_space(3)))
typedef unsigned short bf16_t;
typedef short bf16x8 __attribute__((ext_vector_type(8)));
typedef float f32x4 __attribute__((ext_vector_type(4)));
typedef unsigned u32x4 __attribute__((ext_vector_type(4)));
typedef unsigned u32x2 __attribute__((ext_vector_type(2)));
typedef float f32x16 __attribute__((ext_vector_type(16)));
typedef short s16x4 __attribute__((ext_vector_type(4)));

constexpr int T_TOK = 16384, DM = 1024, NIN = 3592, PW = 3584;
constexpr int NEXP = 256, LIST_CAP = 16384;
constexpr int PC_Z = 0, PC_XBC = 512, PC_Q = 1536, PC_F = 2048, PC_I = 2560, PC_G = 3072;
#define ALPHA_F 1.189207115002721f
#define LN_EPS_F 1e-5f
#define RMS_EPS_F 1e-6f

constexpr size_t MiB = 1u << 20;
constexpr size_t WS_CTL = 0, CTL_ZERO_BYTES = 1 * MiB;
constexpr size_t WS_WIN_T = 2 * MiB, WS_WOUT_T = 9 * MiB, WS_W3_T = 11 * MiB, WS_WDS_T = 13 * MiB, WS_DTRAW = 14 * MiB;
constexpr size_t WS_TOKE = 15 * MiB, WS_TOKPOS = 15 * MiB + 512 * 1024, WS_TOKGATE = 16 * MiB;
constexpr size_t WS_LISTS = 17 * MiB, WS_LOGITS = 33 * MiB, WS_HS = 49 * MiB, WS_YS = 57 * MiB, WS_H1 = 89 * MiB, WS_H1B = 153 * MiB;
constexpr size_t WS_WGU_T = 185 * MiB, WS_WD_T = 441 * MiB;
constexpr size_t WS_X0 = 569 * MiB;
constexpr size_t WS_XB = WS_X0, WS_P = WS_X0 + 32 * MiB, WS_MIX = WS_X0 + 144 * MiB;
constexpr size_t WS_NXBC = WS_X0 + 176 * MiB, WS_NFGK = WS_X0 + 240 * MiB, WS_NQS = WS_X0 + 272 * MiB, WS_NYSSD = WS_X0 + 304 * MiB, WS_NOH = WS_X0 + 336 * MiB, WS_NDTB = WS_X0 + 368 * MiB;
constexpr size_t WS_SSTATE = WS_X0 + 176 * MiB, WS_SPREV = WS_X0 + 208 * MiB, WS_HKV = WS_X0 + 224 * MiB, WS_HSPREV = WS_X0 + 288 * MiB;
constexpr size_t WS_CDECAY = WS_X0 + 320 * MiB, WS_HDECAY = WS_X0 + 320 * MiB + 64 * 1024;
constexpr size_t WS_H = WS_X0, WS_YB = WS_X0 + 65 * MiB;
constexpr size_t WS_END = WS_X0 + 369 * MiB;
constexpr int CW_BAR = 4096;
constexpr int CW_COUNTS = 16384, CNT_STRIDE = 64;

constexpr int RING_BYTES = 131072;
constexpr int LDS_BYTES = 163840;
constexpr int LDS_MISC = LDS_BYTES - 4096;
constexpr int LDS_PREF = LDS_MISC + 256;
constexpr int LDS_OFFS = LDS_PREF + 1040;
constexpr int LDS_CNT = LDS_OFFS + 1040;
constexpr int LDS_PHASE_BYTES = LDS_MISC;

__device__ __forceinline__ int lane_id() { int l; asm volatile("v_mbcnt_lo_u32_b32 %0, -1, 0\n\tv_mbcnt_hi_u32_b32 %0, -1, %0" : "=v"(l)); return l; }
__device__ __forceinline__ float siluf(float x) { return x * __builtin_amdgcn_rcpf(1.0f + __expf(-x)); }
__device__ __forceinline__ float sigmf(float x) { return __builtin_amdgcn_rcpf(1.0f + __expf(-x)); }
template <int CTRL> __device__ __forceinline__ float dpp_f(float v) { return __builtin_bit_cast(float, __builtin_amdgcn_update_dpp(0, __builtin_bit_cast(int, v), CTRL, 0xf, 0xf, true)); }
__device__ __forceinline__ float rdlane_f(float v, int l) { return __builtin_bit_cast(float, __builtin_amdgcn_readlane(__builtin_bit_cast(int, v), l)); }
__device__ __forceinline__ float wave_sum(float v) {
  v += dpp_f<0xB1>(v); v += dpp_f<0x4E>(v); v += dpp_f<0x141>(v); v += dpp_f<0x140>(v);
  return (rdlane_f(v, 0) + rdlane_f(v, 16)) + (rdlane_f(v, 32) + rdlane_f(v, 48));
}
__device__ __forceinline__ float wave_max(float v) {
  v = fmaxf(v, dpp_f<0xB1>(v)); v = fmaxf(v, dpp_f<0x4E>(v)); v = fmaxf(v, dpp_f<0x141>(v)); v = fmaxf(v, dpp_f<0x140>(v));
  return fmaxf(fmaxf(rdlane_f(v, 0), rdlane_f(v, 16)), fmaxf(rdlane_f(v, 32), rdlane_f(v, 48)));
}
__device__ __forceinline__ unsigned cvt_pk_bf16(float lo, float hi) { unsigned r; asm volatile("v_cvt_pk_bf16_f32 %0, %1, %2" : "=v"(r) : "v"(lo), "v"(hi)); return r; }
#define YB_SCALE 64.0f
__device__ __forceinline__ unsigned pk4_fp8(const f32x4 v) {
    const float a = fminf(fmaxf(v[0], -440.f), 440.f), b = fminf(fmaxf(v[1], -440.f), 440.f), c = fminf(fmaxf(v[2], -440.f), 440.f), d = fminf(fmaxf(v[3], -440.f), 440.f);
    int w = 0; w = __builtin_amdgcn_cvt_pk_fp8_f32(a, b, w, false); w = __builtin_amdgcn_cvt_pk_fp8_f32(c, d, w, true); return (unsigned)w; }
__device__ __forceinline__ f32x4 un4_fp8(const unsigned w) { return (f32x4){__builtin_amdgcn_cvt_f32_fp8((int)w, 0), __builtin_amdgcn_cvt_f32_fp8((int)w, 1), __builtin_amdgcn_cvt_f32_fp8((int)w, 2), __builtin_amdgcn_cvt_f32_fp8((int)w, 3)}; }
__device__ __forceinline__ float bf2f(unsigned b) { return __uint_as_float(b << 16); }
__device__ __forceinline__ float bflo(unsigned w) { return __uint_as_float(w << 16); }
__device__ __forceinline__ float bfhi(unsigned w) { return __uint_as_float(w & 0xffff0000u); }

#define XB_TMO      128
#define XB_XCNT(j)  (256  + 64 * (j))
#define XB_XSUB(j)  (1280 + 64 * (j))
#define XB_XGEN(j)  (2304 + 64 * (j))
#define XB_TOP      3328
#define XB_TOPGEN   3392
#define XCD_BAR_WORDS 3456
#define XB_SPIN_CAP (1u << 18)
__device__ __forceinline__ unsigned xb_ld(unsigned* p)              { return __hip_atomic_load(p, __ATOMIC_RELAXED, __HIP_MEMORY_SCOPE_AGENT); }
__device__ __forceinline__ unsigned xb_add(unsigned* p, unsigned v) { return __hip_atomic_fetch_add(p, v, __ATOMIC_RELAXED, __HIP_MEMORY_SCOPE_AGENT); }
__device__ __forceinline__ unsigned xb_xcc_id() { return (unsigned)__builtin_amdgcn_s_getreg((3 << 11) | 20) & 0xFu; }
#define XB_SPIN(cond, bar) do { unsigned _sp = 0; while (cond) { __builtin_amdgcn_s_sleep(1); \
    if ((++_sp & 255u) == 0u) { if (xb_ld(&(bar)[XB_TMO])) break; if (_sp > XB_SPIN_CAP) { atomicAdd(&(bar)[XB_TMO], 1u); break; } } } } while (0)
struct XcdBarrier { unsigned* bar; unsigned x; volatile LAS unsigned* st; int wave; };
__device__ __forceinline__ XcdBarrier xcd_barrier_post(unsigned* bar, volatile LAS unsigned* st, int wave) {
    XcdBarrier b; b.bar = bar; b.x = xb_xcc_id(); b.st = st; b.wave = wave;
    if (wave == 0 && lane_id() == 0) (void)xb_add(&bar[XB_XCNT(b.x)], 1u);
    return b;
}
__device__ __forceinline__ void xcd_barrier_complete(unsigned* bar, unsigned x, unsigned& nloc, unsigned& nx) {
    const unsigned G = gridDim.x * gridDim.y * gridDim.z;
    unsigned sum, cnt, mine, sp = 0u;
    for (;;) {
        sum = 0u; cnt = 0u; mine = 0u;
#pragma unroll
        for (unsigned j = 0; j < 16; ++j) { const unsigned c = xb_ld(&bar[XB_XCNT(j)]); sum += c; cnt += (c > 0u) ? 1u : 0u; mine = (j == x) ? c : mine; }
        if (sum == G) break;
        __builtin_amdgcn_s_sleep(1);
        if ((++sp & 255u) == 0u) { if (xb_ld(&bar[XB_TMO])) break; if (sp > XB_SPIN_CAP) { atomicAdd(&bar[XB_TMO], 1u); break; } }
    }
    nloc = mine > 0u ? mine : 1u; nx = cnt > 0u ? cnt : 1u;
}
__device__ __forceinline__ void xcd_barrier(const XcdBarrier& b) {
    asm volatile("s_waitcnt vmcnt(0)" ::: "memory");
    __syncthreads();
    if (b.wave == 0 && lane_id() == 0) {
        unsigned* bar = b.bar;
        __builtin_amdgcn_s_waitcnt(0);
        unsigned nloc = b.st[0], nx = b.st[1];
        if (nloc == 0u) { xcd_barrier_complete(bar, b.x, nloc, nx); b.st[0] = nloc; b.st[1] = nx; }
        const unsigned old = xb_add(&bar[XB_XSUB(b.x)], 1u);
        const unsigned gen = old / nloc;
        if (old + 1u == (gen + 1u) * nloc) {
            __builtin_amdgcn_fence(__ATOMIC_RELEASE, "agent");
            asm volatile("s_waitcnt vmcnt(0)" ::: "memory");
            const unsigned og = xb_add(&bar[XB_TOP], 1u);
            const unsigned tg = og / nx;
            if (og + 1u == (tg + 1u) * nx) xb_add(&bar[XB_TOPGEN], 1u);
            else XB_SPIN(xb_ld(&bar[XB_TOPGEN]) == tg, bar);
            __builtin_amdgcn_fence(__ATOMIC_ACQUIRE, "agent");
            xb_add(&bar[XB_XGEN(b.x)], 1u);
            asm volatile("s_waitcnt vmcnt(0)" ::: "memory");
        } else {
            XB_SPIN(xb_ld(&bar[XB_XGEN(b.x)]) == gen, bar);
            __builtin_amdgcn_fence(__ATOMIC_ACQUIRE, "agent");
            asm volatile("s_waitcnt vmcnt(0)" ::: "memory");
        }
    }
    __syncthreads();
}

namespace pg8 {
constexpr int BM = 256, BK = 64, HALF = 128, HTB = HALF * BK * 2, STAGE_BYTES = 8 * HTB, NXCD = 8, WGM = 8;
__host__ __device__ __forceinline__ int lds_byte(int r, int c) { const int st = (r >> 4) * 2 + (c >> 5), rr = r & 15, cc = c & 31, ob = rr * 64 + cc * 2; return st * 1024 + (ob ^ (((ob >> 9) & 1) << 5)); }
__host__ __device__ __forceinline__ void stage_rc(int b, int& R, int& C) { const int st = b / 1024, sb = b % 1024, swz = sb ^ (((sb >> 9) & 1) << 5); R = (st >> 1) * 16 + swz / 64; C = (st & 1) * 32 + (swz % 64) / 2; }
__host__ __device__ __forceinline__ int perm32(int rho) { const int n = rho >> 4, i = rho & 15; return 8 * (i >> 2) + 4 * n + (i & 3); }

struct Unit { const char* A; const char* B; int pm, pn, rows, e, slot0, mt; };

struct DenseSched {
    static constexpr bool PER_UNIT_VOFF = false;
    const char* A; const char* B; int K, nM, nN, nwg, G, c;
    __device__ void init(const void* A_, const void* B_, int M, int N, int K_, int G_, int c_) { A = (const char*)A_; B = (const char*)B_; K = K_; nM = M / BM; nN = N / BM; nwg = nM * nN; G = G_; c = c_; }
    __device__ __forceinline__ bool next(int i, Unit& u) const {
        const int L = i * G + c; if (L >= nwg) return false;
        int wgid = L; { const int q = nwg / NXCD, r = nwg % NXCD, xcd = wgid % NXCD, off = wgid / NXCD; wgid = (xcd < r ? xcd * (q + 1) : r * (q + 1) + (xcd - r) * q) + off; }
        const int nig = WGM * nN, gid = wgid / nig, fm = gid * WGM, gsz = (nM - fm) < WGM ? (nM - fm) : WGM;
        u.pm = fm + ((wgid % nig) % gsz); u.pn = (wgid % nig) / gsz; u.rows = 256; u.e = 0; u.slot0 = 0; u.mt = 0;
        u.A = A + (size_t)u.pm * BM * K * 2; u.B = B + (size_t)u.pn * BM * K * 2; return true;
    }
    __device__ __forceinline__ void voff(const Unit&, const int (&sR)[2], const int (&sC)[2], unsigned (&v)[2][2]) const {
#pragma unroll
        for (int h = 0; h < 2; ++h)
#pragma unroll
            for (int i = 0; i < 2; ++i) v[h][i] = (unsigned)((h * HALF + sR[i]) * K + sC[i]) * 2u;
    }
};

template <bool GATHER> struct ExpertSched {
    static constexpr bool PER_UNIT_VOFF = GATHER;
    static constexpr int K = GATHER ? 1024 : 256, NT = GATHER ? 2 : 4;
    static constexpr unsigned WSTRIDE = GATHER ? 512u * 1024u * 2u : 1024u * 256u * 2u;
    LAS unsigned char* lds;
    const int* lists; const char* A; const char* W; int U, G, c;
    __device__ __forceinline__ bool next(int i, Unit& u) const {
        int L = i * G + c; if (L >= U) return false;
        { const int q = U / NXCD, r = U % NXCD, xcd = L % NXCD, off = L / NXCD; L = (xcd < r ? xcd * (q + 1) : r * (q + 1) + (xcd - r) * q) + off; }
        const LAS int* pref = (const LAS int*)(lds + LDS_PREF);
        int lo = 0, hi = NEXP;
        while (hi - lo > 1) { const int mid = (lo + hi) >> 1; const int pv = __builtin_amdgcn_readfirstlane(pref[mid]); if (NT * pv <= L) lo = mid; else hi = mid; }
        const int e = lo, p0 = __builtin_amdgcn_readfirstlane(pref[e]), p1 = __builtin_amdgcn_readfirstlane(pref[e + 1]), tiles = p1 - p0, r = L - NT * p0;
        u.e = e; u.pn = r / tiles; u.mt = r % tiles; u.pm = 0;
        const int n = __builtin_amdgcn_readfirstlane(((const LAS int*)(lds + LDS_CNT))[e]); u.rows = (n - u.mt * 256) < 256 ? (n - u.mt * 256) : 256;
        u.slot0 = __builtin_amdgcn_readfirstlane(((const LAS int*)(lds + LDS_OFFS))[e]) + u.mt * 256;
        u.A = GATHER ? A : A + (size_t)u.slot0 * (K * 2); u.B = W + (size_t)e * WSTRIDE + (size_t)u.pn * (BM * K * 2); return true;
    }
    __device__ __forceinline__ void voff(const Unit& u, const int (&sR)[2], const int (&sC)[2], unsigned (&v)[2][2]) const {
#pragma unroll
        for (int h = 0; h < 2; ++h)
#pragma unroll
            for (int i = 0; i < 2; ++i) {
                const int r = h * HALF + sR[i];
                if (GATHER) { int tok = 0; if (r < u.rows) tok = lists[(size_t)u.e * LIST_CAP + u.mt * 256 + r] >> 3; v[h][i] = (unsigned)(tok * K + sC[i]) * 2u; }
                else v[h][i] = (unsigned)(r * K + sC[i]) * 2u;
            }
    }
};

template <class Epi, class Sched, bool ALIGN_EPI>
__device__ __forceinline__ void gemm_phase(LAS unsigned char* lds, const int K, const Sched& S, const Epi& E, const int wid) {
    const int lane = lane_id(), tid = wid * 64 + lane, wr = wid >> 2, wc = wid & 3, fr = lane & 15, fq = lane >> 4;
    const int nt = K / BK;
    int sR[2], sC[2]; unsigned voffB[2];
#pragma unroll
    for (int i = 0; i < 2; ++i) { stage_rc(tid * 16 + i * 8192, sR[i], sC[i]); const int Rb = Epi::PERM ? ((sR[i] & ~31) + perm32(sR[i] & 31)) : sR[i]; voffB[i] = (unsigned)(Rb * K + sC[i]) * 2u; }
    const size_t kstep = (size_t)(BK * 2);
    const size_t hstep = (size_t)HALF * K * 2;
    const unsigned ldsw = (unsigned)wid * 1024u;
    const int aoff = lds_byte(wr * 64 + fr, fq * 8), boff = lds_byte(wc * 32 + fr, fq * 8);
#define PG8_SA(b, h) (((b) * 2 + (h)) * HTB)
#define PG8_SB(b, h) ((4 + (b) * 2 + (h)) * HTB)
#define PG8_STAGE(bufoff, gbase, voff) do { _Pragma("unroll") for (int _i = 0; _i < 2; ++_i) \
        __builtin_amdgcn_global_load_lds((const unsigned*)((const char*)(gbase) + (voff)[_i]), (LAS unsigned*)(lds + (bufoff) + ldsw + _i * 8192), 16, 0, 0); } while (0)
#define PG8_STAGE_A(bufoff, gbase, h, vset) do { if constexpr (Sched::PER_UNIT_VOFF) { PG8_STAGE(bufoff, gbase, (vset)[h]); } else { PG8_STAGE(bufoff, (gbase) + (h) * hstep, vc[0]); } } while (0)
#define PG8_LDA(dst, b, h) do { _Pragma("unroll") for (int m = 0; m < 4; ++m) _Pragma("unroll") for (int k = 0; k < 2; ++k) dst[m][k] = *(const LAS bf16x8*)(lds + PG8_SA(b, h) + aoff + m * 2048 + k * 1024); } while (0)
#define PG8_LDB(dst, b, h) do { _Pragma("unroll") for (int n = 0; n < 2; ++n) _Pragma("unroll") for (int k = 0; k < 2; ++k) dst[n][k] = *(const LAS bf16x8*)(lds + PG8_SB(b, h) + boff + n * 2048 + k * 1024); } while (0)
#define PG8_MMA(ai, bj, At, Bt) do { __builtin_amdgcn_s_setprio(1); _Pragma("unroll") for (int m = 0; m < 4; ++m) _Pragma("unroll") for (int n = 0; n < 2; ++n) _Pragma("unroll") for (int k = 0; k < 2; ++k) \
        acc[ai][bj][m][n] = __builtin_amdgcn_mfma_f32_16x16x32_bf16(Bt[n][k], At[m][k], acc[ai][bj][m][n], 0, 0, 0); __builtin_amdgcn_s_setprio(0); } while (0)
#define PG8_WAIT_V(n) asm volatile("s_waitcnt vmcnt(" #n ")" ::: "memory")
#define PG8_WAIT_L(n) asm volatile("s_waitcnt lgkmcnt(" #n ")" ::: "memory")
#define PG8_BAR __builtin_amdgcn_s_barrier()
#define PG8_SCHED __builtin_amdgcn_sched_barrier(0)
    Unit cur, nxt; int ui = 0;
    if (!S.next(0, cur)) return;
    unsigned vc[2][2], vn[2][2];
    S.voff(cur, sR, sC, vc);
    f32x4 acc[2][2][4][2];
#pragma unroll
    for (int a = 0; a < 2; ++a)
#pragma unroll
        for (int b = 0; b < 2; ++b)
#pragma unroll
            for (int m = 0; m < 4; ++m)
#pragma unroll
                for (int n = 0; n < 2; ++n) acc[a][b][m][n] = (f32x4){0.f, 0.f, 0.f, 0.f};
    bf16x8 At[4][2], B0[2][2], B1[2][2];
    const char* cA = cur.A; const char* cB = cur.B;
    PG8_STAGE(PG8_SB(0, 0), cB, voffB); PG8_STAGE(PG8_SB(0, 1), cB + hstep, voffB); PG8_STAGE_A(PG8_SA(0, 0), cA, 0, vc); PG8_STAGE_A(PG8_SA(0, 1), cA, 1, vc);
    if (wr == 1) PG8_BAR;
    PG8_WAIT_V(2); PG8_BAR;
    PG8_STAGE(PG8_SB(1, 0), cB + kstep, voffB); PG8_STAGE_A(PG8_SA(1, 0), cA + kstep, 0, vc); PG8_STAGE(PG8_SB(1, 1), cB + hstep + kstep, voffB);
    PG8_WAIT_V(6); PG8_BAR;
    for (;;) {
        const bool has_next = S.next(ui + 1, nxt);
        if constexpr (Sched::PER_UNIT_VOFF) {
            if (has_next) S.voff(nxt, sR, sC, vn);
            else {
#pragma unroll
                for (int h = 0; h < 2; ++h)
#pragma unroll
                    for (int i = 0; i < 2; ++i) vn[h][i] = vc[h][i];
            }
        }
        const char* nA = has_next ? nxt.A : cA; const char* nB = has_next ? nxt.B : cB;
        for (int t = 0; t < nt; t += 2) {
            const bool last = (t == nt - 2);
            const char* a1 = cA + (size_t)(t + 1) * kstep;
            const char* a2 = last ? nA : cA + (size_t)(t + 2) * kstep; const char* b2 = last ? nB : cB + (size_t)(t + 2) * kstep;
            const char* a3 = a2 + kstep; const char* b3 = b2 + kstep;
            unsigned v2[2][2];
#pragma unroll
            for (int h = 0; h < 2; ++h)
#pragma unroll
                for (int i = 0; i < 2; ++i) v2[h][i] = (Sched::PER_UNIT_VOFF && last) ? vn[h][i] : vc[h][i];
            PG8_LDB(B0, 0, 0); PG8_LDB(B1, 0, 1); PG8_SCHED; PG8_LDA(At, 0, 0); PG8_STAGE_A(PG8_SA(1, 1), a1, 1, vc);
            PG8_WAIT_V(8); PG8_WAIT_L(0); PG8_BAR; PG8_MMA(0, 0, At, B0); PG8_MMA(0, 1, At, B1); PG8_BAR; PG8_SCHED;
            PG8_LDA(At, 0, 1); PG8_STAGE(PG8_SB(0, 0), b2, voffB); PG8_STAGE(PG8_SB(0, 1), b2 + hstep, voffB); PG8_STAGE_A(PG8_SA(0, 0), a2, 0, v2);
            PG8_WAIT_V(8); PG8_WAIT_L(0); PG8_BAR; PG8_MMA(1, 0, At, B0); PG8_MMA(1, 1, At, B1); PG8_BAR; PG8_SCHED;
            PG8_LDB(B0, 1, 0); PG8_LDB(B1, 1, 1); PG8_SCHED; PG8_LDA(At, 1, 0); PG8_STAGE_A(PG8_SA(0, 1), a2, 1, v2);
            PG8_WAIT_V(8); PG8_WAIT_L(0); PG8_BAR; PG8_MMA(0, 0, At, B0); PG8_MMA(0, 1, At, B1); PG8_BAR; PG8_SCHED;
            PG8_LDA(At, 1, 1); PG8_STAGE(PG8_SB(1, 0), b3, voffB); PG8_STAGE(PG8_SB(1, 1), b3 + hstep, voffB); PG8_STAGE_A(PG8_SA(1, 0), a3, 0, v2);
            PG8_WAIT_V(8); PG8_WAIT_L(0); PG8_BAR; PG8_MMA(1, 0, At, B0); PG8_MMA(1, 1, At, B1); PG8_BAR; PG8_SCHED;
        }
        if constexpr (ALIGN_EPI) { if (wr == 0) PG8_BAR; }
        E(acc, cur, wr, wc, fr, fq);
        if (!has_next) break;
#pragma unroll
        for (int a = 0; a < 2; ++a)
#pragma unroll
            for (int b = 0; b < 2; ++b)
#pragma unroll
                for (int m = 0; m < 4; ++m)
#pragma unroll
                    for (int n = 0; n < 2; ++n) acc[a][b][m][n] = (f32x4){0.f, 0.f, 0.f, 0.f};
        cur = nxt; cA = nA; cB = nB; ++ui;
        if constexpr (Sched::PER_UNIT_VOFF) {
#pragma unroll
            for (int h = 0; h < 2; ++h)
#pragma unroll
                for (int i = 0; i < 2; ++i) vc[h][i] = vn[h][i];
        }
        if constexpr (ALIGN_EPI) { if (wr == 1) PG8_BAR; }
    }
    PG8_WAIT_V(0);
    if constexpr (!ALIGN_EPI) { if (wr == 0) PG8_BAR; }
    PG8_BAR;
#undef PG8_SA
#undef PG8_SB
#undef PG8_STAGE
#undef PG8_LDA
#undef PG8_STAGE_A
#undef PG8_LDB
#undef PG8_MMA
#undef PG8_WAIT_V
#undef PG8_WAIT_L
#undef PG8_BAR
#undef PG8_SCHED
}

struct EpiP {
    static constexpr bool PERM = true;
    bf16_t* O; int ldc;
    __device__ __forceinline__ void operator()(const f32x4 (&acc)[2][2][4][2], const Unit& u, int wr, int wc, int fr, int fq) const {
        const int row0 = u.pm * BM + wr * 64 + fr, col0 = u.pn * BM + wc * 32 + 8 * fq;
#pragma unroll
        for (int ai = 0; ai < 2; ++ai)
#pragma unroll
            for (int m = 0; m < 4; ++m) { bf16_t* rowp = O + (size_t)(row0 + ai * HALF + m * 16) * ldc + col0;
#pragma unroll
                for (int bj = 0; bj < 2; ++bj) { const f32x4 v0 = acc[ai][bj][m][0], v1 = acc[ai][bj][m][1];
                    u32x4 w; w.x = cvt_pk_bf16(v0[0], v0[1]); w.y = cvt_pk_bf16(v0[2], v0[3]); w.z = cvt_pk_bf16(v1[0], v1[1]); w.w = cvt_pk_bf16(v1[2], v1[3]);
                    *(u32x4*)(rowp + bj * HALF) = w; } }
    }
};
struct EpiU {
    static constexpr bool PERM = false;
    float* U; const float* X;
    __device__ __forceinline__ void operator()(const f32x4 (&acc)[2][2][4][2], const Unit& u, int wr, int wc, int fr, int fq) const {
        const int row0 = u.pm * BM + wr * 64 + fr, col0 = u.pn * BM + wc * 32 + 4 * fq;
#pragma unroll
        for (int ai = 0; ai < 2; ++ai)
#pragma unroll
            for (int m = 0; m < 4; ++m) { const size_t ro = (size_t)(row0 + ai * HALF + m * 16) * DM + col0;
#pragma unroll
                for (int bj = 0; bj < 2; ++bj)
#pragma unroll
                    for (int n = 0; n < 2; ++n) { const f32x4 xv = *(const f32x4*)(X + ro + bj * HALF + n * 16);
                        *(f32x4*)(U + ro + bj * HALF + n * 16) = xv * ALPHA_F + acc[ai][bj][m][n]; } }
    }
};
struct Epi3 {
    static constexpr bool PERM = true;
    float* LG; bf16_t* HS;
    __device__ __forceinline__ void operator()(const f32x4 (&acc)[2][2][4][2], const Unit& u, int wr, int wc, int fr, int fq) const {
        const int row0 = u.pm * BM + wr * 64 + fr;
        if (u.pn == 0) {
#pragma unroll
            for (int ai = 0; ai < 2; ++ai)
#pragma unroll
                for (int m = 0; m < 4; ++m) { float* rowp = LG + (size_t)(row0 + ai * HALF + m * 16) * 256 + wc * 32 + 8 * fq;
#pragma unroll
                    for (int bj = 0; bj < 2; ++bj)
#pragma unroll
                        for (int n = 0; n < 2; ++n) *(f32x4*)(rowp + bj * HALF + 4 * n) = acc[ai][bj][m][n]; }
        } else {
            const int hc0 = (u.pn - 1) * 128 + wc * 32 + 8 * fq;
#pragma unroll
            for (int ai = 0; ai < 2; ++ai)
#pragma unroll
                for (int m = 0; m < 4; ++m) { bf16_t* rowp = HS + (size_t)(row0 + ai * HALF + m * 16) * 256 + hc0;
                    float h[8];
#pragma unroll
                    for (int n = 0; n < 2; ++n)
#pragma unroll
                        for (int j = 0; j < 4; ++j) h[n * 4 + j] = siluf(acc[ai][0][m][n][j]) * acc[ai][1][m][n][j];
                    u32x4 w; w.x = cvt_pk_bf16(h[0], h[1]); w.y = cvt_pk_bf16(h[2], h[3]); w.z = cvt_pk_bf16(h[4], h[5]); w.w = cvt_pk_bf16(h[6], h[7]);
                    *(u32x4*)rowp = w; }
        }
    }
};
struct EpiH {
    static constexpr bool PERM = true;
    bf16_t* H;
    __device__ __forceinline__ void operator()(const f32x4 (&acc)[2][2][4][2], const Unit& u, int wr, int wc, int fr, int fq) const {
        const int hc0 = u.pn * 128 + wc * 32 + 8 * fq;
#pragma unroll
        for (int ai = 0; ai < 2; ++ai)
#pragma unroll
            for (int m = 0; m < 4; ++m) { const int r = ai * HALF + wr * 64 + m * 16 + fr;
                if (r < u.rows) { bf16_t* rowp = H + (size_t)(u.slot0 + r) * 256 + hc0;
                    float h[8];
#pragma unroll
                    for (int n = 0; n < 2; ++n)
#pragma unroll
                        for (int j = 0; j < 4; ++j) h[n * 4 + j] = siluf(acc[ai][0][m][n][j]) * acc[ai][1][m][n][j];
                    u32x4 w; w.x = cvt_pk_bf16(h[0], h[1]); w.y = cvt_pk_bf16(h[2], h[3]); w.z = cvt_pk_bf16(h[4], h[5]); w.w = cvt_pk_bf16(h[6], h[7]);
                    *(u32x4*)rowp = w; } }
    }
};
struct EpiYb {
    static constexpr bool PERM = true;
    bf16_t* YB; const int* lists; const float* tok_gate;
    __device__ __forceinline__ void operator()(const f32x4 (&acc)[2][2][4][2], const Unit& u, int wr, int wc, int fr, int fq) const {
        const int col0 = u.pn * BM + wc * 32 + 8 * fq;
#pragma unroll
        for (int ai = 0; ai < 2; ++ai)
#pragma unroll
            for (int m = 0; m < 4; ++m) { const int r = ai * HALF + wr * 64 + m * 16 + fr;
                if (r < u.rows) { const float g = tok_gate[lists[(size_t)u.e * LIST_CAP + u.mt * 256 + r]];
                    bf16_t* rowp = YB + (size_t)(u.slot0 + r) * 1024 + col0;
#pragma unroll
                    for (int bj = 0; bj < 2; ++bj) { const f32x4 v0 = acc[ai][bj][m][0] * g, v1 = acc[ai][bj][m][1] * g;
                        u32x4 w; w.x = cvt_pk_bf16(v0[0], v0[1]); w.y = cvt_pk_bf16(v0[2], v0[3]); w.z = cvt_pk_bf16(v1[0], v1[1]); w.w = cvt_pk_bf16(v1[2], v1[3]);
                        *(u32x4*)(rowp + bj * HALF) = w; } } }
    }
};
}

template <int OFF> __device__ __forceinline__ unsigned long long karg_u64() { unsigned long long v;
    asm volatile("s_load_dwordx2 %0, %1, %2\n\ts_waitcnt lgkmcnt(0)" : "=s"(v) : "s"(__builtin_amdgcn_kernarg_segment_ptr()), "i"(OFF)); return v; }
#define KARG_IN(k) ((const float*)karg_u64<8 * (k)>())
#define KARG_OUT() ((float*)karg_u64<184>())
struct Args { const float* in[23]; float* out; unsigned char* ws; int ph_lo, ph_hi, mode, li; };
struct Frame { LAS unsigned char* lds; int wave, G, vcu; unsigned char* ws; unsigned* ctl; };
#define F_LANE lane_id()
#define F_TID (F.wave * 64 + lane_id())
constexpr int NPH = 12;

__device__ __forceinline__ void transpose_item(const float* W, int ldw, int c0, int k0, bf16_t* WT, int K, int row0, LAS float* scr, int lane) {
    { float v[32];
#pragma unroll
      for (int i = 0; i < 32; ++i) { const int kk = 2 * i + (lane >> 5); v[i] = W[(size_t)(k0 + kk) * ldw + c0 + (lane & 31)]; }
#pragma unroll
      for (int i = 0; i < 32; ++i) { const int kk = 2 * i + (lane >> 5); scr[kk * 33 + (lane & 31)] = v[i]; } }
    asm volatile("s_waitcnt lgkmcnt(0)" ::: "memory");
    const int c = lane & 7;
#pragma unroll
    for (int j = 0; j < 4; ++j) { const int n = (lane >> 3) + 8 * j; const LAS float* s = scr + (8 * c) * 33 + n;
        u32x4 o; o.x = cvt_pk_bf16(s[0 * 33], s[1 * 33]); o.y = cvt_pk_bf16(s[2 * 33], s[3 * 33]); o.z = cvt_pk_bf16(s[4 * 33], s[5 * 33]); o.w = cvt_pk_bf16(s[6 * 33], s[7 * 33]);
        *(u32x4*)(WT + (size_t)(row0 + n) * K + k0 + 8 * c) = o; }
    asm volatile("s_waitcnt lgkmcnt(0)" ::: "memory");
}

__device__ __forceinline__ void gu_item(const float* Wg, const float* Wu, bf16_t* WT, int item, LAS float* scr, int lane) {
    const int kb = item >> 4, nb = item & 15, row0 = nb * 32, pn = row0 >> 8, half = (row0 >> 7) & 1, r0 = row0 & 127;
    transpose_item(half ? Wu : Wg, 256, pn * 128 + r0, kb * 64, WT, 1024, row0, scr, lane);
}

__device__ __forceinline__ void phase_prep(const Frame& F, const Args& a) {
    LAS float* scr = (LAS float*)(F.lds + F.wave * 16384);
    const int gw = F.vcu * 8 + F.wave, NGW = F.G * 8;
    unsigned char* ws = F.ws;
    bf16_t* Win_t = (bf16_t*)(ws + WS_WIN_T); bf16_t* Wout_t = (bf16_t*)(ws + WS_WOUT_T); bf16_t* W3_t = (bf16_t*)(ws + WS_W3_T); bf16_t* Wds_t = (bf16_t*)(ws + WS_WDS_T);
    bf16_t* Wgu_t = (bf16_t*)(ws + WS_WGU_T); bf16_t* Wd_t = (bf16_t*)(ws + WS_WD_T);
    const float* w_in = KARG_IN(1); const float* w_out = KARG_IN(10); const float* w_router = KARG_IN(13);
    const float* wge = KARG_IN(15); const float* wue = KARG_IN(16); const float* wde = KARG_IN(17);
    const float* wgs = KARG_IN(18); const float* wus = KARG_IN(19); const float* wds = KARG_IN(20);
    constexpr int I_IN = 16 * (PW / 32), I_OUT = 16 * 32, I_R = 16 * 8, I_S = 16 * 16, I_DS = 4 * 32, I_EGU = 16 * 16, I_ED = 4 * 32;
    constexpr int NITEMS = I_IN + I_OUT + I_R + I_S + I_DS;
    for (int it = gw; it < NITEMS; it += NGW) {
        int r = it; const float* W; int ldw, c0, k0, K, row0; bf16_t* WT;
        if (r < I_IN) { const int kb = r / (PW / 32), nb = r % (PW / 32); row0 = nb * 32; c0 = row0 < 1536 ? row0 : row0 + 8; W = w_in; ldw = NIN; k0 = kb * 64; WT = Win_t; K = 1024; }
        else if ((r -= I_IN) < I_OUT) { W = w_out; ldw = 1024; c0 = (r & 31) * 32; k0 = (r >> 5) * 64; WT = Wout_t; K = 1024; row0 = c0; }
        else if ((r -= I_OUT) < I_R) { W = w_router; ldw = 256; c0 = (r & 7) * 32; k0 = (r >> 3) * 64; WT = W3_t; K = 1024; row0 = c0; }
        else if ((r -= I_R) < I_S) { const int kb = r >> 4, nb = r & 15; row0 = nb * 32; const int pn = row0 >> 8, half = (row0 >> 7) & 1, r0 = row0 & 127;
            W = half ? wus : wgs; ldw = 256; c0 = pn * 128 + r0; k0 = kb * 64; WT = W3_t + (size_t)256 * 1024; K = 1024; }
        else { r -= I_S; W = wds; ldw = 1024; c0 = (r & 31) * 32; k0 = (r >> 5) * 64; WT = Wds_t; K = 256; row0 = c0; }
        transpose_item(W, ldw, c0, k0, WT, K, row0, scr, F_LANE);
    }
    float wdt[16][8];
    { const float* w_in0 = KARG_IN(1); const int tid = F_TID;
      __syncthreads();
#pragma unroll
      for (int i = 0; i < 2; ++i) { const int k = tid + 512 * i; const float* src = w_in0 + (size_t)k * NIN + 1536;
          *(LAS f32x4*)(F.lds + k * 32) = *(const f32x4*)src; *(LAS f32x4*)(F.lds + k * 32 + 16) = *(const f32x4*)(src + 4); }
      __syncthreads();
#pragma unroll
      for (int j = 0; j < 16; ++j) { const int k = (j < 8 ? 8 * F_LANE + j : 512 + 8 * F_LANE + (j - 8));
          const f32x4 lo = *(const LAS f32x4*)(F.lds + k * 32), hi = *(const LAS f32x4*)(F.lds + k * 32 + 16);
          wdt[j][0] = lo[0]; wdt[j][1] = lo[1]; wdt[j][2] = lo[2]; wdt[j][3] = lo[3]; wdt[j][4] = hi[0]; wdt[j][5] = hi[1]; wdt[j][6] = hi[2]; wdt[j][7] = hi[3]; }
      __syncthreads(); }
    const float* x = KARG_IN(0); bf16_t* xb = (bf16_t*)(ws + WS_XB); float* dtraw = (float*)(ws + WS_DTRAW);
    f32x4 n0, n1, n2, n3;
    { const float* xr = x + (size_t)(gw < T_TOK ? gw : 0) * DM; n0 = *(const f32x4*)(xr + 8 * F_LANE); n1 = *(const f32x4*)(xr + 8 * F_LANE + 4); n2 = *(const f32x4*)(xr + 512 + 8 * F_LANE); n3 = *(const f32x4*)(xr + 512 + 8 * F_LANE + 4); }
    for (int t = gw; t < T_TOK; t += NGW) {
        const f32x4 a0 = n0, a1 = n1, b0 = n2, b1 = n3;
        { const int tn = t + NGW < T_TOK ? t + NGW : t; const float* xr = x + (size_t)tn * DM;
          n0 = *(const f32x4*)(xr + 8 * F_LANE); n1 = *(const f32x4*)(xr + 8 * F_LANE + 4); n2 = *(const f32x4*)(xr + 512 + 8 * F_LANE); n3 = *(const f32x4*)(xr + 512 + 8 * F_LANE + 4); }
        u32x4 w0; w0.x = cvt_pk_bf16(a0[0], a0[1]); w0.y = cvt_pk_bf16(a0[2], a0[3]); w0.z = cvt_pk_bf16(a1[0], a1[1]); w0.w = cvt_pk_bf16(a1[2], a1[3]);
        u32x4 w1; w1.x = cvt_pk_bf16(b0[0], b0[1]); w1.y = cvt_pk_bf16(b0[2], b0[3]); w1.z = cvt_pk_bf16(b1[0], b1[1]); w1.w = cvt_pk_bf16(b1[2], b1[3]);
        *(u32x4*)(xb + (size_t)t * DM + 8 * F_LANE) = w0; *(u32x4*)(xb + (size_t)t * DM + 512 + 8 * F_LANE) = w1;
        const float xv[16] = {a0[0], a0[1], a0[2], a0[3], a1[0], a1[1], a1[2], a1[3], b0[0], b0[1], b0[2], b0[3], b1[0], b1[1], b1[2], b1[3]};
        float d[8];
#pragma unroll
        for (int h = 0; h < 8; ++h) { float sm = 0.f;
#pragma unroll
            for (int j = 0; j < 16; ++j) sm = fmaf(xv[j], wdt[j][h], sm);
            d[h] = wave_sum(sm); }
        if (F_LANE == 0) { *(f32x4*)(dtraw + t * 8) = (f32x4){d[0], d[1], d[2], d[3]}; *(f32x4*)(dtraw + t * 8 + 4) = (f32x4){d[4], d[5], d[6], d[7]}; }
    }
}

__device__ __forceinline__ void phase_ln1(const Frame& F, const Args& a) {
    const int gw = F.vcu * 8 + F.wave, NGW = F.G * 8;
    float* h1 = (float*)(F.ws + WS_H1); bf16_t* h1b = (bf16_t*)(F.ws + WS_H1B);
    const float* g = KARG_IN(11); const float* b = KARG_IN(12);
    const int c0 = 8 * F_LANE;
    f32x4 gv[4], bv[4];
    gv[0] = *(const f32x4*)(g + c0); gv[1] = *(const f32x4*)(g + c0 + 4); gv[2] = *(const f32x4*)(g + 512 + c0); gv[3] = *(const f32x4*)(g + 512 + c0 + 4);
    bv[0] = *(const f32x4*)(b + c0); bv[1] = *(const f32x4*)(b + c0 + 4); bv[2] = *(const f32x4*)(b + 512 + c0); bv[3] = *(const f32x4*)(b + 512 + c0 + 4);
    for (int t = gw; t < T_TOK; t += NGW) {
        float* r = h1 + (size_t)t * DM;
        f32x4 v[4]; v[0] = *(const f32x4*)(r + c0); v[1] = *(const f32x4*)(r + c0 + 4); v[2] = *(const f32x4*)(r + 512 + c0); v[3] = *(const f32x4*)(r + 512 + c0 + 4);
        float s = 0.f;
#pragma unroll
        for (int j = 0; j < 4; ++j) s += (v[j][0] + v[j][1]) + (v[j][2] + v[j][3]);
        const float mu = wave_sum(s) * (1.0f / 1024.0f);
        float q = 0.f;
#pragma unroll
        for (int j = 0; j < 4; ++j) { v[j] = v[j] - mu; q += (v[j][0] * v[j][0] + v[j][1] * v[j][1]) + (v[j][2] * v[j][2] + v[j][3] * v[j][3]); }
        const float rs = rsqrtf(wave_sum(q) * (1.0f / 1024.0f) + LN_EPS_F);
#pragma unroll
        for (int j = 0; j < 4; ++j) v[j] = v[j] * rs * gv[j] + bv[j];
        u32x4 w0; w0.x = cvt_pk_bf16(v[0][0], v[0][1]); w0.y = cvt_pk_bf16(v[0][2], v[0][3]); w0.z = cvt_pk_bf16(v[1][0], v[1][1]); w0.w = cvt_pk_bf16(v[1][2], v[1][3]);
        u32x4 w1; w1.x = cvt_pk_bf16(v[2][0], v[2][1]); w1.y = cvt_pk_bf16(v[2][2], v[2][3]); w1.z = cvt_pk_bf16(v[3][0], v[3][1]); w1.w = cvt_pk_bf16(v[3][2], v[3][3]);
        *(u32x4*)(h1b + (size_t)t * DM + c0) = w0; *(u32x4*)(h1b + (size_t)t * DM + 512 + c0) = w1;
    }
}

__device__ __forceinline__ void phase_route(const Frame& F, const Args& a) {
    const int gw = F.vcu * 8 + F.wave, NGW = F.G * 8, lane = F_LANE;
    const float* logits = (const float*)(F.ws + WS_LOGITS); const float* rbias = KARG_IN(14);
    int* counts = (int*)(F.ctl + CW_COUNTS); int* tok_e = (int*)(F.ws + WS_TOKE); int* tok_pos = (int*)(F.ws + WS_TOKPOS); float* tok_gate = (float*)(F.ws + WS_TOKGATE);
    int* lists = (int*)(F.ws + WS_LISTS);
    const f32x4 rb = *(const f32x4*)(rbias + lane * 4);
    f32x4 lgn = *(const f32x4*)(logits + (size_t)(gw < T_TOK ? gw : 0) * 256 + lane * 4);
    int p_t = -1, p_e = 0, p_pos = 0;
    for (int t = gw; t < T_TOK; t += NGW) {
        const f32x4 lg = lgn;
        { const int tn = t + NGW < T_TOK ? t + NGW : t; lgn = *(const f32x4*)(logits + (size_t)tn * 256 + lane * 4); }
        float sc[4] = {sigmf(lg[0]), sigmf(lg[1]), sigmf(lg[2]), sigmf(lg[3])};
        float bs[4] = {sc[0] + rb[0], sc[1] + rb[1], sc[2] + rb[2], sc[3] + rb[3]};
        float m1 = fmaxf(bs[0], bs[1]), m2 = fminf(bs[0], bs[1]);
        { const float n1 = fmaxf(bs[2], bs[3]), n2 = fminf(bs[2], bs[3]);
          const float a1 = fmaxf(m1, n1), a2 = fmaxf(fminf(m1, n1), fmaxf(m2, n2)); m1 = a1; m2 = a2; }
        { const float n1 = dpp_f<0xB1>(m1), n2 = dpp_f<0xB1>(m2); const float a1 = fmaxf(m1, n1), a2 = fmaxf(fminf(m1, n1), fmaxf(m2, n2)); m1 = a1; m2 = a2; }
        { const float n1 = dpp_f<0x4E>(m1), n2 = dpp_f<0x4E>(m2); const float a1 = fmaxf(m1, n1), a2 = fmaxf(fminf(m1, n1), fmaxf(m2, n2)); m1 = a1; m2 = a2; }
        { const float n1 = dpp_f<0x141>(m1), n2 = dpp_f<0x141>(m2); const float a1 = fmaxf(m1, n1), a2 = fmaxf(fminf(m1, n1), fmaxf(m2, n2)); m1 = a1; m2 = a2; }
        const float gs = m1 + m2; const int mygrp = lane >> 3; int rank = 0;
#pragma unroll
        for (int gI = 0; gI < 8; ++gI) { const float og = rdlane_f(gs, gI * 8); rank += (og > gs || (og == gs && gI < mygrp)) ? 1 : 0; }
        const bool sel = rank < 4;
        float cand[4];
#pragma unroll
        for (int j = 0; j < 4; ++j) cand[j] = sel ? bs[j] : -INFINITY;
        int my_e = -1; float my_s = 0.f; float gsum = 0.f;
#pragma unroll
        for (int k = 0; k < 8; ++k) {
            const float mx = wave_max(fmaxf(fmaxf(cand[0], cand[1]), fmaxf(cand[2], cand[3])));
            int be = 1 << 20;
#pragma unroll
            for (int j = 0; j < 4; ++j) { const unsigned long long bm = __ballot(cand[j] == mx); const int ej = bm ? (__ffsll((long long)bm) - 1) * 4 + j : (1 << 20); be = ej < be ? ej : be; }
            be = __builtin_amdgcn_readfirstlane(be);
            const int wj = be & 3, bl = be >> 2;
            const float mysc = wj == 0 ? sc[0] : wj == 1 ? sc[1] : wj == 2 ? sc[2] : sc[3];
            const float wsc = rdlane_f(mysc, bl);
#pragma unroll
            for (int j = 0; j < 4; ++j) cand[j] = (lane == bl && j == wj) ? -INFINITY : cand[j];
            gsum += wsc;
            if (lane == k) { my_e = be; my_s = wsc; }
        }
        if (lane < 8) {
            if (p_t >= 0) { tok_pos[p_t * 8 + lane] = p_pos; lists[(size_t)p_e * LIST_CAP + p_pos] = p_t * 8 + lane; }
            const float gate = my_s / gsum * 2.5f;
            p_pos = atomicAdd(&counts[my_e * CNT_STRIDE], 1); p_e = my_e; p_t = t;
            tok_e[t * 8 + lane] = my_e; tok_gate[t * 8 + lane] = gate;
        }
    }
    if (lane < 8 && p_t >= 0) { tok_pos[p_t * 8 + lane] = p_pos; lists[(size_t)p_e * LIST_CAP + p_pos] = p_t * 8 + lane; }
}

__device__ __forceinline__ void build_tables(const Frame& F) {
    const int* counts = (const int*)(F.ctl + CW_COUNTS);
    LAS int* pref = (LAS int*)(F.lds + LDS_PREF); LAS int* offs = (LAS int*)(F.lds + LDS_OFFS); LAS int* cnt = (LAS int*)(F.lds + LDS_CNT);
    LAS int* wt = (LAS int*)(F.lds);
    const int tid = F_TID, lane = tid & 63;
    __syncthreads();
    int n = 0, nt = 0, in_ = 0, it_ = 0;
    if (F.wave < 4) {
        n = __hip_atomic_load(&counts[tid * CNT_STRIDE], __ATOMIC_RELAXED, __HIP_MEMORY_SCOPE_AGENT); nt = (n + 255) >> 8; in_ = n; it_ = nt;
#pragma unroll
        for (int o = 1; o < 64; o <<= 1) { const int a = __shfl_up(in_, o), b = __shfl_up(it_, o); if (lane >= o) { in_ += a; it_ += b; } }
        if (lane == 63) { wt[F.wave] = in_; wt[4 + F.wave] = it_; }
    }
    __syncthreads();
    if (F.wave < 4) {
        for (int w = 0; w < F.wave; ++w) { in_ += wt[w]; it_ += wt[4 + w]; }
        cnt[tid] = n; offs[tid] = in_ - n; pref[tid] = it_ - nt;
        if (tid == NEXP - 1) { offs[NEXP] = in_; pref[NEXP] = it_; }
    }
    __syncthreads();
}

__device__ __forceinline__ void phase_final(const Frame& F, const Args& a) {
    const int gw = F.vcu * 8 + F.wave, NGW = F.G * 8;
    const float* h1 = (const float*)(F.ws + WS_H1); const bf16_t* ys = (const bf16_t*)(F.ws + WS_YS); const bf16_t* yb = (const bf16_t*)(F.ws + WS_YB);
    const int* tok_e = (const int*)(F.ws + WS_TOKE); const int* tok_pos = (const int*)(F.ws + WS_TOKPOS);
    const LAS int* offs = (const LAS int*)(F.lds + LDS_OFFS);
    const float* g = KARG_IN(21); const float* b = KARG_IN(22); float* out = KARG_OUT();
    const int c0 = 8 * F_LANE;
    f32x4 gv[4], bv[4];
    gv[0] = *(const f32x4*)(g + c0); gv[1] = *(const f32x4*)(g + c0 + 4); gv[2] = *(const f32x4*)(g + 512 + c0); gv[3] = *(const f32x4*)(g + 512 + c0 + 4);
    bv[0] = *(const f32x4*)(b + c0); bv[1] = *(const f32x4*)(b + c0 + 4); bv[2] = *(const f32x4*)(b + 512 + c0); bv[3] = *(const f32x4*)(b + 512 + c0 + 4);
    const int lane8 = F_LANE;
    const bf16_t* h1b = (const bf16_t*)(F.ws + WS_H1B); const unsigned char* yb8 = (const unsigned char*)(F.ws + WS_YB);
    int ekn = 0, pkn = 0;
    if (gw < T_TOK && lane8 < 8) { ekn = tok_e[gw * 8 + lane8]; pkn = tok_pos[gw * 8 + lane8]; }
    for (int t = gw; t < T_TOK; t += NGW) {
        const int myrow = lane8 < 8 ? offs[ekn] + pkn : 0;
        const u32x4 r0 = *(const u32x4*)(h1b + (size_t)t * DM + c0), r1 = *(const u32x4*)(h1b + (size_t)t * DM + 512 + c0);
        const u32x4 s0 = *(const u32x4*)(ys + (size_t)t * DM + c0), s1 = *(const u32x4*)(ys + (size_t)t * DM + 512 + c0);
        u32x2 W[8][2];
#pragma unroll
        for (int k = 0; k < 8; ++k) { const unsigned char* src = yb8 + (size_t)__shfl(myrow, k) * 1024; W[k][0] = *(const u32x2*)(src + c0); W[k][1] = *(const u32x2*)(src + 512 + c0); }
        { const int tn = t + NGW; if (tn < T_TOK && lane8 < 8) { ekn = tok_e[tn * 8 + lane8]; pkn = tok_pos[tn * 8 + lane8]; } }
        f32x4 v[4], y[4];
        v[0] = (f32x4){bflo(r0.x), bfhi(r0.x), bflo(r0.y), bfhi(r0.y)}; v[1] = (f32x4){bflo(r0.z), bfhi(r0.z), bflo(r0.w), bfhi(r0.w)};
        v[2] = (f32x4){bflo(r1.x), bfhi(r1.x), bflo(r1.y), bfhi(r1.y)}; v[3] = (f32x4){bflo(r1.z), bfhi(r1.z), bflo(r1.w), bfhi(r1.w)};
#pragma unroll
        for (int j = 0; j < 4; ++j) { v[j] = v[j] * ALPHA_F; y[j] = (f32x4){0.f, 0.f, 0.f, 0.f}; }
        v[0] = v[0] + (f32x4){bflo(s0.x), bfhi(s0.x), bflo(s0.y), bfhi(s0.y)}; v[1] = v[1] + (f32x4){bflo(s0.z), bfhi(s0.z), bflo(s0.w), bfhi(s0.w)};
        v[2] = v[2] + (f32x4){bflo(s1.x), bfhi(s1.x), bflo(s1.y), bfhi(s1.y)}; v[3] = v[3] + (f32x4){bflo(s1.z), bfhi(s1.z), bflo(s1.w), bfhi(s1.w)};
#pragma unroll
        for (int k = 0; k < 8; ++k) { y[0] = y[0] + un4_fp8(W[k][0].x); y[1] = y[1] + un4_fp8(W[k][0].y); y[2] = y[2] + un4_fp8(W[k][1].x); y[3] = y[3] + un4_fp8(W[k][1].y); }
#pragma unroll
        for (int j = 0; j < 4; ++j) v[j] = v[j] + y[j] * (1.0f / YB_SCALE);
        float s = 0.f;
#pragma unroll
        for (int j = 0; j < 4; ++j) s += (v[j][0] + v[j][1]) + (v[j][2] + v[j][3]);
        const float mu = wave_sum(s) * (1.0f / 1024.0f);
        float q = 0.f;
#pragma unroll
        for (int j = 0; j < 4; ++j) { v[j] = v[j] - mu; q += (v[j][0] * v[j][0] + v[j][1] * v[j][1]) + (v[j][2] * v[j][2] + v[j][3] * v[j][3]); }
        const float rs = rsqrtf(wave_sum(q) * (1.0f / 1024.0f) + LN_EPS_F);
        float* o = out + (size_t)t * DM;
#pragma unroll
        for (int j = 0; j < 4; ++j) v[j] = v[j] * rs * gv[j] + bv[j];
        *(f32x4*)(o + c0) = v[0]; *(f32x4*)(o + c0 + 4) = v[1]; *(f32x4*)(o + 512 + c0) = v[2]; *(f32x4*)(o + 512 + c0 + 4) = v[3];
    }
}


namespace xk {
constexpr int B_IMG = 16384, A_SLOT = 16384, L_B0 = 0, L_A0 = 4 * B_IMG, L_GATE = 8 * 16384;
typedef __amdgpu_buffer_rsrc_t rsrc_t;
__device__ __forceinline__ rsrc_t make_rsrc(const void* p) { return __builtin_amdgcn_make_buffer_rsrc((void*)p, 0, 0x7fffffff, 0x00020000); }
__device__ __forceinline__ u32x4 make_srd(const void* p) { const unsigned long long v = (unsigned long long)p; u32x4 d;
    d.x = (unsigned)__builtin_amdgcn_readfirstlane((int)(unsigned)v); d.y = (unsigned)__builtin_amdgcn_readfirstlane((int)(unsigned)(v >> 32)) & 0xffffu; d.z = 0x7fffffffu; d.w = 0x00020000u; return d; }
__device__ __forceinline__ void dma16(const u32x4 srd, unsigned voff, int soff, unsigned lds_addr) {
    asm volatile("s_mov_b32 m0, %0\n\ts_nop 0\n\tbuffer_load_dwordx4 %1, %2, %3 offen lds" :: "s"(lds_addr), "v"(voff), "s"(srd), "s"(soff) : "m0", "memory");
}
__device__ __forceinline__ void a_piece_rc(int b, int& R, int& C) { const int st = b >> 10, sb = b & 1023, ob = sb ^ (((sb >> 9) & 1) << 5); R = st * 16 + (ob >> 6); C = (ob & 63) >> 1; }
struct PassDesc { u32x4 ra; unsigned aoff[2]; rsrc_t rb0, rb1; int bcol, ncol; unsigned boff; int nh; bool preloaded, chain; };
typedef f32x4 Acc[2][4][2][2];

template <bool GU> __device__ __forceinline__ void kloop(LAS unsigned char* lds, const PassDesc& P, const int wid, const int lane, const int bir, Acc& acc, f32x4 (&Br)[4][4]) {
    const int wr = wid >> 2, wc = wid & 3, fr = lane & 15, fq = lane >> 4, hl = lane >> 5;
    const int KB = GU ? 32 * 256 * 4 : 32 * 1024 * 4;
#define XK_DMAA(hh, slot) do { _Pragma("unroll") for (int _i = 0; _i < 2; ++_i) dma16(P.ra, P.aoff[_i], (hh) * 64, (unsigned)(size_t)(lds + L_A0 + (slot) * A_SLOT + _i * 8192 + wid * 1024)); } while (0)
#define XK_LOADB(col, hh, st) do { _Pragma("unroll") for (int _i = 0; _i < 4; ++_i) { \
            const u32x4 _v = GU ? __builtin_amdgcn_raw_buffer_load_b128((_i >> 1) ? P.rb1 : P.rb0, P.boff, (col) + (hh) * KB + (_i & 1) * (2 * 256 * 4), 0) \
                                : __builtin_amdgcn_raw_buffer_load_b128(P.rb0, P.boff, (col) + (hh) * KB + _i * (1024 * 4), 0); \
            Br[st][_i] = __builtin_bit_cast(f32x4, _v); } } while (0)
    const unsigned swg = (unsigned)(((wid >> 1) & 1) << 4);
    unsigned bw0 = (unsigned)(size_t)(lds + L_B0) + (GU ? (4 * wid + hl) * 512 + (bir ^ (hl << 7) ^ swg) : 4 * wid * 512 + (bir ^ swg));
    const int q = (lane & 15) >> 2, p = lane & 3;
    unsigned br0 = (unsigned)(size_t)(lds + L_B0) + (8 * fq + q) * 512 + ((128 * wc + 32 * p) ^ ((q & 1) << 7) ^ (((q >> 1) & 1) << 3) ^ ((fq & 1) << 4));
    const LAS unsigned char* arp = lds + L_A0 + (wr * 4) * 1024 + ((fr * 64 + 16 * fq) ^ ((fr >> 3) << 5));
#define XK_WRITEB(st, img) do { _Pragma("unroll") for (int _i = 0; _i < 4; ++_i) { u32x2 _w; _w.x = cvt_pk_bf16(Br[st][_i][0], Br[st][_i][1]); _w.y = cvt_pk_bf16(Br[st][_i][2], Br[st][_i][3]); \
        if (GU) *(LAS u32x2*)(size_t)((bw0 ^ (unsigned)(((_i >> 1) << 4) | ((_i & 1) << 3))) + (img) * B_IMG + 2 * (_i & 1) * 512) = _w; \
        else *(LAS u32x2*)(size_t)((bw0 ^ (unsigned)(((_i & 1) << 7) | (((_i >> 1) & 1) << 3))) + (img) * B_IMG + _i * 512) = _w; } } while (0)
#define XK_FRAGS(slot, img) do { \
        _Pragma("unroll") for (int gI = 0; gI < 2; ++gI) _Pragma("unroll") for (int nn = 0; nn < 2; ++nn) { \
            const LAS unsigned char* _a = (const LAS unsigned char*)(size_t)((br0 ^ (unsigned)(16 * gI + 8 * nn)) + (img) * B_IMG); \
            const s16x4 _lo = __builtin_amdgcn_ds_read_tr16_b64_v4i16((LAS s16x4*)_a), _hi = __builtin_amdgcn_ds_read_tr16_b64_v4i16((LAS s16x4*)(_a + 2048)); \
            wf[gI][nn] = (bf16x8){_lo[0], _lo[1], _lo[2], _lo[3], _hi[0], _hi[1], _hi[2], _hi[3]}; } \
        _Pragma("unroll") for (int ai = 0; ai < 2; ++ai) _Pragma("unroll") for (int m = 0; m < 4; ++m) xf[ai][m] = *(const LAS bf16x8*)(arp + (slot) * A_SLOT + (8 * ai + m) * 1024); } while (0)
#define XK_MMA() do { __builtin_amdgcn_s_setprio(1); \
        _Pragma("unroll") for (int ai = 0; ai < 2; ++ai) _Pragma("unroll") for (int m = 0; m < 4; ++m) _Pragma("unroll") for (int gI = 0; gI < 2; ++gI) _Pragma("unroll") for (int nn = 0; nn < 2; ++nn) \
            acc[ai][m][gI][nn] = __builtin_amdgcn_mfma_f32_16x16x32_bf16(wf[gI][nn], xf[ai][m], acc[ai][m][gI][nn], 0, 0, 0); \
        __builtin_amdgcn_s_setprio(0); } while (0)
    bf16x8 wf[2][2], xf[2][4];
    const int nh = P.nh;
    if (!P.preloaded) {
        XK_LOADB(P.bcol, 0, 0); XK_LOADB(P.bcol, 1, 1); XK_LOADB(P.bcol, 2, 2); XK_DMAA(0, 0); XK_DMAA(1, 1);
        XK_WRITEB(0, 0);
        asm volatile("s_waitcnt vmcnt(0)" ::: "memory");
        __syncthreads();
    }
    const int tcol = P.chain ? P.ncol : P.bcol;
    if (wid >= 4) __builtin_amdgcn_s_barrier();
#define XK_ITER(j) do { const int _h = hb + (j); asm volatile("" : "+v"(bw0), "+v"(br0));     \
        { const bool _in2 = _h + 2 < nh; XK_DMAA(_in2 ? _h + 2 : _h + 2 - nh, ((j) + 2) & 3); \
          const bool _in3 = _h + 3 < nh; XK_LOADB(_in3 ? P.bcol : tcol, _in3 ? _h + 3 : _h + 3 - nh, ((j) + 3) & 3); } \
        XK_WRITEB(((j) + 1) & 3, ((j) + 1) & 3); \
        XK_FRAGS((j), (j));        \
        asm volatile("s_waitcnt vmcnt(10)" ::: "memory");     \
        asm volatile("s_waitcnt lgkmcnt(0)" ::: "memory"); __builtin_amdgcn_sched_barrier(0); __builtin_amdgcn_s_barrier(); __builtin_amdgcn_sched_barrier(0); \
        XK_MMA(); \
        __builtin_amdgcn_sched_barrier(0); __builtin_amdgcn_s_barrier(); __builtin_amdgcn_sched_barrier(0); } while (0)
    for (int hb = 0; hb < nh; hb += 4) { XK_ITER(0); XK_ITER(1); XK_ITER(2); XK_ITER(3); }
    if (wid < 4) __builtin_amdgcn_s_barrier();
#undef XK_ITER
#undef XK_DMAA
#undef XK_LOADB
#undef XK_WRITEB
#undef XK_FRAGS
#undef XK_MMA
}
}

__device__ __forceinline__ void phase_experts(const Frame& F, const Args& a, const int mode) {
    build_tables(F);
    const int wid = F.wave, wr = wid >> 2, wc = wid & 3;
    const LAS int* pref = (const LAS int*)(F.lds + LDS_PREF);
    const int U = __builtin_amdgcn_readfirstlane(pref[NEXP]);
    const int* lists = (const int*)(F.ws + WS_LISTS); const float* tok_gate = (const float*)(F.ws + WS_TOKGATE);
    const char* h1b = (const char*)(F.ws + WS_H1B); bf16_t* H = (bf16_t*)(F.ws + WS_H); bf16_t* YB = (bf16_t*)(F.ws + WS_YB);
    f32x4 Br[4][4];
    for (int ui = 0;; ++ui) {
        int L = ui * F.G + blockIdx.x; if (L >= U) break;
        { const int qq = U / 8, rr = U % 8, xcd = L % 8, off = L / 8; L = (xcd < rr ? xcd * (qq + 1) : rr * (qq + 1) + (xcd - rr) * qq) + off; }
        int lo = 0, hi = NEXP;
        while (hi - lo > 1) { const int mid = (lo + hi) >> 1; const int pv = __builtin_amdgcn_readfirstlane(pref[mid]); if (pv <= L) lo = mid; else hi = mid; }
        const int e = lo, mt = L - __builtin_amdgcn_readfirstlane(pref[e]);
        const int n = __builtin_amdgcn_readfirstlane(((const LAS int*)(F.lds + LDS_CNT))[e]);
        const int rows = (n - mt * 256) < 256 ? (n - mt * 256) : 256;
        const int slot0 = __builtin_amdgcn_readfirstlane(((const LAS int*)(F.lds + LDS_OFFS))[e]) + mt * 256;
        const int* lst = lists + (size_t)e * LIST_CAP + mt * 256;
        const int ew = (mode & 1) ? 0 : e;
        const float* Wg = KARG_IN(15) + (size_t)ew * 1024 * 256; const float* Wu = KARG_IN(16) + (size_t)ew * 1024 * 256; const float* Wd = KARG_IN(17) + (size_t)ew * 256 * 1024;
        {
            xk::PassDesc P; P.ra = xk::make_srd(h1b);
            { const int lane = lane_id(), tid = wid * 64 + lane;
#pragma unroll
              for (int i = 0; i < 2; ++i) { int R, C; xk::a_piece_rc(tid * 16 + i * 8192, R, C); int tok = 0; if (R < rows) tok = lst[R] >> 3; if (mode & 2) tok = (slot0 + R) & 16383; P.aoff[i] = (unsigned)(tok * 1024 + C) * 2u; }
              P.boff = (unsigned)((4 * wid + (lane >> 5)) * 256 + 4 * (lane & 31)) * 4u; }
            P.nh = 32; P.rb0 = xk::make_rsrc(Wg); P.rb1 = xk::make_rsrc(Wu);
#pragma unroll 1
            for (int pn = 0; pn < 2; ++pn) {
                P.bcol = pn * 128 * 4; P.ncol = 128 * 4;
                P.preloaded = pn == 1; P.chain = pn == 0;
                xk::Acc acc;
#pragma unroll
                for (int ai = 0; ai < 2; ++ai)
#pragma unroll
                    for (int m = 0; m < 4; ++m)
#pragma unroll
                        for (int gI = 0; gI < 2; ++gI)
#pragma unroll
                            for (int nn = 0; nn < 2; ++nn) acc[ai][m][gI][nn] = (f32x4){0.f, 0.f, 0.f, 0.f};
                { const int lane = lane_id(); xk::kloop<true>(F.lds, P, wid, lane, 128 * ((lane & 31) >> 3) + 32 * (((lane & 31) >> 1) & 3) + 8 * (lane & 1), acc, Br); }
                const int lane = lane_id(), fr = lane & 15, fq = lane >> 4;
                const xk::rsrc_t rH = xk::make_rsrc(H + (size_t)slot0 * 256);
#pragma unroll
                for (int ai = 0; ai < 2; ++ai)
#pragma unroll
                    for (int m = 0; m < 4; ++m) { const int r = ai * 128 + wr * 64 + m * 16 + fr;
                        if (r < rows && !(mode & 4) && !(mode & 16)) { float h[8];
#pragma unroll
                            for (int nn = 0; nn < 2; ++nn)
#pragma unroll
                                for (int j = 0; j < 4; ++j) h[nn * 4 + j] = siluf(acc[ai][m][0][nn][j]) * acc[ai][m][1][nn][j];
                            u32x4 w; w.x = cvt_pk_bf16(h[0], h[1]); w.y = cvt_pk_bf16(h[2], h[3]); w.z = cvt_pk_bf16(h[4], h[5]); w.w = cvt_pk_bf16(h[6], h[7]);
                            __builtin_amdgcn_raw_buffer_store_b128(w, rH, (unsigned)(r * 256 + pn * 128 + wc * 32 + 8 * fq) * 2u, 0, 0); } }
            }
        }
        { const int t = wid * 64 + lane_id();
          if (t < 256) ((LAS float*)(F.lds + xk::L_GATE))[t] = t < rows ? tok_gate[lst[t]] : 0.f; }
        asm volatile("s_waitcnt vmcnt(0)" ::: "memory");
        __syncthreads();
        {
            xk::PassDesc P; P.ra = xk::make_srd(H + (size_t)slot0 * 256);
            { const int lane = lane_id(), tid = wid * 64 + lane;
#pragma unroll
              for (int i = 0; i < 2; ++i) { int R, C; xk::a_piece_rc(tid * 16 + i * 8192, R, C); P.aoff[i] = (unsigned)(R * 256 + C) * 2u; }
              P.boff = (unsigned)(4 * wid * 1024 + 4 * lane) * 4u; }
            P.nh = 8; P.rb0 = xk::make_rsrc(Wd); P.rb1 = P.rb0;
#pragma unroll 1
            for (int pn = 0; pn < 4; ++pn) {
                P.bcol = pn * 256 * 4; P.ncol = (pn + 1) * 256 * 4;
                P.preloaded = pn > 0; P.chain = pn < 3;
                xk::Acc acc;
#pragma unroll
                for (int ai = 0; ai < 2; ++ai)
#pragma unroll
                    for (int m = 0; m < 4; ++m)
#pragma unroll
                        for (int gI = 0; gI < 2; ++gI)
#pragma unroll
                            for (int nn = 0; nn < 2; ++nn) acc[ai][m][gI][nn] = (f32x4){0.f, 0.f, 0.f, 0.f};
                { const int lane = lane_id(); xk::kloop<false>(F.lds, P, wid, lane, 8 * lane, acc, Br); }
                const int lane = lane_id(), fr = lane & 15, fq = lane >> 4;
                const xk::rsrc_t rY = xk::make_rsrc((const unsigned char*)YB + (size_t)slot0 * 1024);
#pragma unroll
                for (int ai = 0; ai < 2; ++ai)
#pragma unroll
                    for (int m = 0; m < 4; ++m) { const int r = ai * 128 + wr * 64 + m * 16 + fr;
                        if (r < rows && !(mode & 4) && !(mode & 8)) { const float g = ((const LAS float*)(F.lds + xk::L_GATE))[r] * YB_SCALE;
                            u32x4 w; w.x = pk4_fp8(acc[ai][m][0][0] * g); w.y = pk4_fp8(acc[ai][m][0][1] * g); w.z = pk4_fp8(acc[ai][m][1][0] * g); w.w = pk4_fp8(acc[ai][m][1][1] * g);
                            __builtin_amdgcn_raw_buffer_store_b128(w, rY, (unsigned)(r * 1024 + pn * 256 + 64 * wc + 16 * fq), 0, 0); } }
            }
        }
        __syncthreads();
    }
}

__device__ __forceinline__ float ldp(const bf16_t* p, size_t t, int c) { return bf2f(p[t * PW + c]); }
__device__ __forceinline__ void phase_m1(const Frame& F, const Args& a) {
  const bf16_t* p = (const bf16_t*)(F.ws + WS_P); const float* dtraw = (const float*)(F.ws + WS_DTRAW);
  const float* conv_w = KARG_IN(2); const float* conv_b = KARG_IN(3); const float* dt_bias = KARG_IN(4); const float* lb_logits = KARG_IN(8);
  float* xbc = (float*)(F.ws + WS_NXBC); float* fgk = (float*)(F.ws + WS_NFGK); float* qs = (float*)(F.ws + WS_NQS); float* dtb = (float*)(F.ws + WS_NDTB);
  const int tid = F_TID;
  for (int t = blockIdx.x; t < T_TOK; t += F.G) {
    for (int c = tid; c < 1024; c += 512) {
      float acc = conv_b[c];
#pragma unroll
      for (int j = 0; j < 4; ++j) { const int tt = t - 3 + j; if (tt >= 0) acc = fmaf(conv_w[j * 1024 + c], ldp(p, tt, PC_XBC + c), acc); }
      xbc[(size_t)t * 1024 + c] = siluf(acc);
    }
    { const int c = tid;
      const float l0 = lb_logits[c], l1 = lb_logits[512 + c];
      const float mx = fmaxf(l0, l1);
      const float e0 = expf(l0 - mx), e1 = expf(l1 - mx);
      const float lb = e0 / (e0 + e1);
      const float f = ldp(p, t, PC_F + c);
      fgk[(size_t)t * 512 + c] = lb + (1.0f - lb) * (1.0f / (1.0f + expf(-f)));
      const float q = ldp(p, t, PC_Q + c);
      qs[(size_t)t * 512 + c] = q / (1.0f + expf(-q)); }
    if (tid < 8) { const float v = dtraw[t * 8 + tid] + dt_bias[tid]; dtb[t * 8 + tid] = v > 20.f ? v : log1pf(expf(v)); }
  }
}
__device__ __forceinline__ void phase_m2(const Frame& F, const Args& a) {
  const int item = F.wave * F.G + blockIdx.x, lane = F_LANE;
  const float* xbc = (const float*)(F.ws + WS_NXBC); const float* dtb = (const float*)(F.ws + WS_NDTB);
  const float* fgk = (const float*)(F.ws + WS_NFGK); const float* qs = (const float*)(F.ws + WS_NQS); const bf16_t* p = (const bf16_t*)(F.ws + WS_P);
  float* y_ssd = (float*)(F.ws + WS_NYSSD); float* o_h = (float*)(F.ws + WS_NOH);
  if (item < 512) {
    const int h = item >> 6, pp = item & 63, g = h >> 2;
    const float aa = -expf(KARG_IN(5)[h]), D = KARG_IN(6)[h];
    float h0 = 0.f, h1 = 0.f;
    const float* xp = xbc + h * 64 + pp; const float* Bp = xbc + 512 + g * 128 + lane; const float* Cp = xbc + 768 + g * 128 + lane;
    for (int t0 = 0; t0 < T_TOK; t0 += 8) {
      float Bv0[8], Bv1[8], Cv0[8], Cv1[8], xv[8], dv[8];
#pragma unroll
      for (int i = 0; i < 8; ++i) { const size_t o = (size_t)(t0 + i) * 1024;
        Bv0[i] = Bp[o]; Bv1[i] = Bp[o + 64]; Cv0[i] = Cp[o]; Cv1[i] = Cp[o + 64]; xv[i] = xp[o]; dv[i] = dtb[(t0 + i) * 8 + h]; }
#pragma unroll
      for (int i = 0; i < 8; ++i) {
        const float dA = expf(dv[i] * aa), dx = dv[i] * xv[i];
        h0 = fmaf(dA, h0, dx * Bv0[i]); h1 = fmaf(dA, h1, dx * Bv1[i]);
        float part = wave_sum(Cv0[i] * h0 + Cv1[i] * h1);
        if (lane == 0) y_ssd[(size_t)(t0 + i) * 512 + h * 64 + pp] = part + D * xv[i];
      }
    }
  } else if (item < 1024) {
    const int it = item - 512, h = it >> 7, e = it & 127;
    float S0 = 0.f, S1 = 0.f;
    const float* fp = fgk + h * 128 + lane; const float* qp = qs + h * 128 + lane;
    for (int t0 = 0; t0 < T_TOK; t0 += 8) {
      float f0[8], f1[8], q0[8], q1[8], iv[8];
#pragma unroll
      for (int i = 0; i < 8; ++i) { const size_t o = (size_t)(t0 + i) * 512;
        f0[i] = fp[o]; f1[i] = fp[o + 64]; q0[i] = qp[o]; q1[i] = qp[o + 64]; iv[i] = ldp(p, t0 + i, PC_I + h * 128 + e); }
#pragma unroll
      for (int i = 0; i < 8; ++i) {
        S0 = fmaf(f0[i], S0, (1.0f - f0[i]) * iv[i]); S1 = fmaf(f1[i], S1, (1.0f - f1[i]) * iv[i]);
        float part = wave_sum(q0[i] * S0 + q1[i] * S1);
        if (lane == 0) o_h[(size_t)(t0 + i) * 512 + h * 128 + e] = part;
      }
    }
  }
}
__device__ __forceinline__ void phase_m3(const Frame& F, const Args& a) {
  const int gw = F.vcu * 8 + F.wave, NGW = F.G * 8, lane = F_LANE;
  const float* y_ssd = (const float*)(F.ws + WS_NYSSD); const float* o_h = (const float*)(F.ws + WS_NOH); const bf16_t* p = (const bf16_t*)(F.ws + WS_P);
  const float* snw = KARG_IN(7); const float* hnw = KARG_IN(9); bf16_t* mix = (bf16_t*)(F.ws + WS_MIX);
  for (int idx = gw; idx < T_TOK * 2; idx += NGW) {
    const int t = idx >> 1, g = idx & 1;
    float v[4]; float ss = 0.f;
#pragma unroll
    for (int j = 0; j < 4; ++j) { const int c = g * 256 + lane + 64 * j; v[j] = y_ssd[(size_t)t * 512 + c] * siluf(ldp(p, t, PC_Z + c)); ss += v[j] * v[j]; }
    ss = wave_sum(ss);
    const float r = rsqrtf(ss * (1.0f / 256.0f) + RMS_EPS_F);
#pragma unroll
    for (int j = 0; j < 4; ++j) { const int c = g * 256 + lane + 64 * j; mix[(size_t)t * 1024 + c] = (bf16_t)(cvt_pk_bf16(v[j] * r * snw[c], 0.f) & 0xffffu); }
  }
  for (int idx = gw; idx < T_TOK * 4; idx += NGW) {
    const int t = idx >> 2, h = idx & 3;
    float v[2]; float ss = 0.f;
#pragma unroll
    for (int j = 0; j < 2; ++j) { const int c = h * 128 + lane + 64 * j; v[j] = o_h[(size_t)t * 512 + c]; ss += v[j] * v[j]; }
    ss = wave_sum(ss);
    const float r = rsqrtf(ss * (1.0f / 128.0f) + RMS_EPS_F);
#pragma unroll
    for (int j = 0; j < 2; ++j) { const int c = h * 128 + lane + 64 * j;
      mix[(size_t)t * 1024 + 512 + c] = (bf16_t)(cvt_pk_bf16(v[j] * r * hnw[c] * siluf(ldp(p, t, PC_G + c)), 0.f) & 0xffffu); }
  }
}


#define MFMA32(a, b, c) __builtin_amdgcn_mfma_f32_32x32x16_bf16((a), (b), (c), 0, 0, 0)
__device__ __forceinline__ int drow(int r, int lane) { return (r & 3) + 8 * (r >> 2) + 4 * (lane >> 5); }
__device__ __forceinline__ bf16x8 frag_row(const LAS unsigned char* base, int pitch, int row0, int k0, int lane) {
    return *(const LAS bf16x8*)(base + (row0 + (lane & 31)) * pitch + (k0 + 8 * (lane >> 5)) * 2);
}
template <bool PERM> __device__ __forceinline__ bf16x8 frag_tr(const LAS unsigned char* base, int pitch, int k0, int col0, int lane) {
    const int h = lane >> 5, blk = (lane >> 4) & 1, q = (lane & 15) >> 2, p = lane & 3;
    const LAS unsigned char* a0 = base + (k0 + (PERM ? 4 : 8) * h + q) * pitch + (col0 + 16 * blk + 4 * p) * 2;
    const s16x4 lo = __builtin_amdgcn_ds_read_tr16_b64_v4i16((LAS s16x4*)a0);
    const s16x4 hi = __builtin_amdgcn_ds_read_tr16_b64_v4i16((LAS s16x4*)(a0 + (PERM ? 8 : 4) * pitch));
    return (bf16x8){lo[0], lo[1], lo[2], lo[3], hi[0], hi[1], hi[2], hi[3]};
}
__device__ __forceinline__ bf16x8 acc_frag(const f32x16& x, int s) {
    u32x4 w; w.x = cvt_pk_bf16(x[8 * s + 0], x[8 * s + 1]); w.y = cvt_pk_bf16(x[8 * s + 2], x[8 * s + 3]); w.z = cvt_pk_bf16(x[8 * s + 4], x[8 * s + 5]); w.w = cvt_pk_bf16(x[8 * s + 6], x[8 * s + 7]);
    return __builtin_bit_cast(bf16x8, w);
}
__device__ __forceinline__ float softplusf(float v) { return v > 20.f ? v : log1pf(__expf(v)); }
__device__ __forceinline__ unsigned short f2bf1(float v) { return (unsigned short)(cvt_pk_bf16(v, 0.f) & 0xffffu); }
__device__ __forceinline__ float half_sum(float v) {
    v += dpp_f<0xB1>(v); v += dpp_f<0x4E>(v); v += dpp_f<0x141>(v); v += dpp_f<0x140>(v);
    float a = v, b = v;
    asm volatile("s_nop 1\n\tv_permlane16_swap_b32 %0, %1" : "+v"(a), "+v"(b));
    return a + b;
}

constexpr int SX_PITCH = 576, SB_TR_PITCH = 320, SB_ROW_PITCH = 272;
constexpr int SL_X = 0, SL_B = 128 * SX_PITCH  , SL_C = SL_B + 128 * SB_TR_PITCH  ;
constexpr int SL_DT = 151552, SL_ACUM = SL_DT + 2048, SL_SSQ = SL_ACUM + 2048;
static_assert(SL_C + 128 * SB_ROW_PITCH <= SL_DT && SL_SSQ + 1024 <= LDS_PHASE_BYTES, "SSD LDS map");
constexpr int HL_QD = 0, HL_QP = 64 * 272, HL_KP = 2 * 64 * 272, HL_V = 3 * 64 * 272  , HL_KD = HL_V + 64 * 320  , HL_SEG = HL_KD + 64 * 320  , HL_SSQ = HL_SEG + 4096;
static_assert(HL_SSQ + 1024 <= LDS_PHASE_BYTES, "HGRN LDS map");

__device__ __forceinline__ void ssd_dt_acum(const Frame& F, const Args& a, int c, int g) {
    if (F.wave < 4) {
        const int hh = g * 4 + F.wave, lane = F_LANE; const float* dtraw = (const float*)(F.ws + WS_DTRAW);
        const float bias = KARG_IN(4)[hh], aa = -__expf(KARG_IN(5)[hh]);
        const int t = c * 128 + 2 * lane;
        const float d0 = softplusf(dtraw[(size_t)t * 8 + hh] + bias), d1 = softplusf(dtraw[(size_t)(t + 1) * 8 + hh] + bias);
        const float a0 = d0 * aa, a1 = d1 * aa;
        float incl = a0 + a1;
#pragma unroll
        for (int o = 1; o < 64; o <<= 1) { const float v = __shfl_up(incl, o); if (lane >= o) incl += v; }
        LAS float* dts = (LAS float*)(F.lds + SL_DT) + F.wave * 128; LAS float* acs = (LAS float*)(F.lds + SL_ACUM) + F.wave * 128;
        dts[2 * lane] = d0; dts[2 * lane + 1] = d1; acs[2 * lane] = incl - a1; acs[2 * lane + 1] = incl;
    }
}
__device__ __forceinline__ void ssd_conv_item(const Frame& F, const Args& a, int c, int src_ch, int seg, int hl, int mode, LAS unsigned char* dst, int pitch, int dst_col) {
    const bf16_t* p = (const bf16_t*)(F.ws + WS_P) + PC_XBC + src_ch;
    const float* cw = KARG_IN(2) + src_ch; const float* cb = KARG_IN(3) + src_ch;
    float w[4][8], bias[8];
#pragma unroll
    for (int j = 0; j < 4; ++j) { const f32x4 x0 = *(const f32x4*)(cw + j * 1024), x1 = *(const f32x4*)(cw + j * 1024 + 4);
        w[j][0] = x0[0]; w[j][1] = x0[1]; w[j][2] = x0[2]; w[j][3] = x0[3]; w[j][4] = x1[0]; w[j][5] = x1[1]; w[j][6] = x1[2]; w[j][7] = x1[3]; }
    { const f32x4 x0 = *(const f32x4*)cb, x1 = *(const f32x4*)(cb + 4); bias[0] = x0[0]; bias[1] = x0[1]; bias[2] = x0[2]; bias[3] = x0[3]; bias[4] = x1[0]; bias[5] = x1[1]; bias[6] = x1[2]; bias[7] = x1[3]; }
    const int l0 = seg * 16, t0 = c * 128 + l0;
    u32x4 rw[19];
#pragma unroll
    for (int j = 0; j < 19; ++j) { const int tt = t0 - 3 + j; rw[j] = tt >= 0 ? *(const u32x4*)(p + (size_t)tt * PW) : (u32x4){0u, 0u, 0u, 0u}; }
    const LAS float* dts = (const LAS float*)(F.lds + SL_DT) + hl * 128; const LAS float* acs = (const LAS float*)(F.lds + SL_ACUM) + hl * 128;
    const float alast = acs[127];
#pragma unroll
    for (int i = 0; i < 16; ++i) {
        float v[8];
#pragma unroll
        for (int k = 0; k < 4; ++k) {
            const unsigned r0 = rw[i][k], r1 = rw[i + 1][k], r2 = rw[i + 2][k], r3 = rw[i + 3][k];
            v[2 * k] = siluf(fmaf(w[3][2 * k], bflo(r3), fmaf(w[2][2 * k], bflo(r2), fmaf(w[1][2 * k], bflo(r1), fmaf(w[0][2 * k], bflo(r0), bias[2 * k])))));
            v[2 * k + 1] = siluf(fmaf(w[3][2 * k + 1], bfhi(r3), fmaf(w[2][2 * k + 1], bfhi(r2), fmaf(w[1][2 * k + 1], bfhi(r1), fmaf(w[0][2 * k + 1], bfhi(r0), bias[2 * k + 1])))));
        }
        float sc = 1.f;
        if (mode >= 1) sc = dts[l0 + i];
        if (mode == 2) sc *= __expf(alast - acs[l0 + i]);
        u32x4 o; o.x = cvt_pk_bf16(v[0] * sc, v[1] * sc); o.y = cvt_pk_bf16(v[2] * sc, v[3] * sc); o.z = cvt_pk_bf16(v[4] * sc, v[5] * sc); o.w = cvt_pk_bf16(v[6] * sc, v[7] * sc);
        *(LAS u32x4*)(dst + (l0 + i) * pitch + dst_col * 2) = o;
    }
}

__device__ __forceinline__ void ssd_states_unit(const Frame& F, const Args& a, int c, int g) {
    const int tid = F_TID, lane = F_LANE;
    __syncthreads();
    ssd_dt_acum(F, a, c, g);
    __syncthreads();
    { const int cg = tid & 63, seg = tid >> 6; const bool isx = cg < 32;
      if (cg < 48) ssd_conv_item(F, a, c, isx ? g * 256 + cg * 8 : 512 + g * 128 + (cg - 32) * 8, seg, isx ? (cg >> 3) : 0, isx ? 2 : 0,
                                 F.lds + (isx ? SL_X : SL_B), isx ? SX_PITCH : SB_TR_PITCH, isx ? cg * 8 : (cg - 32) * 8); }
    __syncthreads();
    const int hl = F.wave >> 1, pt = F.wave & 1, hh = g * 4 + hl;
    f32x16 S[4];
#pragma unroll
    for (int nt = 0; nt < 4; ++nt)
#pragma unroll
        for (int r = 0; r < 16; ++r) S[nt][r] = 0.f;
#pragma unroll 2
    for (int ks = 0; ks < 8; ++ks) {
        const bf16x8 A = frag_tr<false>(F.lds + SL_X, SX_PITCH, 16 * ks, hl * 64 + 32 * pt, lane);
#pragma unroll
        for (int nt = 0; nt < 4; ++nt) { const bf16x8 B = frag_tr<false>(F.lds + SL_B, SB_TR_PITCH, 16 * ks, 32 * nt, lane); S[nt] = MFMA32(A, B, S[nt]); }
    }
    float* st = (float*)(F.ws + WS_SSTATE) + ((size_t)(c * 8 + hh) * 64 + 32 * pt) * 128;
#pragma unroll
    for (int nt = 0; nt < 4; ++nt)
#pragma unroll
        for (int r = 0; r < 16; ++r) st[(size_t)drow(r, lane) * 128 + 32 * nt + (lane & 31)] = S[nt][r];
    if (tid < 4) ((float*)(F.ws + WS_CDECAY))[c * 8 + g * 4 + tid] = __expf(((const LAS float*)(F.lds + SL_ACUM))[tid * 128 + 127]);
}

__device__ __forceinline__ void ssd_out_unit(const Frame& F, const Args& a, int c, int g, const int xm = 0) {
    const int lane = F_LANE;
    __syncthreads();
    ssd_dt_acum(F, a, c, g);
    __syncthreads();
    if (!(xm & 4)) { const int tid = F_TID, cg = tid & 63, seg = tid >> 6; const bool isx = cg < 32, isb = cg < 48;
      ssd_conv_item(F, a, c, isx ? g * 256 + cg * 8 : (isb ? 512 + g * 128 + (cg - 32) * 8 : 768 + g * 128 + (cg - 48) * 8), seg, isx ? (cg >> 3) : 0, isx ? 1 : 0,
                    F.lds + (isx ? SL_X : (isb ? SL_B : SL_C)), isx ? SX_PITCH : SB_ROW_PITCH, isx ? cg * 8 : (isb ? (cg - 32) * 8 : (cg - 48) * 8)); }
    const int lt = F.wave >> 1, hp = F.wave & 1;
    const int lcol = 32 * lt + (lane & 31);
    bf16x8 Bsv[2][2][8];
#pragma unroll
    for (int hi = 0; hi < 2; ++hi) {
        const bf16_t* sp = (const bf16_t*)(F.ws + WS_SPREV) + (size_t)(c * 8 + g * 4 + hp * 2 + hi) * 64 * 128 + (size_t)(lane & 31) * 128 + 8 * (lane >> 5);
#pragma unroll
        for (int pt = 0; pt < 2; ++pt)
#pragma unroll
            for (int ks = 0; ks < 8; ++ks) Bsv[hi][pt][ks] = *(const bf16x8*)(sp + (size_t)(32 * pt) * 128 + 16 * ks);
    }
    __syncthreads();
    f32x16 acc[2][2];
#pragma unroll
    for (int hi = 0; hi < 2; ++hi)
#pragma unroll
        for (int pt = 0; pt < 2; ++pt)
#pragma unroll
            for (int r = 0; r < 16; ++r) acc[hi][pt][r] = 0.f;
    if (!(xm & 8))
#pragma unroll
    for (int hi = 0; hi < 2; ++hi) {
        const int hl = hp * 2 + hi;
#pragma unroll
        for (int ks = 0; ks < 8; ++ks) {
            const bf16x8 A = frag_row(F.lds + SL_C, SB_ROW_PITCH, 32 * lt, 16 * ks, lane);
#pragma unroll
            for (int pt = 0; pt < 2; ++pt) acc[hi][pt] = MFMA32(A, Bsv[hi][pt][ks], acc[hi][pt]);
        }
        const LAS float* acs = (const LAS float*)(F.lds + SL_ACUM) + hl * 128;
#pragma unroll
        for (int r = 0; r < 16; ++r) { const float e = __expf(acs[32 * lt + drow(r, lane)]); acc[hi][0][r] *= e; acc[hi][1][r] *= e; }
    }
    unsigned short zv[2][2][16];
    { const bf16_t* pz = (const bf16_t*)(F.ws + WS_P) + (size_t)(c * 128 + 32 * lt) * PW + PC_Z + g * 256 + hp * 128 + (lane & 31);
#pragma unroll
      for (int hi = 0; hi < 2; ++hi)
#pragma unroll
        for (int pt = 0; pt < 2; ++pt)
#pragma unroll
            for (int r = 0; r < 16; ++r) zv[hi][pt][r] = pz[(size_t)drow(r, lane) * PW + hi * 64 + 32 * pt]; }
    float dskip[2]; { const float* dsp = KARG_IN(6); dskip[0] = dsp[g * 4 + hp * 2]; dskip[1] = dsp[g * 4 + hp * 2 + 1]; }
#pragma unroll 1
    for (int st = (xm & 16) ? lt + 1 : 0; st <= lt; ++st) {
        f32x16 GT;
#pragma unroll
        for (int r = 0; r < 16; ++r) GT[r] = 0.f;
#pragma unroll 2
        for (int ks = 0; ks < 8; ++ks) {
            const bf16x8 A = frag_row(F.lds + SL_B, SB_ROW_PITCH, 32 * st, 16 * ks, lane), B = frag_row(F.lds + SL_C, SB_ROW_PITCH, 32 * lt, 16 * ks, lane);
            GT = MFMA32(A, B, GT);
        }
#pragma unroll
        for (int hi = 0; hi < 2; ++hi) {
            const int hl = hp * 2 + hi, hh = g * 4 + hl;
            const LAS float* dts = (const LAS float*)(F.lds + SL_DT) + hl * 128; const LAS float* acs = (const LAS float*)(F.lds + SL_ACUM) + hl * 128;
            const float al = acs[lcol], dsk = dskip[hi] * __builtin_amdgcn_rcpf(dts[lcol]);
            f32x16 M; float av[16];
#pragma unroll
            for (int r = 0; r < 16; ++r) av[r] = acs[32 * st + drow(r, lane)];
#pragma unroll
            for (int r = 0; r < 16; ++r) { const int srow = 32 * st + drow(r, lane);
                const float e = __expf(fminf(al - av[r], 0.f));
                M[r] = GT[r] * e * (srow <= lcol ? 1.f : 0.f) + (srow == lcol ? dsk : 0.f); }
#pragma unroll
            for (int s2 = 0; s2 < 2; ++s2) { const bf16x8 A = acc_frag(M, s2);
#pragma unroll
                for (int pt = 0; pt < 2; ++pt) { const bf16x8 B = frag_tr<true>(F.lds + SL_X, SX_PITCH, 32 * st + 16 * s2, hl * 64 + 32 * pt, lane); acc[hi][pt] = MFMA32(A, B, acc[hi][pt]); } }
        }
    }
    float ssq[16];
#pragma unroll
    for (int r = 0; r < 16; ++r) ssq[r] = 0.f;
    if (!(xm & 32)) {
#pragma unroll
        for (int hi = 0; hi < 2; ++hi)
#pragma unroll
            for (int pt = 0; pt < 2; ++pt)
#pragma unroll
                for (int r = 0; r < 16; ++r) { const float z = bf2f(zv[hi][pt][r]);
                    const float y = acc[hi][pt][r] * siluf(z); acc[hi][pt][r] = y; ssq[r] += y * y; }
    }
    LAS float* ssqs = (LAS float*)(F.lds + SL_SSQ);
#pragma unroll
    for (int r = 0; r < 16; ++r) ssq[r] = half_sum(ssq[r]);
    if ((lane & 31) == 0) {
#pragma unroll
        for (int r = 0; r < 16; ++r) ssqs[F.wave * 32 + drow(r, lane)] = ssq[r]; }
    __syncthreads();
    const float* nw = KARG_IN(7) + g * 256 + hp * 128 + (lane & 31);
#pragma unroll
    for (int r = 0; r < 16; ++r) { const int row = drow(r, lane);
        const float rs = rsqrtf((ssqs[F.wave * 32 + row] + ssqs[(F.wave ^ 1) * 32 + row]) * (1.0f / 256.0f) + RMS_EPS_F);
#pragma unroll
        for (int hi = 0; hi < 2; ++hi)
#pragma unroll
            for (int pt = 0; pt < 2; ++pt) *(LAS unsigned short*)(F.lds + SL_X + (32 * lt + row) * 528 + (hp * 128 + hi * 64 + 32 * pt + (lane & 31)) * 2) = f2bf1(acc[hi][pt][r] * rs * nw[hi * 64 + 32 * pt]); }
    __syncthreads();
    { const int tid = F_TID; bf16_t* mo = (bf16_t*)(F.ws + WS_MIX) + (size_t)(c * 128) * DM + g * 256;
#pragma unroll
      for (int i = 0; i < 8; ++i) { const int pc = tid + 512 * i, row = pc >> 5, ch = (pc & 31) * 8;
          *(u32x4*)(mo + (size_t)row * DM + ch) = *(const LAS u32x4*)(F.lds + SL_X + row * 528 + ch * 2); } }
}

struct HgrnLocal { float fg[8][2], cum[8][2], qv[8][2], iv[8][2], tot[2], mid[2]; };
struct HgrnRaw { unsigned fw[8], iw[8], qw[8]; };
template <bool NEEDQ> __device__ __forceinline__ void hgrn_fetch(const Frame& F, int c, int h, HgrnRaw& R) {
    const int tid = F_TID, cp = tid & 63, seg = tid >> 6, d0 = 2 * cp;
    const bf16_t* p = (const bf16_t*)(F.ws + WS_P) + (size_t)(c * 64 + seg * 8) * PW + h * 128 + d0;
#pragma unroll
    for (int i = 0; i < 8; ++i) { R.fw[i] = *(const unsigned*)(p + (size_t)i * PW + PC_F); R.iw[i] = *(const unsigned*)(p + (size_t)i * PW + PC_I);
        if (NEEDQ) R.qw[i] = *(const unsigned*)(p + (size_t)i * PW + PC_Q); }
}
__device__ __forceinline__ void hgrn_lb(const Frame& F, int h, float (&lb)[2]) {
    const int d0 = 2 * (F_TID & 63); const float* lg = KARG_IN(8);
#pragma unroll
    for (int j = 0; j < 2; ++j) { const float l0 = lg[h * 128 + d0 + j], l1 = lg[512 + h * 128 + d0 + j]; const float mx = fmaxf(l0, l1), e0 = __expf(l0 - mx), e1 = __expf(l1 - mx); lb[j] = e0 / (e0 + e1); }
}
template <bool NEEDQ> __device__ __forceinline__ void hgrn_load(const Frame& F, const Args& a, int h, const HgrnRaw& R, HgrnLocal& L, const float (&lb)[2]) {
    const int tid = F_TID, cp = tid & 63, seg = tid >> 6, d0 = 2 * cp;
    float run[2] = {0.f, 0.f};
#pragma unroll
    for (int i = 0; i < 8; ++i) {
        const unsigned fw = R.fw[i], iw = R.iw[i];
        const float fr[2] = {bflo(fw), bfhi(fw)};
        L.iv[i][0] = bflo(iw); L.iv[i][1] = bfhi(iw);
        if (NEEDQ) { const unsigned qw = R.qw[i]; L.qv[i][0] = siluf(bflo(qw)); L.qv[i][1] = siluf(bfhi(qw)); }
#pragma unroll
        for (int j = 0; j < 2; ++j) { const float fg = lb[j] + (1.0f - lb[j]) * sigmf(fr[j]); L.fg[i][j] = fg; run[j] += __logf(fg); L.cum[i][j] = run[j]; }
    }
    LAS float* segs = (LAS float*)(F.lds + HL_SEG);
    segs[seg * 128 + d0] = run[0]; segs[seg * 128 + d0 + 1] = run[1];
    __syncthreads();
    float pre[2] = {0.f, 0.f}, tot[2] = {0.f, 0.f}, mid[2] = {0.f, 0.f};
#pragma unroll
    for (int s2 = 0; s2 < 8; ++s2) {
#pragma unroll
        for (int j = 0; j < 2; ++j) { const float v = segs[s2 * 128 + d0 + j]; tot[j] += v; if (s2 < seg) pre[j] += v; if (s2 < 4) mid[j] += v; }
    }
#pragma unroll
    for (int i = 0; i < 8; ++i)
#pragma unroll
        for (int j = 0; j < 2; ++j) L.cum[i][j] += pre[j];
    L.tot[0] = tot[0]; L.tot[1] = tot[1]; L.mid[0] = mid[0]; L.mid[1] = mid[1];
}

__device__ __forceinline__ void hgrn_states_unit(const Frame& F, const Args& a, int c, int h, const HgrnRaw& R, const float (&lb)[2]) {
    const int tid = F_TID, lane = F_LANE, cp = tid & 63, seg = tid >> 6, d0 = 2 * cp;
    __syncthreads();
    HgrnLocal L; hgrn_load<false>(F, a, h, R, L, lb);
#pragma unroll
    for (int i = 0; i < 8; ++i) { const int t = seg * 8 + i;
        *(LAS unsigned*)(F.lds + HL_KD + t * 320 + d0 * 2) = cvt_pk_bf16((1.0f - L.fg[i][0]) * __expf(L.tot[0] - L.cum[i][0]), (1.0f - L.fg[i][1]) * __expf(L.tot[1] - L.cum[i][1]));
        *(LAS unsigned*)(F.lds + HL_V + t * 320 + d0 * 2) = cvt_pk_bf16(L.iv[i][0], L.iv[i][1]); }
    if (seg == 0) { float* hd = (float*)(F.ws + WS_HDECAY) + (size_t)(c * 4 + h) * 128 + d0; hd[0] = __expf(L.tot[0]); hd[1] = __expf(L.tot[1]); }
    __syncthreads();
    const int et = F.wave >> 1, dh = F.wave & 1;
    f32x16 acc[2];
#pragma unroll
    for (int dj = 0; dj < 2; ++dj)
#pragma unroll
        for (int r = 0; r < 16; ++r) acc[dj][r] = 0.f;
#pragma unroll
    for (int ks = 0; ks < 4; ++ks) {
        const bf16x8 A = frag_tr<false>(F.lds + HL_V, 320, 16 * ks, 32 * et, lane);
#pragma unroll
        for (int dj = 0; dj < 2; ++dj) { const bf16x8 B = frag_tr<false>(F.lds + HL_KD, 320, 16 * ks, 32 * (2 * dh + dj), lane); acc[dj] = MFMA32(A, B, acc[dj]); }
    }
    float* kv = (float*)(F.ws + WS_HKV) + ((size_t)(c * 4 + h) * 128 + 32 * et) * 128;
#pragma unroll
    for (int dj = 0; dj < 2; ++dj)
#pragma unroll
        for (int r = 0; r < 16; ++r) kv[(size_t)drow(r, lane) * 128 + 32 * (2 * dh + dj) + (lane & 31)] = acc[dj][r];
}

__device__ __forceinline__ void hgrn_out_unit(const Frame& F, const Args& a, int c, int h, const HgrnRaw& R, const float (&lb)[2]) {
    const int tid = F_TID, lane = F_LANE, cp = tid & 63, seg = tid >> 6, d0 = 2 * cp;
    const int tt = F.wave >> 2, et = F.wave & 3;
    bf16x8 Bs[8];
    { const bf16_t* sp = (const bf16_t*)(F.ws + WS_HSPREV) + ((size_t)(c * 4 + h) * 128 + 32 * et) * 128 + (size_t)(lane & 31) * 128 + 8 * (lane >> 5);
#pragma unroll
      for (int ks = 0; ks < 8; ++ks) Bs[ks] = *(const bf16x8*)(sp + 16 * ks); }
    const int e = 32 * et + (lane & 31);
    unsigned short gv[16];
    { const bf16_t* pg = (const bf16_t*)(F.ws + WS_P) + (size_t)(c * 64 + 32 * tt) * PW + PC_G + h * 128 + e;
#pragma unroll
      for (int r = 0; r < 16; ++r) gv[r] = pg[(size_t)drow(r, lane) * PW]; }
    const float nw = KARG_IN(9)[h * 128 + e];
    __syncthreads();
    HgrnLocal L; hgrn_load<true>(F, a, h, R, L, lb);
#pragma unroll
    for (int i = 0; i < 8; ++i) { const int t = seg * 8 + i;
        float qd[2], qp[2], kp[2];
#pragma unroll
        for (int j = 0; j < 2; ++j) { qd[j] = L.qv[i][j] * __expf(L.cum[i][j]); qp[j] = L.qv[i][j] * __expf(L.cum[i][j] - L.mid[j]); kp[j] = (1.0f - L.fg[i][j]) * __expf(L.mid[j] - L.cum[i][j]); }
        *(LAS unsigned*)(F.lds + HL_QD + t * 272 + d0 * 2) = cvt_pk_bf16(qd[0], qd[1]);
        *(LAS unsigned*)(F.lds + HL_QP + t * 272 + d0 * 2) = cvt_pk_bf16(qp[0], qp[1]);
        *(LAS unsigned*)(F.lds + HL_KP + t * 272 + d0 * 2) = cvt_pk_bf16(kp[0], kp[1]);
        *(LAS unsigned*)(F.lds + HL_V + t * 320 + d0 * 2) = cvt_pk_bf16(L.iv[i][0], L.iv[i][1]); }
    __syncthreads();
    f32x16 acc;
#pragma unroll
    for (int r = 0; r < 16; ++r) acc[r] = 0.f;
#pragma unroll
    for (int ks = 0; ks < 8; ++ks) { const bf16x8 A = frag_row(F.lds + HL_QD, 272, 32 * tt, 16 * ks, lane); acc = MFMA32(A, Bs[ks], acc); }
    const int tcol = 32 * tt + (lane & 31);
#pragma unroll
    for (int st = 0; st < 2; ++st) {
        if (st <= tt) {
            f32x16 X;
#pragma unroll
            for (int r = 0; r < 16; ++r) X[r] = 0.f;
#pragma unroll 2
            for (int ks = 0; ks < 8; ++ks) { const bf16x8 A = frag_row(F.lds + HL_KP, 272, 32 * st, 16 * ks, lane), B = frag_row(F.lds + HL_QP, 272, 32 * tt, 16 * ks, lane); X = MFMA32(A, B, X); }
#pragma unroll
            for (int r = 0; r < 16; ++r) X[r] = (32 * st + drow(r, lane) <= tcol) ? X[r] : 0.f;
#pragma unroll
            for (int s2 = 0; s2 < 2; ++s2) { const bf16x8 A = acc_frag(X, s2), B = frag_tr<true>(F.lds + HL_V, 320, 32 * st + 16 * s2, 32 * et, lane); acc = MFMA32(A, B, acc); }
        }
    }
    LAS float* ssqs = (LAS float*)(F.lds + HL_SSQ);
    { float sm[16];
#pragma unroll
      for (int r = 0; r < 16; ++r) sm[r] = half_sum(acc[r] * acc[r]);
      if ((lane & 31) == 0) {
#pragma unroll
          for (int r = 0; r < 16; ++r) ssqs[F.wave * 32 + drow(r, lane)] = sm[r]; } }
    __syncthreads();
#pragma unroll
    for (int r = 0; r < 16; ++r) { const int row = drow(r, lane);
        const float ss = ssqs[(tt * 4 + 0) * 32 + row] + ssqs[(tt * 4 + 1) * 32 + row] + ssqs[(tt * 4 + 2) * 32 + row] + ssqs[(tt * 4 + 3) * 32 + row];
        const float rs = rsqrtf(ss * (1.0f / 128.0f) + RMS_EPS_F);
        *(LAS unsigned short*)(F.lds + HL_QD + (32 * tt + row) * 272 + e * 2) = f2bf1(acc[r] * rs * nw * siluf(bf2f(gv[r]))); }
    __syncthreads();
    { bf16_t* mo = (bf16_t*)(F.ws + WS_MIX) + (size_t)(c * 64) * DM + 512 + h * 128;
#pragma unroll
      for (int i = 0; i < 2; ++i) { const int pc = tid + 512 * i, row = pc >> 4, ch = (pc & 15) * 8;
          *(u32x4*)(mo + (size_t)row * DM + ch) = *(const LAS u32x4*)(F.lds + HL_QD + row * 272 + ch * 2); } }
}

__device__ __forceinline__ void phase_mix_states(const Frame& F, const Args& a, const int mode) {
    HgrnRaw Ra, Rb; int u = blockIdx.x; float lb[2]; int hcur = -1;
    if (!(mode & 2) && u < 1024) hgrn_fetch<false>(F, u >> 2, u & 3, Ra);
    if (!(mode & 1)) for (int us = blockIdx.x; us < 256; us += F.G) ssd_states_unit(F, a, us >> 1, us & 1);
    if (!(mode & 2)) {
        while (u < 1024) {
            int un = u + F.G; if (un < 1024) hgrn_fetch<false>(F, un >> 2, un & 3, Rb);
            if ((u & 3) != hcur) { hcur = u & 3; hgrn_lb(F, hcur, lb); }
            hgrn_states_unit(F, a, u >> 2, u & 3, Ra, lb); u = un; if (u >= 1024) break;
            un = u + F.G; if (un < 1024) hgrn_fetch<false>(F, un >> 2, un & 3, Ra);
            if ((u & 3) != hcur) { hcur = u & 3; hgrn_lb(F, hcur, lb); }
            hgrn_states_unit(F, a, u >> 2, u & 3, Rb, lb); u = un;
        }
    }
}
__device__ __forceinline__ void phase_mix_out(const Frame& F, const Args& a, const int mode) {
    HgrnRaw Ra, Rb; int u = blockIdx.x; float lb[2]; int hcur = -1;
    if (!(mode & 2) && u < 1024) hgrn_fetch<true>(F, u >> 2, u & 3, Ra);
    if (!(mode & 1)) for (int rep = 0; rep < ((mode & 64) ? 2 : 1); ++rep) for (int us = blockIdx.x; us < 256; us += F.G) ssd_out_unit(F, a, us >> 1, us & 1, mode);
    if (!(mode & 2)) {
        while (u < 1024) {
            int un = u + F.G; if (un < 1024) hgrn_fetch<true>(F, un >> 2, un & 3, Rb);
            if ((u & 3) != hcur) { hcur = u & 3; hgrn_lb(F, hcur, lb); }
            hgrn_out_unit(F, a, u >> 2, u & 3, Ra, lb); u = un; if (u >= 1024) break;
            un = u + F.G; if (un < 1024) hgrn_fetch<true>(F, un >> 2, un & 3, Ra);
            if ((u & 3) != hcur) { hcur = u & 3; hgrn_lb(F, hcur, lb); }
            hgrn_out_unit(F, a, u >> 2, u & 3, Rb, lb); u = un;
        }
    }
}
template <int NCH> __device__ __forceinline__ void scan_chain(const float* st, const float* dec, const int dstride, bf16_t* sp) {
    constexpr int B = 32;
    float v[B], d[B], nv[B], nd[B]; float S = 0.f;
#pragma unroll
    for (int i = 0; i < B; ++i) { v[i] = st[(size_t)i * 65536]; d[i] = dec[(size_t)i * dstride]; }
#pragma unroll 1
    for (int c0 = 0; c0 < NCH; c0 += B) {
        const int cn = c0 + B < NCH ? c0 + B : c0;
#pragma unroll
        for (int i = 0; i < B; ++i) { nv[i] = st[(size_t)(cn + i) * 65536]; nd[i] = dec[(size_t)(cn + i) * dstride]; }
#pragma unroll
        for (int i = 0; i < B; ++i) { sp[(size_t)(c0 + i) * 65536] = f2bf1(S); S = fmaf(S, d[i], v[i]); }
#pragma unroll
        for (int i = 0; i < B; ++i) { v[i] = nv[i]; d[i] = nd[i]; }
    }
}
__device__ __forceinline__ void phase_mix_scan(const Frame& F, const Args& a) {
    const int gt = blockIdx.x * 512 + F_TID;
    if (blockIdx.x < 128 || F.G < 256) {
        for (int idx = gt; idx < 65536; idx += (F.G < 256 ? F.G : 128) * 512) {
            const int hh = idx >> 13;
            scan_chain<128>((const float*)(F.ws + WS_SSTATE) + idx, (const float*)(F.ws + WS_CDECAY) + hh, 8, (bf16_t*)(F.ws + WS_SPREV) + idx);
        }
    }
    if (blockIdx.x >= 128 || F.G < 256) {
        const int gt2 = F.G < 256 ? gt : gt - 128 * 512;
        for (int idx = gt2; idx < 65536; idx += (F.G < 256 ? F.G : 128) * 512) {
            const int h = idx >> 14, d = idx & 127;
            scan_chain<256>((const float*)(F.ws + WS_HKV) + idx, (const float*)(F.ws + WS_HDECAY) + h * 128 + d, 512, (bf16_t*)(F.ws + WS_HSPREV) + idx);
        }
    }
}

__global__ void __launch_bounds__(512, 2) mk_fwd(Args args) {
    extern __shared__ __attribute__((aligned(16))) unsigned char lds_raw[];
    Frame F;
    F.lds = (LAS unsigned char*)lds_raw;
    F.wave = __builtin_amdgcn_readfirstlane(threadIdx.x >> 6);
    F.G = gridDim.x; { const int bx = blockIdx.x; F.vcu = (F.G % 8 == 0) ? (bx % 8) * (F.G / 8) + bx / 8 : bx; }
    F.ws = args.ws; F.ctl = (unsigned*)(args.ws + WS_CTL);
    volatile LAS unsigned* MISC = (volatile LAS unsigned*)(F.lds + LDS_MISC);
    if (F_TID < 64) MISC[F_TID] = 0u;
    __syncthreads();
    const bool use_bar = (args.ph_hi - args.ph_lo) > 1;
    XcdBarrier bar; bar.bar = F.ctl + CW_BAR + args.li * XCD_BAR_WORDS; bar.x = 0; bar.st = MISC + 8; bar.wave = F.wave;
    if (use_bar) bar = xcd_barrier_post(F.ctl + CW_BAR + args.li * XCD_BAR_WORDS, MISC + 8, F.wave);
#define PH(k) (args.ph_lo <= (k) && (k) < args.ph_hi)
#define SEAM(k) do { if (use_bar && (k) + 1 < args.ph_hi && (k) >= args.ph_lo) xcd_barrier(bar); } while (0)
    unsigned char* ws = F.ws;
    if (PH(0)) phase_prep(F, args);
    SEAM(0);
    if (PH(1)) {
        pg8::DenseSched S; S.init(ws + WS_XB, ws + WS_WIN_T, T_TOK, 3072, 1024, F.G, blockIdx.x);
        pg8::EpiP E; E.O = (bf16_t*)(ws + WS_P); E.ldc = PW;
        pg8::gemm_phase<pg8::EpiP, pg8::DenseSched, true>(F.lds, 1024, S, E, F.wave);
    }
    SEAM(1);
#if defined(MK_NAIVE_MIX)
    if (PH(2)) phase_m1(F, args);
    SEAM(2);
    if (PH(3)) phase_m2(F, args);
    SEAM(3);
    if (PH(4)) phase_m3(F, args);
#else
    if (PH(2)) phase_mix_states(F, args, args.mode);
    SEAM(2);
    if (PH(3)) {
        phase_mix_scan(F, args);
        if (blockIdx.x < 128 && F.G >= 256) {
            __syncthreads();
            pg8::DenseSched S; S.init(ws + WS_XB, ws + WS_WIN_T + (size_t)3072 * 1024 * 2, T_TOK, 512, 1024, 128, blockIdx.x);
            pg8::EpiP E; E.O = (bf16_t*)(ws + WS_P) + 3072; E.ldc = PW;
            pg8::gemm_phase<pg8::EpiP, pg8::DenseSched, true>(F.lds, 1024, S, E, F.wave);
        } else if (F.G < 256) {
            __syncthreads();
            pg8::DenseSched S; S.init(ws + WS_XB, ws + WS_WIN_T + (size_t)3072 * 1024 * 2, T_TOK, 512, 1024, F.G, blockIdx.x);
            pg8::EpiP E; E.O = (bf16_t*)(ws + WS_P) + 3072; E.ldc = PW;
            pg8::gemm_phase<pg8::EpiP, pg8::DenseSched, true>(F.lds, 1024, S, E, F.wave);
        }
    }
    SEAM(3);
    if (PH(4)) phase_mix_out(F, args, args.mode);
#endif
    SEAM(4);
    if (PH(5)) {
        pg8::DenseSched S; S.init(ws + WS_MIX, ws + WS_WOUT_T, T_TOK, 1024, 1024, F.G, blockIdx.x);
        pg8::EpiU E; E.U = (float*)(ws + WS_H1); E.X = KARG_IN(0);
        pg8::gemm_phase<pg8::EpiU, pg8::DenseSched, false>(F.lds, 1024, S, E, F.wave);
    }
    SEAM(5);
    if (PH(6)) phase_ln1(F, args);
    SEAM(6);
    if (PH(7)) {
        pg8::DenseSched S; S.init(ws + WS_H1B, ws + WS_W3_T, T_TOK, 768, 1024, F.G, blockIdx.x);
        pg8::Epi3 E; E.LG = (float*)(ws + WS_LOGITS); E.HS = (bf16_t*)(ws + WS_HS);
        pg8::gemm_phase<pg8::Epi3, pg8::DenseSched, false>(F.lds, 1024, S, E, F.wave);
    }
    SEAM(7);
    if (PH(8)) {
        if (!(args.mode & 32)) phase_route(F, args);
        if (!(args.mode & 64)) {
        pg8::DenseSched S; S.init(ws + WS_HS, ws + WS_WDS_T, T_TOK, 1024, 256, F.G, blockIdx.x);
        pg8::EpiP E; E.O = (bf16_t*)(ws + WS_YS); E.ldc = 1024;
        pg8::gemm_phase<pg8::EpiP, pg8::DenseSched, false>(F.lds, 256, S, E, F.wave); }
    }
    SEAM(8);
#if defined(MK_OLD_EXPERTS)
    if (PH(9)) {
        build_tables(F);
        pg8::ExpertSched<true> S; S.lds = F.lds;
        S.lists = (const int*)(ws + WS_LISTS); S.A = (const char*)(ws + WS_H1B); S.W = (const char*)(ws + WS_WGU_T);
        S.U = 2 * __builtin_amdgcn_readfirstlane(((const LAS int*)(F.lds + LDS_PREF))[NEXP]); S.G = F.G; S.c = blockIdx.x;
        pg8::EpiH E; E.H = (bf16_t*)(ws + WS_H);
        pg8::gemm_phase<pg8::EpiH, pg8::ExpertSched<true>, true>(F.lds, 1024, S, E, F.wave);
    }
    SEAM(9);
    if (PH(10)) {
        build_tables(F);
        pg8::ExpertSched<false> S; S.lds = F.lds;
        S.lists = (const int*)(ws + WS_LISTS); S.A = (const char*)(ws + WS_H); S.W = (const char*)(ws + WS_WD_T);
        S.U = 4 * __builtin_amdgcn_readfirstlane(((const LAS int*)(F.lds + LDS_PREF))[NEXP]); S.G = F.G; S.c = blockIdx.x;
        pg8::EpiYb E; E.YB = (bf16_t*)(ws + WS_YB); E.lists = (const int*)(ws + WS_LISTS); E.tok_gate = (const float*)(ws + WS_TOKGATE);
        pg8::gemm_phase<pg8::EpiYb, pg8::ExpertSched<false>, true>(F.lds, 256, S, E, F.wave);
    }
    SEAM(10);
#else
    if (PH(9)) phase_experts(F, args, args.mode);
    SEAM(9);
#endif
    if (PH(11)) { build_tables(F); phase_final(F, args); }
}

extern "C" void kernel_launch(void* const* d_in, const int* in_sizes, int n_in, void* d_out, int out_size, void* d_ws, size_t ws_size, hipStream_t stream) {
    static int grid = 0;
    if (grid == 0) {
        int dev = 0, cus = 0;
        if (hipGetDevice(&dev) != hipSuccess || hipDeviceGetAttribute(&cus, hipDeviceAttributeMultiprocessorCount, dev) != hipSuccess) { fprintf(stderr, "device query failed\n"); grid = -1; return; }
        if (hipFuncSetAttribute((const void*)mk_fwd, hipFuncAttributeMaxDynamicSharedMemorySize, LDS_BYTES) != hipSuccess) { fprintf(stderr, "hipFuncSetAttribute failed\n"); grid = -1; return; }
        if (ws_size < WS_END) { fprintf(stderr, "workspace too small: %zu < %zu\n", ws_size, (size_t)WS_END); grid = -1; return; }
        (void)hipGetLastError();
        grid = cus;
    }
    if (grid < 0) return;
    unsigned char* ws = (unsigned char*)d_ws;
    (void)hipMemsetAsync(ws + WS_CTL, 0, CTL_ZERO_BYTES, stream);
    Args a{};
    for (int i = 0; i < 23; ++i) a.in[i] = (const float*)d_in[i];
    a.out = (float*)d_out; a.ws = ws;
    auto launch = [&](int lo, int hi) { a.ph_lo = lo; a.ph_hi = hi; hipLaunchKernelGGL(mk_fwd, dim3(grid), dim3(512), LDS_BYTES, stream, a); };
#if defined(MK_PER_PHASE)
    for (int ph = 0; ph < NPH; ++ph) launch(ph, ph + 1);
#else
    launch(0, NPH);
#endif
}
```
